# Optimizing an MI355X kernel written in HIP

```python
import math
import jax
import jax.numpy as jnp
from jax import lax
import numpy as np

D_MODEL = 1024
BATCH = 32
SEQ = 2048
DEPTH = 4

GRID_W = 64
CTX_LEN = 256
N_MIXERS = 4
EPS = 1e-6
ROPE_THETA = 10000.0
Q_BLOCK = 128
NEG_INF = -1e30

MLA_HEADS = 16
MLA_NOPE = 64
MLA_ROPE = 32
MLA_QK = MLA_NOPE + MLA_ROPE
MLA_V = 64
MLA_Q_LORA = 384
MLA_KV_LORA = 256

S5_GROUP = 16
S5_GROUPS = D_MODEL // S5_GROUP
S5_STATE = 64
S5_DT_MIN = 1e-3
S5_DT_MAX = 1e-1

NA_HEADS = 16
NA_HEAD_DIM = D_MODEL // NA_HEADS
NA_WIN_H = 8
NA_WIN_W = 16

GQA_HEADS = 8
GQA_KV_HEADS = 2
GQA_HEAD_DIM = D_MODEL // GQA_HEADS

FFN_HIDDEN = -(-(8 * D_MODEL) // (3 * 256)) * 256

kernel_name = 'hybrid_interleaved_mla_s5_natten_gqa_dit'


def rmsnorm(x, g):
    xf = x.astype(jnp.float32)
    y = xf * lax.rsqrt(jnp.mean(xf * xf, axis=-1, keepdims=True) + EPS)
    return (y * g.astype(jnp.float32)).astype(x.dtype)


def modulate(x, g, shift, scale):
    return rmsnorm(x, g) * (1 + scale) + shift


def ada_terms(cvec, w, b):
    m = jax.nn.silu(cvec) @ w + b
    return jnp.split(m[..., None, :], 6, axis=-1)


def swiglu(h, w_in, w_out):
    a, b = jnp.split(h @ w_in, 2, axis=-1)
    return (jax.nn.silu(a) * b) @ w_out


def axial_rope_tables(n_tokens, rot_dim):
    t = jnp.arange(n_tokens, dtype=jnp.int32)
    axis_dim = rot_dim // 2
    inv_freq = ROPE_THETA ** (-jnp.arange(0, axis_dim, 2, dtype=jnp.float32) / axis_dim)

    def table(pos):
        ang = pos.astype(jnp.float32)[:, None] * inv_freq[None, :]
        return jnp.cos(ang), jnp.sin(ang)

    return table(t // GRID_W), table(t % GRID_W)


def rotate_pairs(x, cos, sin):
    d2 = x.shape[-1] // 2
    x1, x2 = x[..., :d2], x[..., d2:]
    c, s = cos[:, None, :], sin[:, None, :]
    return jnp.concatenate([x1 * c - x2 * s, x1 * s + x2 * c], axis=-1).astype(x.dtype)


def apply_axial_rope(x, tables):
    (cos_r, sin_r), (cos_c, sin_c) = tables
    half = x.shape[-1] // 2
    return jnp.concatenate([rotate_pairs(x[..., :half], cos_r, sin_r),
                            rotate_pairs(x[..., half:], cos_c, sin_c)], axis=-1)


def ctx_attention(q, k, v):
    B, C, H, dk = q.shape
    Hk = k.shape[2]
    qg = q.reshape(B, C, Hk, H // Hk, dk)
    s = jnp.einsum('bqkgd,bnkd->bkgqn', qg, k).astype(jnp.float32) * (dk ** -0.5)
    p = jax.nn.softmax(s, axis=-1).astype(v.dtype)
    o = jnp.einsum('bkgqn,bnkd->bqkgd', p, v)
    return o.reshape(B, C, H, v.shape[-1])


def latent_attention(q, kc, vc, kl, vl):
    B, S, H, dk = q.shape
    Hk = kl.shape[2]
    G = H // Hk
    dv = vl.shape[-1]
    k = jnp.concatenate([kc, kl], axis=1)
    v = jnp.concatenate([vc, vl], axis=1)
    nb = S // Q_BLOCK
    qb = q.reshape(B, nb, Q_BLOCK, Hk, G, dk).transpose(1, 0, 2, 3, 4, 5)
    scale = dk ** -0.5

    def one_block(qi):
        s = jnp.einsum('bqkgd,bnkd->bkgqn', qi, k).astype(jnp.float32) * scale
        p = jax.nn.softmax(s, axis=-1).astype(v.dtype)
        return jnp.einsum('bkgqn,bnkd->bqkgd', p, v)

    o = lax.map(one_block, qb)
    return o.transpose(1, 0, 2, 3, 4, 5).reshape(B, S, H, dv)


def qk_normed_qkv(h, w_qkv, n_q, n_kv, dh, g_qn, g_kn, tables, need_q):
    B, L, _ = h.shape
    q_cols = n_q * dh
    if need_q:
        z = h @ w_qkv
        q = rmsnorm(z[..., :q_cols].reshape(B, L, n_q, dh), g_qn)
        kv = z[..., q_cols:]
    else:
        q = None
        kv = h @ w_qkv[:, q_cols:]
    k = rmsnorm(kv[..., :n_kv * dh].reshape(B, L, n_kv, dh), g_kn)
    v = kv[..., n_kv * dh:].reshape(B, L, n_kv, dh)
    if tables is not None:
        k = apply_axial_rope(k, tables)
        if need_q:
            q = apply_axial_rope(q, tables)
    return q, k, v


def mla_queries(h, w_in, g_q, w_uq, g_qn, tables):
    B, L, _ = h.shape
    cq = rmsnorm(h @ w_in[:, :MLA_Q_LORA], g_q)
    q = rmsnorm((cq @ w_uq).reshape(B, L, MLA_HEADS, MLA_QK), g_qn)
    if tables is not None:
        q = jnp.concatenate([q[..., :MLA_NOPE], apply_axial_rope(q[..., MLA_NOPE:], tables)], axis=-1)
    return q


def mla_keys_values(h, w_in, g_kv, w_ukv, g_kn, tables):
    B, L, _ = h.shape
    z = h @ w_in[:, MLA_Q_LORA:]
    ckv = rmsnorm(z[..., :MLA_KV_LORA], g_kv)
    k_rope = jnp.broadcast_to(z[..., None, MLA_KV_LORA:], (B, L, MLA_HEADS, MLA_ROPE))
    kv = (ckv @ w_ukv).reshape(B, L, MLA_HEADS, MLA_NOPE + MLA_V)
    k = rmsnorm(jnp.concatenate([kv[..., :MLA_NOPE], k_rope], axis=-1), g_kn)
    if tables is not None:
        k = jnp.concatenate([k[..., :MLA_NOPE], apply_axial_rope(k[..., MLA_NOPE:], tables)], axis=-1)
    return k, kv[..., MLA_NOPE:]


def mla_mixer(hc, hl, w_in, g_q, g_kv, w_uq, w_ukv, g_qn, g_kn, w_o, tables, ctx_out):
    B, S, _ = hl.shape
    kc, vc = mla_keys_values(hc, w_in, g_kv, w_ukv, g_kn, None)
    kl, vl = mla_keys_values(hl, w_in, g_kv, w_ukv, g_kn, tables)
    ql = mla_queries(hl, w_in, g_q, w_uq, g_qn, tables)
    yl = latent_attention(ql, kc, vc, kl, vl).reshape(B, S, MLA_HEADS * MLA_V) @ w_o
    yc = None
    if ctx_out:
        qc = mla_queries(hc, w_in, g_q, w_uq, g_qn, None)
        yc = ctx_attention(qc, kc, vc).reshape(B, hc.shape[1], MLA_HEADS * MLA_V) @ w_o
    return yc, yl


def s5_discretise(a_re, a_im, log_dt, b_re, b_im):
    f32 = jnp.float32
    a_re, a_im = a_re.astype(f32), a_im.astype(f32)
    b_re, b_im = b_re.astype(f32), b_im.astype(f32)
    dt = jnp.exp(log_dt.astype(f32))[:, None]
    mag = jnp.exp(dt * a_re)
    ab_re = mag * jnp.cos(dt * a_im)
    ab_im = mag * jnp.sin(dt * a_im)
    den = a_re * a_re + a_im * a_im
    nr = ab_re - 1.0
    f_re = (nr * a_re + ab_im * a_im) / den
    f_im = (ab_im * a_re - nr * a_im) / den
    bb_re = f_re[..., None] * b_re - f_im[..., None] * b_im
    bb_im = f_re[..., None] * b_im + f_im[..., None] * b_re
    return ab_re, ab_im, bb_re, bb_im


def complex_affine_combine(e1, e2):
    a1r, a1i, b1r, b1i = e1
    a2r, a2i, b2r, b2i = e2
    return (a2r * a1r - a2i * a1i, a2r * a1i + a2i * a1r,
            a2r * b1r - a2i * b1i + b2r, a2r * b1i + a2i * b1r + b2i)


def s5_scan(ab_re, ab_im, bu_re, bu_im, reverse):
    L = bu_re.shape[1]
    a_re = jnp.broadcast_to(ab_re, (1, L) + ab_re.shape)
    a_im = jnp.broadcast_to(ab_im, (1, L) + ab_im.shape)
    _, _, h_re, h_im = lax.associative_scan(complex_affine_combine, (a_re, a_im, bu_re, bu_im),
                                            reverse=reverse, axis=1)
    return h_re, h_im


def s5_drive(u, bb_re, bb_im):
    return (jnp.einsum('blgc,gpc->blgp', u, bb_re), jnp.einsum('blgc,gpc->blgp', u, bb_im))


def s5_readout(h_re, h_im, c_re, c_im):
    return jnp.einsum('blgp,gcp->blgc', h_re, c_re) - jnp.einsum('blgp,gcp->blgc', h_im, c_im)


def s5_glu(y, w_glu):
    g = jax.nn.gelu(y)
    a, b = jnp.split(g @ w_glu, 2, axis=-1)
    return a * jax.nn.sigmoid(b)


def s5_mixer(hc, hl, a_re, a_im, log_dt, b_re, b_im, c_re, c_im, d_skip, w_glu, ctx_out):
    f32 = jnp.float32
    B, S, D = hl.shape
    C = hc.shape[1]
    uc = hc.astype(f32).reshape(B, C, S5_GROUPS, S5_GROUP)
    ul = hl.astype(f32).reshape(B, S, S5_GROUPS, S5_GROUP)
    yl = d_skip.astype(f32) * hl.astype(f32)
    yc = d_skip.astype(f32) * hc.astype(f32) if ctx_out else None
    for direction in range(2):
        reverse = direction == 1
        ab_re, ab_im, bb_re, bb_im = s5_discretise(a_re[direction], a_im[direction], log_dt[direction],
                                                   b_re[direction], b_im[direction])
        cr, ci = c_re[direction].astype(f32), c_im[direction].astype(f32)
        bc_re, bc_im = s5_drive(uc, bb_re, bb_im)
        sc_re, sc_im = s5_scan(ab_re, ab_im, bc_re, bc_im, reverse)
        edge_c = 0 if reverse else C - 1
        h0_re, h0_im = sc_re[:, edge_c], sc_im[:, edge_c]
        bl_re, bl_im = s5_drive(ul, bb_re, bb_im)
        edge_l = S - 1 if reverse else 0
        bl_re = bl_re.at[:, edge_l].add(ab_re * h0_re - ab_im * h0_im)
        bl_im = bl_im.at[:, edge_l].add(ab_re * h0_im + ab_im * h0_re)
        sl_re, sl_im = s5_scan(ab_re, ab_im, bl_re, bl_im, reverse)
        yl = yl + s5_readout(sl_re, sl_im, cr, ci).reshape(B, S, D)
        if ctx_out:
            yc = yc + s5_readout(sc_re, sc_im, cr, ci).reshape(B, C, D)
    out_l = s5_glu(yl.astype(hl.dtype), w_glu)
    out_c = s5_glu(yc.astype(hc.dtype), w_glu) if ctx_out else None
    return out_c, out_l


def na_mixer(hc, hl, w_qkv, g_qn, g_kn, rpb, w_o, ctx_out):
    B, S, _ = hl.shape
    rows = S // GRID_W
    kh = min(NA_WIN_H, rows)
    qc, kc, vc = qk_normed_qkv(hc, w_qkv, NA_HEADS, NA_HEADS, NA_HEAD_DIM, g_qn, g_kn, None, ctx_out)
    ql, kl, vl = qk_normed_qkv(hl, w_qkv, NA_HEADS, NA_HEADS, NA_HEAD_DIM, g_qn, g_kn, None, True)
    grid = (B, rows, GRID_W, NA_HEADS, NA_HEAD_DIM)
    q_grid, k_grid, v_grid = ql.reshape(grid), kl.reshape(grid), vl.reshape(grid)
    j = jnp.arange(GRID_W)
    col_start = jnp.clip(j - NA_WIN_W // 2, 0, GRID_W - NA_WIN_W)
    col_ok = (j[None, :] >= col_start[:, None]) & (j[None, :] < col_start[:, None] + NA_WIN_W)
    col_idx = jnp.clip(j[None, :] - j[:, None] + NA_WIN_W - 1, 0, 2 * NA_WIN_W - 2)
    key_ok = jnp.broadcast_to(col_ok[:, None, :], (GRID_W, kh, GRID_W)).reshape(GRID_W, kh * GRID_W)
    scale = NA_HEAD_DIM ** -0.5
    n_ctx = kc.shape[1]

    def one_row(i):
        r0 = jnp.clip(i - kh // 2, 0, rows - kh)
        kb = lax.dynamic_slice_in_dim(k_grid, r0, kh, axis=1).reshape(B, kh * GRID_W, NA_HEADS, NA_HEAD_DIM)
        vb = lax.dynamic_slice_in_dim(v_grid, r0, kh, axis=1).reshape(B, kh * GRID_W, NA_HEADS, NA_HEAD_DIM)
        qi = lax.dynamic_index_in_dim(q_grid, i, axis=1, keepdims=False)
        row_idx = r0 + jnp.arange(kh) - i + NA_WIN_H - 1
        bias = rpb[:, row_idx][:, :, col_idx]
        bias = bias.transpose(0, 2, 1, 3).reshape(NA_HEADS, GRID_W, kh * GRID_W).astype(jnp.float32)
        s_lat = jnp.einsum('bqhd,bkhd->bhqk', qi, kb).astype(jnp.float32) * scale + bias
        s_lat = jnp.where(key_ok, s_lat, NEG_INF)
        s_ctx = jnp.einsum('bqhd,bkhd->bhqk', qi, kc).astype(jnp.float32) * scale
        p = jax.nn.softmax(jnp.concatenate([s_ctx, s_lat], axis=-1), axis=-1).astype(vb.dtype)
        return (jnp.einsum('bhqk,bkhd->bqhd', p[..., :n_ctx], vc)
                + jnp.einsum('bhqk,bkhd->bqhd', p[..., n_ctx:], vb))

    o = lax.map(one_row, jnp.arange(rows))
    yl = o.transpose(1, 0, 2, 3, 4).reshape(B, S, NA_HEADS * NA_HEAD_DIM) @ w_o
    yc = None
    if ctx_out:
        yc = ctx_attention(qc, kc, vc).reshape(B, n_ctx, NA_HEADS * NA_HEAD_DIM) @ w_o
    return yc, yl


def gqa_mixer(hc, hl, w_qkv, g_qn, g_kn, w_o, tables, ctx_out):
    B, S, _ = hl.shape
    qc, kc, vc = qk_normed_qkv(hc, w_qkv, GQA_HEADS, GQA_KV_HEADS, GQA_HEAD_DIM, g_qn, g_kn, None, ctx_out)
    ql, kl, vl = qk_normed_qkv(hl, w_qkv, GQA_HEADS, GQA_KV_HEADS, GQA_HEAD_DIM, g_qn, g_kn, tables, True)
    yl = latent_attention(ql, kc, vc, kl, vl).reshape(B, S, GQA_HEADS * GQA_HEAD_DIM) @ w_o
    yc = None
    if ctx_out:
        yc = ctx_attention(qc, kc, vc).reshape(B, hc.shape[1], GQA_HEADS * GQA_HEAD_DIM) @ w_o
    return yc, yl


def setup_inputs(seed: int = 0) -> dict:
    key = jax.random.key(seed)
    keys = jax.random.split(key, 64)
    counter = iter(range(64))
    f32 = jnp.float32
    D = D_MODEL
    G, P, CG = S5_GROUPS, S5_STATE, S5_GROUP
    nA, nB, nC, nD = (len(range(k, DEPTH, N_MIXERS)) for k in range(N_MIXERS))

    def nrm(shape, scale):
        return scale * jax.random.normal(keys[next(counter)], shape, f32)

    def gain(shape):
        return 1.0 + nrm(shape, 0.05)

    n_idx = jnp.arange(S5_STATE, dtype=f32)
    return {
        'x': nrm((BATCH, SEQ, D), 1.0),
        'c': nrm((BATCH, D), 1.0),
        'ctx': nrm((BATCH, CTX_LEN, D), 1.0),
        'c_ctx': nrm((D,), 1.0),
        'ada_w': nrm((DEPTH, D, 6 * D), 0.5 * D ** -0.5),
        'ada_b': nrm((DEPTH, 6 * D), 0.02),
        'norm_mix': gain((DEPTH, D)),
        'norm_ffn': gain((DEPTH, D)),
        'ffn_w_in': nrm((DEPTH, D, 2 * FFN_HIDDEN), D ** -0.5),
        'ffn_w_out': nrm((DEPTH, FFN_HIDDEN, D), FFN_HIDDEN ** -0.5),
        'mla_w_in': nrm((nA, D, MLA_Q_LORA + MLA_KV_LORA + MLA_ROPE), D ** -0.5),
        'mla_g_q': gain((nA, MLA_Q_LORA)),
        'mla_g_kv': gain((nA, MLA_KV_LORA)),
        'mla_w_uq': nrm((nA, MLA_Q_LORA, MLA_HEADS * MLA_QK), MLA_Q_LORA ** -0.5),
        'mla_w_ukv': nrm((nA, MLA_KV_LORA, MLA_HEADS * (MLA_NOPE + MLA_V)), MLA_KV_LORA ** -0.5),
        'mla_g_qn': gain((nA, MLA_QK)),
        'mla_g_kn': gain((nA, MLA_QK)),
        'mla_w_o': nrm((nA, MLA_HEADS * MLA_V, D), (MLA_HEADS * MLA_V) ** -0.5),
        's5_a_re': -0.5 + nrm((nB, 2, G, P), 0.01),
        's5_a_im': jnp.pi * n_idx + nrm((nB, 2, G, P), 0.01),
        's5_log_dt': jax.random.uniform(keys[next(counter)], (nB, 2, G), f32,
                                        math.log(S5_DT_MIN), math.log(S5_DT_MAX)),
        's5_b_re': nrm((nB, 2, G, P, CG), (2 * CG) ** -0.5),
        's5_b_im': nrm((nB, 2, G, P, CG), (2 * CG) ** -0.5),
        's5_c_re': nrm((nB, 2, G, CG, P), P ** -0.5),
        's5_c_im': nrm((nB, 2, G, CG, P), P ** -0.5),
        's5_d': nrm((nB, D), 0.5),
        's5_w_glu': nrm((nB, D, 2 * D), D ** -0.5),
        'na_w_qkv': nrm((nC, D, 3 * NA_HEADS * NA_HEAD_DIM), D ** -0.5),
        'na_g_qn': gain((nC, NA_HEAD_DIM)),
        'na_g_kn': gain((nC, NA_HEAD_DIM)),
        'na_rpb': nrm((nC, NA_HEADS, 2 * NA_WIN_H - 1, 2 * NA_WIN_W - 1), 0.1),
        'na_w_o': nrm((nC, NA_HEADS * NA_HEAD_DIM, D), (NA_HEADS * NA_HEAD_DIM) ** -0.5),
        'gqa_w_qkv': nrm((nD, D, (GQA_HEADS + 2 * GQA_KV_HEADS) * GQA_HEAD_DIM), D ** -0.5),
        'gqa_g_qn': gain((nD, GQA_HEAD_DIM)),
        'gqa_g_kn': gain((nD, GQA_HEAD_DIM)),
        'gqa_w_o': nrm((nD, GQA_HEADS * GQA_HEAD_DIM, D), (GQA_HEADS * GQA_HEAD_DIM) ** -0.5),
    }


def reference(x, c, ctx, c_ctx, ada_w, ada_b, norm_mix, norm_ffn, ffn_w_in, ffn_w_out,
              mla_w_in, mla_g_q, mla_g_kv, mla_w_uq, mla_w_ukv, mla_g_qn, mla_g_kn, mla_w_o,
              s5_a_re, s5_a_im, s5_log_dt, s5_b_re, s5_b_im, s5_c_re, s5_c_im, s5_d, s5_w_glu,
              na_w_qkv, na_g_qn, na_g_kn, na_rpb, na_w_o,
              gqa_w_qkv, gqa_g_qn, gqa_g_kn, gqa_w_o):
    S = x.shape[1]
    mla_tables = axial_rope_tables(S, MLA_ROPE)
    gqa_tables = axial_rope_tables(S, GQA_HEAD_DIM)
    xl, xc = x, ctx
    for i in range(DEPTH):
        kind, j = i % N_MIXERS, i // N_MIXERS
        ctx_out = i < DEPTH - 1
        sh_l, sc_l, gt_l, sh2_l, sc2_l, gt2_l = ada_terms(c, ada_w[i], ada_b[i])
        sh_c, sc_c, gt_c, sh2_c, sc2_c, gt2_c = ada_terms(c_ctx, ada_w[i], ada_b[i])
        hl = modulate(xl, norm_mix[i], sh_l, sc_l)
        hc = modulate(xc, norm_mix[i], sh_c, sc_c)
        if kind == 0:
            yc, yl = mla_mixer(hc, hl, mla_w_in[j], mla_g_q[j], mla_g_kv[j], mla_w_uq[j], mla_w_ukv[j],
                               mla_g_qn[j], mla_g_kn[j], mla_w_o[j], mla_tables, ctx_out)
        elif kind == 1:
            yc, yl = s5_mixer(hc, hl, s5_a_re[j], s5_a_im[j], s5_log_dt[j], s5_b_re[j], s5_b_im[j],
                              s5_c_re[j], s5_c_im[j], s5_d[j], s5_w_glu[j], ctx_out)
        elif kind == 2:
            yc, yl = na_mixer(hc, hl, na_w_qkv[j], na_g_qn[j], na_g_kn[j], na_rpb[j], na_w_o[j], ctx_out)
        else:
            yc, yl = gqa_mixer(hc, hl, gqa_w_qkv[j], gqa_g_qn[j], gqa_g_kn[j], gqa_w_o[j], gqa_tables, ctx_out)
        xl = xl + gt_l * yl
        xl = xl + gt2_l * swiglu(modulate(xl, norm_ffn[i], sh2_l, sc2_l), ffn_w_in[i], ffn_w_out[i])
        if ctx_out:
            xc = xc + gt_c * yc
            xc = xc + gt2_c * swiglu(modulate(xc, norm_ffn[i], sh2_c, sc2_c), ffn_w_in[i], ffn_w_out[i])
    return xl
```

```cpp
#include <hip/hip_runtime.h>
#include <hip/hip_cooperative_groups.h>
#include <cstdio>
#include <cstring>
namespace cg = cooperative_groups;

#define DI __device__ __forceinline__
#define LAS __attribute__((address_space(3)))
typedef unsigned short bf16_t;
typedef short bf16x8 __attribute__((ext_vector_type(8)));
typedef short s16x4 __attribute__((ext_vector_type(4)));
typedef float f32x4 __attribute__((ext_vector_type(4)));
typedef float f32x16 __attribute__((ext_vector_type(16)));
typedef unsigned u32x4 __attribute__((ext_vector_type(4)));
typedef unsigned u32x2 __attribute__((ext_vector_type(2)));
typedef __bf16 bf2_t __attribute__((ext_vector_type(2)));
typedef float f2_t __attribute__((ext_vector_type(2)));

constexpr int NB = 32, SEQ = 2048, CTXL = 256, TT = 2304, NR = NB * TT, DM = 1024, FH = 2816;
constexpr float EPS = 1e-6f, LOG2E = 1.4426950408889634f, L2_10000 = 13.287712379549449f;
constexpr int LDS_BYTES = 131072;

enum { I_X, I_C, I_CTX, I_CCTX, I_ADAW, I_ADAB, I_NMIX, I_NFFN, I_FWIN, I_FWOUT,
       I_MWIN, I_MGQ, I_MGKV, I_MWUQ, I_MWUKV, I_MGQN, I_MGKN, I_MWO,
       I_SARE, I_SAIM, I_SLDT, I_SBRE, I_SBIM, I_SCRE, I_SCIM, I_SD, I_SWGLU,
       I_NWQKV, I_NGQN, I_NGKN, I_NRPB, I_NWO, I_GWQKV, I_GGQN, I_GGKN, I_GWO, N_IN };

constexpr size_t SZ_WFI = (size_t)5632 * 1024 * 2, SZ_WFO = (size_t)1024 * 2816 * 2;
constexpr size_t OFF_WFI = 0;
constexpr size_t OFF_WFO = OFF_WFI + 4 * SZ_WFI;
constexpr size_t OFF_WMI = OFF_WFO + 4 * SZ_WFO;
constexpr size_t OFF_WUQ = OFF_WMI + (size_t)768 * 1024 * 2;
constexpr size_t OFF_WUKV = OFF_WUQ + (size_t)1536 * 384 * 2;
constexpr size_t OFF_WMO = OFF_WUKV + (size_t)2048 * 256 * 2;
constexpr size_t OFF_WGLU = OFF_WMO + (size_t)1024 * 1024 * 2;
constexpr size_t OFF_WNQ = OFF_WGLU + (size_t)2048 * 1024 * 2;
constexpr size_t OFF_WNO = OFF_WNQ + (size_t)3072 * 1024 * 2;
constexpr size_t OFF_WGQ = OFF_WNO + (size_t)1024 * 1024 * 2;
constexpr size_t OFF_WGO = OFF_WGQ + (size_t)1536 * 1024 * 2;
constexpr size_t OFF_ADA = OFF_WGO + (size_t)1024 * 1024 * 2;
constexpr size_t OFF_XC = OFF_ADA + (size_t)4 * 33 * 6144 * 4;
constexpr size_t OFF_HB = OFF_XC + (size_t)NB * CTXL * 1024 * 4;
constexpr size_t OFF_BIG = OFF_HB + (size_t)NR * 1024 * 2;
constexpr size_t OFF_KV = OFF_BIG;
constexpr size_t OFF_QB = OFF_KV + (size_t)NR * 2560 * 2;
constexpr size_t OFF_CQN = OFF_QB + (size_t)NR * 1536 * 2;
constexpr size_t OFF_CKVN = OFF_CQN + (size_t)NR * 384 * 2;
constexpr size_t OFF_KR = OFF_CKVN + (size_t)NR * 256 * 2;
constexpr size_t WS_NEED = OFF_KR + (size_t)NR * 32 * 2;

struct Params {
    const float* in[N_IN];
    float* out;
    unsigned char* ws;
    int ph_lo, ph_hi;
};

DI unsigned pk_bf16(float a, float b) { f2_t v = {a, b}; bf2_t r = __builtin_convertvector(v, bf2_t); return __builtin_bit_cast(unsigned, r); }
DI float bf_lo(unsigned u) { return __uint_as_float(u << 16); }
DI float bf_hi(unsigned u) { return __uint_as_float(u & 0xffff0000u); }
DI float wsum(float v) {
#pragma unroll
    for (int o = 32; o > 0; o >>= 1) v += __shfl_xor(v, o);
    return v;
}
DI int otid() { int t = threadIdx.x; asm volatile("" : "+v"(t)); return t; }
DI int obid() { int b = blockIdx.x; asm volatile("" : "+s"(b)); return b; }
DI int clampi(int v, int lo, int hi) { return v < lo ? lo : (v > hi ? hi : v); }
DI float fexp2(float x) { return __builtin_amdgcn_exp2f(x); }
DI float frcp(float x) { return __builtin_amdgcn_rcpf(x); }
DI float silu_f(float a) { return a * frcp(1.f + __expf(-a)); }
DI float sigmoid_f(float a) { return frcp(1.f + __expf(-a)); }
DI float gelu_tanh(float y) {
    const float z = 0.7978845608028654f * (y + 0.044715f * y * y * y);
    const float t = 1.f - 2.f * frcp(__expf(2.f * z) + 1.f);
    return 0.5f * y * (1.f + t);
}
DI void unpack8(const u32x4 u, float* f) {
#pragma unroll
    for (int i = 0; i < 4; ++i) { f[2 * i] = bf_lo(u[i]); f[2 * i + 1] = bf_hi(u[i]); }
}
DI u32x4 pack8(const float* f) { return (u32x4){pk_bf16(f[0], f[1]), pk_bf16(f[2], f[3]), pk_bf16(f[4], f[5]), pk_bf16(f[6], f[7])}; }

namespace pg8 {
constexpr int BM = 256, BK = 64, HALF = 128, HTB = HALF * BK * 2, NXCD = 8, WGM = 8;
DI int lds_byte(int r, int c) { const int st = (r >> 4) * 2 + (c >> 5), rr = r & 15, cc = c & 31, ob = rr * 64 + cc * 2; return st * 1024 + (ob ^ (((ob >> 9) & 1) << 5)); }
DI void stage_rc(int b, int& R, int& C) { const int st = b / 1024, sb = b % 1024, swz = sb ^ (((sb >> 9) & 1) << 5); R = (st >> 1) * 16 + swz / 64; C = (st & 1) * 32 + (swz % 64) / 2; }
DI int perm32(int rho) { const int n = rho >> 4, i = rho & 15; return 8 * (i >> 2) + 4 * n + (i & 3); }
struct Unit { int pm, pn; };
struct Gemm { const bf16_t* A; const bf16_t* Bt; int M, N, K; };
struct Order {
    int nM, nN, nwg, G, c, skip;
    DI void init(int N, int G_, int c_, int skipctx) { skip = skipctx; nM = skipctx ? 256 : 288; nN = N / BM; nwg = nM * nN; G = G_; c = c_; }
    DI bool next(int i, Unit& u) const {
        const long L = (long)i * G + c; if (L >= nwg) return false;
        int wgid = (int)L; { const int q = nwg / NXCD, r = nwg % NXCD, xcd = wgid % NXCD, off = wgid / NXCD; wgid = (xcd < r ? xcd * (q + 1) : r * (q + 1) + (xcd - r) * q) + off; }
        const int nig = WGM * nN, gid = wgid / nig, fm = gid * WGM, gsz = (nM - fm) < WGM ? (nM - fm) : WGM;
        int pm = fm + ((wgid % nig) % gsz); u.pn = (wgid % nig) / gsz;
        if (skip) pm = pm + (pm >> 3) + 1;
        u.pm = pm; return true;
    }
};

DI float* tile_res_base(float* lat, float* xc, int pm) { const int bb = pm / 9, sub = pm - bb * 9; return sub == 0 ? xc + ((size_t)bb * CTXL << 10) : lat + ((size_t)(bb * SEQ + (sub - 1) * 256) << 10); }
DI int tile_ada_row(int pm) { const int bb = pm / 9, sub = pm - bb * 9; return sub == 0 ? 32 : bb; }

struct EpiStore {
    static constexpr bool PERM = true;
    bf16_t* O; int ldc; int remap;
    DI void operator()(const f32x4 (&acc)[2][2][4][2], const Unit& u, int wr, int wc, int fr, int fq) const {
        const int row0 = u.pm * BM + wr * 64 + fr, col0 = u.pn * BM + wc * 32 + 8 * fq;
#pragma unroll
        for (int ai = 0; ai < 2; ++ai)
#pragma unroll
            for (int m = 0; m < 4; ++m) {
                bf16_t* rowp = O + (size_t)(row0 + ai * HALF + m * 16) * ldc;
#pragma unroll
                for (int bj = 0; bj < 2; ++bj) {
                    const int c = col0 + bj * HALF; const int cc = remap ? (c >> 7) * 160 + (c & 127) : c;
                    const f32x4 v0 = acc[ai][bj][m][0], v1 = acc[ai][bj][m][1];
                    *(u32x4*)(rowp + cc) = (u32x4){pk_bf16(v0[0], v0[1]), pk_bf16(v0[2], v0[3]), pk_bf16(v1[0], v1[1]), pk_bf16(v1[2], v1[3])};
                }
            }
    }
};
struct EpiSwiglu {
    static constexpr bool PERM = true;
    bf16_t* O; int ldc;
    DI void operator()(const f32x4 (&acc)[2][2][4][2], const Unit& u, int wr, int wc, int fr, int fq) const {
        const int row0 = u.pm * BM + wr * 64 + fr, col0 = u.pn * HALF + wc * 32 + 8 * fq;
#pragma unroll
        for (int ai = 0; ai < 2; ++ai)
#pragma unroll
            for (int m = 0; m < 4; ++m) {
                float v[8];
#pragma unroll
                for (int n = 0; n < 2; ++n)
#pragma unroll
                    for (int i = 0; i < 4; ++i) v[n * 4 + i] = silu_f(acc[ai][0][m][n][i]) * acc[ai][1][m][n][i];
                *(u32x4*)(O + (size_t)(row0 + ai * HALF + m * 16) * ldc + col0) = pack8(v);
            }
    }
};
struct EpiGluRes {
    static constexpr bool PERM = true;
    float* lat; float* xc; const float* ada; int gidx;
    DI void operator()(const f32x4 (&acc)[2][2][4][2], const Unit& u, int wr, int wc, int fr, int fq) const {
        float* base = tile_res_base(lat, xc, u.pm);
        const float* gate = ada + (size_t)tile_ada_row(u.pm) * 6144 + gidx * 1024;
        const int col0 = u.pn * HALF + wc * 32 + 8 * fq;
        const f32x4 g0 = *(const f32x4*)(gate + col0), g1 = *(const f32x4*)(gate + col0 + 4);
#pragma unroll
        for (int ai = 0; ai < 2; ++ai)
#pragma unroll
            for (int m = 0; m < 4; ++m) {
                float* rp = base + ((size_t)(ai * HALF + wr * 64 + m * 16 + fr) << 10) + col0;
                f32x4 x0 = *(f32x4*)rp, x1 = *(f32x4*)(rp + 4);
#pragma unroll
                for (int i = 0; i < 4; ++i) {
                    x0[i] += g0[i] * (acc[ai][0][m][0][i] * sigmoid_f(acc[ai][1][m][0][i]));
                    x1[i] += g1[i] * (acc[ai][0][m][1][i] * sigmoid_f(acc[ai][1][m][1][i]));
                }
                *(f32x4*)rp = x0; *(f32x4*)(rp + 4) = x1;
            }
    }
};
struct EpiRes {
    static constexpr bool PERM = false;
    float* lat; float* xc; const float* ada; int gidx;
    DI void operator()(const f32x4 (&acc)[2][2][4][2], const Unit& u, int wr, int wc, int fr, int fq) const {
        float* base = tile_res_base(lat, xc, u.pm);
        const float* gate = ada + (size_t)tile_ada_row(u.pm) * 6144 + gidx * 1024;
        const int col0 = u.pn * BM + wc * 32 + 4 * fq;
        f32x4 gv[2][2];
#pragma unroll
        for (int bj = 0; bj < 2; ++bj)
#pragma unroll
            for (int n = 0; n < 2; ++n) gv[bj][n] = *(const f32x4*)(gate + col0 + bj * HALF + n * 16);
#pragma unroll
        for (int ai = 0; ai < 2; ++ai)
#pragma unroll
            for (int m = 0; m < 4; ++m) {
                float* rp = base + ((size_t)(ai * HALF + wr * 64 + m * 16 + fr) << 10) + col0;
#pragma unroll
                for (int bj = 0; bj < 2; ++bj)
#pragma unroll
                    for (int n = 0; n < 2; ++n) {
                        f32x4 x = *(f32x4*)(rp + bj * HALF + n * 16);
                        x += gv[bj][n] * acc[ai][bj][m][n];
                        *(f32x4*)(rp + bj * HALF + n * 16) = x;
                    }
            }
    }
};

template <class Epi>
DI void gemm_phase(LAS unsigned char* lds, const Gemm g, const Order& S, const Epi& E) {
    const int TIDX = otid(); const int BIDX = obid(); (void)TIDX; (void)BIDX;
    const int tid = TIDX, wid = __builtin_amdgcn_readfirstlane(tid >> 6), lane = tid & 63, wr = wid >> 2, wc = wid & 3, fr = lane & 15, fq = lane >> 4;
    const int K = g.K, nt = K / BK;
    unsigned voffA[2], voffB[2];
#pragma unroll
    for (int i = 0; i < 2; ++i) { int R, C; stage_rc(tid * 16 + i * 8192, R, C); const int Rb = Epi::PERM ? ((R & ~31) + perm32(R & 31)) : R;
        voffA[i] = (unsigned)(R * K + C) * 2u; voffB[i] = (unsigned)(Rb * K + C) * 2u; }
    const size_t kstep = (size_t)(BK * 2);
    const size_t hstep = (size_t)HALF * K * 2;
    const size_t tstep = 2 * hstep;
    const unsigned ldsw = (unsigned)wid * 1024u;
    const int aoff = lds_byte(wr * 64 + fr, fq * 8), boff = lds_byte(wc * 32 + fr, fq * 8);
#define PG8_SA(b, h) (((b) * 2 + (h)) * HTB)
#define PG8_SB(b, h) ((4 + (b) * 2 + (h)) * HTB)
#define PG8_STAGE(bufoff, gbase, voff) do { _Pragma("unroll") for (int _i = 0; _i < 2; ++_i) \
        __builtin_amdgcn_global_load_lds((const unsigned*)((const char*)(gbase) + (voff)[_i]), (LAS unsigned*)(lds + (bufoff) + ldsw + _i * 8192), 16, 0, 0); } while (0)
#define PG8_LDA(dst, b, h) do { _Pragma("unroll") for (int m = 0; m < 4; ++m) _Pragma("unroll") for (int k = 0; k < 2; ++k) dst[m][k] = *(const LAS bf16x8*)(lds + PG8_SA(b, h) + aoff + m * 2048 + k * 1024); } while (0)
#define PG8_LDB(dst, b, h) do { _Pragma("unroll") for (int n = 0; n < 2; ++n) _Pragma("unroll") for (int k = 0; k < 2; ++k) dst[n][k] = *(const LAS bf16x8*)(lds + PG8_SB(b, h) + boff + n * 2048 + k * 1024); } while (0)
#define PG8_MMA(ai, bj, At, Bt) do { __builtin_amdgcn_s_setprio(1); _Pragma("unroll") for (int m = 0; m < 4; ++m) _Pragma("unroll") for (int n = 0; n < 2; ++n) _Pragma("unroll") for (int k = 0; k < 2; ++k) \
        acc[ai][bj][m][n] = __builtin_amdgcn_mfma_f32_16x16x32_bf16(Bt[n][k], At[m][k], acc[ai][bj][m][n], 0, 0, 0); __builtin_amdgcn_s_setprio(0); } while (0)
#define PG8_WAIT_V(n) asm volatile("s_waitcnt vmcnt(" #n ")" ::: "memory")
#define PG8_WAIT_L(n) asm volatile("s_waitcnt lgkmcnt(" #n ")" ::: "memory")
#define PG8_BAR __builtin_amdgcn_s_barrier()
#define PG8_SCHED __builtin_amdgcn_sched_barrier(0)
    Unit cur, nxt; int ui = 0;
    if (!S.next(0, cur)) return;
    f32x4 acc[2][2][4][2];
#pragma unroll
    for (int a = 0; a < 2; ++a)
#pragma unroll
        for (int b = 0; b < 2; ++b)
#pragma unroll
            for (int m = 0; m < 4; ++m)
#pragma unroll
                for (int n = 0; n < 2; ++n) acc[a][b][m][n] = (f32x4){0.f, 0.f, 0.f, 0.f};
    bf16x8 At[4][2], B0[2][2], B1[2][2];
    const char* cA = (const char*)g.A + (size_t)cur.pm * tstep; const char* cB = (const char*)g.Bt + (size_t)cur.pn * tstep;
    PG8_STAGE(PG8_SB(0, 0), cB, voffB); PG8_STAGE(PG8_SA(0, 0), cA, voffA); PG8_STAGE(PG8_SB(0, 1), cB + hstep, voffB); PG8_STAGE(PG8_SA(0, 1), cA + hstep, voffA);
    if (wr == 1) PG8_BAR;
    PG8_WAIT_V(4); PG8_BAR;
    PG8_STAGE(PG8_SB(1, 0), cB + kstep, voffB); PG8_STAGE(PG8_SA(1, 0), cA + kstep, voffA); PG8_STAGE(PG8_SB(1, 1), cB + hstep + kstep, voffB);
    PG8_WAIT_V(6); PG8_BAR;
    for (;;) {
        const bool has_next = S.next(ui + 1, nxt);
        const char* nA = has_next ? (const char*)g.A + (size_t)nxt.pm * tstep : cA; const char* nB = has_next ? (const char*)g.Bt + (size_t)nxt.pn * tstep : cB;
        for (int t = 0; t < nt; t += 2) {
            const bool last = (t == nt - 2);
            const char* a1 = cA + (size_t)(t + 1) * kstep;
            const char* a2 = last ? nA : cA + (size_t)(t + 2) * kstep; const char* b2 = last ? nB : cB + (size_t)(t + 2) * kstep;
            const char* a3 = a2 + kstep; const char* b3 = b2 + kstep;
            PG8_LDB(B0, 0, 0); PG8_SCHED; PG8_LDA(At, 0, 0); PG8_STAGE(PG8_SA(1, 1), a1 + hstep, voffA);
            PG8_WAIT_L(8); PG8_BAR; PG8_WAIT_L(0); PG8_MMA(0, 0, At, B0); PG8_BAR; PG8_SCHED;
            PG8_LDB(B1, 0, 1); PG8_STAGE(PG8_SB(0, 0), b2, voffB);
            PG8_BAR; PG8_WAIT_L(0); PG8_MMA(0, 1, At, B1); PG8_BAR;
            PG8_LDA(At, 0, 1); PG8_STAGE(PG8_SA(0, 0), a2, voffA);
            PG8_BAR; PG8_WAIT_L(0); PG8_MMA(1, 0, At, B0); PG8_BAR; PG8_SCHED;
            PG8_STAGE(PG8_SB(0, 1), b2 + hstep, voffB);
            PG8_WAIT_V(6); PG8_BAR; PG8_MMA(1, 1, At, B1); PG8_BAR;
            PG8_LDB(B0, 1, 0); PG8_SCHED; PG8_LDA(At, 1, 0); PG8_STAGE(PG8_SA(0, 1), a2 + hstep, voffA);
            PG8_WAIT_L(8); PG8_BAR; PG8_WAIT_L(0); PG8_MMA(0, 0, At, B0); PG8_BAR; PG8_SCHED;
            PG8_LDB(B1, 1, 1); PG8_STAGE(PG8_SB(1, 0), b3, voffB);
            PG8_BAR; PG8_WAIT_L(0); PG8_MMA(0, 1, At, B1); PG8_BAR;
            PG8_LDA(At, 1, 1); PG8_STAGE(PG8_SA(1, 0), a3, voffA);
            PG8_BAR; PG8_WAIT_L(0); PG8_MMA(1, 0, At, B0); PG8_BAR; PG8_SCHED;
            PG8_STAGE(PG8_SB(1, 1), b3 + hstep, voffB);
            PG8_WAIT_V(6); PG8_BAR; PG8_MMA(1, 1, At, B1); PG8_BAR;
        }
        E(acc, cur, wr, wc, fr, fq);
        if (!has_next) break;
#pragma unroll
        for (int a = 0; a < 2; ++a)
#pragma unroll
            for (int b = 0; b < 2; ++b)
#pragma unroll
                for (int m = 0; m < 4; ++m)
#pragma unroll
                    for (int n = 0; n < 2; ++n) acc[a][b][m][n] = (f32x4){0.f, 0.f, 0.f, 0.f};
        cur = nxt; cA = nA; cB = nB; ++ui;
    }
    PG8_WAIT_V(0);
    if (wr == 0) PG8_BAR;
    PG8_BAR;
#undef PG8_SA
#undef PG8_SB
#undef PG8_STAGE
#undef PG8_LDA
#undef PG8_LDB
#undef PG8_MMA
#undef PG8_WAIT_V
#undef PG8_WAIT_L
#undef PG8_BAR
#undef PG8_SCHED
}
}

template <class Epi>
DI void run_gemm(LAS unsigned char* lds, const bf16_t* A, const bf16_t* Bt, int N, int K, int skipctx, const Epi& E) {
    const int BIDX = obid();
    pg8::Order S; S.init(N, (int)gridDim.x, BIDX, skipctx);
    pg8::Gemm g{A, Bt, NR, N, K};
    pg8::gemm_phase<Epi>(lds, g, S, E);
}

struct WDesc { const float* src; bf16_t* dst; int K, N, Nout, half; };
DI void prep_weight(LAS float* tile, const WDesc w) {
    const int TIDX = otid(); const int BIDX = obid(); (void)TIDX; (void)BIDX;
    const int tid = TIDX;
    const int ntk = w.K / 64, ntn = w.Nout / 64;
    for (int tidx = BIDX; tidx < ntk * ntn; tidx += gridDim.x) {
        const int kt = tidx % ntk, nt = tidx / ntk;
        const int n0 = nt * 64;
        int scol = n0;
        if (w.half) { const int t256 = n0 >> 8, ww = n0 & 255; scol = (ww >= 128 ? w.half : 0) + t256 * 128 + (ww & 127); }
        const int c4 = (tid & 15) * 4;
#pragma unroll
        for (int rr = 0; rr < 2; ++rr) {
            const int r = (tid >> 4) + rr * 32;
            f32x4 v = (f32x4){0.f, 0.f, 0.f, 0.f};
            if (scol + c4 < w.N) v = *(const f32x4*)(w.src + (size_t)(kt * 64 + r) * w.N + scol + c4);
#pragma unroll
            for (int i = 0; i < 4; ++i) tile[r * 65 + c4 + i] = v[i];
        }
        __syncthreads();
        {
            const int n = tid >> 3, kc = (tid & 7) * 8;
            float f[8];
#pragma unroll
            for (int i = 0; i < 8; ++i) f[i] = tile[(kc + i) * 65 + n];
            *(u32x4*)(w.dst + (size_t)(n0 + n) * w.K + kt * 64 + kc) = pack8(f);
        }
        __syncthreads();
    }
}

DI void ada_phase(const Params& p, float* ADA) {
    const int TIDX = otid(); const int BIDX = obid(); (void)TIDX; (void)BIDX;
    const int wave = __builtin_amdgcn_readfirstlane(TIDX >> 6), lane = TIDX & 63;
    const int gw = BIDX * 8 + wave, nw = gridDim.x * 8;
    const int v = lane < 33 ? lane : 32;
    const float* cv = v < 32 ? p.in[I_C] + v * 1024 : p.in[I_CCTX];
    for (int item = gw; item < 4 * 384; item += nw) {
        const int layer = item / 384, n0 = (item - layer * 384) * 16;
        const float* W = p.in[I_ADAW] + (size_t)layer * 1024 * 6144 + n0;
        float acc[16];
#pragma unroll
        for (int n = 0; n < 16; ++n) acc[n] = 0.f;
        for (int k0 = 0; k0 < 1024; k0 += 8) {
            float s[8];
            const f32x4 c0 = *(const f32x4*)(cv + k0), c1 = *(const f32x4*)(cv + k0 + 4);
#pragma unroll
            for (int i = 0; i < 4; ++i) { s[i] = silu_f(c0[i]); s[4 + i] = silu_f(c1[i]); }
#pragma unroll
            for (int kk = 0; kk < 8; ++kk) {
                const float* wr_ = W + (size_t)(k0 + kk) * 6144;
#pragma unroll
                for (int n = 0; n < 16; ++n) acc[n] += s[kk] * wr_[n];
            }
        }
        if (lane < 33) {
            float* o = ADA + ((size_t)layer * 33 + lane) * 6144 + n0;
            const float* bb = p.in[I_ADAB] + layer * 6144 + n0;
#pragma unroll
            for (int n = 0; n < 16; ++n) o[n] = acc[n] + bb[n];
        }
    }
}

DI void norm_phase(const float* lat_in, const float* ctx_in, float* lat_out, float* ctx_out, bool copy, const float* g,
                   const float* ada, int shidx, bf16_t* H, bool skipctx) {
    const int TIDX = otid(); const int BIDX = obid(); (void)TIDX; (void)BIDX;
    const int wave = TIDX >> 6, lane = TIDX & 63;
    for (int row = BIDX * 8 + wave; row < NR; row += gridDim.x * 8) {
        const int b = row / TT, t = row - b * TT;
        if (skipctx && t < CTXL) continue;
        const size_t ro = t < CTXL ? ((size_t)(b * CTXL + t) << 10) : ((size_t)(b * SEQ + t - CTXL) << 10);
        const float* src = (t < CTXL ? ctx_in : lat_in) + ro;
        const float* sh = ada + (size_t)(t < CTXL ? 32 : b) * 6144 + shidx * 1024;
        const float* sc = sh + 1024;
        f32x4 a[4];
        a[0] = *(const f32x4*)(src + lane * 8); a[1] = *(const f32x4*)(src + lane * 8 + 4);
        a[2] = *(const f32x4*)(src + 512 + lane * 8); a[3] = *(const f32x4*)(src + 512 + lane * 8 + 4);
        float ss = 0.f;
#pragma unroll
        for (int i = 0; i < 4; ++i)
#pragma unroll
            for (int j = 0; j < 4; ++j) ss += a[i][j] * a[i][j];
        ss = wsum(ss);
        const float r = rsqrtf(ss * (1.f / 1024.f) + EPS);
        if (copy) {
            float* dst = (t < CTXL ? ctx_out : lat_out) + ro;
            *(f32x4*)(dst + lane * 8) = a[0]; *(f32x4*)(dst + lane * 8 + 4) = a[1];
            *(f32x4*)(dst + 512 + lane * 8) = a[2]; *(f32x4*)(dst + 512 + lane * 8 + 4) = a[3];
        }
#pragma unroll
        for (int hf = 0; hf < 2; ++hf) {
            const int c0 = hf * 512 + lane * 8;
            float y[8];
#pragma unroll
            for (int q = 0; q < 2; ++q) {
                const f32x4 gv = *(const f32x4*)(g + c0 + q * 4), sv = *(const f32x4*)(sc + c0 + q * 4), hv = *(const f32x4*)(sh + c0 + q * 4);
#pragma unroll
                for (int j = 0; j < 4; ++j) y[q * 4 + j] = a[hf * 2 + q][j] * r * gv[j] * (1.f + sv[j]) + hv[j];
            }
            *(u32x4*)(H + ((size_t)row << 10) + c0) = pack8(y);
        }
    }
}

DI void mla_r1(const bf16_t* Z, bf16_t* CQN, bf16_t* CKVN, bf16_t* KR, const float* gq, const float* gkv) {
    const int TIDX = otid(); const int BIDX = obid(); (void)TIDX; (void)BIDX;
    const int wave = TIDX >> 6, lane = TIDX & 63;
    for (int row = BIDX * 8 + wave; row < NR; row += gridDim.x * 8) {
        const bf16_t* z = Z + (size_t)row * 768;
        float q[6], kv[4];
#pragma unroll
        for (int i = 0; i < 3; ++i) { const unsigned u = *(const unsigned*)(z + lane * 6 + 2 * i); q[2 * i] = bf_lo(u); q[2 * i + 1] = bf_hi(u); }
        { const u32x2 u = *(const u32x2*)(z + 384 + lane * 4); kv[0] = bf_lo(u[0]); kv[1] = bf_hi(u[0]); kv[2] = bf_lo(u[1]); kv[3] = bf_hi(u[1]); }
        unsigned kr = 0;
        if (lane < 16) kr = *(const unsigned*)(z + 640 + lane * 2);
        float sq = 0.f, sk = 0.f;
#pragma unroll
        for (int i = 0; i < 6; ++i) sq += q[i] * q[i];
#pragma unroll
        for (int i = 0; i < 4; ++i) sk += kv[i] * kv[i];
        sq = wsum(sq); sk = wsum(sk);
        const float rq = rsqrtf(sq * (1.f / 384.f) + EPS), rk = rsqrtf(sk * (1.f / 256.f) + EPS);
#pragma unroll
        for (int i = 0; i < 3; ++i) {
            const int c = lane * 6 + 2 * i;
            *(unsigned*)(CQN + (size_t)row * 384 + c) = pk_bf16(q[2 * i] * rq * gq[c], q[2 * i + 1] * rq * gq[c + 1]);
        }
        { const int c = lane * 4;
          *(u32x2*)(CKVN + (size_t)row * 256 + c) = (u32x2){pk_bf16(kv[0] * rk * gkv[c], kv[1] * rk * gkv[c + 1]), pk_bf16(kv[2] * rk * gkv[c + 2], kv[3] * rk * gkv[c + 3])}; }
        if (lane < 16) *(unsigned*)(KR + (size_t)row * 32 + lane * 2) = kr;
    }
}

DI void mla_rope8(float* v, int sub, int s) {
    const float pos = (float)((sub < 2) ? (s >> 6) : (s & 63));
    const bool isx2 = sub & 1;
#pragma unroll
    for (int i = 0; i < 8; ++i) {
        const float other = __shfl_xor(v[i], 1);
        const float ang = pos * fexp2(-(float)i * (L2_10000 / 8.f));
        const float c = __cosf(ang), sn = __sinf(ang);
        v[i] = isx2 ? (other * sn + v[i] * c) : (v[i] * c - other * sn);
    }
}

DI void mla_r2(bf16_t* QB, bf16_t* KV, const bf16_t* KR, const float* gqn, const float* gkn) {
    const int TIDX = otid(); const int BIDX = obid(); (void)TIDX; (void)BIDX;
    const int wave = TIDX >> 6, lane = TIDX & 63, hd = lane >> 2, sub = lane & 3;
    for (int row = BIDX * 8 + wave; row < NR; row += gridDim.x * 8) {
        const int b = row / TT, t = row - b * TT; const bool latent = t >= CTXL; const int s = t - CTXL;
        bf16_t* qp = QB + (size_t)row * 1536 + hd * 96;
        bf16_t* kp = KV + (size_t)row * 2560 + hd * 160;
        const u32x4 q0 = *(const u32x4*)(qp + sub * 16), q1 = *(const u32x4*)(qp + sub * 16 + 8), q2 = *(const u32x4*)(qp + 64 + sub * 8);
        const u32x4 k0 = *(const u32x4*)(kp + sub * 16), k1 = *(const u32x4*)(kp + sub * 16 + 8);
        const u32x4 v0 = *(const u32x4*)(kp + 64 + sub * 16), v1 = *(const u32x4*)(kp + 64 + sub * 16 + 8);
        const u32x4 k2 = *(const u32x4*)(KR + (size_t)row * 32 + sub * 8);
        asm volatile("s_waitcnt vmcnt(0)" ::: "memory");
        float qn[16], qr[8], kn[16], kr[8];
        unpack8(q0, qn); unpack8(q1, qn + 8); unpack8(q2, qr);
        unpack8(k0, kn); unpack8(k1, kn + 8); unpack8(k2, kr);
        float sq = 0.f, sk = 0.f;
#pragma unroll
        for (int i = 0; i < 16; ++i) { sq += qn[i] * qn[i]; sk += kn[i] * kn[i]; }
#pragma unroll
        for (int i = 0; i < 8; ++i) { sq += qr[i] * qr[i]; sk += kr[i] * kr[i]; }
        sq += __shfl_xor(sq, 1); sq += __shfl_xor(sq, 2);
        sk += __shfl_xor(sk, 1); sk += __shfl_xor(sk, 2);
        const float rq = rsqrtf(sq * (1.f / 96.f) + EPS), rk = rsqrtf(sk * (1.f / 96.f) + EPS);
#pragma unroll
        for (int i = 0; i < 16; ++i) { qn[i] *= rq * gqn[sub * 16 + i]; kn[i] *= rk * gkn[sub * 16 + i]; }
#pragma unroll
        for (int i = 0; i < 8; ++i) { qr[i] *= rq * gqn[64 + sub * 8 + i]; kr[i] *= rk * gkn[64 + sub * 8 + i]; }
        if (latent) { mla_rope8(qr, sub, s); mla_rope8(kr, sub, s); }
        *(u32x4*)(qp + sub * 16) = pack8(qn); *(u32x4*)(qp + sub * 16 + 8) = pack8(qn + 8); *(u32x4*)(qp + 64 + sub * 8) = pack8(qr);
        *(u32x4*)(kp + sub * 16) = pack8(kn); *(u32x4*)(kp + sub * 16 + 8) = pack8(kn + 8); *(u32x4*)(kp + 64 + sub * 8) = pack8(kr);
        *(u32x4*)(kp + 96 + sub * 16) = v0; *(u32x4*)(kp + 96 + sub * 16 + 8) = v1;
    }
}

template <int HD, int LPH, int ROPE>
DI void headnorm_phase(bf16_t* X, int stride, int nq, int koff, int nk, const float* gq, const float* gk) {
    const int TIDX = otid(); const int BIDX = obid(); (void)TIDX; (void)BIDX;
    constexpr int HPP = 64 / LPH;
    const int wave = TIDX >> 6, lane = TIDX & 63, sub = lane % LPH, hl = lane / LPH;
    for (int row = BIDX * 8 + wave; row < NR; row += gridDim.x * 8) {
        const int b = row / TT, t = row - b * TT; const bool latent = t >= CTXL; const int s = t - CTXL;
        for (int pass = 0; pass < 2; ++pass) {
            const int nh = pass ? nk : nq, base = pass ? koff : 0; const float* g = pass ? gk : gq;
            for (int h0 = 0; h0 < nh; h0 += HPP) {
                const int hd = h0 + hl; const bool act = hd < nh;
                bf16_t* ptr = X + (size_t)row * stride + base + hd * HD + sub * 16;
                u32x4 u0 = (u32x4){0, 0, 0, 0}, u1 = (u32x4){0, 0, 0, 0};
                if (act) { u0 = *(const u32x4*)ptr; u1 = *(const u32x4*)(ptr + 8); }
                float v[16]; unpack8(u0, v); unpack8(u1, v + 8);
                float ss = 0.f;
#pragma unroll
                for (int i = 0; i < 16; ++i) ss += v[i] * v[i];
#pragma unroll
                for (int o = 1; o < LPH; o <<= 1) ss += __shfl_xor(ss, o);
                const float rr = rsqrtf(ss * (1.f / HD) + EPS);
#pragma unroll
                for (int i = 0; i < 16; ++i) v[i] *= rr * g[sub * 16 + i];
                if (ROPE) {
                    if (latent) {
                        const int axis = sub >> 2; const bool isx2 = (sub >> 1) & 1;
                        const float pos = (float)(axis ? (s & 63) : (s >> 6));
#pragma unroll
                        for (int i = 0; i < 16; ++i) {
                            const float other = __shfl_xor(v[i], 2);
                            const int fi = (sub & 1) * 16 + i;
                            const float ang = pos * fexp2(-(float)fi * (L2_10000 / 32.f));
                            const float c = __cosf(ang), sn = __sinf(ang);
                            v[i] = isx2 ? (other * sn + v[i] * c) : (v[i] * c - other * sn);
                        }
                    }
                }
                if (act) { *(u32x4*)ptr = pack8(v); *(u32x4*)(ptr + 8) = pack8(v + 8); }
            }
        }
    }
}

struct AttnArgs { const bf16_t* Q; const bf16_t* K; const bf16_t* V; bf16_t* O; int qs, qh, ks, kh, vs, vh, nheads, gshift, ctx_out; const float* rpb; float sc; };

template <int DK, int DV, int NA>
DI void attn_phase(LAS unsigned char* lds, const AttnArgs a) {
    const int TIDX = otid(); const int BIDX = obid(); (void)TIDX; (void)BIDX;
    constexpr int KROW = DK * 2 + 16, VROW = DV * 2 + 16;
    constexpr int KBUF = 64 * KROW, VBUF = 64 * VROW;
    constexpr int OFFK = 0, OFFV = 2 * KBUF, OFFR = OFFV + 2 * VBUF;
    constexpr int KCH = DK / 8, VCH = DV / 8, NKC = 64 * KCH, NVC = 64 * VCH;
    constexpr int KPT = (NKC + 511) / 512, VPT = (NVC + 511) / 512;
    const int tid = TIDX, wave = __builtin_amdgcn_readfirstlane(tid >> 6), lane = tid & 63, r = lane & 31, hh = lane >> 5;
    const int i16 = lane & 15, tq = i16 >> 2, tp = i16 & 3, blk = (lane >> 4) & 1;
    const int nlat = NB * a.nheads * 8, ntot = nlat + (a.ctx_out ? NB * a.nheads : 0);
    LAS float* rpbL = (LAS float*)(lds + OFFR);
    for (int item = BIDX; item < ntot; item += gridDim.x) {
        int b, h, qb = 0; const bool isctx = item >= nlat;
        if (!isctx) { qb = item & 7; const int bh = item >> 3; h = bh % a.nheads; b = bh / a.nheads; }
        else { const int bh = item - nlat; h = bh % a.nheads; b = bh / a.nheads; }
        const int hk = h >> a.gshift;
        const size_t rb = (size_t)b * TT;
        const bf16_t* Kb = a.K + hk * a.kh; const bf16_t* Vb = a.V + hk * a.vh;
        int ntiles = isctx ? 4 : 36, rlo = 0, wi = 0, wr0 = 0, c0 = 0;
        if (NA) {
            if (!isctx) { const int i0 = qb * 4; rlo = clampi(i0 - 4, 0, 24); const int rhi = clampi(i0 - 1, 0, 24) + 8; ntiles = 4 + rhi - rlo;
                wi = i0 + (wave >> 1); wr0 = clampi(wi - 4, 0, 24); c0 = (wave & 1) * 32; }
            if (tid < 465) rpbL[tid] = a.rpb[h * 465 + tid] * LOG2E;
        }
        const size_t qrow = rb + (isctx ? 0 : 256 + qb * 256) + wave * 32 + r;
        bf16x8 qf[DK / 16];
#pragma unroll
        for (int k0 = 0; k0 < DK / 16; ++k0) qf[k0] = *(const bf16x8*)(a.Q + qrow * a.qs + h * a.qh + k0 * 16 + hh * 8);
        u32x4 kreg[KPT], vreg[VPT];
#define ATT_TILE_ROW(j) ((NA && (j) >= 4) ? rb + 256 + (size_t)(rlo + (j) - 4) * 64 : rb + (size_t)(j) * 64)
#define ATT_GLOAD(j) do { const size_t _tr = ATT_TILE_ROW(j); \
        _Pragma("unroll") for (int _i = 0; _i < KPT; ++_i) { const int _c = tid + _i * 512; if (_c < NKC) { const int _row = _c / KCH, _cc = _c - _row * KCH; kreg[_i] = *(const u32x4*)(Kb + (_tr + _row) * a.ks + _cc * 8); } } \
        _Pragma("unroll") for (int _i = 0; _i < VPT; ++_i) { const int _c = tid + _i * 512; if (_c < NVC) { const int _row = _c / VCH, _cc = _c - _row * VCH; vreg[_i] = *(const u32x4*)(Vb + (_tr + _row) * a.vs + _cc * 8); } } } while (0)
#define ATT_LSTORE(buf) do { \
        _Pragma("unroll") for (int _i = 0; _i < KPT; ++_i) { const int _c = tid + _i * 512; if (_c < NKC) { const int _row = _c / KCH, _cc = _c - _row * KCH; *(LAS u32x4*)(lds + OFFK + (buf) * KBUF + _row * KROW + _cc * 16) = kreg[_i]; } } \
        _Pragma("unroll") for (int _i = 0; _i < VPT; ++_i) { const int _c = tid + _i * 512; if (_c < NVC) { const int _row = _c / VCH, _cc = _c - _row * VCH; *(LAS u32x4*)(lds + OFFV + (buf) * VBUF + _row * VROW + _cc * 16) = vreg[_i]; } } } while (0)
        ATT_GLOAD(0); ATT_LSTORE(0);
        __syncthreads();
        f32x16 o[DV / 32];
#pragma unroll
        for (int d = 0; d < DV / 32; ++d)
#pragma unroll
            for (int i = 0; i < 16; ++i) o[d][i] = 0.f;
        float m_run = -1e30f, lsum = 0.f;
        for (int j = 0; j < ntiles; ++j) {
            const bool more = j + 1 < ntiles;
            if (more) ATT_GLOAD(j + 1);
            bool active = true; int kr = 0;
            if (NA && j >= 4) { kr = rlo + j - 4; active = (kr >= wr0) && (kr < wr0 + 8); }
            if (active) {
                const LAS unsigned char* Kt = lds + OFFK + (j & 1) * KBUF;
                const LAS unsigned char* Vt = lds + OFFV + (j & 1) * VBUF;
                f32x16 s[2];
#pragma unroll
                for (int kb = 0; kb < 2; ++kb) {
#pragma unroll
                    for (int i = 0; i < 16; ++i) s[kb][i] = 0.f;
#pragma unroll
                    for (int k0 = 0; k0 < DK / 16; ++k0) {
                        const bf16x8 kf = *(const LAS bf16x8*)(Kt + (kb * 32 + r) * KROW + k0 * 32 + hh * 16);
                        s[kb] = __builtin_amdgcn_mfma_f32_32x32x16_bf16(kf, qf[k0], s[kb], 0, 0, 0);
                    }
                }
                float mx = m_run;
                if (NA && j >= 4) {
                    const int ri = kr - wi + 7, qj = c0 + r, cs = clampi(qj - 8, 0, 48);
#pragma unroll
                    for (int kb = 0; kb < 2; ++kb)
#pragma unroll
                        for (int i = 0; i < 16; ++i) {
                            const int kj = kb * 32 + (i & 3) + 8 * (i >> 2) + 4 * hh;
                            const bool valid = (kj >= cs) && (kj < cs + 16);
                            const int ci = clampi(kj - qj + 15, 0, 30);
                            const float bias = rpbL[ri * 31 + ci];
                            const float x = valid ? s[kb][i] * a.sc + bias : -1e30f;
                            s[kb][i] = x; mx = fmaxf(mx, x);
                        }
                } else {
#pragma unroll
                    for (int kb = 0; kb < 2; ++kb)
#pragma unroll
                        for (int i = 0; i < 16; ++i) { const float x = s[kb][i] * a.sc; s[kb][i] = x; mx = fmaxf(mx, x); }
                }
                mx = fmaxf(mx, __shfl_xor(mx, 32));
                const float alpha = fexp2(m_run - mx);
                m_run = mx; lsum *= alpha;
#pragma unroll
                for (int d = 0; d < DV / 32; ++d)
#pragma unroll
                    for (int i = 0; i < 16; ++i) o[d][i] *= alpha;
#pragma unroll
                for (int kb = 0; kb < 2; ++kb)
#pragma unroll
                    for (int i = 0; i < 16; ++i) { const float pp = fexp2(s[kb][i] - mx); lsum += pp; s[kb][i] = pp; }
#pragma unroll
                for (int kb = 0; kb < 2; ++kb)
#pragma unroll
                    for (int st = 0; st < 2; ++st) {
                        const u32x4 pu = (u32x4){pk_bf16(s[kb][8 * st], s[kb][8 * st + 1]), pk_bf16(s[kb][8 * st + 2], s[kb][8 * st + 3]),
                                                 pk_bf16(s[kb][8 * st + 4], s[kb][8 * st + 5]), pk_bf16(s[kb][8 * st + 6], s[kb][8 * st + 7])};
                        const bf16x8 pf = __builtin_bit_cast(bf16x8, pu);
#pragma unroll
                        for (int d = 0; d < DV / 32; ++d) {
                            const LAS unsigned char* ad = Vt + (kb * 32 + 16 * st + 4 * hh + tq) * VROW + (d * 32 + 16 * blk + 4 * tp) * 2;
                            const s16x4 lo = __builtin_amdgcn_ds_read_tr16_b64_v4i16((LAS s16x4*)ad);
                            const s16x4 hi = __builtin_amdgcn_ds_read_tr16_b64_v4i16((LAS s16x4*)(ad + 8 * VROW));
                            const bf16x8 vf = __builtin_shufflevector(lo, hi, 0, 1, 2, 3, 4, 5, 6, 7);
                            o[d] = __builtin_amdgcn_mfma_f32_32x32x16_bf16(vf, pf, o[d], 0, 0, 0);
                        }
                    }
            }
            if (more) ATT_LSTORE((j + 1) & 1);
            __syncthreads();
        }
        lsum += __shfl_xor(lsum, 32);
        const float inv = frcp(lsum);
        bf16_t* orow = a.O + (qrow << 10) + h * DV;
#pragma unroll
        for (int d = 0; d < DV / 32; ++d)
#pragma unroll
            for (int g = 0; g < 4; ++g)
                *(u32x2*)(orow + d * 32 + 8 * g + 4 * hh) = (u32x2){pk_bf16(o[d][4 * g] * inv, o[d][4 * g + 1] * inv), pk_bf16(o[d][4 * g + 2] * inv, o[d][4 * g + 3] * inv)};
#undef ATT_TILE_ROW
#undef ATT_GLOAD
#undef ATT_LSTORE
    }
}

DI void s5_scan_phase(LAS unsigned char* lds, const Params& p, const bf16_t* H, float* YF, float* YB) {
    const int TIDX = otid(); const int BIDX = obid(); (void)TIDX; (void)BIDX;
    const int wave = __builtin_amdgcn_readfirstlane(TIDX >> 6), lane = TIDX & 63;
    LAS float* BU = (LAS float*)(lds + wave * 12800);
    LAS bf16_t* Hh = (LAS bf16_t*)(lds + wave * 12800 + 8448);
    const int l15 = lane & 15, l4 = lane >> 4;
    for (int item = BIDX * 8 + wave; item < NB * 2 * 64; item += gridDim.x * 8) {
        const int g = item & 63, dir = (item >> 6) & 1, b = item >> 7;
        const int pg = dir * 64 + g;
        const float dt = __expf(p.in[I_SLDT][pg]);
        const float* are = p.in[I_SARE] + pg * 64; const float* aim = p.in[I_SAIM] + pg * 64;
        float abr, abi;
        { const float ar = are[lane], ai = aim[lane]; const float mag = __expf(dt * ar); abr = mag * __cosf(dt * ai); abi = mag * __sinf(dt * ai); }
        bf16x8 bfr[8], cfr[4];
#pragma unroll
        for (int nt = 0; nt < 8; ++nt) {
            const int st = (nt & 3) * 16 + l15;
            const float ar = are[st], ai = aim[st]; const float mag = __expf(dt * ar);
            const float er = mag * __cosf(dt * ai), ei = mag * __sinf(dt * ai);
            const float den = ar * ar + ai * ai, nr = er - 1.f;
            const float fre = (nr * ar + ei * ai) / den, fim = (ei * ar - nr * ai) / den;
            float bb[8];
#pragma unroll
            for (int j = 0; j < 8; ++j) bb[j] = 0.f;
            if (lane < 32) {
                const float* br = p.in[I_SBRE] + ((size_t)pg * 64 + st) * 16 + l4 * 8; const float* bi = p.in[I_SBIM] + ((size_t)pg * 64 + st) * 16 + l4 * 8;
#pragma unroll
                for (int j = 0; j < 8; ++j) bb[j] = (nt < 4) ? (fre * br[j] - fim * bi[j]) : (fre * bi[j] + fim * br[j]);
            }
            bfr[nt] = __builtin_bit_cast(bf16x8, pack8(bb));
        }
#pragma unroll
        for (int kk = 0; kk < 4; ++kk) {
            const int k = (kk & 1) * 32 + l4 * 8;
            const float* cp = (kk < 2 ? p.in[I_SCRE] : p.in[I_SCIM]) + ((size_t)pg * 16 + l15) * 64 + k;
            float cc[8];
#pragma unroll
            for (int j = 0; j < 8; ++j) cc[j] = (kk < 2) ? cp[j] : -cp[j];
            cfr[kk] = __builtin_bit_cast(bf16x8, pack8(cc));
        }
        float* Y = dir ? YB : YF;
        float hr = 0.f, hi = 0.f;
        for (int j = 0; j < 144; ++j) {
            const int tb = dir ? (j < 16 ? 16 * (15 - j) : 256 + 16 * (143 - j)) : 16 * j;
            const size_t row0 = (size_t)b * TT + tb;
            bf16x8 uf = (bf16x8){0, 0, 0, 0, 0, 0, 0, 0};
            if (lane < 32) uf = *(const bf16x8*)(H + ((row0 + l15) << 10) + g * 16 + l4 * 8);
#pragma unroll
            for (int nt = 0; nt < 8; ++nt) {
                const f32x4 acc = __builtin_amdgcn_mfma_f32_16x16x32_bf16(uf, bfr[nt], (f32x4){0.f, 0.f, 0.f, 0.f}, 0, 0, 0);
#pragma unroll
                for (int i = 0; i < 4; ++i) BU[(l4 * 4 + i) * 132 + nt * 16 + l15] = acc[i];
            }
            float bur[16], bui[16];
#pragma unroll
            for (int tt = 0; tt < 16; ++tt) { bur[tt] = BU[tt * 132 + lane]; bui[tt] = BU[tt * 132 + 64 + lane]; }
#pragma unroll
            for (int tt = 0; tt < 16; ++tt) {
                const int tok = dir ? 15 - tt : tt;
                const float br_ = dir ? bur[15 - tt] : bur[tt], bi_ = dir ? bui[15 - tt] : bui[tt];
                const float nhr = abr * hr - abi * hi + br_, nhi = abr * hi + abi * hr + bi_;
                hr = nhr; hi = nhi;
                const unsigned pr = pk_bf16(hr, hi);
                Hh[tok * 136 + lane] = (bf16_t)(pr & 0xffffu); Hh[tok * 136 + 64 + lane] = (bf16_t)(pr >> 16);
            }
            f32x4 ya = (f32x4){0.f, 0.f, 0.f, 0.f};
#pragma unroll
            for (int kk = 0; kk < 4; ++kk) {
                const bf16x8 af = *(const LAS bf16x8*)(Hh + l15 * 136 + kk * 32 + l4 * 8);
                ya = __builtin_amdgcn_mfma_f32_16x16x32_bf16(af, cfr[kk], ya, 0, 0, 0);
            }
#pragma unroll
            for (int i = 0; i < 4; ++i) Y[((row0 + l4 * 4 + i) << 10) + g * 16 + l15] = ya[i];
        }
    }
}

DI void s5_combine(bf16_t* H, const float* YF, const float* YB, const float* dsk) {
    const int TIDX = otid(); const int BIDX = obid(); (void)TIDX; (void)BIDX;
    const int wave = TIDX >> 6, lane = TIDX & 63;
    for (int row = BIDX * 8 + wave; row < NR; row += gridDim.x * 8) {
#pragma unroll
        for (int hf = 0; hf < 2; ++hf) {
            const int c0 = hf * 512 + lane * 8; const size_t o = ((size_t)row << 10) + c0;
            float h[8]; unpack8(*(const u32x4*)(H + o), h);
            float y[8];
#pragma unroll
            for (int q = 0; q < 2; ++q) {
                const f32x4 f = *(const f32x4*)(YF + o + q * 4), bk = *(const f32x4*)(YB + o + q * 4), d = *(const f32x4*)(dsk + c0 + q * 4);
#pragma unroll
                for (int j = 0; j < 4; ++j) y[q * 4 + j] = gelu_tanh(d[j] * h[q * 4 + j] + f[j] + bk[j]);
            }
            *(u32x4*)(H + o) = pack8(y);
        }
    }
}

__global__ void __launch_bounds__(512, 2) mega(const Params p) {
    extern __shared__ __attribute__((aligned(16))) unsigned char shm[];
    LAS unsigned char* lds = (LAS unsigned char*)shm;
    cg::grid_group grid = cg::this_grid();
    unsigned char* ws = p.ws;
    float* ADA = (float*)(ws + OFF_ADA);
    float* XC = (float*)(ws + OFF_XC);
    bf16_t* HB = (bf16_t*)(ws + OFF_HB);
    float* LAT = p.out;
    int pid = 0;
#define PH_BEGIN if (pid >= p.ph_lo && pid < p.ph_hi) {
#define PH_END if (pid + 1 < p.ph_hi) grid.sync(); } ++pid;

    PH_BEGIN
    {
        LAS float* tile = (LAS float*)lds;
        for (int i = 0; i < 4; ++i) {
            prep_weight(tile, WDesc{p.in[I_FWIN] + (size_t)i * 1024 * 5632, (bf16_t*)(ws + OFF_WFI + i * SZ_WFI), 1024, 5632, 5632, 2816});
            prep_weight(tile, WDesc{p.in[I_FWOUT] + (size_t)i * 2816 * 1024, (bf16_t*)(ws + OFF_WFO + i * SZ_WFO), 2816, 1024, 1024, 0});
        }
        prep_weight(tile, WDesc{p.in[I_MWIN], (bf16_t*)(ws + OFF_WMI), 1024, 672, 768, 0});
        prep_weight(tile, WDesc{p.in[I_MWUQ], (bf16_t*)(ws + OFF_WUQ), 384, 1536, 1536, 0});
        prep_weight(tile, WDesc{p.in[I_MWUKV], (bf16_t*)(ws + OFF_WUKV), 256, 2048, 2048, 0});
        prep_weight(tile, WDesc{p.in[I_MWO], (bf16_t*)(ws + OFF_WMO), 1024, 1024, 1024, 0});
        prep_weight(tile, WDesc{p.in[I_SWGLU], (bf16_t*)(ws + OFF_WGLU), 1024, 2048, 2048, 1024});
        prep_weight(tile, WDesc{p.in[I_NWQKV], (bf16_t*)(ws + OFF_WNQ), 1024, 3072, 3072, 0});
        prep_weight(tile, WDesc{p.in[I_NWO], (bf16_t*)(ws + OFF_WNO), 1024, 1024, 1024, 0});
        prep_weight(tile, WDesc{p.in[I_GWQKV], (bf16_t*)(ws + OFF_WGQ), 1024, 1536, 1536, 0});
        prep_weight(tile, WDesc{p.in[I_GWO], (bf16_t*)(ws + OFF_WGO), 1024, 1024, 1024, 0});
        ada_phase(p, ADA);
    }
    PH_END

    for (int layer = 0; layer < 4; ++layer) {
        const float* ada = ADA + (size_t)layer * 33 * 6144;
        const int last = layer == 3;
        PH_BEGIN
        norm_phase(layer == 0 ? p.in[I_X] : LAT, layer == 0 ? p.in[I_CTX] : XC, LAT, XC, layer == 0, p.in[I_NMIX] + layer * 1024, ada, 0, HB, false);
        PH_END
        if (layer == 0) {
            bf16_t* Z = (bf16_t*)(ws + OFF_KV); bf16_t* KV = (bf16_t*)(ws + OFF_KV); bf16_t* QB = (bf16_t*)(ws + OFF_QB);
            bf16_t* CQN = (bf16_t*)(ws + OFF_CQN); bf16_t* CKVN = (bf16_t*)(ws + OFF_CKVN); bf16_t* KR = (bf16_t*)(ws + OFF_KR);
            PH_BEGIN
            run_gemm(lds, HB, (const bf16_t*)(ws + OFF_WMI), 768, 1024, 0, pg8::EpiStore{Z, 768, 0});
            PH_END
            PH_BEGIN
            mla_r1(Z, CQN, CKVN, KR, p.in[I_MGQ], p.in[I_MGKV]);
            PH_END
            PH_BEGIN
            run_gemm(lds, CQN, (const bf16_t*)(ws + OFF_WUQ), 1536, 384, 0, pg8::EpiStore{QB, 1536, 0});
            run_gemm(lds, CKVN, (const bf16_t*)(ws + OFF_WUKV), 2048, 256, 0, pg8::EpiStore{KV, 2560, 1});
            PH_END
            PH_BEGIN
            mla_r2(QB, KV, KR, p.in[I_MGQN], p.in[I_MGKN]);
            PH_END
            PH_BEGIN
            attn_phase<96, 64, 0>(lds, AttnArgs{QB, KV, KV + 96, HB, 1536, 96, 2560, 160, 2560, 160, 16, 0, 1, nullptr, 0.10206207261596575f * LOG2E});
            PH_END
            PH_BEGIN
            run_gemm(lds, HB, (const bf16_t*)(ws + OFF_WMO), 1024, 1024, 0, pg8::EpiRes{LAT, XC, ada, 2});
            PH_END
        } else if (layer == 1) {
            float* YF = (float*)(ws + OFF_BIG); float* YB = YF + (size_t)NR * 1024;
            PH_BEGIN
            s5_scan_phase(lds, p, HB, YF, YB);
            PH_END
            PH_BEGIN
            s5_combine(HB, YF, YB, p.in[I_SD]);
            PH_END
            PH_BEGIN
            run_gemm(lds, HB, (const bf16_t*)(ws + OFF_WGLU), 2048, 1024, 0, pg8::EpiGluRes{LAT, XC, ada, 2});
            PH_END
        } else if (layer == 2) {
            bf16_t* QKV = (bf16_t*)(ws + OFF_BIG);
            PH_BEGIN
            run_gemm(lds, HB, (const bf16_t*)(ws + OFF_WNQ), 3072, 1024, 0, pg8::EpiStore{QKV, 3072, 0});
            PH_END
            PH_BEGIN
            headnorm_phase<64, 4, 0>(QKV, 3072, 16, 1024, 16, p.in[I_NGQN], p.in[I_NGKN]);
            PH_END
            PH_BEGIN
            attn_phase<64, 64, 1>(lds, AttnArgs{QKV, QKV + 1024, QKV + 2048, HB, 3072, 64, 3072, 64, 3072, 64, 16, 0, 1, p.in[I_NRPB], 0.125f * LOG2E});
            PH_END
            PH_BEGIN
            run_gemm(lds, HB, (const bf16_t*)(ws + OFF_WNO), 1024, 1024, 0, pg8::EpiRes{LAT, XC, ada, 2});
            PH_END
        } else {
            bf16_t* QKV = (bf16_t*)(ws + OFF_BIG);
            PH_BEGIN
            run_gemm(lds, HB, (const bf16_t*)(ws + OFF_WGQ), 1536, 1024, 0, pg8::EpiStore{QKV, 1536, 0});
            PH_END
            PH_BEGIN
            headnorm_phase<128, 8, 1>(QKV, 1536, 8, 1024, 2, p.in[I_GGQN], p.in[I_GGKN]);
            PH_END
            PH_BEGIN
            attn_phase<128, 128, 0>(lds, AttnArgs{QKV, QKV + 1024, QKV + 1280, HB, 1536, 128, 1536, 128, 1536, 128, 8, 2, 0, nullptr, 0.08838834764831845f * LOG2E});
            PH_END
            PH_BEGIN
            run_gemm(lds, HB, (const bf16_t*)(ws + OFF_WGO), 1024, 1024, 1, pg8::EpiRes{LAT, XC, ada, 2});
            PH_END
        }
        bf16_t* ACT = (bf16_t*)(ws + OFF_BIG);
        PH_BEGIN
        norm_phase(LAT, XC, LAT, XC, false, p.in[I_NFFN] + layer * 1024, ada, 3, HB, last);
        PH_END
        PH_BEGIN
        run_gemm(lds, HB, (const bf16_t*)(ws + OFF_WFI + layer * SZ_WFI), 5632, 1024, last, pg8::EpiSwiglu{ACT, FH});
        PH_END
        PH_BEGIN
        run_gemm(lds, ACT, (const bf16_t*)(ws + OFF_WFO + layer * SZ_WFO), 1024, 2816, last, pg8::EpiRes{LAT, XC, ada, 5});
        PH_END
    }
}

extern "C" void kernel_launch(void* const* d_in, const int* in_sizes, int n_in, void* d_out, int out_size, void* d_ws, size_t ws_size, hipStream_t stream) {
    static int grid_blocks = 0;
    if (!grid_blocks) {
        hipFuncSetAttribute((const void*)mega, hipFuncAttributeMaxDynamicSharedMemorySize, LDS_BYTES);
        int dev = 0, cus = 0, per_cu = 0;
        hipGetDevice(&dev);
        hipDeviceGetAttribute(&cus, hipDeviceAttributeMultiprocessorCount, dev);
        hipOccupancyMaxActiveBlocksPerMultiprocessor(&per_cu, mega, 512, LDS_BYTES);
        if (per_cu < 1) per_cu = 1;
        grid_blocks = cus * 1;
    }
    if (ws_size < WS_NEED) fprintf(stderr, "workspace too small: %zu < %zu\n", ws_size, (size_t)WS_NEED);
    Params p; memset(&p, 0, sizeof(p));
    for (int i = 0; i < N_IN; ++i) p.in[i] = (const float*)d_in[i];
    p.out = (float*)d_out; p.ws = (unsigned char*)d_ws; p.ph_lo = 0; p.ph_hi = 1000;
    void* args[] = {&p};
    hipError_t e = hipLaunchCooperativeKernel((const void*)mega, dim3(grid_blocks), dim3(512), args, LDS_BYTES, stream);
    if (e != hipSuccess) fprintf(stderr, "cooperative launch failed: %s (grid %d)\n", hipGetErrorString(e), grid_blocks);
}
```

```cpp
#include <hip/hip_runtime.h>
#include <hip/hip_cooperative_groups.h>
#include <cstdio>
#include <cstring>
namespace cg = cooperative_groups;

#define DI __device__ __forceinline__
#define LAS __attribute__((address_space(3)))
typedef unsigned short bf16_t;
typedef short bf16x8 __attribute__((ext_vector_type(8)));
typedef short s16x4 __attribute__((ext_vector_type(4)));
typedef float f32x4 __attribute__((ext_vector_type(4)));
typedef float f32x16 __attribute__((ext_vector_type(16)));
typedef unsigned u32x4 __attribute__((ext_vector_type(4)));
typedef unsigned u32x2 __attribute__((ext_vector_type(2)));
typedef __bf16 bf2_t __attribute__((ext_vector_type(2)));
typedef float f2_t __attribute__((ext_vector_type(2)));

constexpr int NB = 32, SEQ = 2048, CTXL = 256, TT = 2304, NR = NB * TT, DM = 1024, FH = 2816;
constexpr float EPS = 1e-6f, LOG2E = 1.4426950408889634f, L2_10000 = 13.287712379549449f;
constexpr int LDS_BYTES = 131072 + 64;

enum { I_X, I_C, I_CTX, I_CCTX, I_ADAW, I_ADAB, I_NMIX, I_NFFN, I_FWIN, I_FWOUT,
       I_MWIN, I_MGQ, I_MGKV, I_MWUQ, I_MWUKV, I_MGQN, I_MGKN, I_MWO,
       I_SARE, I_SAIM, I_SLDT, I_SBRE, I_SBIM, I_SCRE, I_SCIM, I_SD, I_SWGLU,
       I_NWQKV, I_NGQN, I_NGKN, I_NRPB, I_NWO, I_GWQKV, I_GGQN, I_GGKN, I_GWO, N_IN };

constexpr size_t SZ_WFI = (size_t)5632 * 1024 * 2, SZ_WFO = (size_t)1024 * 2816 * 2;
constexpr size_t OFF_WFI = 0;
constexpr size_t OFF_WFO = OFF_WFI + 4 * SZ_WFI;
constexpr size_t OFF_WMI = OFF_WFO + 4 * SZ_WFO;
constexpr size_t OFF_WUQ = OFF_WMI + (size_t)768 * 1024 * 2;
constexpr size_t OFF_WUKV = OFF_WUQ + (size_t)1536 * 384 * 2;
constexpr size_t OFF_WMO = OFF_WUKV + (size_t)2048 * 256 * 2;
constexpr size_t OFF_WGLU = OFF_WMO + (size_t)1024 * 1024 * 2;
constexpr size_t OFF_WNQ = OFF_WGLU + (size_t)2048 * 1024 * 2;
constexpr size_t OFF_WNO = OFF_WNQ + (size_t)3072 * 1024 * 2;
constexpr size_t OFF_WGQ = OFF_WNO + (size_t)1024 * 1024 * 2;
constexpr size_t OFF_WGO = OFF_WGQ + (size_t)1536 * 1024 * 2;
constexpr size_t OFF_ADA = OFF_WGO + (size_t)1024 * 1024 * 2;
constexpr size_t OFF_XC = OFF_ADA + (size_t)4 * 33 * 6144 * 4;
constexpr size_t OFF_HB = OFF_XC + (size_t)NB * CTXL * 1024 * 4;
constexpr size_t OFF_BIG = OFF_HB + (size_t)NR * 1024 * 2;
constexpr size_t OFF_KV = OFF_BIG;
constexpr size_t OFF_QB = OFF_KV + (size_t)NR * 2560 * 2;
constexpr size_t OFF_Z = OFF_QB + (size_t)NR * 1536 * 2;
constexpr size_t OFF_BAR = OFF_Z + (size_t)NR * 768 * 2;
constexpr size_t WS_NEED = OFF_BAR + 16384;

struct Params {
    const float* in[N_IN];
    float* out;
    unsigned char* ws;
    int ph_lo, ph_hi;
};

DI unsigned pk_bf16(float a, float b) { f2_t v = {a, b}; bf2_t r = __builtin_convertvector(v, bf2_t); return __builtin_bit_cast(unsigned, r); }
DI float bf_lo(unsigned u) { return __uint_as_float(u << 16); }
DI float bf_hi(unsigned u) { return __uint_as_float(u & 0xffff0000u); }
DI float wsum(float v) {
#pragma unroll
    for (int o = 32; o > 0; o >>= 1) v += __shfl_xor(v, o);
    return v;
}
DI int otid() { int t = threadIdx.x; asm volatile("" : "+v"(t)); return t; }
DI int obid() { int b = blockIdx.x; asm volatile("" : "+s"(b)); return b; }
DI int clampi(int v, int lo, int hi) { return v < lo ? lo : (v > hi ? hi : v); }
DI float fexp2(float x) { return __builtin_amdgcn_exp2f(x); }
DI float frcp(float x) { return __builtin_amdgcn_rcpf(x); }
DI float silu_f(float a) { return a * frcp(1.f + __expf(-a)); }
DI float sigmoid_f(float a) { return frcp(1.f + __expf(-a)); }
DI float gelu_tanh(float y) {
    const float z = 0.7978845608028654f * (y + 0.044715f * y * y * y);
    const float t = 1.f - 2.f * frcp(__expf(2.f * z) + 1.f);
    return 0.5f * y * (1.f + t);
}
DI void unpack8(const u32x4 u, float* f) {
#pragma unroll
    for (int i = 0; i < 4; ++i) { f[2 * i] = bf_lo(u[i]); f[2 * i + 1] = bf_hi(u[i]); }
}
DI u32x4 pack8(const float* f) { return (u32x4){pk_bf16(f[0], f[1]), pk_bf16(f[2], f[3]), pk_bf16(f[4], f[5]), pk_bf16(f[6], f[7])}; }

namespace pg8 {
constexpr int BM = 256, BK = 64, HALF = 128, HTB = HALF * BK * 2, NXCD = 8, WGM = 8;
DI int lds_byte(int r, int c) { const int st = (r >> 4) * 2 + (c >> 5), rr = r & 15, cc = c & 31, ob = rr * 64 + cc * 2; return st * 1024 + (ob ^ (((ob >> 9) & 1) << 5)); }
DI void stage_rc(int b, int& R, int& C) { const int st = b / 1024, sb = b % 1024, swz = sb ^ (((sb >> 9) & 1) << 5); R = (st >> 1) * 16 + swz / 64; C = (st & 1) * 32 + (swz % 64) / 2; }
DI int perm32(int rho) { const int n = rho >> 4, i = rho & 15; return 8 * (i >> 2) + 4 * n + (i & 3); }
struct Unit { int pm, pn; };
struct Gemm { const bf16_t* A; const bf16_t* Bt; int M, N, K, lda; };
struct Order {
    int nM, nN, nwg, G, c, skip;
    DI void init(int N, int G_, int c_, int skipctx) { skip = skipctx; nM = skipctx ? 256 : 288; nN = N / BM; nwg = nM * nN; G = G_; c = c_; }
    DI bool next(int i, Unit& u) const {
        const long L = (long)i * G + c; if (L >= nwg) return false;
        int wgid = (int)L; { const int q = nwg / NXCD, r = nwg % NXCD, xcd = wgid % NXCD, off = wgid / NXCD; wgid = (xcd < r ? xcd * (q + 1) : r * (q + 1) + (xcd - r) * q) + off; }
        const int nig = WGM * nN, gid = wgid / nig, fm = gid * WGM, gsz = (nM - fm) < WGM ? (nM - fm) : WGM;
        int pm = fm + ((wgid % nig) % gsz); u.pn = (wgid % nig) / gsz;
        if (skip) pm = pm + (pm >> 3) + 1;
        u.pm = pm; return true;
    }
};

DI float* tile_res_base(float* lat, float* xc, int pm) { const int bb = pm / 9, sub = pm - bb * 9; return sub == 0 ? xc + ((size_t)bb * CTXL << 10) : lat + ((size_t)(bb * SEQ + (sub - 1) * 256) << 10); }
DI int tile_ada_row(int pm) { const int bb = pm / 9, sub = pm - bb * 9; return sub == 0 ? 32 : bb; }

struct EpiStore {
    static constexpr bool PERM = true;
    bf16_t* O; int ldc; int remap;
    DI void operator()(const f32x4 (&acc)[2][2][4][2], const Unit& u, int wr, int wc, int fr, int fq) const {
        const int row0 = u.pm * BM + wr * 64 + fr, col0 = u.pn * BM + wc * 32 + 8 * fq;
#pragma unroll
        for (int ai = 0; ai < 2; ++ai)
#pragma unroll
            for (int m = 0; m < 4; ++m) {
                bf16_t* rowp = O + (size_t)(row0 + ai * HALF + m * 16) * ldc;
#pragma unroll
                for (int bj = 0; bj < 2; ++bj) {
                    const int c = col0 + bj * HALF; const int cc = remap ? (c >> 7) * 160 + (c & 127) : c;
                    const f32x4 v0 = acc[ai][bj][m][0], v1 = acc[ai][bj][m][1];
                    *(u32x4*)(rowp + cc) = (u32x4){pk_bf16(v0[0], v0[1]), pk_bf16(v0[2], v0[3]), pk_bf16(v1[0], v1[1]), pk_bf16(v1[2], v1[3])};
                }
            }
    }
};
struct EpiSwiglu {
    static constexpr bool PERM = true;
    bf16_t* O; int ldc;
    DI void operator()(const f32x4 (&acc)[2][2][4][2], const Unit& u, int wr, int wc, int fr, int fq) const {
        const int row0 = u.pm * BM + wr * 64 + fr, col0 = u.pn * HALF + wc * 32 + 8 * fq;
#pragma unroll
        for (int ai = 0; ai < 2; ++ai)
#pragma unroll
            for (int m = 0; m < 4; ++m) {
                float v[8];
#pragma unroll
                for (int n = 0; n < 2; ++n)
#pragma unroll
                    for (int i = 0; i < 4; ++i) v[n * 4 + i] = silu_f(acc[ai][0][m][n][i]) * acc[ai][1][m][n][i];
                *(u32x4*)(O + (size_t)(row0 + ai * HALF + m * 16) * ldc + col0) = pack8(v);
            }
    }
};
struct EpiGluRes {
    static constexpr bool PERM = true;
    float* lat; float* xc; const float* ada; int gidx;
    DI void operator()(const f32x4 (&acc)[2][2][4][2], const Unit& u, int wr, int wc, int fr, int fq) const {
        float* base = tile_res_base(lat, xc, u.pm);
        const float* gate = ada + (size_t)tile_ada_row(u.pm) * 6144 + gidx * 1024;
        const int col0 = u.pn * HALF + wc * 32 + 8 * fq;
        const f32x4 g0 = *(const f32x4*)(gate + col0), g1 = *(const f32x4*)(gate + col0 + 4);
#pragma unroll
        for (int ai = 0; ai < 2; ++ai)
#pragma unroll
            for (int m = 0; m < 4; ++m) {
                float* rp = base + ((size_t)(ai * HALF + wr * 64 + m * 16 + fr) << 10) + col0;
                f32x4 x0 = *(f32x4*)rp, x1 = *(f32x4*)(rp + 4);
#pragma unroll
                for (int i = 0; i < 4; ++i) {
                    x0[i] += g0[i] * (acc[ai][0][m][0][i] * sigmoid_f(acc[ai][1][m][0][i]));
                    x1[i] += g1[i] * (acc[ai][0][m][1][i] * sigmoid_f(acc[ai][1][m][1][i]));
                }
                *(f32x4*)rp = x0; *(f32x4*)(rp + 4) = x1;
            }
    }
};
struct EpiRes {
    static constexpr bool PERM = false;
    float* lat; float* xc; const float* ada; int gidx;
    DI void operator()(const f32x4 (&acc)[2][2][4][2], const Unit& u, int wr, int wc, int fr, int fq) const {
        float* base = tile_res_base(lat, xc, u.pm);
        const float* gate = ada + (size_t)tile_ada_row(u.pm) * 6144 + gidx * 1024;
        const int col0 = u.pn * BM + wc * 32 + 4 * fq;
        f32x4 gv[2][2];
#pragma unroll
        for (int bj = 0; bj < 2; ++bj)
#pragma unroll
            for (int n = 0; n < 2; ++n) gv[bj][n] = *(const f32x4*)(gate + col0 + bj * HALF + n * 16);
#pragma unroll
        for (int ai = 0; ai < 2; ++ai)
#pragma unroll
            for (int m = 0; m < 4; ++m) {
                float* rp = base + ((size_t)(ai * HALF + wr * 64 + m * 16 + fr) << 10) + col0;
#pragma unroll
                for (int bj = 0; bj < 2; ++bj)
#pragma unroll
                    for (int n = 0; n < 2; ++n) {
                        f32x4 x = *(f32x4*)(rp + bj * HALF + n * 16);
                        x += gv[bj][n] * acc[ai][bj][m][n];
                        *(f32x4*)(rp + bj * HALF + n * 16) = x;
                    }
            }
    }
};

template <class Epi>
DI void gemm_phase(LAS unsigned char* lds, const Gemm g, const Order& S, const Epi& E) {
    const int TIDX = otid(); const int BIDX = obid(); (void)TIDX; (void)BIDX;
    const int tid = TIDX, wid = __builtin_amdgcn_readfirstlane(tid >> 6), lane = tid & 63, wr = wid >> 2, wc = wid & 3, fr = lane & 15, fq = lane >> 4;
    const int K = g.K, nt = K / BK;
    unsigned voffA[2], voffB[2];
#pragma unroll
    for (int i = 0; i < 2; ++i) { int R, C; stage_rc(tid * 16 + i * 8192, R, C); const int Rb = Epi::PERM ? ((R & ~31) + perm32(R & 31)) : R;
        voffA[i] = (unsigned)(R * g.lda + C) * 2u; voffB[i] = (unsigned)(Rb * K + C) * 2u; }
    const size_t kstep = (size_t)(BK * 2);
    const size_t hstep = (size_t)HALF * K * 2, hstepA = (size_t)HALF * g.lda * 2;
    const size_t tstep = 2 * hstep, tstepA = 2 * hstepA;
    const unsigned ldsw = (unsigned)wid * 1024u;
    const int aoff = lds_byte(wr * 64 + fr, fq * 8), boff = lds_byte(wc * 32 + fr, fq * 8);
#define PG8_SA(b, h) (((b) * 2 + (h)) * HTB)
#define PG8_SB(b, h) ((4 + (b) * 2 + (h)) * HTB)
#define PG8_STAGE(bufoff, gbase, voff) do { _Pragma("unroll") for (int _i = 0; _i < 2; ++_i) \
        __builtin_amdgcn_global_load_lds((const unsigned*)((const char*)(gbase) + (voff)[_i]), (LAS unsigned*)(lds + (bufoff) + ldsw + _i * 8192), 16, 0, 0); } while (0)
#define PG8_LDA(dst, b, h) do { _Pragma("unroll") for (int m = 0; m < 4; ++m) _Pragma("unroll") for (int k = 0; k < 2; ++k) dst[m][k] = *(const LAS bf16x8*)(lds + PG8_SA(b, h) + aoff + m * 2048 + k * 1024); } while (0)
#define PG8_LDB(dst, b, h) do { _Pragma("unroll") for (int n = 0; n < 2; ++n) _Pragma("unroll") for (int k = 0; k < 2; ++k) dst[n][k] = *(const LAS bf16x8*)(lds + PG8_SB(b, h) + boff + n * 2048 + k * 1024); } while (0)
#define PG8_MMA(ai, bj, At, Bt) do { __builtin_amdgcn_s_setprio(1); _Pragma("unroll") for (int m = 0; m < 4; ++m) _Pragma("unroll") for (int n = 0; n < 2; ++n) _Pragma("unroll") for (int k = 0; k < 2; ++k) \
        acc[ai][bj][m][n] = __builtin_amdgcn_mfma_f32_16x16x32_bf16(Bt[n][k], At[m][k], acc[ai][bj][m][n], 0, 0, 0); __builtin_amdgcn_s_setprio(0); } while (0)
#define PG8_WAIT_V(n) asm volatile("s_waitcnt vmcnt(" #n ")" ::: "memory")
#define PG8_WAIT_L(n) asm volatile("s_waitcnt lgkmcnt(" #n ")" ::: "memory")
#define PG8_BAR __builtin_amdgcn_s_barrier()
#define PG8_SCHED __builtin_amdgcn_sched_barrier(0)
    Unit cur, nxt; int ui = 0;
    if (!S.next(0, cur)) return;
    f32x4 acc[2][2][4][2];
#pragma unroll
    for (int a = 0; a < 2; ++a)
#pragma unroll
        for (int b = 0; b < 2; ++b)
#pragma unroll
            for (int m = 0; m < 4; ++m)
#pragma unroll
                for (int n = 0; n < 2; ++n) acc[a][b][m][n] = (f32x4){0.f, 0.f, 0.f, 0.f};
    bf16x8 At[4][2], B0[2][2], B1[2][2];
    const char* cA = (const char*)g.A + (size_t)cur.pm * tstepA; const char* cB = (const char*)g.Bt + (size_t)cur.pn * tstep;
    PG8_STAGE(PG8_SB(0, 0), cB, voffB); PG8_STAGE(PG8_SA(0, 0), cA, voffA); PG8_STAGE(PG8_SB(0, 1), cB + hstep, voffB); PG8_STAGE(PG8_SA(0, 1), cA + hstepA, voffA);
    if (wr == 1) PG8_BAR;
    PG8_WAIT_V(4); PG8_BAR;
    PG8_STAGE(PG8_SB(1, 0), cB + kstep, voffB); PG8_STAGE(PG8_SA(1, 0), cA + kstep, voffA); PG8_STAGE(PG8_SB(1, 1), cB + hstep + kstep, voffB);
    PG8_WAIT_V(6); PG8_BAR;
    for (;;) {
        const bool has_next = S.next(ui + 1, nxt);
        const char* nA = has_next ? (const char*)g.A + (size_t)nxt.pm * tstepA : cA; const char* nB = has_next ? (const char*)g.Bt + (size_t)nxt.pn * tstep : cB;
        for (int t = 0; t < nt; t += 2) {
            const bool last = (t == nt - 2);
            const char* a1 = cA + (size_t)(t + 1) * kstep;
            const char* a2 = last ? nA : cA + (size_t)(t + 2) * kstep; const char* b2 = last ? nB : cB + (size_t)(t + 2) * kstep;
            const char* a3 = a2 + kstep; const char* b3 = b2 + kstep;
            PG8_LDB(B0, 0, 0); PG8_SCHED; PG8_LDA(At, 0, 0); PG8_STAGE(PG8_SA(1, 1), a1 + hstepA, voffA);
            PG8_WAIT_L(8); PG8_BAR; PG8_WAIT_L(0); PG8_MMA(0, 0, At, B0); PG8_BAR; PG8_SCHED;
            PG8_LDB(B1, 0, 1); PG8_STAGE(PG8_SB(0, 0), b2, voffB);
            PG8_BAR; PG8_WAIT_L(0); PG8_MMA(0, 1, At, B1); PG8_BAR;
            PG8_LDA(At, 0, 1); PG8_STAGE(PG8_SA(0, 0), a2, voffA);
            PG8_BAR; PG8_WAIT_L(0); PG8_MMA(1, 0, At, B0); PG8_BAR; PG8_SCHED;
            PG8_STAGE(PG8_SB(0, 1), b2 + hstep, voffB);
            PG8_WAIT_V(6); PG8_BAR; PG8_MMA(1, 1, At, B1); PG8_BAR;
            PG8_LDB(B0, 1, 0); PG8_SCHED; PG8_LDA(At, 1, 0); PG8_STAGE(PG8_SA(0, 1), a2 + hstepA, voffA);
            PG8_WAIT_L(8); PG8_BAR; PG8_WAIT_L(0); PG8_MMA(0, 0, At, B0); PG8_BAR; PG8_SCHED;
            PG8_LDB(B1, 1, 1); PG8_STAGE(PG8_SB(1, 0), b3, voffB);
            PG8_BAR; PG8_WAIT_L(0); PG8_MMA(0, 1, At, B1); PG8_BAR;
            PG8_LDA(At, 1, 1); PG8_STAGE(PG8_SA(1, 0), a3, voffA);
            PG8_BAR; PG8_WAIT_L(0); PG8_MMA(1, 0, At, B0); PG8_BAR; PG8_SCHED;
            PG8_STAGE(PG8_SB(1, 1), b3 + hstep, voffB);
            PG8_WAIT_V(6); PG8_BAR; PG8_MMA(1, 1, At, B1); PG8_BAR;
        }
        E(acc, cur, wr, wc, fr, fq);
        if (!has_next) break;
#pragma unroll
        for (int a = 0; a < 2; ++a)
#pragma unroll
            for (int b = 0; b < 2; ++b)
#pragma unroll
                for (int m = 0; m < 4; ++m)
#pragma unroll
                    for (int n = 0; n < 2; ++n) acc[a][b][m][n] = (f32x4){0.f, 0.f, 0.f, 0.f};
        cur = nxt; cA = nA; cB = nB; ++ui;
    }
    PG8_WAIT_V(0);
    if (wr == 0) PG8_BAR;
    PG8_BAR;
#undef PG8_SA
#undef PG8_SB
#undef PG8_STAGE
#undef PG8_LDA
#undef PG8_LDB
#undef PG8_MMA
#undef PG8_WAIT_V
#undef PG8_WAIT_L
#undef PG8_BAR
#undef PG8_SCHED
}
}

template <class Epi>
DI void run_gemm(LAS unsigned char* lds, const bf16_t* A, int lda, const bf16_t* Bt, int N, int K, int skipctx, const Epi& E) {
    const int BIDX = obid();
    pg8::Order S; S.init(N, (int)gridDim.x, BIDX, skipctx);
    pg8::Gemm g{A, Bt, NR, N, K, lda};
    pg8::gemm_phase<Epi>(lds, g, S, E);
}

struct WDesc { const float* src; bf16_t* dst; int K, N, Nout, half; const float* kscale; };
DI void prep_weight(LAS float* tile, const WDesc w) {
    const int TIDX = otid(); const int BIDX = obid(); (void)TIDX; (void)BIDX;
    const int tid = TIDX;
    const int ntk = w.K / 64, ntn = w.Nout / 64;
    for (int tidx = BIDX; tidx < ntk * ntn; tidx += gridDim.x) {
        const int kt = tidx % ntk, nt = tidx / ntk;
        const int n0 = nt * 64;
        int scol = n0;
        if (w.half) { const int t256 = n0 >> 8, ww = n0 & 255; scol = (ww >= 128 ? w.half : 0) + t256 * 128 + (ww & 127); }
        const int c4 = (tid & 15) * 4;
#pragma unroll
        for (int rr = 0; rr < 2; ++rr) {
            const int r = (tid >> 4) + rr * 32;
            f32x4 v = (f32x4){0.f, 0.f, 0.f, 0.f};
            if (scol + c4 < w.N) v = *(const f32x4*)(w.src + (size_t)(kt * 64 + r) * w.N + scol + c4);
            if (w.kscale) v *= w.kscale[kt * 64 + r];
#pragma unroll
            for (int i = 0; i < 4; ++i) tile[r * 65 + c4 + i] = v[i];
        }
        __syncthreads();
        {
            const int n = tid >> 3, kc = (tid & 7) * 8;
            float f[8];
#pragma unroll
            for (int i = 0; i < 8; ++i) f[i] = tile[(kc + i) * 65 + n];
            *(u32x4*)(w.dst + (size_t)(n0 + n) * w.K + kt * 64 + kc) = pack8(f);
        }
        __syncthreads();
    }
}

DI void ada_phase(const Params& p, float* ADA) {
    const int TIDX = otid(); const int BIDX = obid(); (void)TIDX; (void)BIDX;
    const int wave = __builtin_amdgcn_readfirstlane(TIDX >> 6), lane = TIDX & 63;
    const int gw = BIDX * 8 + wave, nw = gridDim.x * 8;
    const int v = lane < 33 ? lane : 32;
    const float* cv = v < 32 ? p.in[I_C] + v * 1024 : p.in[I_CCTX];
    for (int item = gw; item < 4 * 384; item += nw) {
        const int layer = item / 384, n0 = (item - layer * 384) * 16;
        const float* W = p.in[I_ADAW] + (size_t)layer * 1024 * 6144 + n0;
        float acc[16];
#pragma unroll
        for (int n = 0; n < 16; ++n) acc[n] = 0.f;
        for (int k0 = 0; k0 < 1024; k0 += 8) {
            float s[8];
            const f32x4 c0 = *(const f32x4*)(cv + k0), c1 = *(const f32x4*)(cv + k0 + 4);
#pragma unroll
            for (int i = 0; i < 4; ++i) { s[i] = silu_f(c0[i]); s[4 + i] = silu_f(c1[i]); }
#pragma unroll
            for (int kk = 0; kk < 8; ++kk) {
                const float* wr_ = W + (size_t)(k0 + kk) * 6144;
#pragma unroll
                for (int n = 0; n < 16; ++n) acc[n] += s[kk] * wr_[n];
            }
        }
        if (lane < 33) {
            float* o = ADA + ((size_t)layer * 33 + lane) * 6144 + n0;
            const float* bb = p.in[I_ADAB] + layer * 6144 + n0;
#pragma unroll
            for (int n = 0; n < 16; ++n) o[n] = acc[n] + bb[n];
        }
    }
}

DI void norm_phase(const float* lat_in, const float* ctx_in, float* lat_out, float* ctx_out, bool copy, const float* g,
                   const float* ada, int shidx, bf16_t* H, bool skipctx) {
    const int TIDX = otid(); const int BIDX = obid(); (void)TIDX; (void)BIDX;
    const int wave = TIDX >> 6, lane = TIDX & 63;
    for (int row = BIDX * 8 + wave; row < NR; row += gridDim.x * 8) {
        const int b = row / TT, t = row - b * TT;
        if (skipctx && t < CTXL) continue;
        const size_t ro = t < CTXL ? ((size_t)(b * CTXL + t) << 10) : ((size_t)(b * SEQ + t - CTXL) << 10);
        const float* src = (t < CTXL ? ctx_in : lat_in) + ro;
        const float* sh = ada + (size_t)(t < CTXL ? 32 : b) * 6144 + shidx * 1024;
        const float* sc = sh + 1024;
        f32x4 a[4];
        a[0] = *(const f32x4*)(src + lane * 8); a[1] = *(const f32x4*)(src + lane * 8 + 4);
        a[2] = *(const f32x4*)(src + 512 + lane * 8); a[3] = *(const f32x4*)(src + 512 + lane * 8 + 4);
        float ss = 0.f;
#pragma unroll
        for (int i = 0; i < 4; ++i)
#pragma unroll
            for (int j = 0; j < 4; ++j) ss += a[i][j] * a[i][j];
        ss = wsum(ss);
        const float r = rsqrtf(ss * (1.f / 1024.f) + EPS);
        if (copy) {
            float* dst = (t < CTXL ? ctx_out : lat_out) + ro;
            *(f32x4*)(dst + lane * 8) = a[0]; *(f32x4*)(dst + lane * 8 + 4) = a[1];
            *(f32x4*)(dst + 512 + lane * 8) = a[2]; *(f32x4*)(dst + 512 + lane * 8 + 4) = a[3];
        }
#pragma unroll
        for (int hf = 0; hf < 2; ++hf) {
            const int c0 = hf * 512 + lane * 8;
            float y[8];
#pragma unroll
            for (int q = 0; q < 2; ++q) {
                const f32x4 gv = *(const f32x4*)(g + c0 + q * 4), sv = *(const f32x4*)(sc + c0 + q * 4), hv = *(const f32x4*)(sh + c0 + q * 4);
#pragma unroll
                for (int j = 0; j < 4; ++j) y[q * 4 + j] = a[hf * 2 + q][j] * r * gv[j] * (1.f + sv[j]) + hv[j];
            }
            *(u32x4*)(H + ((size_t)row << 10) + c0) = pack8(y);
        }
    }
}

DI void mla_rope8(float* v, int sub, int s) {
    const float pos = (float)((sub < 2) ? (s >> 6) : (s & 63));
    const bool isx2 = sub & 1;
#pragma unroll
    for (int i = 0; i < 8; ++i) {
        const float other = __shfl_xor(v[i], 1);
        const float ang = pos * fexp2(-(float)i * (L2_10000 / 8.f));
        const float c = __cosf(ang), sn = __sinf(ang);
        v[i] = isx2 ? (other * sn + v[i] * c) : (v[i] * c - other * sn);
    }
}

DI void mla_r2(bf16_t* QB, bf16_t* KV, const bf16_t* Z, const float* gqn, const float* gkn) {
    const int TIDX = otid(); const int BIDX = obid(); (void)TIDX; (void)BIDX;
    const int wave = TIDX >> 6, lane = TIDX & 63, hd = lane >> 2, sub = lane & 3;
    for (int row = BIDX * 8 + wave; row < NR; row += gridDim.x * 8) {
        const int b = row / TT, t = row - b * TT; const bool latent = t >= CTXL; const int s = t - CTXL;
        const bf16_t* z = Z + (size_t)row * 768;
        bf16_t* qp = QB + (size_t)row * 1536 + hd * 96;
        bf16_t* kp = KV + (size_t)row * 2560 + hd * 160;
        unsigned zq[3];
#pragma unroll
        for (int i = 0; i < 3; ++i) zq[i] = *(const unsigned*)(z + lane * 6 + 2 * i);
        const u32x2 zk = *(const u32x2*)(z + 384 + lane * 4);
        const u32x4 q0 = *(const u32x4*)(qp + sub * 16), q1 = *(const u32x4*)(qp + sub * 16 + 8), q2 = *(const u32x4*)(qp + 64 + sub * 8);
        const u32x4 k0 = *(const u32x4*)(kp + sub * 16), k1 = *(const u32x4*)(kp + sub * 16 + 8);
        const u32x4 v0 = *(const u32x4*)(kp + 64 + sub * 16), v1 = *(const u32x4*)(kp + 64 + sub * 16 + 8);
        const u32x4 k2 = *(const u32x4*)(z + 640 + sub * 8);
        asm volatile("s_waitcnt vmcnt(0)" ::: "memory");
        float sq0 = 0.f, sk0 = 0.f;
#pragma unroll
        for (int i = 0; i < 3; ++i) { const float a0 = bf_lo(zq[i]), a1 = bf_hi(zq[i]); sq0 += a0 * a0 + a1 * a1; }
        { const float a0 = bf_lo(zk[0]), a1 = bf_hi(zk[0]), a2 = bf_lo(zk[1]), a3 = bf_hi(zk[1]); sk0 = a0 * a0 + a1 * a1 + a2 * a2 + a3 * a3; }
        sq0 = wsum(sq0); sk0 = wsum(sk0);
        const float rq0 = rsqrtf(sq0 * (1.f / 384.f) + EPS), rk0 = rsqrtf(sk0 * (1.f / 256.f) + EPS);
        float qn[16], qr[8], kn[16], kr[8], vv[16];
        unpack8(q0, qn); unpack8(q1, qn + 8); unpack8(q2, qr);
        unpack8(k0, kn); unpack8(k1, kn + 8); unpack8(k2, kr);
        unpack8(v0, vv); unpack8(v1, vv + 8);
#pragma unroll
        for (int i = 0; i < 16; ++i) { qn[i] *= rq0; kn[i] *= rk0; vv[i] *= rk0; }
#pragma unroll
        for (int i = 0; i < 8; ++i) qr[i] *= rq0;
        float sq = 0.f, sk = 0.f;
#pragma unroll
        for (int i = 0; i < 16; ++i) { sq += qn[i] * qn[i]; sk += kn[i] * kn[i]; }
#pragma unroll
        for (int i = 0; i < 8; ++i) { sq += qr[i] * qr[i]; sk += kr[i] * kr[i]; }
        sq += __shfl_xor(sq, 1); sq += __shfl_xor(sq, 2);
        sk += __shfl_xor(sk, 1); sk += __shfl_xor(sk, 2);
        const float rq = rsqrtf(sq * (1.f / 96.f) + EPS), rk = rsqrtf(sk * (1.f / 96.f) + EPS);
#pragma unroll
        for (int i = 0; i < 16; ++i) { qn[i] *= rq * gqn[sub * 16 + i]; kn[i] *= rk * gkn[sub * 16 + i]; }
#pragma unroll
        for (int i = 0; i < 8; ++i) { qr[i] *= rq * gqn[64 + sub * 8 + i]; kr[i] *= rk * gkn[64 + sub * 8 + i]; }
        if (latent) { mla_rope8(qr, sub, s); mla_rope8(kr, sub, s); }
        *(u32x4*)(qp + sub * 16) = pack8(qn); *(u32x4*)(qp + sub * 16 + 8) = pack8(qn + 8); *(u32x4*)(qp + 64 + sub * 8) = pack8(qr);
        *(u32x4*)(kp + sub * 16) = pack8(kn); *(u32x4*)(kp + sub * 16 + 8) = pack8(kn + 8); *(u32x4*)(kp + 64 + sub * 8) = pack8(kr);
        *(u32x4*)(kp + 96 + sub * 16) = pack8(vv); *(u32x4*)(kp + 96 + sub * 16 + 8) = pack8(vv + 8);
    }
}

template <int HD, int LPH, int ROPE>
DI void headnorm_phase(bf16_t* X, int stride, int nq, int koff, int nk, const float* gq, const float* gk) {
    const int TIDX = otid(); const int BIDX = obid(); (void)TIDX; (void)BIDX;
    constexpr int HPP = 64 / LPH;
    const int wave = TIDX >> 6, lane = TIDX & 63, sub = lane % LPH, hl = lane / LPH;
    for (int row = BIDX * 8 + wave; row < NR; row += gridDim.x * 8) {
        const int b = row / TT, t = row - b * TT; const bool latent = t >= CTXL; const int s = t - CTXL;
        for (int pass = 0; pass < 2; ++pass) {
            const int nh = pass ? nk : nq, base = pass ? koff : 0; const float* g = pass ? gk : gq;
            for (int h0 = 0; h0 < nh; h0 += HPP) {
                const int hd = h0 + hl; const bool act = hd < nh;
                bf16_t* ptr = X + (size_t)row * stride + base + hd * HD + sub * 16;
                u32x4 u0 = (u32x4){0, 0, 0, 0}, u1 = (u32x4){0, 0, 0, 0};
                if (act) { u0 = *(const u32x4*)ptr; u1 = *(const u32x4*)(ptr + 8); }
                float v[16]; unpack8(u0, v); unpack8(u1, v + 8);
                float ss = 0.f;
#pragma unroll
                for (int i = 0; i < 16; ++i) ss += v[i] * v[i];
#pragma unroll
                for (int o = 1; o < LPH; o <<= 1) ss += __shfl_xor(ss, o);
                const float rr = rsqrtf(ss * (1.f / HD) + EPS);
#pragma unroll
                for (int i = 0; i < 16; ++i) v[i] *= rr * g[sub * 16 + i];
                if (ROPE) {
                    if (latent) {
                        const int axis = sub >> 2; const bool isx2 = (sub >> 1) & 1;
                        const float pos = (float)(axis ? (s & 63) : (s >> 6));
#pragma unroll
                        for (int i = 0; i < 16; ++i) {
                            const float other = __shfl_xor(v[i], 2);
                            const int fi = (sub & 1) * 16 + i;
                            const float ang = pos * fexp2(-(float)fi * (L2_10000 / 32.f));
                            const float c = __cosf(ang), sn = __sinf(ang);
                            v[i] = isx2 ? (other * sn + v[i] * c) : (v[i] * c - other * sn);
                        }
                    }
                }
                if (act) { *(u32x4*)ptr = pack8(v); *(u32x4*)(ptr + 8) = pack8(v + 8); }
            }
        }
    }
}

struct AttnArgs { const bf16_t* Q; const bf16_t* K; const bf16_t* V; bf16_t* O; int qs, qh, ks, kh, vs, vh, nheads, gshift, ctx_out; const float* rpb; float sc; };

template <int DK, int DV, int NA>
DI void attn_phase(LAS unsigned char* lds, const AttnArgs a) {
    const int TIDX = otid(); const int BIDX = obid(); (void)TIDX; (void)BIDX;
    constexpr int KROW = DK * 2 + 16, VROW = DV * 2 + 16;
    constexpr int KBUF = 64 * KROW, VBUF = 64 * VROW;
    constexpr int OFFK = 0, OFFV = 2 * KBUF, OFFR = OFFV + 2 * VBUF;
    constexpr int KCH = DK / 8, VCH = DV / 8, NKC = 64 * KCH, NVC = 64 * VCH;
    constexpr int KPT = (NKC + 511) / 512, VPT = (NVC + 511) / 512;
    const int tid = TIDX, wave = __builtin_amdgcn_readfirstlane(tid >> 6), lane = tid & 63, r = lane & 31, hh = lane >> 5;
    const int i16 = lane & 15, tq = i16 >> 2, tp = i16 & 3, blk = (lane >> 4) & 1;
    const int nlat = NB * a.nheads * 8, ntot = nlat + (a.ctx_out ? NB * a.nheads : 0);
    LAS float* rpbL = (LAS float*)(lds + OFFR);
    for (int item = BIDX; item < ntot; item += gridDim.x) {
        int b, h, qb = 0; const bool isctx = item >= nlat;
        if (!isctx) { qb = item & 7; const int bh = item >> 3; h = bh % a.nheads; b = bh / a.nheads; }
        else { const int bh = item - nlat; h = bh % a.nheads; b = bh / a.nheads; }
        const int hk = h >> a.gshift;
        const size_t rb = (size_t)b * TT;
        const bf16_t* Kb = a.K + hk * a.kh; const bf16_t* Vb = a.V + hk * a.vh;
        int ntiles = isctx ? 4 : 36, rlo = 0, wi = 0, wr0 = 0, c0 = 0;
        if (NA) {
            if (!isctx) { const int i0 = qb * 4; rlo = clampi(i0 - 4, 0, 24); const int rhi = clampi(i0 - 1, 0, 24) + 8; ntiles = 4 + rhi - rlo;
                wi = i0 + (wave >> 1); wr0 = clampi(wi - 4, 0, 24); c0 = (wave & 1) * 32; }
            if (tid < 465) rpbL[tid] = a.rpb[h * 465 + tid] * LOG2E;
        }
        const size_t qrow = rb + (isctx ? 0 : 256 + qb * 256) + wave * 32 + r;
        bf16x8 qf[DK / 16];
#pragma unroll
        for (int k0 = 0; k0 < DK / 16; ++k0) qf[k0] = *(const bf16x8*)(a.Q + qrow * a.qs + h * a.qh + k0 * 16 + hh * 8);
        u32x4 kreg[KPT], vreg[VPT];
#define ATT_TILE_ROW(j) ((NA && (j) >= 4) ? rb + 256 + (size_t)(rlo + (j) - 4) * 64 : rb + (size_t)(j) * 64)
#define ATT_GLOAD(j) do { const size_t _tr = ATT_TILE_ROW(j); \
        _Pragma("unroll") for (int _i = 0; _i < KPT; ++_i) { const int _c = tid + _i * 512; if (_c < NKC) { const int _row = _c / KCH, _cc = _c - _row * KCH; kreg[_i] = *(const u32x4*)(Kb + (_tr + _row) * a.ks + _cc * 8); } } \
        _Pragma("unroll") for (int _i = 0; _i < VPT; ++_i) { const int _c = tid + _i * 512; if (_c < NVC) { const int _row = _c / VCH, _cc = _c - _row * VCH; vreg[_i] = *(const u32x4*)(Vb + (_tr + _row) * a.vs + _cc * 8); } } } while (0)
#define ATT_LSTORE(buf) do { \
        _Pragma("unroll") for (int _i = 0; _i < KPT; ++_i) { const int _c = tid + _i * 512; if (_c < NKC) { const int _row = _c / KCH, _cc = _c - _row * KCH; *(LAS u32x4*)(lds + OFFK + (buf) * KBUF + _row * KROW + _cc * 16) = kreg[_i]; } } \
        _Pragma("unroll") for (int _i = 0; _i < VPT; ++_i) { const int _c = tid + _i * 512; if (_c < NVC) { const int _row = _c / VCH, _cc = _c - _row * VCH; *(LAS u32x4*)(lds + OFFV + (buf) * VBUF + _row * VROW + _cc * 16) = vreg[_i]; } } } while (0)
        ATT_GLOAD(0); ATT_LSTORE(0);
        __syncthreads();
        f32x16 o[DV / 32];
#pragma unroll
        for (int d = 0; d < DV / 32; ++d)
#pragma unroll
            for (int i = 0; i < 16; ++i) o[d][i] = 0.f;
        float m_run = -1e30f, lsum = 0.f;
        for (int j = 0; j < ntiles; ++j) {
            const bool more = j + 1 < ntiles;
            if (more) ATT_GLOAD(j + 1);
            bool active = true; int kr = 0;
            if (NA && j >= 4) { kr = rlo + j - 4; active = (kr >= wr0) && (kr < wr0 + 8); }
            if (active) {
                const LAS unsigned char* Kt = lds + OFFK + (j & 1) * KBUF;
                const LAS unsigned char* Vt = lds + OFFV + (j & 1) * VBUF;
                f32x16 s[2];
#pragma unroll
                for (int kb = 0; kb < 2; ++kb) {
#pragma unroll
                    for (int i = 0; i < 16; ++i) s[kb][i] = 0.f;
#pragma unroll
                    for (int k0 = 0; k0 < DK / 16; ++k0) {
                        const bf16x8 kf = *(const LAS bf16x8*)(Kt + (kb * 32 + r) * KROW + k0 * 32 + hh * 16);
                        s[kb] = __builtin_amdgcn_mfma_f32_32x32x16_bf16(kf, qf[k0], s[kb], 0, 0, 0);
                    }
                }
                float mx = m_run;
                if (NA && j >= 4) {
                    const int ri = kr - wi + 7, qj = c0 + r, cs = clampi(qj - 8, 0, 48);
#pragma unroll
                    for (int kb = 0; kb < 2; ++kb)
#pragma unroll
                        for (int i = 0; i < 16; ++i) {
                            const int kj = kb * 32 + (i & 3) + 8 * (i >> 2) + 4 * hh;
                            const bool valid = (kj >= cs) && (kj < cs + 16);
                            const int ci = clampi(kj - qj + 15, 0, 30);
                            const float bias = rpbL[ri * 31 + ci];
                            const float x = valid ? s[kb][i] * a.sc + bias : -1e30f;
                            s[kb][i] = x; mx = fmaxf(mx, x);
                        }
                } else {
#pragma unroll
                    for (int kb = 0; kb < 2; ++kb)
#pragma unroll
                        for (int i = 0; i < 16; ++i) { const float x = s[kb][i] * a.sc; s[kb][i] = x; mx = fmaxf(mx, x); }
                }
                mx = fmaxf(mx, __shfl_xor(mx, 32));
                const float alpha = fexp2(m_run - mx);
                m_run = mx; lsum *= alpha;
#pragma unroll
                for (int d = 0; d < DV / 32; ++d)
#pragma unroll
                    for (int i = 0; i < 16; ++i) o[d][i] *= alpha;
#pragma unroll
                for (int kb = 0; kb < 2; ++kb)
#pragma unroll
                    for (int i = 0; i < 16; ++i) { const float pp = fexp2(s[kb][i] - mx); lsum += pp; s[kb][i] = pp; }
#pragma unroll
                for (int kb = 0; kb < 2; ++kb)
#pragma unroll
                    for (int st = 0; st < 2; ++st) {
                        const u32x4 pu = (u32x4){pk_bf16(s[kb][8 * st], s[kb][8 * st + 1]), pk_bf16(s[kb][8 * st + 2], s[kb][8 * st + 3]),
                                                 pk_bf16(s[kb][8 * st + 4], s[kb][8 * st + 5]), pk_bf16(s[kb][8 * st + 6], s[kb][8 * st + 7])};
                        const bf16x8 pf = __builtin_bit_cast(bf16x8, pu);
#pragma unroll
                        for (int d = 0; d < DV / 32; ++d) {
                            const LAS unsigned char* ad = Vt + (kb * 32 + 16 * st + 4 * hh + tq) * VROW + (d * 32 + 16 * blk + 4 * tp) * 2;
                            const s16x4 lo = __builtin_amdgcn_ds_read_tr16_b64_v4i16((LAS s16x4*)ad);
                            const s16x4 hi = __builtin_amdgcn_ds_read_tr16_b64_v4i16((LAS s16x4*)(ad + 8 * VROW));
                            const bf16x8 vf = __builtin_shufflevector(lo, hi, 0, 1, 2, 3, 4, 5, 6, 7);
                            o[d] = __builtin_amdgcn_mfma_f32_32x32x16_bf16(vf, pf, o[d], 0, 0, 0);
                        }
                    }
            }
            if (more) ATT_LSTORE((j + 1) & 1);
            __syncthreads();
        }
        lsum += __shfl_xor(lsum, 32);
        const float inv = frcp(lsum);
        bf16_t* orow = a.O + (qrow << 10) + h * DV;
#pragma unroll
        for (int d = 0; d < DV / 32; ++d)
#pragma unroll
            for (int g = 0; g < 4; ++g)
                *(u32x2*)(orow + d * 32 + 8 * g + 4 * hh) = (u32x2){pk_bf16(o[d][4 * g] * inv, o[d][4 * g + 1] * inv), pk_bf16(o[d][4 * g + 2] * inv, o[d][4 * g + 3] * inv)};
#undef ATT_TILE_ROW
#undef ATT_GLOAD
#undef ATT_LSTORE
    }
}

DI void s5_scan_phase(LAS unsigned char* lds, const Params& p, bf16_t* H, float* YF) {
    const int TIDX = otid(); const int BIDX = obid(); (void)TIDX; (void)BIDX;
    const int wave = __builtin_amdgcn_readfirstlane(TIDX >> 6), lane = TIDX & 63;
    LAS float* BU = (LAS float*)(lds + wave * 12800);
    LAS bf16_t* Hh = (LAS bf16_t*)(lds + wave * 12800 + 8448);
    const int l15 = lane & 15, l4 = lane >> 4;
    for (int item = BIDX * 8 + wave; item < NB * 64; item += gridDim.x * 8) {
        const int g = item & 63, b = item >> 6;
        const float dsk = p.in[I_SD][g * 16 + l15];
        for (int dir = 0; dir < 2; ++dir) {
            const int pg = dir * 64 + g;
            const float dt = __expf(p.in[I_SLDT][pg]);
            const float* are = p.in[I_SARE] + pg * 64; const float* aim = p.in[I_SAIM] + pg * 64;
            float abr, abi;
            { const float ar = are[lane], ai = aim[lane]; const float mag = __expf(dt * ar); abr = mag * __cosf(dt * ai); abi = mag * __sinf(dt * ai); }
            bf16x8 bfr[8], cfr[4];
#pragma unroll
            for (int nt = 0; nt < 8; ++nt) {
                const int st = (nt & 3) * 16 + l15;
                const float ar = are[st], ai = aim[st]; const float mag = __expf(dt * ar);
                const float er = mag * __cosf(dt * ai), ei = mag * __sinf(dt * ai);
                const float den = ar * ar + ai * ai, nr = er - 1.f;
                const float fre = (nr * ar + ei * ai) / den, fim = (ei * ar - nr * ai) / den;
                float bb[8];
#pragma unroll
                for (int j = 0; j < 8; ++j) bb[j] = 0.f;
                if (lane < 32) {
                    const float* br = p.in[I_SBRE] + ((size_t)pg * 64 + st) * 16 + l4 * 8; const float* bi = p.in[I_SBIM] + ((size_t)pg * 64 + st) * 16 + l4 * 8;
#pragma unroll
                    for (int j = 0; j < 8; ++j) bb[j] = (nt < 4) ? (fre * br[j] - fim * bi[j]) : (fre * bi[j] + fim * br[j]);
                }
                bfr[nt] = __builtin_bit_cast(bf16x8, pack8(bb));
            }
#pragma unroll
            for (int kk = 0; kk < 4; ++kk) {
                const int k = (kk & 1) * 32 + l4 * 8;
                const float* cp = (kk < 2 ? p.in[I_SCRE] : p.in[I_SCIM]) + ((size_t)pg * 16 + l15) * 64 + k;
                float cc[8];
#pragma unroll
                for (int j = 0; j < 8; ++j) cc[j] = (kk < 2) ? cp[j] : -cp[j];
                cfr[kk] = __builtin_bit_cast(bf16x8, pack8(cc));
            }
            float hr = 0.f, hi = 0.f;
            for (int j = 0; j < 144; ++j) {
                const int tb = dir ? (j < 16 ? 16 * (15 - j) : 256 + 16 * (143 - j)) : 16 * j;
                const size_t row0 = (size_t)b * TT + tb;
                bf16x8 uf = (bf16x8){0, 0, 0, 0, 0, 0, 0, 0};
                if (lane < 32) uf = *(const bf16x8*)(H + ((row0 + l15) << 10) + g * 16 + l4 * 8);
#pragma unroll
                for (int nt = 0; nt < 8; ++nt) {
                    const f32x4 acc = __builtin_amdgcn_mfma_f32_16x16x32_bf16(uf, bfr[nt], (f32x4){0.f, 0.f, 0.f, 0.f}, 0, 0, 0);
#pragma unroll
                    for (int i = 0; i < 4; ++i) BU[(l4 * 4 + i) * 132 + nt * 16 + l15] = acc[i];
                }
                float bur[16], bui[16];
#pragma unroll
                for (int tt = 0; tt < 16; ++tt) { bur[tt] = BU[tt * 132 + lane]; bui[tt] = BU[tt * 132 + 64 + lane]; }
                if (dir) {
#pragma unroll
                    for (int tt = 15; tt >= 0; --tt) {
                        const float nhr = abr * hr - abi * hi + bur[tt], nhi = abr * hi + abi * hr + bui[tt];
                        hr = nhr; hi = nhi;
                        const unsigned pr = pk_bf16(hr, hi);
                        Hh[tt * 136 + lane] = (bf16_t)(pr & 0xffffu); Hh[tt * 136 + 64 + lane] = (bf16_t)(pr >> 16);
                    }
                } else {
#pragma unroll
                    for (int tt = 0; tt < 16; ++tt) {
                        const float nhr = abr * hr - abi * hi + bur[tt], nhi = abr * hi + abi * hr + bui[tt];
                        hr = nhr; hi = nhi;
                        const unsigned pr = pk_bf16(hr, hi);
                        Hh[tt * 136 + lane] = (bf16_t)(pr & 0xffffu); Hh[tt * 136 + 64 + lane] = (bf16_t)(pr >> 16);
                    }
                }
                f32x4 ya = (f32x4){0.f, 0.f, 0.f, 0.f};
#pragma unroll
                for (int kk = 0; kk < 4; ++kk) {
                    const bf16x8 af = *(const LAS bf16x8*)(Hh + l15 * 136 + kk * 32 + l4 * 8);
                    ya = __builtin_amdgcn_mfma_f32_16x16x32_bf16(af, cfr[kk], ya, 0, 0, 0);
                }
                if (dir == 0) {
#pragma unroll
                    for (int i = 0; i < 4; ++i) YF[((row0 + l4 * 4 + i) << 10) + g * 16 + l15] = ya[i];
                } else {
#pragma unroll
                    for (int i = 0; i < 4; ++i) {
                        const size_t o = ((row0 + l4 * 4 + i) << 10) + g * 16 + l15;
                        const float u = __uint_as_float(((unsigned)H[o]) << 16);
                        const float y = gelu_tanh(dsk * u + YF[o] + ya[i]);
                        H[o] = (bf16_t)(pk_bf16(y, 0.f) & 0xffffu);
                    }
                }
            }
        }
    }
}

#define XB_TMO      128
#define XB_XCNT(j)  (256  + 64 * (j))
#define XB_XSUB(j)  (1280 + 64 * (j))
#define XB_XGEN(j)  (2304 + 64 * (j))
#define XB_TOP      3328
#define XB_TOPGEN   3392
#define XCD_BAR_WORDS 3456
#define XB_SPIN_CAP (1u << 18)
DI unsigned xb_ld(unsigned* p)              { return __hip_atomic_load(p, __ATOMIC_RELAXED, __HIP_MEMORY_SCOPE_AGENT); }
DI unsigned xb_add(unsigned* p, unsigned v) { return __hip_atomic_fetch_add(p, v, __ATOMIC_RELAXED, __HIP_MEMORY_SCOPE_AGENT); }
DI unsigned xb_xcc_id() { return (unsigned)__builtin_amdgcn_s_getreg((3 << 11) | 20) & 0xFu; }
#define XB_SPIN(cond, bar) do { unsigned _sp = 0; while (cond) { __builtin_amdgcn_s_sleep(1); \
    if ((++_sp & 255u) == 0u) { if (xb_ld(&(bar)[XB_TMO])) break; if (_sp > XB_SPIN_CAP) { atomicAdd(&(bar)[XB_TMO], 1u); break; } } } } while (0)
struct XcdBarrier { unsigned* bar; unsigned x; volatile LAS unsigned* st; };
DI XcdBarrier xcd_barrier_post(unsigned* bar, volatile LAS unsigned* st) {
    XcdBarrier b; b.bar = bar; b.x = xb_xcc_id(); b.st = st;
    if (threadIdx.x == 0) (void)xb_add(&bar[XB_XCNT(b.x)], 1u);
    return b;
}
DI void xcd_barrier_complete(unsigned* bar, unsigned x, unsigned& nloc, unsigned& nx) {
    const unsigned G = gridDim.x * gridDim.y * gridDim.z;
    unsigned sum, cnt, mine, sp = 0u;
    for (;;) {
        sum = 0u; cnt = 0u; mine = 0u;
#pragma unroll
        for (unsigned j = 0; j < 16; ++j) { const unsigned c = xb_ld(&bar[XB_XCNT(j)]); sum += c; cnt += (c > 0u) ? 1u : 0u; mine = (j == x) ? c : mine; }
        if (sum == G) break;
        __builtin_amdgcn_s_sleep(1);
        if ((++sp & 255u) == 0u) { if (xb_ld(&bar[XB_TMO])) break; if (sp > XB_SPIN_CAP) { atomicAdd(&bar[XB_TMO], 1u); break; } }
    }
    nloc = mine > 0u ? mine : 1u; nx = cnt > 0u ? cnt : 1u;
}
DI void xcd_barrier(const XcdBarrier& b) {
    asm volatile("s_waitcnt vmcnt(0)" ::: "memory");
    __syncthreads();
    if (threadIdx.x == 0) {
        unsigned* bar = b.bar;
        __builtin_amdgcn_s_waitcnt(0);
        unsigned nloc = b.st[0], nx = b.st[1];
        if (nloc == 0u) { xcd_barrier_complete(bar, b.x, nloc, nx); b.st[0] = nloc; b.st[1] = nx; }
        const unsigned old = xb_add(&bar[XB_XSUB(b.x)], 1u);
        const unsigned gen = old / nloc;
        if (old + 1u == (gen + 1u) * nloc) {
            __builtin_amdgcn_fence(__ATOMIC_RELEASE, "agent");
            asm volatile("s_waitcnt vmcnt(0)" ::: "memory");
            const unsigned og = xb_add(&bar[XB_TOP], 1u);
            const unsigned tg = og / nx;
            if (og + 1u == (tg + 1u) * nx) xb_add(&bar[XB_TOPGEN], 1u);
            else XB_SPIN(xb_ld(&bar[XB_TOPGEN]) == tg, bar);
            __builtin_amdgcn_fence(__ATOMIC_ACQUIRE, "agent");
            xb_add(&bar[XB_XGEN(b.x)], 1u);
            asm volatile("s_waitcnt vmcnt(0)" ::: "memory");
        } else {
            XB_SPIN(xb_ld(&bar[XB_XGEN(b.x)]) == gen, bar);
            __builtin_amdgcn_fence(__ATOMIC_ACQUIRE, "agent");
            asm volatile("s_waitcnt vmcnt(0)" ::: "memory");
        }
    }
    __syncthreads();
}

__global__ void __launch_bounds__(512, 2) mega(const Params p) {
    extern __shared__ __attribute__((aligned(16))) unsigned char shm[];
    LAS unsigned char* lds = (LAS unsigned char*)shm;
    cg::grid_group grid = cg::this_grid();
    LAS unsigned* xbst = (LAS unsigned*)(lds + 131072);
    if (threadIdx.x < 4) xbst[threadIdx.x] = 0u;
    __syncthreads();
    const XcdBarrier xb = xcd_barrier_post((unsigned*)(p.ws + OFF_BAR), (volatile LAS unsigned*)xbst);
    unsigned char* ws = p.ws;
    float* ADA = (float*)(ws + OFF_ADA);
    float* XC = (float*)(ws + OFF_XC);
    bf16_t* HB = (bf16_t*)(ws + OFF_HB);
    float* LAT = p.out;
    int pid = 0;
#define PH_BEGIN if (pid >= p.ph_lo && pid < p.ph_hi) {
#define PH_END if (pid + 1 < p.ph_hi) { if (pid == 0) grid.sync(); else xcd_barrier(xb); } } ++pid;

    PH_BEGIN
    {
        LAS float* tile = (LAS float*)lds;
        for (int i = 0; i < 4; ++i) {
            prep_weight(tile, WDesc{p.in[I_FWIN] + (size_t)i * 1024 * 5632, (bf16_t*)(ws + OFF_WFI + i * SZ_WFI), 1024, 5632, 5632, 2816, nullptr});
            prep_weight(tile, WDesc{p.in[I_FWOUT] + (size_t)i * 2816 * 1024, (bf16_t*)(ws + OFF_WFO + i * SZ_WFO), 2816, 1024, 1024, 0, nullptr});
        }
        prep_weight(tile, WDesc{p.in[I_MWIN], (bf16_t*)(ws + OFF_WMI), 1024, 672, 768, 0, nullptr});
        prep_weight(tile, WDesc{p.in[I_MWUQ], (bf16_t*)(ws + OFF_WUQ), 384, 1536, 1536, 0, p.in[I_MGQ]});
        prep_weight(tile, WDesc{p.in[I_MWUKV], (bf16_t*)(ws + OFF_WUKV), 256, 2048, 2048, 0, p.in[I_MGKV]});
        prep_weight(tile, WDesc{p.in[I_MWO], (bf16_t*)(ws + OFF_WMO), 1024, 1024, 1024, 0, nullptr});
        prep_weight(tile, WDesc{p.in[I_SWGLU], (bf16_t*)(ws + OFF_WGLU), 1024, 2048, 2048, 1024, nullptr});
        prep_weight(tile, WDesc{p.in[I_NWQKV], (bf16_t*)(ws + OFF_WNQ), 1024, 3072, 3072, 0, nullptr});
        prep_weight(tile, WDesc{p.in[I_NWO], (bf16_t*)(ws + OFF_WNO), 1024, 1024, 1024, 0, nullptr});
        prep_weight(tile, WDesc{p.in[I_GWQKV], (bf16_t*)(ws + OFF_WGQ), 1024, 1536, 1536, 0, nullptr});
        prep_weight(tile, WDesc{p.in[I_GWO], (bf16_t*)(ws + OFF_WGO), 1024, 1024, 1024, 0, nullptr});
        ada_phase(p, ADA);
    }
    PH_END

    for (int layer = 0; layer < 4; ++layer) {
        const float* ada = ADA + (size_t)layer * 33 * 6144;
        const int last = layer == 3;
        PH_BEGIN
        norm_phase(layer == 0 ? p.in[I_X] : LAT, layer == 0 ? p.in[I_CTX] : XC, LAT, XC, layer == 0, p.in[I_NMIX] + layer * 1024, ada, 0, HB, false);
        PH_END
        if (layer == 0) {
            bf16_t* Z = (bf16_t*)(ws + OFF_Z); bf16_t* KV = (bf16_t*)(ws + OFF_KV); bf16_t* QB = (bf16_t*)(ws + OFF_QB);
            PH_BEGIN
            run_gemm(lds, HB, 1024, (const bf16_t*)(ws + OFF_WMI), 768, 1024, 0, pg8::EpiStore{Z, 768, 0});
            PH_END
            PH_BEGIN
            run_gemm(lds, Z, 768, (const bf16_t*)(ws + OFF_WUQ), 1536, 384, 0, pg8::EpiStore{QB, 1536, 0});
            run_gemm(lds, Z + 384, 768, (const bf16_t*)(ws + OFF_WUKV), 2048, 256, 0, pg8::EpiStore{KV, 2560, 1});
            PH_END
            PH_BEGIN
            mla_r2(QB, KV, Z, p.in[I_MGQN], p.in[I_MGKN]);
            PH_END
            PH_BEGIN
            attn_phase<96, 64, 0>(lds, AttnArgs{QB, KV, KV + 96, HB, 1536, 96, 2560, 160, 2560, 160, 16, 0, 1, nullptr, 0.10206207261596575f * LOG2E});
            PH_END
            PH_BEGIN
            run_gemm(lds, HB, 1024, (const bf16_t*)(ws + OFF_WMO), 1024, 1024, 0, pg8::EpiRes{LAT, XC, ada, 2});
            PH_END
        } else if (layer == 1) {
            float* YF = (float*)(ws + OFF_BIG);
            PH_BEGIN
            s5_scan_phase(lds, p, HB, YF);
            PH_END
            PH_BEGIN
            run_gemm(lds, HB, 1024, (const bf16_t*)(ws + OFF_WGLU), 2048, 1024, 0, pg8::EpiGluRes{LAT, XC, ada, 2});
            PH_END
        } else if (layer == 2) {
            bf16_t* QKV = (bf16_t*)(ws + OFF_BIG);
            PH_BEGIN
            run_gemm(lds, HB, 1024, (const bf16_t*)(ws + OFF_WNQ), 3072, 1024, 0, pg8::EpiStore{QKV, 3072, 0});
            PH_END
            PH_BEGIN
            headnorm_phase<64, 4, 0>(QKV, 3072, 16, 1024, 16, p.in[I_NGQN], p.in[I_NGKN]);
            PH_END
            PH_BEGIN
            attn_phase<64, 64, 1>(lds, AttnArgs{QKV, QKV + 1024, QKV + 2048, HB, 3072, 64, 3072, 64, 3072, 64, 16, 0, 1, p.in[I_NRPB], 0.125f * LOG2E});
            PH_END
            PH_BEGIN
            run_gemm(lds, HB, 1024, (const bf16_t*)(ws + OFF_WNO), 1024, 1024, 0, pg8::EpiRes{LAT, XC, ada, 2});
            PH_END
        } else {
            bf16_t* QKV = (bf16_t*)(ws + OFF_BIG);
            PH_BEGIN
            run_gemm(lds, HB, 1024, (const bf16_t*)(ws + OFF_WGQ), 1536, 1024, 0, pg8::EpiStore{QKV, 1536, 0});
            PH_END
            PH_BEGIN
            headnorm_phase<128, 8, 1>(QKV, 1536, 8, 1024, 2, p.in[I_GGQN], p.in[I_GGKN]);
            PH_END
            PH_BEGIN
            attn_phase<128, 128, 0>(lds, AttnArgs{QKV, QKV + 1024, QKV + 1280, HB, 1536, 128, 1536, 128, 1536, 128, 8, 2, 0, nullptr, 0.08838834764831845f * LOG2E});
            PH_END
            PH_BEGIN
            run_gemm(lds, HB, 1024, (const bf16_t*)(ws + OFF_WGO), 1024, 1024, 1, pg8::EpiRes{LAT, XC, ada, 2});
            PH_END
        }
        bf16_t* ACT = (bf16_t*)(ws + OFF_BIG);
        PH_BEGIN
        norm_phase(LAT, XC, LAT, XC, false, p.in[I_NFFN] + layer * 1024, ada, 3, HB, last);
        PH_END
        PH_BEGIN
        run_gemm(lds, HB, 1024, (const bf16_t*)(ws + OFF_WFI + layer * SZ_WFI), 5632, 1024, last, pg8::EpiSwiglu{ACT, FH});
        PH_END
        PH_BEGIN
        run_gemm(lds, ACT, 2816, (const bf16_t*)(ws + OFF_WFO + layer * SZ_WFO), 1024, 2816, last, pg8::EpiRes{LAT, XC, ada, 5});
        PH_END
    }
}

extern "C" void kernel_launch(void* const* d_in, const int* in_sizes, int n_in, void* d_out, int out_size, void* d_ws, size_t ws_size, hipStream_t stream) {
    static int grid_blocks = 0;
    if (!grid_blocks) {
        hipFuncSetAttribute((const void*)mega, hipFuncAttributeMaxDynamicSharedMemorySize, LDS_BYTES);
        int dev = 0, cus = 0, per_cu = 0;
        hipGetDevice(&dev);
        hipDeviceGetAttribute(&cus, hipDeviceAttributeMultiprocessorCount, dev);
        hipOccupancyMaxActiveBlocksPerMultiprocessor(&per_cu, mega, 512, LDS_BYTES);
        if (per_cu < 1) per_cu = 1;
        grid_blocks = cus * 1;
    }
    if (ws_size < WS_NEED) fprintf(stderr, "workspace too small: %zu < %zu\n", ws_size, (size_t)WS_NEED);
    Params p; memset(&p, 0, sizeof(p));
    for (int i = 0; i < N_IN; ++i) p.in[i] = (const float*)d_in[i];
    p.out = (float*)d_out; p.ws = (unsigned char*)d_ws; p.ph_lo = 0; p.ph_hi = 1000;
    hipMemsetAsync((unsigned char*)d_ws + OFF_BAR, 0, 16384, stream);
    void* args[] = {&p};
    hipError_t e = hipLaunchCooperativeKernel((const void*)mega, dim3(grid_blocks), dim3(512), args, LDS_BYTES, stream);
    if (e != hipSuccess) fprintf(stderr, "cooperative launch failed: %s (grid %d)\n", hipGetErrorString(e), grid_blocks);
}
```

```cpp
#include <hip/hip_runtime.h>
#include <hip/hip_cooperative_groups.h>
#include <cstdio>
#include <cstring>
namespace cg = cooperative_groups;

#define DI __device__ __forceinline__
#define LAS __attribute__((address_space(3)))
typedef unsigned short bf16_t;
typedef short bf16x8 __attribute__((ext_vector_type(8)));
typedef short s16x4 __attribute__((ext_vector_type(4)));
typedef float f32x4 __attribute__((ext_vector_type(4)));
typedef float f32x16 __attribute__((ext_vector_type(16)));
typedef unsigned u32x4 __attribute__((ext_vector_type(4)));
typedef unsigned u32x2 __attribute__((ext_vector_type(2)));
typedef __bf16 bf2_t __attribute__((ext_vector_type(2)));
typedef float f2_t __attribute__((ext_vector_type(2)));

constexpr int NB = 32, SEQ = 2048, CTXL = 256, TT = 2304, NR = NB * TT, DM = 1024, FH = 2816;
constexpr float EPS = 1e-6f, LOG2E = 1.4426950408889634f, L2_10000 = 13.287712379549449f;
constexpr int LDS_BYTES = 131072 + 64;

enum { I_X, I_C, I_CTX, I_CCTX, I_ADAW, I_ADAB, I_NMIX, I_NFFN, I_FWIN, I_FWOUT,
       I_MWIN, I_MGQ, I_MGKV, I_MWUQ, I_MWUKV, I_MGQN, I_MGKN, I_MWO,
       I_SARE, I_SAIM, I_SLDT, I_SBRE, I_SBIM, I_SCRE, I_SCIM, I_SD, I_SWGLU,
       I_NWQKV, I_NGQN, I_NGKN, I_NRPB, I_NWO, I_GWQKV, I_GGQN, I_GGKN, I_GWO, N_IN };

constexpr size_t SZ_WFI = (size_t)5632 * 1024 * 2, SZ_WFO = (size_t)1024 * 2816 * 2;
constexpr size_t OFF_WFI = 0;
constexpr size_t OFF_WFO = OFF_WFI + 4 * SZ_WFI;
constexpr size_t OFF_WMI = OFF_WFO + 4 * SZ_WFO;
constexpr size_t OFF_WUQ = OFF_WMI + (size_t)768 * 1024 * 2;
constexpr size_t OFF_WUKV = OFF_WUQ + (size_t)1536 * 384 * 2;
constexpr size_t OFF_WMO = OFF_WUKV + (size_t)2048 * 256 * 2;
constexpr size_t OFF_WGLU = OFF_WMO + (size_t)1024 * 1024 * 2;
constexpr size_t OFF_WNQ = OFF_WGLU + (size_t)2048 * 1024 * 2;
constexpr size_t OFF_WNO = OFF_WNQ + (size_t)3072 * 1024 * 2;
constexpr size_t OFF_WGQ = OFF_WNO + (size_t)1024 * 1024 * 2;
constexpr size_t OFF_WGO = OFF_WGQ + (size_t)1536 * 1024 * 2;
constexpr size_t OFF_ADA = OFF_WGO + (size_t)1024 * 1024 * 2;
constexpr size_t OFF_XC = OFF_ADA + (size_t)4 * 33 * 6144 * 4;
constexpr size_t OFF_HB = OFF_XC + (size_t)NB * CTXL * 1024 * 4;
constexpr size_t OFF_BIG = OFF_HB + (size_t)NR * 1024 * 2;
constexpr size_t OFF_KV = OFF_BIG;
constexpr size_t OFF_QB = OFF_KV + (size_t)NR * 2560 * 2;
constexpr size_t OFF_Z = OFF_QB + (size_t)NR * 1536 * 2;
constexpr size_t OFF_BAR = OFF_Z + (size_t)NR * 768 * 2;
constexpr size_t WS_NEED = OFF_BAR + 16384;

struct Params {
    const float* in[N_IN];
    float* out;
    unsigned char* ws;
    int ph_lo, ph_hi;
};

DI unsigned pk_bf16(float a, float b) { f2_t v = {a, b}; bf2_t r = __builtin_convertvector(v, bf2_t); return __builtin_bit_cast(unsigned, r); }
DI float bf_lo(unsigned u) { return __uint_as_float(u << 16); }
DI float bf_hi(unsigned u) { return __uint_as_float(u & 0xffff0000u); }
DI float wsum(float v) {
#pragma unroll
    for (int o = 32; o > 0; o >>= 1) v += __shfl_xor(v, o);
    return v;
}
DI int otid() { int t = threadIdx.x; asm volatile("" : "+v"(t)); return t; }
DI int obid() { int b = blockIdx.x; asm volatile("" : "+s"(b)); return b; }
DI int clampi(int v, int lo, int hi) { return v < lo ? lo : (v > hi ? hi : v); }
DI float fexp2(float x) { return __builtin_amdgcn_exp2f(x); }
DI float frcp(float x) { return __builtin_amdgcn_rcpf(x); }
DI float silu_f(float a) { return a * frcp(1.f + __expf(-a)); }
DI float sigmoid_f(float a) { return frcp(1.f + __expf(-a)); }
DI float gelu_tanh(float y) {
    const float z = 0.7978845608028654f * (y + 0.044715f * y * y * y);
    const float t = 1.f - 2.f * frcp(__expf(2.f * z) + 1.f);
    return 0.5f * y * (1.f + t);
}
DI void unpack8(const u32x4 u, float* f) {
#pragma unroll
    for (int i = 0; i < 4; ++i) { f[2 * i] = bf_lo(u[i]); f[2 * i + 1] = bf_hi(u[i]); }
}
DI u32x4 pack8(const float* f) { return (u32x4){pk_bf16(f[0], f[1]), pk_bf16(f[2], f[3]), pk_bf16(f[4], f[5]), pk_bf16(f[6], f[7])}; }

namespace pg8 {
constexpr int BM = 256, BK = 64, HALF = 128, HTB = HALF * BK * 2, NXCD = 8, WGM = 8;
DI int lds_byte(int r, int c) { const int st = (r >> 4) * 2 + (c >> 5), rr = r & 15, cc = c & 31, ob = rr * 64 + cc * 2; return st * 1024 + (ob ^ (((ob >> 9) & 1) << 5)); }
DI void stage_rc(int b, int& R, int& C) { const int st = b / 1024, sb = b % 1024, swz = sb ^ (((sb >> 9) & 1) << 5); R = (st >> 1) * 16 + swz / 64; C = (st & 1) * 32 + (swz % 64) / 2; }
DI int perm32(int rho) { const int n = rho >> 4, i = rho & 15; return 8 * (i >> 2) + 4 * n + (i & 3); }
struct Unit { int pm, pn; };
struct Gemm { const bf16_t* A; const bf16_t* Bt; int M, N, K, lda; };
struct Order {
    int nM, nN, nwg, G, c, skip;
    DI void init(int N, int G_, int c_, int skipctx) { skip = skipctx; nM = skipctx ? 256 : 288; nN = N / BM; nwg = nM * nN; G = G_; c = c_; }
    DI bool next(int i, Unit& u) const {
        const long L = (long)i * G + c; if (L >= nwg) return false;
        int wgid = (int)L; { const int q = nwg / NXCD, r = nwg % NXCD, xcd = wgid % NXCD, off = wgid / NXCD; wgid = (xcd < r ? xcd * (q + 1) : r * (q + 1) + (xcd - r) * q) + off; }
        const int nig = WGM * nN, gid = wgid / nig, fm = gid * WGM, gsz = (nM - fm) < WGM ? (nM - fm) : WGM;
        int pm = fm + ((wgid % nig) % gsz); u.pn = (wgid % nig) / gsz;
        if (skip) pm = pm + (pm >> 3) + 1;
        u.pm = pm; return true;
    }
};

DI float* tile_res_base(float* lat, float* xc, int pm) { const int bb = pm / 9, sub = pm - bb * 9; return sub == 0 ? xc + ((size_t)bb * CTXL << 10) : lat + ((size_t)(bb * SEQ + (sub - 1) * 256) << 10); }
DI int tile_ada_row(int pm) { const int bb = pm / 9, sub = pm - bb * 9; return sub == 0 ? 32 : bb; }

struct EpiStore {
    static constexpr bool PERM = true;
    bf16_t* O; int ldc; int remap;
    DI void operator()(const f32x4 (&acc)[2][2][4][2], const Unit& u, int wr, int wc, int fr, int fq) const {
        const int row0 = u.pm * BM + wr * 64 + fr, col0 = u.pn * BM + wc * 32 + 8 * fq;
#pragma unroll
        for (int ai = 0; ai < 2; ++ai)
#pragma unroll
            for (int m = 0; m < 4; ++m) {
                bf16_t* rowp = O + (size_t)(row0 + ai * HALF + m * 16) * ldc;
#pragma unroll
                for (int bj = 0; bj < 2; ++bj) {
                    const int c = col0 + bj * HALF; const int cc = remap ? (c >> 7) * 160 + (c & 127) : c;
                    const f32x4 v0 = acc[ai][bj][m][0], v1 = acc[ai][bj][m][1];
                    *(u32x4*)(rowp + cc) = (u32x4){pk_bf16(v0[0], v0[1]), pk_bf16(v0[2], v0[3]), pk_bf16(v1[0], v1[1]), pk_bf16(v1[2], v1[3])};
                }
            }
    }
};
struct EpiSwiglu {
    static constexpr bool PERM = true;
    bf16_t* O; int ldc;
    DI void operator()(const f32x4 (&acc)[2][2][4][2], const Unit& u, int wr, int wc, int fr, int fq) const {
        const int row0 = u.pm * BM + wr * 64 + fr, col0 = u.pn * HALF + wc * 32 + 8 * fq;
#pragma unroll
        for (int ai = 0; ai < 2; ++ai)
#pragma unroll
            for (int m = 0; m < 4; ++m) {
                float v[8];
#pragma unroll
                for (int n = 0; n < 2; ++n)
#pragma unroll
                    for (int i = 0; i < 4; ++i) v[n * 4 + i] = silu_f(acc[ai][0][m][n][i]) * acc[ai][1][m][n][i];
                *(u32x4*)(O + (size_t)(row0 + ai * HALF + m * 16) * ldc + col0) = pack8(v);
            }
    }
};
struct EpiGluRes {
    static constexpr bool PERM = true;
    float* lat; float* xc; const float* ada; int gidx;
    DI void operator()(const f32x4 (&acc)[2][2][4][2], const Unit& u, int wr, int wc, int fr, int fq) const {
        float* base = tile_res_base(lat, xc, u.pm);
        const float* gate = ada + (size_t)tile_ada_row(u.pm) * 6144 + gidx * 1024;
        const int col0 = u.pn * HALF + wc * 32 + 8 * fq;
        const f32x4 g0 = *(const f32x4*)(gate + col0), g1 = *(const f32x4*)(gate + col0 + 4);
#pragma unroll
        for (int ai = 0; ai < 2; ++ai)
#pragma unroll
            for (int m = 0; m < 4; ++m) {
                float* rp = base + ((size_t)(ai * HALF + wr * 64 + m * 16 + fr) << 10) + col0;
                f32x4 x0 = *(f32x4*)rp, x1 = *(f32x4*)(rp + 4);
#pragma unroll
                for (int i = 0; i < 4; ++i) {
                    x0[i] += g0[i] * (acc[ai][0][m][0][i] * sigmoid_f(acc[ai][1][m][0][i]));
                    x1[i] += g1[i] * (acc[ai][0][m][1][i] * sigmoid_f(acc[ai][1][m][1][i]));
                }
                *(f32x4*)rp = x0; *(f32x4*)(rp + 4) = x1;
            }
    }
};
struct EpiRes {
    static constexpr bool PERM = false;
    float* lat; float* xc; const float* ada; int gidx;
    DI void operator()(const f32x4 (&acc)[2][2][4][2], const Unit& u, int wr, int wc, int fr, int fq) const {
        float* base = tile_res_base(lat, xc, u.pm);
        const float* gate = ada + (size_t)tile_ada_row(u.pm) * 6144 + gidx * 1024;
        const int col0 = u.pn * BM + wc * 32 + 4 * fq;
        f32x4 gv[2][2];
#pragma unroll
        for (int bj = 0; bj < 2; ++bj)
#pragma unroll
            for (int n = 0; n < 2; ++n) gv[bj][n] = *(const f32x4*)(gate + col0 + bj * HALF + n * 16);
#pragma unroll
        for (int ai = 0; ai < 2; ++ai)
#pragma unroll
            for (int m = 0; m < 4; ++m) {
                float* rp = base + ((size_t)(ai * HALF + wr * 64 + m * 16 + fr) << 10) + col0;
#pragma unroll
                for (int bj = 0; bj < 2; ++bj)
#pragma unroll
                    for (int n = 0; n < 2; ++n) {
                        f32x4 x = *(f32x4*)(rp + bj * HALF + n * 16);
                        x += gv[bj][n] * acc[ai][bj][m][n];
                        *(f32x4*)(rp + bj * HALF + n * 16) = x;
                    }
            }
    }
};

template <class Epi>
DI void gemm_phase(LAS unsigned char* lds, const Gemm g, const Order& S, const Epi& E) {
    const int TIDX = otid(); const int BIDX = obid(); (void)TIDX; (void)BIDX;
    const int tid = TIDX, wid = __builtin_amdgcn_readfirstlane(tid >> 6), lane = tid & 63, wr = wid >> 2, wc = wid & 3, fr = lane & 15, fq = lane >> 4;
    const int K = g.K, nt = K / BK;
    unsigned voffA[2], voffB[2];
#pragma unroll
    for (int i = 0; i < 2; ++i) { int R, C; stage_rc(tid * 16 + i * 8192, R, C); const int Rb = Epi::PERM ? ((R & ~31) + perm32(R & 31)) : R;
        voffA[i] = (unsigned)(R * g.lda + C) * 2u; voffB[i] = (unsigned)(Rb * K + C) * 2u; }
    const size_t kstep = (size_t)(BK * 2);
    const size_t hstep = (size_t)HALF * K * 2, hstepA = (size_t)HALF * g.lda * 2;
    const size_t tstep = 2 * hstep, tstepA = 2 * hstepA;
    const unsigned ldsw = (unsigned)wid * 1024u;
    const int aoff = lds_byte(wr * 64 + fr, fq * 8), boff = lds_byte(wc * 32 + fr, fq * 8);
#define PG8_SA(b, h) (((b) * 2 + (h)) * HTB)
#define PG8_SB(b, h) ((4 + (b) * 2 + (h)) * HTB)
#define PG8_STAGE(bufoff, gbase, voff) do { _Pragma("unroll") for (int _i = 0; _i < 2; ++_i) \
        __builtin_amdgcn_global_load_lds((const unsigned*)((const char*)(gbase) + (voff)[_i]), (LAS unsigned*)(lds + (bufoff) + ldsw + _i * 8192), 16, 0, 0); } while (0)
#define PG8_LDA(dst, b, h) do { _Pragma("unroll") for (int m = 0; m < 4; ++m) _Pragma("unroll") for (int k = 0; k < 2; ++k) dst[m][k] = *(const LAS bf16x8*)(lds + PG8_SA(b, h) + aoff + m * 2048 + k * 1024); } while (0)
#define PG8_LDB(dst, b, h) do { _Pragma("unroll") for (int n = 0; n < 2; ++n) _Pragma("unroll") for (int k = 0; k < 2; ++k) dst[n][k] = *(const LAS bf16x8*)(lds + PG8_SB(b, h) + boff + n * 2048 + k * 1024); } while (0)
#define PG8_MMA(ai, bj, At, Bt) do { __builtin_amdgcn_s_setprio(1); _Pragma("unroll") for (int m = 0; m < 4; ++m) _Pragma("unroll") for (int n = 0; n < 2; ++n) _Pragma("unroll") for (int k = 0; k < 2; ++k) \
        acc[ai][bj][m][n] = __builtin_amdgcn_mfma_f32_16x16x32_bf16(Bt[n][k], At[m][k], acc[ai][bj][m][n], 0, 0, 0); __builtin_amdgcn_s_setprio(0); } while (0)
#define PG8_WAIT_V(n) asm volatile("s_waitcnt vmcnt(" #n ")" ::: "memory")
#define PG8_WAIT_L(n) asm volatile("s_waitcnt lgkmcnt(" #n ")" ::: "memory")
#define PG8_BAR __builtin_amdgcn_s_barrier()
#define PG8_SCHED __builtin_amdgcn_sched_barrier(0)
    Unit cur, nxt; int ui = 0;
    if (!S.next(0, cur)) return;
    f32x4 acc[2][2][4][2];
#pragma unroll
    for (int a = 0; a < 2; ++a)
#pragma unroll
        for (int b = 0; b < 2; ++b)
#pragma unroll
            for (int m = 0; m < 4; ++m)
#pragma unroll
                for (int n = 0; n < 2; ++n) acc[a][b][m][n] = (f32x4){0.f, 0.f, 0.f, 0.f};
    bf16x8 At[4][2], B0[2][2], B1[2][2];
    const char* cA = (const char*)g.A + (size_t)cur.pm * tstepA; const char* cB = (const char*)g.Bt + (size_t)cur.pn * tstep;
    PG8_STAGE(PG8_SB(0, 0), cB, voffB); PG8_STAGE(PG8_SA(0, 0), cA, voffA); PG8_STAGE(PG8_SB(0, 1), cB + hstep, voffB); PG8_STAGE(PG8_SA(0, 1), cA + hstepA, voffA);
    if (wr == 1) PG8_BAR;
    PG8_WAIT_V(4); PG8_BAR;
    PG8_STAGE(PG8_SB(1, 0), cB + kstep, voffB); PG8_STAGE(PG8_SA(1, 0), cA + kstep, voffA); PG8_STAGE(PG8_SB(1, 1), cB + hstep + kstep, voffB);
    PG8_WAIT_V(6); PG8_BAR;
    for (;;) {
        const bool has_next = S.next(ui + 1, nxt);
        const char* nA = has_next ? (const char*)g.A + (size_t)nxt.pm * tstepA : cA; const char* nB = has_next ? (const char*)g.Bt + (size_t)nxt.pn * tstep : cB;
        for (int t = 0; t < nt; t += 2) {
            const bool last = (t == nt - 2);
            const char* a1 = cA + (size_t)(t + 1) * kstep;
            const char* a2 = last ? nA : cA + (size_t)(t + 2) * kstep; const char* b2 = last ? nB : cB + (size_t)(t + 2) * kstep;
            const char* a3 = a2 + kstep; const char* b3 = b2 + kstep;
            PG8_LDB(B0, 0, 0); PG8_SCHED; PG8_LDA(At, 0, 0); PG8_STAGE(PG8_SA(1, 1), a1 + hstepA, voffA);
            PG8_WAIT_L(8); PG8_BAR; PG8_WAIT_L(0); PG8_MMA(0, 0, At, B0); PG8_BAR; PG8_SCHED;
            PG8_LDB(B1, 0, 1); PG8_STAGE(PG8_SB(0, 0), b2, voffB);
            PG8_BAR; PG8_WAIT_L(0); PG8_MMA(0, 1, At, B1); PG8_BAR;
            PG8_LDA(At, 0, 1); PG8_STAGE(PG8_SA(0, 0), a2, voffA);
            PG8_BAR; PG8_WAIT_L(0); PG8_MMA(1, 0, At, B0); PG8_BAR; PG8_SCHED;
            PG8_STAGE(PG8_SB(0, 1), b2 + hstep, voffB);
            PG8_WAIT_V(6); PG8_BAR; PG8_MMA(1, 1, At, B1); PG8_BAR;
            PG8_LDB(B0, 1, 0); PG8_SCHED; PG8_LDA(At, 1, 0); PG8_STAGE(PG8_SA(0, 1), a2 + hstepA, voffA);
            PG8_WAIT_L(8); PG8_BAR; PG8_WAIT_L(0); PG8_MMA(0, 0, At, B0); PG8_BAR; PG8_SCHED;
            PG8_LDB(B1, 1, 1); PG8_STAGE(PG8_SB(1, 0), b3, voffB);
            PG8_BAR; PG8_WAIT_L(0); PG8_MMA(0, 1, At, B1); PG8_BAR;
            PG8_LDA(At, 1, 1); PG8_STAGE(PG8_SA(1, 0), a3, voffA);
            PG8_BAR; PG8_WAIT_L(0); PG8_MMA(1, 0, At, B0); PG8_BAR; PG8_SCHED;
            PG8_STAGE(PG8_SB(1, 1), b3 + hstep, voffB);
            PG8_WAIT_V(6); PG8_BAR; PG8_MMA(1, 1, At, B1); PG8_BAR;
        }
        E(acc, cur, wr, wc, fr, fq);
        if (!has_next) break;
#pragma unroll
        for (int a = 0; a < 2; ++a)
#pragma unroll
            for (int b = 0; b < 2; ++b)
#pragma unroll
                for (int m = 0; m < 4; ++m)
#pragma unroll
                    for (int n = 0; n < 2; ++n) acc[a][b][m][n] = (f32x4){0.f, 0.f, 0.f, 0.f};
        cur = nxt; cA = nA; cB = nB; ++ui;
    }
    PG8_WAIT_V(0);
    if (wr == 0) PG8_BAR;
    PG8_BAR;
#undef PG8_SA
#undef PG8_SB
#undef PG8_STAGE
#undef PG8_LDA
#undef PG8_LDB
#undef PG8_MMA
#undef PG8_WAIT_V
#undef PG8_WAIT_L
#undef PG8_BAR
#undef PG8_SCHED
}
}

template <class Epi>
DI void run_gemm(LAS unsigned char* lds, const bf16_t* A, int lda, const bf16_t* Bt, int N, int K, int skipctx, const Epi& E) {
    const int BIDX = obid();
    pg8::Order S; S.init(N, (int)gridDim.x, BIDX, skipctx);
    pg8::Gemm g{A, Bt, NR, N, K, lda};
    pg8::gemm_phase<Epi>(lds, g, S, E);
}

struct WDesc { const float* src; bf16_t* dst; int K, N, Nout, half; const float* kscale; };
DI void prep_weight(LAS float* tile, const WDesc w) {
    const int TIDX = otid(); const int BIDX = obid(); (void)TIDX; (void)BIDX;
    const int tid = TIDX;
    const int ntk = w.K / 64, ntn = w.Nout / 64;
    for (int tidx = BIDX; tidx < ntk * ntn; tidx += gridDim.x) {
        const int kt = tidx % ntk, nt = tidx / ntk;
        const int n0 = nt * 64;
        int scol = n0;
        if (w.half) { const int t256 = n0 >> 8, ww = n0 & 255; scol = (ww >= 128 ? w.half : 0) + t256 * 128 + (ww & 127); }
        const int c4 = (tid & 15) * 4;
#pragma unroll
        for (int rr = 0; rr < 2; ++rr) {
            const int r = (tid >> 4) + rr * 32;
            f32x4 v = (f32x4){0.f, 0.f, 0.f, 0.f};
            if (scol + c4 < w.N) v = *(const f32x4*)(w.src + (size_t)(kt * 64 + r) * w.N + scol + c4);
            if (w.kscale) v *= w.kscale[kt * 64 + r];
#pragma unroll
            for (int i = 0; i < 4; ++i) tile[r * 65 + c4 + i] = v[i];
        }
        __syncthreads();
        {
            const int n = tid >> 3, kc = (tid & 7) * 8;
            float f[8];
#pragma unroll
            for (int i = 0; i < 8; ++i) f[i] = tile[(kc + i) * 65 + n];
            *(u32x4*)(w.dst + (size_t)(n0 + n) * w.K + kt * 64 + kc) = pack8(f);
        }
        __syncthreads();
    }
}

DI void ada_phase(const Params& p, float* ADA) {
    const int TIDX = otid(); const int BIDX = obid(); (void)TIDX; (void)BIDX;
    const int wave = __builtin_amdgcn_readfirstlane(TIDX >> 6), lane = TIDX & 63;
    const int gw = BIDX * 8 + wave, nw = gridDim.x * 8;
    const int v = lane < 33 ? lane : 32;
    const float* cv = v < 32 ? p.in[I_C] + v * 1024 : p.in[I_CCTX];
    for (int item = gw; item < 4 * 384; item += nw) {
        const int layer = item / 384, n0 = (item - layer * 384) * 16;
        const float* W = p.in[I_ADAW] + (size_t)layer * 1024 * 6144 + n0;
        float acc[16];
#pragma unroll
        for (int n = 0; n < 16; ++n) acc[n] = 0.f;
        for (int k0 = 0; k0 < 1024; k0 += 8) {
            float s[8];
            const f32x4 c0 = *(const f32x4*)(cv + k0), c1 = *(const f32x4*)(cv + k0 + 4);
#pragma unroll
            for (int i = 0; i < 4; ++i) { s[i] = silu_f(c0[i]); s[4 + i] = silu_f(c1[i]); }
#pragma unroll
            for (int kk = 0; kk < 8; ++kk) {
                const float* wr_ = W + (size_t)(k0 + kk) * 6144;
#pragma unroll
                for (int n = 0; n < 16; ++n) acc[n] += s[kk] * wr_[n];
            }
        }
        if (lane < 33) {
            float* o = ADA + ((size_t)layer * 33 + lane) * 6144 + n0;
            const float* bb = p.in[I_ADAB] + layer * 6144 + n0;
#pragma unroll
            for (int n = 0; n < 16; ++n) o[n] = acc[n] + bb[n];
        }
    }
}

DI void norm_phase(const float* lat_in, const float* ctx_in, float* lat_out, float* ctx_out, bool copy, const float* g,
                   const float* ada, int shidx, bf16_t* H, bool skipctx) {
    const int TIDX = otid(); const int BIDX = obid(); (void)TIDX; (void)BIDX;
    const int wave = TIDX >> 6, lane = TIDX & 63;
    for (int row = BIDX * 8 + wave; row < NR; row += gridDim.x * 8) {
        const int b = row / TT, t = row - b * TT;
        if (skipctx && t < CTXL) continue;
        const size_t ro = t < CTXL ? ((size_t)(b * CTXL + t) << 10) : ((size_t)(b * SEQ + t - CTXL) << 10);
        const float* src = (t < CTXL ? ctx_in : lat_in) + ro;
        const float* sh = ada + (size_t)(t < CTXL ? 32 : b) * 6144 + shidx * 1024;
        const float* sc = sh + 1024;
        f32x4 a[4];
        a[0] = *(const f32x4*)(src + lane * 8); a[1] = *(const f32x4*)(src + lane * 8 + 4);
        a[2] = *(const f32x4*)(src + 512 + lane * 8); a[3] = *(const f32x4*)(src + 512 + lane * 8 + 4);
        float ss = 0.f;
#pragma unroll
        for (int i = 0; i < 4; ++i)
#pragma unroll
            for (int j = 0; j < 4; ++j) ss += a[i][j] * a[i][j];
        ss = wsum(ss);
        const float r = rsqrtf(ss * (1.f / 1024.f) + EPS);
        if (copy) {
            float* dst = (t < CTXL ? ctx_out : lat_out) + ro;
            *(f32x4*)(dst + lane * 8) = a[0]; *(f32x4*)(dst + lane * 8 + 4) = a[1];
            *(f32x4*)(dst + 512 + lane * 8) = a[2]; *(f32x4*)(dst + 512 + lane * 8 + 4) = a[3];
        }
#pragma unroll
        for (int hf = 0; hf < 2; ++hf) {
            const int c0 = hf * 512 + lane * 8;
            float y[8];
#pragma unroll
            for (int q = 0; q < 2; ++q) {
                const f32x4 gv = *(const f32x4*)(g + c0 + q * 4), sv = *(const f32x4*)(sc + c0 + q * 4), hv = *(const f32x4*)(sh + c0 + q * 4);
#pragma unroll
                for (int j = 0; j < 4; ++j) y[q * 4 + j] = a[hf * 2 + q][j] * r * gv[j] * (1.f + sv[j]) + hv[j];
            }
            *(u32x4*)(H + ((size_t)row << 10) + c0) = pack8(y);
        }
    }
}

DI void mla_rope8(float* v, int sub, int s) {
    const float pos = (float)((sub < 2) ? (s >> 6) : (s & 63));
    const bool isx2 = sub & 1;
#pragma unroll
    for (int i = 0; i < 8; ++i) {
        const float other = __shfl_xor(v[i], 1);
        const float ang = pos * fexp2(-(float)i * (L2_10000 / 8.f));
        const float c = __cosf(ang), sn = __sinf(ang);
        v[i] = isx2 ? (other * sn + v[i] * c) : (v[i] * c - other * sn);
    }
}

DI void mla_r2(bf16_t* QB, bf16_t* KV, const bf16_t* Z, const float* gqn, const float* gkn) {
    const int TIDX = otid(); const int BIDX = obid(); (void)TIDX; (void)BIDX;
    const int wave = TIDX >> 6, lane = TIDX & 63, hd = lane >> 2, sub = lane & 3;
    for (int row = BIDX * 8 + wave; row < NR; row += gridDim.x * 8) {
        const int b = row / TT, t = row - b * TT; const bool latent = t >= CTXL; const int s = t - CTXL;
        const bf16_t* z = Z + (size_t)row * 768;
        bf16_t* qp = QB + (size_t)row * 1536 + hd * 96;
        bf16_t* kp = KV + (size_t)row * 2560 + hd * 160;
        unsigned zq[3];
#pragma unroll
        for (int i = 0; i < 3; ++i) zq[i] = *(const unsigned*)(z + lane * 6 + 2 * i);
        const u32x2 zk = *(const u32x2*)(z + 384 + lane * 4);
        const u32x4 q0 = *(const u32x4*)(qp + sub * 16), q1 = *(const u32x4*)(qp + sub * 16 + 8), q2 = *(const u32x4*)(qp + 64 + sub * 8);
        const u32x4 k0 = *(const u32x4*)(kp + sub * 16), k1 = *(const u32x4*)(kp + sub * 16 + 8);
        const u32x4 v0 = *(const u32x4*)(kp + 64 + sub * 16), v1 = *(const u32x4*)(kp + 64 + sub * 16 + 8);
        const u32x4 k2 = *(const u32x4*)(z + 640 + sub * 8);
        asm volatile("s_waitcnt vmcnt(0)" ::: "memory");
        float sq0 = 0.f, sk0 = 0.f;
#pragma unroll
        for (int i = 0; i < 3; ++i) { const float a0 = bf_lo(zq[i]), a1 = bf_hi(zq[i]); sq0 += a0 * a0 + a1 * a1; }
        { const float a0 = bf_lo(zk[0]), a1 = bf_hi(zk[0]), a2 = bf_lo(zk[1]), a3 = bf_hi(zk[1]); sk0 = a0 * a0 + a1 * a1 + a2 * a2 + a3 * a3; }
        sq0 = wsum(sq0); sk0 = wsum(sk0);
        const float rq0 = rsqrtf(sq0 * (1.f / 384.f) + EPS), rk0 = rsqrtf(sk0 * (1.f / 256.f) + EPS);
        float qn[16], qr[8], kn[16], kr[8], vv[16];
        unpack8(q0, qn); unpack8(q1, qn + 8); unpack8(q2, qr);
        unpack8(k0, kn); unpack8(k1, kn + 8); unpack8(k2, kr);
        unpack8(v0, vv); unpack8(v1, vv + 8);
#pragma unroll
        for (int i = 0; i < 16; ++i) { qn[i] *= rq0; kn[i] *= rk0; vv[i] *= rk0; }
#pragma unroll
        for (int i = 0; i < 8; ++i) qr[i] *= rq0;
        float sq = 0.f, sk = 0.f;
#pragma unroll
        for (int i = 0; i < 16; ++i) { sq += qn[i] * qn[i]; sk += kn[i] * kn[i]; }
#pragma unroll
        for (int i = 0; i < 8; ++i) { sq += qr[i] * qr[i]; sk += kr[i] * kr[i]; }
        sq += __shfl_xor(sq, 1); sq += __shfl_xor(sq, 2);
        sk += __shfl_xor(sk, 1); sk += __shfl_xor(sk, 2);
        const float rq = rsqrtf(sq * (1.f / 96.f) + EPS), rk = rsqrtf(sk * (1.f / 96.f) + EPS);
#pragma unroll
        for (int i = 0; i < 16; ++i) { qn[i] *= rq * gqn[sub * 16 + i]; kn[i] *= rk * gkn[sub * 16 + i]; }
#pragma unroll
        for (int i = 0; i < 8; ++i) { qr[i] *= rq * gqn[64 + sub * 8 + i]; kr[i] *= rk * gkn[64 + sub * 8 + i]; }
        if (latent) { mla_rope8(qr, sub, s); mla_rope8(kr, sub, s); }
        *(u32x4*)(qp + sub * 16) = pack8(qn); *(u32x4*)(qp + sub * 16 + 8) = pack8(qn + 8); *(u32x4*)(qp + 64 + sub * 8) = pack8(qr);
        *(u32x4*)(kp + sub * 16) = pack8(kn); *(u32x4*)(kp + sub * 16 + 8) = pack8(kn + 8); *(u32x4*)(kp + 64 + sub * 8) = pack8(kr);
        *(u32x4*)(kp + 96 + sub * 16) = pack8(vv); *(u32x4*)(kp + 96 + sub * 16 + 8) = pack8(vv + 8);
    }
}

template <int HD, int LPH, int ROPE>
DI void headnorm_phase(bf16_t* X, int stride, int nq, int koff, int nk, const float* gq, const float* gk) {
    const int TIDX = otid(); const int BIDX = obid(); (void)TIDX; (void)BIDX;
    constexpr int HPP = 64 / LPH;
    const int wave = TIDX >> 6, lane = TIDX & 63, sub = lane % LPH, hl = lane / LPH;
    for (int row = BIDX * 8 + wave; row < NR; row += gridDim.x * 8) {
        const int b = row / TT, t = row - b * TT; const bool latent = t >= CTXL; const int s = t - CTXL;
        for (int pass = 0; pass < 2; ++pass) {
            const int nh = pass ? nk : nq, base = pass ? koff : 0; const float* g = pass ? gk : gq;
            for (int h0 = 0; h0 < nh; h0 += HPP) {
                const int hd = h0 + hl; const bool act = hd < nh;
                bf16_t* ptr = X + (size_t)row * stride + base + hd * HD + sub * 16;
                u32x4 u0 = (u32x4){0, 0, 0, 0}, u1 = (u32x4){0, 0, 0, 0};
                if (act) { u0 = *(const u32x4*)ptr; u1 = *(const u32x4*)(ptr + 8); }
                float v[16]; unpack8(u0, v); unpack8(u1, v + 8);
                float ss = 0.f;
#pragma unroll
                for (int i = 0; i < 16; ++i) ss += v[i] * v[i];
#pragma unroll
                for (int o = 1; o < LPH; o <<= 1) ss += __shfl_xor(ss, o);
                const float rr = rsqrtf(ss * (1.f / HD) + EPS);
#pragma unroll
                for (int i = 0; i < 16; ++i) v[i] *= rr * g[sub * 16 + i];
                if (ROPE) {
                    if (latent) {
                        const int axis = sub >> 2; const bool isx2 = (sub >> 1) & 1;
                        const float pos = (float)(axis ? (s & 63) : (s >> 6));
#pragma unroll
                        for (int i = 0; i < 16; ++i) {
                            const float other = __shfl_xor(v[i], 2);
                            const int fi = (sub & 1) * 16 + i;
                            const float ang = pos * fexp2(-(float)fi * (L2_10000 / 32.f));
                            const float c = __cosf(ang), sn = __sinf(ang);
                            v[i] = isx2 ? (other * sn + v[i] * c) : (v[i] * c - other * sn);
                        }
                    }
                }
                if (act) { *(u32x4*)ptr = pack8(v); *(u32x4*)(ptr + 8) = pack8(v + 8); }
            }
        }
    }
}

struct AttnArgs { const bf16_t* Q; const bf16_t* K; const bf16_t* V; bf16_t* O; int qs, qh, ks, kh, vs, vh, nheads, gshift, ctx_out; const float* rpb; float sc; };

template <int DK, int DV, int NA>
DI void attn_phase(LAS unsigned char* lds, const AttnArgs a) {
    const int TIDX = otid(); const int BIDX = obid(); (void)TIDX; (void)BIDX;
    constexpr int KROW = DK * 2 + 16, VROW = DV * 2 + 16;
    constexpr int KBUF = 64 * KROW, VBUF = 64 * VROW;
    constexpr int OFFK = 0, OFFV = 2 * KBUF, OFFR = OFFV + 2 * VBUF;
    constexpr int KCH = DK / 8, VCH = DV / 8, NKC = 64 * KCH, NVC = 64 * VCH;
    constexpr int KPT = (NKC + 511) / 512, VPT = (NVC + 511) / 512;
    constexpr int NK0 = DK / 16, NQG = NK0 / 2;
    const int tid = TIDX, wave = __builtin_amdgcn_readfirstlane(tid >> 6), lane = tid & 63, r = lane & 31, hh = lane >> 5;
    const int i16 = lane & 15, tq = i16 >> 2, tp = i16 & 3, blk = (lane >> 4) & 1;
    const int nlat = NB * a.nheads * 8, ntot = nlat + (a.ctx_out ? NB * a.nheads : 0);
    LAS float* rpbL = (LAS float*)(lds + OFFR);
    for (int item = BIDX; item < ntot; item += gridDim.x) {
        int b, h, qb = 0; const bool isctx = item >= nlat;
        if (!isctx) { const int R = item >> 8, u = item & 255; const int qp = (R * 8 + (u & 7)) * 4 + (u >> 6); qb = (u >> 3) & 7; h = qp % a.nheads; b = qp / a.nheads; }
        else { const int bh = item - nlat; h = bh % a.nheads; b = bh / a.nheads; }
        const int hk = h >> a.gshift;
        const size_t rb = (size_t)b * TT;
        const bf16_t* Kb = a.K + hk * a.kh; const bf16_t* Vb = a.V + hk * a.vh;
        int ntiles = isctx ? 4 : 36, rlo = 0, wi = 0, wr0 = 0, c0 = 0;
        if (NA) {
            if (!isctx) { const int i0 = qb * 4; rlo = clampi(i0 - 4, 0, 24); const int rhi = clampi(i0 - 1, 0, 24) + 8; ntiles = 4 + rhi - rlo;
                wi = i0 + (wave >> 1); wr0 = clampi(wi - 4, 0, 24); c0 = (wave & 1) * 32; }
            if (tid < 465) rpbL[64 + tid] = a.rpb[h * 465 + tid] * LOG2E;
        }
        const size_t qrow = rb + (isctx ? 0 : 256 + qb * 256) + wave * 32 + r;
        bf16x8 qf[DK / 16];
#pragma unroll
        for (int k0 = 0; k0 < DK / 16; ++k0) qf[k0] = *(const bf16x8*)(a.Q + qrow * a.qs + h * a.qh + k0 * 16 + hh * 8);
        u32x4 kreg[KPT], vreg[VPT];
#define ATT_TILE_ROW(j) ((NA && (j) >= 4) ? rb + 256 + (size_t)(rlo + (j) - 4) * 64 : rb + (size_t)(j) * 64)
#define ATT_GLOADK(j) do { const size_t _tr = ATT_TILE_ROW(j); \
        _Pragma("unroll") for (int _i = 0; _i < KPT; ++_i) { const int _c = tid + _i * 512; if (_c < NKC) { const int _row = _c / KCH, _cc = _c - _row * KCH; kreg[_i] = *(const u32x4*)(Kb + (_tr + _row) * a.ks + _cc * 8); } } } while (0)
#define ATT_GLOADV(j) do { const size_t _tr = ATT_TILE_ROW(j); \
        _Pragma("unroll") for (int _i = 0; _i < VPT; ++_i) { const int _c = tid + _i * 512; if (_c < NVC) { const int _row = _c / VCH, _cc = _c - _row * VCH; vreg[_i] = *(const u32x4*)(Vb + (_tr + _row) * a.vs + _cc * 8); } } } while (0)
#define ATT_LSTOREK(buf) do { \
        _Pragma("unroll") for (int _i = 0; _i < KPT; ++_i) { const int _c = tid + _i * 512; if (_c < NKC) { const int _row = _c / KCH, _cc = _c - _row * KCH; *(LAS u32x4*)(lds + OFFK + (buf) * KBUF + _row * KROW + _cc * 16) = kreg[_i]; } } } while (0)
#define ATT_LSTOREV(buf) do { \
        _Pragma("unroll") for (int _i = 0; _i < VPT; ++_i) { const int _c = tid + _i * 512; if (_c < NVC) { const int _row = _c / VCH, _cc = _c - _row * VCH; *(LAS u32x4*)(lds + OFFV + (buf) * VBUF + _row * VROW + _cc * 16) = vreg[_i]; } } } while (0)
#define ATT_KFRAG(buf, idx) (*(const LAS bf16x8*)(lds + OFFK + (buf) * KBUF + (((idx) / NK0) * 32 + r) * KROW + ((idx) % NK0) * 32 + hh * 16))
#define ATT_QK(dst, buf) do { \
        _Pragma("unroll") for (int _x = 0; _x < 2 * NK0; ++_x) { const bf16x8 kf = ATT_KFRAG(buf, _x); \
            dst[_x / NK0] = __builtin_amdgcn_mfma_f32_32x32x16_bf16(kf, qf[_x % NK0], (_x % NK0) == 0 ? zero16 : dst[_x / NK0], 0, 0, 0); } } while (0)
#define ATT_ACTIVE(j) (!(NA && (j) >= 4) || ((rlo + (j) - 4 >= wr0) && (rlo + (j) - 4 < wr0 + 8)))
#define ATT_TILE(j, S, SN) do { \
        if ((j) + 2 < ntiles) ATT_GLOADK((j) + 2); \
        if ((j) + 1 < ntiles) ATT_GLOADV((j) + 1); \
        if (ATT_ACTIVE(j)) { \
            const int nb = ((j) + 1) & 1; \
            const LAS unsigned char* Vt = lds + OFFV + ((j) & 1) * VBUF; \
            bf16x8 kfr[2][NQG]; \
            _Pragma("unroll") for (int q = 0; q < NQG; ++q) kfr[0][q] = ATT_KFRAG(nb, q); \
            float mx = m_run; \
            if (NA && (j) >= 4) { \
                const int kr = rlo + (j) - 4; \
                const int ri = kr - wi + 7, qj = c0 + r, cs = clampi(qj - 8, 0, 48); \
                const LAS float* bp = rpbL + 64 + ri * 31 + (4 * hh - qj + 15); \
                const int vb = 4 * hh - cs; \
                _Pragma("unroll") for (int kb = 0; kb < 2; ++kb) \
                    _Pragma("unroll") for (int i = 0; i < 16; ++i) { \
                        const int ci = kb * 32 + (i & 3) + 8 * (i >> 2); \
                        const bool valid = (unsigned)(vb + ci) < 16u; \
                        const float x = valid ? __builtin_fmaf(S[kb][i], a.sc, bp[ci]) : -1e30f; \
                        S[kb][i] = x; mx = fmaxf(mx, x); } \
                mx = fmaxf(mx, __shfl_xor(mx, 32)); \
            } else { \
                float mr = -1e30f; \
                _Pragma("unroll") for (int kb = 0; kb < 2; ++kb) \
                    _Pragma("unroll") for (int i = 0; i < 16; ++i) mr = fmaxf(mr, S[kb][i]); \
                mr = fmaxf(mr, __shfl_xor(mr, 32)); \
                mx = fmaxf(mx, mr * a.sc); \
            } \
            if (__any(mx != m_run)) { \
                const float alpha = fexp2(m_run - mx); \
                lsum *= alpha; \
                _Pragma("unroll") for (int d = 0; d < DV / 32; ++d) \
                    _Pragma("unroll") for (int i = 0; i < 16; ++i) o[d][i] *= alpha; \
            } \
            m_run = mx; \
            __builtin_amdgcn_sched_barrier(0); \
            _Pragma("unroll") for (int grp = 0; grp < 4; ++grp) { \
                const int kb = grp >> 1, st = grp & 1; \
                if (grp < 3) { _Pragma("unroll") for (int q = 0; q < NQG; ++q) kfr[(grp + 1) & 1][q] = ATT_KFRAG(nb, (grp + 1) * NQG + q); } \
                bf16x8 vf[DV / 32]; \
                _Pragma("unroll") for (int d = 0; d < DV / 32; ++d) { \
                    const LAS unsigned char* ad = Vt + (kb * 32 + 16 * st + 4 * hh + tq) * VROW + (d * 32 + 16 * blk + 4 * tp) * 2; \
                    const s16x4 lo = __builtin_amdgcn_ds_read_tr16_b64_v4i16((LAS s16x4*)ad); \
                    const s16x4 hi = __builtin_amdgcn_ds_read_tr16_b64_v4i16((LAS s16x4*)(ad + 8 * VROW)); \
                    vf[d] = __builtin_shufflevector(lo, hi, 0, 1, 2, 3, 4, 5, 6, 7); } \
                _Pragma("unroll") for (int q = 0; q < NQG; ++q) { const int idx = grp * NQG + q; \
                    SN[idx / NK0] = __builtin_amdgcn_mfma_f32_32x32x16_bf16(kfr[grp & 1][q], qf[idx % NK0], (idx % NK0) == 0 ? zero16 : SN[idx / NK0], 0, 0, 0); } \
                __builtin_amdgcn_sched_barrier(0); \
                float pp[8]; \
                _Pragma("unroll") for (int i = 0; i < 8; ++i) { \
                    pp[i] = (NA && (j) >= 4) ? fexp2(S[kb][8 * st + i] - mx) : fexp2(__builtin_fmaf(S[kb][8 * st + i], a.sc, -mx)); lsum += pp[i]; } \
                const bf16x8 pf = __builtin_bit_cast(bf16x8, pack8(pp)); \
                __builtin_amdgcn_sched_barrier(0); \
                _Pragma("unroll") for (int d = 0; d < DV / 32; ++d) o[d] = __builtin_amdgcn_mfma_f32_32x32x16_bf16(vf[d], pf, o[d], 0, 0, 0); \
                __builtin_amdgcn_sched_barrier(0); \
            } \
        } else { \
            ATT_QK(SN, ((j) + 1) & 1); \
        } \
        if ((j) + 2 < ntiles) ATT_LSTOREK((j) & 1); \
        if ((j) + 1 < ntiles) ATT_LSTOREV(((j) + 1) & 1); \
        __syncthreads(); } while (0)
        ATT_GLOADK(0); ATT_GLOADV(0); ATT_LSTOREK(0); ATT_LSTOREV(0);
        ATT_GLOADK(1); ATT_LSTOREK(1);
        __syncthreads();
        f32x16 o[DV / 32];
#pragma unroll
        for (int d = 0; d < DV / 32; ++d)
#pragma unroll
            for (int i = 0; i < 16; ++i) o[d][i] = 0.f;
        f32x16 zero16;
#pragma unroll
        for (int i = 0; i < 16; ++i) zero16[i] = 0.f;
        float m_run = -1e30f, lsum = 0.f;
        f32x16 s[2], sn[2];
        ATT_QK(s, 0);
        __syncthreads();
        for (int j = 0; j < ntiles; j += 2) {
            ATT_TILE(j, s, sn);
            if (j + 1 < ntiles) ATT_TILE(j + 1, sn, s);
        }
        lsum += __shfl_xor(lsum, 32);
        const float inv = frcp(lsum);
        bf16_t* orow = a.O + (qrow << 10) + h * DV;
#pragma unroll
        for (int d = 0; d < DV / 32; ++d)
#pragma unroll
            for (int g = 0; g < 4; ++g)
                *(u32x2*)(orow + d * 32 + 8 * g + 4 * hh) = (u32x2){pk_bf16(o[d][4 * g] * inv, o[d][4 * g + 1] * inv), pk_bf16(o[d][4 * g + 2] * inv, o[d][4 * g + 3] * inv)};
#undef ATT_TILE_ROW
#undef ATT_GLOADK
#undef ATT_GLOADV
#undef ATT_LSTOREK
#undef ATT_LSTOREV
#undef ATT_KFRAG
#undef ATT_QK
#undef ATT_ACTIVE
#undef ATT_TILE
    }
}

DI void s5_scan_phase(LAS unsigned char* lds, const Params& p, bf16_t* H, float* YF) {
    const int TIDX = otid(); const int BIDX = obid(); (void)TIDX; (void)BIDX;
    const int wave = __builtin_amdgcn_readfirstlane(TIDX >> 6), lane = TIDX & 63;
    LAS float* BU = (LAS float*)(lds + wave * 12800);
    LAS bf16_t* Hh = (LAS bf16_t*)(lds + wave * 12800 + 8448);
    const int l15 = lane & 15, l4 = lane >> 4;
    for (int item = BIDX * 8 + wave; item < NB * 64; item += gridDim.x * 8) {
        const int g = item & 63, b = item >> 6;
        const float dsk = p.in[I_SD][g * 16 + l15];
        for (int dir = 0; dir < 2; ++dir) {
            const int pg = dir * 64 + g;
            const float dt = __expf(p.in[I_SLDT][pg]);
            const float* are = p.in[I_SARE] + pg * 64; const float* aim = p.in[I_SAIM] + pg * 64;
            float abr, abi;
            { const float ar = are[lane], ai = aim[lane]; const float mag = __expf(dt * ar); abr = mag * __cosf(dt * ai); abi = mag * __sinf(dt * ai); }
            bf16x8 bfr[8], cfr[4];
#pragma unroll
            for (int nt = 0; nt < 8; ++nt) {
                const int st = (nt & 3) * 16 + l15;
                const float ar = are[st], ai = aim[st]; const float mag = __expf(dt * ar);
                const float er = mag * __cosf(dt * ai), ei = mag * __sinf(dt * ai);
                const float den = ar * ar + ai * ai, nr = er - 1.f;
                const float fre = (nr * ar + ei * ai) / den, fim = (ei * ar - nr * ai) / den;
                float bb[8];
#pragma unroll
                for (int j = 0; j < 8; ++j) bb[j] = 0.f;
                if (lane < 32) {
                    const float* br = p.in[I_SBRE] + ((size_t)pg * 64 + st) * 16 + l4 * 8; const float* bi = p.in[I_SBIM] + ((size_t)pg * 64 + st) * 16 + l4 * 8;
#pragma unroll
                    for (int j = 0; j < 8; ++j) bb[j] = (nt < 4) ? (fre * br[j] - fim * bi[j]) : (fre * bi[j] + fim * br[j]);
                }
                bfr[nt] = __builtin_bit_cast(bf16x8, pack8(bb));
            }
#pragma unroll
            for (int kk = 0; kk < 4; ++kk) {
                const int k = (kk & 1) * 32 + l4 * 8;
                const float* cp = (kk < 2 ? p.in[I_SCRE] : p.in[I_SCIM]) + ((size_t)pg * 16 + l15) * 64 + k;
                float cc[8];
#pragma unroll
                for (int j = 0; j < 8; ++j) cc[j] = (kk < 2) ? cp[j] : -cp[j];
                cfr[kk] = __builtin_bit_cast(bf16x8, pack8(cc));
            }
            float hr = 0.f, hi = 0.f;
            for (int j = 0; j < 144; ++j) {
                const int tb = dir ? (j < 16 ? 16 * (15 - j) : 256 + 16 * (143 - j)) : 16 * j;
                const size_t row0 = (size_t)b * TT + tb;
                bf16x8 uf = (bf16x8){0, 0, 0, 0, 0, 0, 0, 0};
                if (lane < 32) uf = *(const bf16x8*)(H + ((row0 + l15) << 10) + g * 16 + l4 * 8);
#pragma unroll
                for (int nt = 0; nt < 8; ++nt) {
                    const f32x4 acc = __builtin_amdgcn_mfma_f32_16x16x32_bf16(uf, bfr[nt], (f32x4){0.f, 0.f, 0.f, 0.f}, 0, 0, 0);
#pragma unroll
                    for (int i = 0; i < 4; ++i) BU[(l4 * 4 + i) * 132 + nt * 16 + l15] = acc[i];
                }
                float bur[16], bui[16];
#pragma unroll
                for (int tt = 0; tt < 16; ++tt) { bur[tt] = BU[tt * 132 + lane]; bui[tt] = BU[tt * 132 + 64 + lane]; }
                if (dir) {
#pragma unroll
                    for (int tt = 15; tt >= 0; --tt) {
                        const float nhr = abr * hr - abi * hi + bur[tt], nhi = abr * hi + abi * hr + bui[tt];
                        hr = nhr; hi = nhi;
                        const unsigned pr = pk_bf16(hr, hi);
                        Hh[tt * 136 + lane] = (bf16_t)(pr & 0xffffu); Hh[tt * 136 + 64 + lane] = (bf16_t)(pr >> 16);
                    }
                } else {
#pragma unroll
                    for (int tt = 0; tt < 16; ++tt) {
                        const float nhr = abr * hr - abi * hi + bur[tt], nhi = abr * hi + abi * hr + bui[tt];
                        hr = nhr; hi = nhi;
                        const unsigned pr = pk_bf16(hr, hi);
                        Hh[tt * 136 + lane] = (bf16_t)(pr & 0xffffu); Hh[tt * 136 + 64 + lane] = (bf16_t)(pr >> 16);
                    }
                }
                f32x4 ya = (f32x4){0.f, 0.f, 0.f, 0.f};
#pragma unroll
                for (int kk = 0; kk < 4; ++kk) {
                    const bf16x8 af = *(const LAS bf16x8*)(Hh + l15 * 136 + kk * 32 + l4 * 8);
                    ya = __builtin_amdgcn_mfma_f32_16x16x32_bf16(af, cfr[kk], ya, 0, 0, 0);
                }
                if (dir == 0) {
#pragma unroll
                    for (int i = 0; i < 4; ++i) YF[((row0 + l4 * 4 + i) << 10) + g * 16 + l15] = ya[i];
                } else {
#pragma unroll
                    for (int i = 0; i < 4; ++i) {
                        const size_t o = ((row0 + l4 * 4 + i) << 10) + g * 16 + l15;
                        const float u = __uint_as_float(((unsigned)H[o]) << 16);
                        const float y = gelu_tanh(dsk * u + YF[o] + ya[i]);
                        H[o] = (bf16_t)(pk_bf16(y, 0.f) & 0xffffu);
                    }
                }
            }
        }
    }
}

#define XB_TMO      128
#define XB_XCNT(j)  (256  + 64 * (j))
#define XB_XSUB(j)  (1280 + 64 * (j))
#define XB_XGEN(j)  (2304 + 64 * (j))
#define XB_TOP      3328
#define XB_TOPGEN   3392
#define XCD_BAR_WORDS 3456
#define XB_SPIN_CAP (1u << 18)
DI unsigned xb_ld(unsigned* p)              { return __hip_atomic_load(p, __ATOMIC_RELAXED, __HIP_MEMORY_SCOPE_AGENT); }
DI unsigned xb_add(unsigned* p, unsigned v) { return __hip_atomic_fetch_add(p, v, __ATOMIC_RELAXED, __HIP_MEMORY_SCOPE_AGENT); }
DI unsigned xb_xcc_id() { return (unsigned)__builtin_amdgcn_s_getreg((3 << 11) | 20) & 0xFu; }
#define XB_SPIN(cond, bar) do { unsigned _sp = 0; while (cond) { __builtin_amdgcn_s_sleep(1); \
    if ((++_sp & 255u) == 0u) { if (xb_ld(&(bar)[XB_TMO])) break; if (_sp > XB_SPIN_CAP) { atomicAdd(&(bar)[XB_TMO], 1u); break; } } } } while (0)
struct XcdBarrier { unsigned* bar; unsigned x; volatile LAS unsigned* st; };
DI XcdBarrier xcd_barrier_post(unsigned* bar, volatile LAS unsigned* st) {
    XcdBarrier b; b.bar = bar; b.x = xb_xcc_id(); b.st = st;
    if (threadIdx.x == 0) (void)xb_add(&bar[XB_XCNT(b.x)], 1u);
    return b;
}
DI void xcd_barrier_complete(unsigned* bar, unsigned x, unsigned& nloc, unsigned& nx) {
    const unsigned G = gridDim.x * gridDim.y * gridDim.z;
    unsigned sum, cnt, mine, sp = 0u;
    for (;;) {
        sum = 0u; cnt = 0u; mine = 0u;
#pragma unroll
        for (unsigned j = 0; j < 16; ++j) { const unsigned c = xb_ld(&bar[XB_XCNT(j)]); sum += c; cnt += (c > 0u) ? 1u : 0u; mine = (j == x) ? c : mine; }
        if (sum == G) break;
        __builtin_amdgcn_s_sleep(1);
        if ((++sp & 255u) == 0u) { if (xb_ld(&bar[XB_TMO])) break; if (sp > XB_SPIN_CAP) { atomicAdd(&bar[XB_TMO], 1u); break; } }
    }
    nloc = mine > 0u ? mine : 1u; nx = cnt > 0u ? cnt : 1u;
}
DI void xcd_barrier(const XcdBarrier& b) {
    asm volatile("s_waitcnt vmcnt(0)" ::: "memory");
    __syncthreads();
    if (threadIdx.x == 0) {
        unsigned* bar = b.bar;
        __builtin_amdgcn_s_waitcnt(0);
        unsigned nloc = b.st[0], nx = b.st[1];
        if (nloc == 0u) { xcd_barrier_complete(bar, b.x, nloc, nx); b.st[0] = nloc; b.st[1] = nx; }
        const unsigned old = xb_add(&bar[XB_XSUB(b.x)], 1u);
        const unsigned gen = old / nloc;
        if (old + 1u == (gen + 1u) * nloc) {
            __builtin_amdgcn_fence(__ATOMIC_RELEASE, "agent");
            asm volatile("s_waitcnt vmcnt(0)" ::: "memory");
            const unsigned og = xb_add(&bar[XB_TOP], 1u);
            const unsigned tg = og / nx;
            if (og + 1u == (tg + 1u) * nx) xb_add(&bar[XB_TOPGEN], 1u);
            else XB_SPIN(xb_ld(&bar[XB_TOPGEN]) == tg, bar);
            __builtin_amdgcn_fence(__ATOMIC_ACQUIRE, "agent");
            xb_add(&bar[XB_XGEN(b.x)], 1u);
            asm volatile("s_waitcnt vmcnt(0)" ::: "memory");
        } else {
            XB_SPIN(xb_ld(&bar[XB_XGEN(b.x)]) == gen, bar);
            __builtin_amdgcn_fence(__ATOMIC_ACQUIRE, "agent");
            asm volatile("s_waitcnt vmcnt(0)" ::: "memory");
        }
    }
    __syncthreads();
}

__global__ void __launch_bounds__(512, 2) mega(const Params p) {
    extern __shared__ __attribute__((aligned(16))) unsigned char shm[];
    LAS unsigned char* lds = (LAS unsigned char*)shm;
    cg::grid_group grid = cg::this_grid();
    LAS unsigned* xbst = (LAS unsigned*)(lds + 131072);
    if (threadIdx.x < 4) xbst[threadIdx.x] = 0u;
    __syncthreads();
    const XcdBarrier xb = xcd_barrier_post((unsigned*)(p.ws + OFF_BAR), (volatile LAS unsigned*)xbst);
    unsigned char* ws = p.ws;
    float* ADA = (float*)(ws + OFF_ADA);
    float* XC = (float*)(ws + OFF_XC);
    bf16_t* HB = (bf16_t*)(ws + OFF_HB);
    float* LAT = p.out;
    int pid = 0;
#define PH_BEGIN if (pid >= p.ph_lo && pid < p.ph_hi) {
#define PH_END if (pid + 1 < p.ph_hi) { if (pid == 0) grid.sync(); else xcd_barrier(xb); } } ++pid;

    PH_BEGIN
    {
        LAS float* tile = (LAS float*)lds;
        for (int i = 0; i < 4; ++i) {
            prep_weight(tile, WDesc{p.in[I_FWIN] + (size_t)i * 1024 * 5632, (bf16_t*)(ws + OFF_WFI + i * SZ_WFI), 1024, 5632, 5632, 2816, nullptr});
            prep_weight(tile, WDesc{p.in[I_FWOUT] + (size_t)i * 2816 * 1024, (bf16_t*)(ws + OFF_WFO + i * SZ_WFO), 2816, 1024, 1024, 0, nullptr});
        }
        prep_weight(tile, WDesc{p.in[I_MWIN], (bf16_t*)(ws + OFF_WMI), 1024, 672, 768, 0, nullptr});
        prep_weight(tile, WDesc{p.in[I_MWUQ], (bf16_t*)(ws + OFF_WUQ), 384, 1536, 1536, 0, p.in[I_MGQ]});
        prep_weight(tile, WDesc{p.in[I_MWUKV], (bf16_t*)(ws + OFF_WUKV), 256, 2048, 2048, 0, p.in[I_MGKV]});
        prep_weight(tile, WDesc{p.in[I_MWO], (bf16_t*)(ws + OFF_WMO), 1024, 1024, 1024, 0, nullptr});
        prep_weight(tile, WDesc{p.in[I_SWGLU], (bf16_t*)(ws + OFF_WGLU), 1024, 2048, 2048, 1024, nullptr});
        prep_weight(tile, WDesc{p.in[I_NWQKV], (bf16_t*)(ws + OFF_WNQ), 1024, 3072, 3072, 0, nullptr});
        prep_weight(tile, WDesc{p.in[I_NWO], (bf16_t*)(ws + OFF_WNO), 1024, 1024, 1024, 0, nullptr});
        prep_weight(tile, WDesc{p.in[I_GWQKV], (bf16_t*)(ws + OFF_WGQ), 1024, 1536, 1536, 0, nullptr});
        prep_weight(tile, WDesc{p.in[I_GWO], (bf16_t*)(ws + OFF_WGO), 1024, 1024, 1024, 0, nullptr});
        ada_phase(p, ADA);
    }
    PH_END

    for (int layer = 0; layer < 4; ++layer) {
        const float* ada = ADA + (size_t)layer * 33 * 6144;
        const int last = layer == 3;
        PH_BEGIN
        norm_phase(layer == 0 ? p.in[I_X] : LAT, layer == 0 ? p.in[I_CTX] : XC, LAT, XC, layer == 0, p.in[I_NMIX] + layer * 1024, ada, 0, HB, false);
        PH_END
        if (layer == 0) {
            bf16_t* Z = (bf16_t*)(ws + OFF_Z); bf16_t* KV = (bf16_t*)(ws + OFF_KV); bf16_t* QB = (bf16_t*)(ws + OFF_QB);
            PH_BEGIN
            run_gemm(lds, HB, 1024, (const bf16_t*)(ws + OFF_WMI), 768, 1024, 0, pg8::EpiStore{Z, 768, 0});
            PH_END
            PH_BEGIN
            run_gemm(lds, Z, 768, (const bf16_t*)(ws + OFF_WUQ), 1536, 384, 0, pg8::EpiStore{QB, 1536, 0});
            run_gemm(lds, Z + 384, 768, (const bf16_t*)(ws + OFF_WUKV), 2048, 256, 0, pg8::EpiStore{KV, 2560, 1});
            PH_END
            PH_BEGIN
            mla_r2(QB, KV, Z, p.in[I_MGQN], p.in[I_MGKN]);
            PH_END
            PH_BEGIN
            attn_phase<96, 64, 0>(lds, AttnArgs{QB, KV, KV + 96, HB, 1536, 96, 2560, 160, 2560, 160, 16, 0, 1, nullptr, 0.10206207261596575f * LOG2E});
            PH_END
            PH_BEGIN
            run_gemm(lds, HB, 1024, (const bf16_t*)(ws + OFF_WMO), 1024, 1024, 0, pg8::EpiRes{LAT, XC, ada, 2});
            PH_END
        } else if (layer == 1) {
            float* YF = (float*)(ws + OFF_BIG);
            PH_BEGIN
            s5_scan_phase(lds, p, HB, YF);
            PH_END
            PH_BEGIN
            run_gemm(lds, HB, 1024, (const bf16_t*)(ws + OFF_WGLU), 2048, 1024, 0, pg8::EpiGluRes{LAT, XC, ada, 2});
            PH_END
        } else if (layer == 2) {
            bf16_t* QKV = (bf16_t*)(ws + OFF_BIG);
            PH_BEGIN
            run_gemm(lds, HB, 1024, (const bf16_t*)(ws + OFF_WNQ), 3072, 1024, 0, pg8::EpiStore{QKV, 3072, 0});
            PH_END
            PH_BEGIN
            headnorm_phase<64, 4, 0>(QKV, 3072, 16, 1024, 16, p.in[I_NGQN], p.in[I_NGKN]);
            PH_END
            PH_BEGIN
            attn_phase<64, 64, 1>(lds, AttnArgs{QKV, QKV + 1024, QKV + 2048, HB, 3072, 64, 3072, 64, 3072, 64, 16, 0, 1, p.in[I_NRPB], 0.125f * LOG2E});
            PH_END
            PH_BEGIN
            run_gemm(lds, HB, 1024, (const bf16_t*)(ws + OFF_WNO), 1024, 1024, 0, pg8::EpiRes{LAT, XC, ada, 2});
            PH_END
        } else {
            bf16_t* QKV = (bf16_t*)(ws + OFF_BIG);
            PH_BEGIN
            run_gemm(lds, HB, 1024, (const bf16_t*)(ws + OFF_WGQ), 1536, 1024, 0, pg8::EpiStore{QKV, 1536, 0});
            PH_END
            PH_BEGIN
            headnorm_phase<128, 8, 1>(QKV, 1536, 8, 1024, 2, p.in[I_GGQN], p.in[I_GGKN]);
            PH_END
            PH_BEGIN
            attn_phase<128, 128, 0>(lds, AttnArgs{QKV, QKV + 1024, QKV + 1280, HB, 1536, 128, 1536, 128, 1536, 128, 8, 2, 0, nullptr, 0.08838834764831845f * LOG2E});
            PH_END
            PH_BEGIN
            run_gemm(lds, HB, 1024, (const bf16_t*)(ws + OFF_WGO), 1024, 1024, 1, pg8::EpiRes{LAT, XC, ada, 2});
            PH_END
        }
        bf16_t* ACT = (bf16_t*)(ws + OFF_BIG);
        PH_BEGIN
        norm_phase(LAT, XC, LAT, XC, false, p.in[I_NFFN] + layer * 1024, ada, 3, HB, last);
        PH_END
        PH_BEGIN
        run_gemm(lds, HB, 1024, (const bf16_t*)(ws + OFF_WFI + layer * SZ_WFI), 5632, 1024, last, pg8::EpiSwiglu{ACT, FH});
        PH_END
        PH_BEGIN
        run_gemm(lds, ACT, 2816, (const bf16_t*)(ws + OFF_WFO + layer * SZ_WFO), 1024, 2816, last, pg8::EpiRes{LAT, XC, ada, 5});
        PH_END
    }
}

extern "C" void kernel_launch(void* const* d_in, const int* in_sizes, int n_in, void* d_out, int out_size, void* d_ws, size_t ws_size, hipStream_t stream) {
    static int grid_blocks = 0;
    if (!grid_blocks) {
        hipFuncSetAttribute((const void*)mega, hipFuncAttributeMaxDynamicSharedMemorySize, LDS_BYTES);
        int dev = 0, cus = 0, per_cu = 0;
        hipGetDevice(&dev);
        hipDeviceGetAttribute(&cus, hipDeviceAttributeMultiprocessorCount, dev);
        hipOccupancyMaxActiveBlocksPerMultiprocessor(&per_cu, mega, 512, LDS_BYTES);
        if (per_cu < 1) per_cu = 1;
        grid_blocks = cus * 1;
    }
    if (ws_size < WS_NEED) fprintf(stderr, "workspace too small: %zu < %zu\n", ws_size, (size_t)WS_NEED);
    Params p; memset(&p, 0, sizeof(p));
    for (int i = 0; i < N_IN; ++i) p.in[i] = (const float*)d_in[i];
    p.out = (float*)d_out; p.ws = (unsigned char*)d_ws; p.ph_lo = 0; p.ph_hi = 1000;
    hipMemsetAsync((unsigned char*)d_ws + OFF_BAR, 0, 16384, stream);
    void* args[] = {&p};
    hipError_t e = hipLaunchCooperativeKernel((const void*)mega, dim3(grid_blocks), dim3(512), args, LDS_BYTES, stream);
    if (e != hipSuccess) fprintf(stderr, "cooperative launch failed: %s (grid %d)\n", hipGetErrorString(e), grid_blocks);
}
```

```cpp
#include <hip/hip_runtime.h>
#include <hip/hip_cooperative_groups.h>
#include <cstdio>
#include <cstring>
namespace cg = cooperative_groups;

#define DI __device__ __forceinline__
#define LAS __attribute__((address_space(3)))
typedef unsigned short bf16_t;
typedef short bf16x8 __attribute__((ext_vector_type(8)));
typedef short s16x4 __attribute__((ext_vector_type(4)));
typedef float f32x4 __attribute__((ext_vector_type(4)));
typedef float f32x16 __attribute__((ext_vector_type(16)));
typedef unsigned u32x4 __attribute__((ext_vector_type(4)));
typedef unsigned u32x2 __attribute__((ext_vector_type(2)));
typedef __bf16 bf2_t __attribute__((ext_vector_type(2)));
typedef float f2_t __attribute__((ext_vector_type(2)));

constexpr int NB = 32, SEQ = 2048, CTXL = 256, TT = 2304, NR = NB * TT, DM = 1024, FH = 2816;
constexpr float EPS = 1e-6f, LOG2E = 1.4426950408889634f, L2_10000 = 13.287712379549449f;
constexpr int LDS_BYTES = 133120 + 64;

enum { I_X, I_C, I_CTX, I_CCTX, I_ADAW, I_ADAB, I_NMIX, I_NFFN, I_FWIN, I_FWOUT,
       I_MWIN, I_MGQ, I_MGKV, I_MWUQ, I_MWUKV, I_MGQN, I_MGKN, I_MWO,
       I_SARE, I_SAIM, I_SLDT, I_SBRE, I_SBIM, I_SCRE, I_SCIM, I_SD, I_SWGLU,
       I_NWQKV, I_NGQN, I_NGKN, I_NRPB, I_NWO, I_GWQKV, I_GGQN, I_GGKN, I_GWO, N_IN };

constexpr size_t SZ_WFI = (size_t)5632 * 1024 * 2, SZ_WFO = (size_t)1024 * 2816 * 2;
constexpr size_t OFF_WFI = 0;
constexpr size_t OFF_WFO = OFF_WFI + 4 * SZ_WFI;
constexpr size_t OFF_WMI = OFF_WFO + 4 * SZ_WFO;
constexpr size_t OFF_WUQ = OFF_WMI + (size_t)768 * 1024 * 2;
constexpr size_t OFF_WUKV = OFF_WUQ + (size_t)1536 * 384 * 2;
constexpr size_t OFF_WMO = OFF_WUKV + (size_t)2048 * 256 * 2;
constexpr size_t OFF_WGLU = OFF_WMO + (size_t)1024 * 1024 * 2;
constexpr size_t OFF_WNQ = OFF_WGLU + (size_t)2048 * 1024 * 2;
constexpr size_t OFF_WNO = OFF_WNQ + (size_t)3072 * 1024 * 2;
constexpr size_t OFF_WGQ = OFF_WNO + (size_t)1024 * 1024 * 2;
constexpr size_t OFF_WGO = OFF_WGQ + (size_t)1536 * 1024 * 2;
constexpr size_t OFF_ADA = OFF_WGO + (size_t)1024 * 1024 * 2;
constexpr size_t OFF_XC = OFF_ADA + (size_t)4 * 33 * 6144 * 4;
constexpr size_t OFF_HB = OFF_XC + (size_t)NB * CTXL * 1024 * 4;
constexpr size_t OFF_BIG = OFF_HB + (size_t)NR * 1024 * 2;
constexpr size_t OFF_KV = OFF_BIG;
constexpr size_t OFF_QB = OFF_KV + (size_t)NR * 2560 * 2;
constexpr size_t OFF_Z = OFF_QB + (size_t)NR * 1536 * 2;
constexpr size_t OFF_BAR = OFF_Z + (size_t)NR * 768 * 2;
constexpr size_t WS_NEED = OFF_BAR + 16384;

struct Params {
    const float* in[N_IN];
    float* out;
    unsigned char* ws;
    int ph_lo, ph_hi;
};

DI unsigned pk_bf16(float a, float b) { f2_t v = {a, b}; bf2_t r = __builtin_convertvector(v, bf2_t); return __builtin_bit_cast(unsigned, r); }
DI float bf_lo(unsigned u) { return __uint_as_float(u << 16); }
DI float bf_hi(unsigned u) { return __uint_as_float(u & 0xffff0000u); }
DI float wsum(float v) {
#pragma unroll
    for (int o = 32; o > 0; o >>= 1) v += __shfl_xor(v, o);
    return v;
}
DI int otid() { int t = threadIdx.x; asm volatile("" : "+v"(t)); return t; }
DI int obid() { int b = blockIdx.x; asm volatile("" : "+s"(b)); return b; }
DI int clampi(int v, int lo, int hi) { return v < lo ? lo : (v > hi ? hi : v); }
DI float fexp2(float x) { return __builtin_amdgcn_exp2f(x); }
DI float frcp(float x) { return __builtin_amdgcn_rcpf(x); }
DI float silu_f(float a) { return a * frcp(1.f + __expf(-a)); }
DI float sigmoid_f(float a) { return frcp(1.f + __expf(-a)); }
DI float gelu_tanh(float y) {
    const float z = 0.7978845608028654f * (y + 0.044715f * y * y * y);
    const float t = 1.f - 2.f * frcp(__expf(2.f * z) + 1.f);
    return 0.5f * y * (1.f + t);
}
DI void unpack8(const u32x4 u, float* f) {
#pragma unroll
    for (int i = 0; i < 4; ++i) { f[2 * i] = bf_lo(u[i]); f[2 * i + 1] = bf_hi(u[i]); }
}
DI u32x4 pack8(const float* f) { return (u32x4){pk_bf16(f[0], f[1]), pk_bf16(f[2], f[3]), pk_bf16(f[4], f[5]), pk_bf16(f[6], f[7])}; }

namespace pg8 {
constexpr int BM = 256, BK = 64, HALF = 128, HTB = HALF * BK * 2, NXCD = 8, WGM = 8;
DI int lds_byte(int r, int c) { const int st = (r >> 4) * 2 + (c >> 5), rr = r & 15, cc = c & 31, ob = rr * 64 + cc * 2; return st * 1024 + (ob ^ (((ob >> 9) & 1) << 5)); }
DI void stage_rc(int b, int& R, int& C) { const int st = b / 1024, sb = b % 1024, swz = sb ^ (((sb >> 9) & 1) << 5); R = (st >> 1) * 16 + swz / 64; C = (st & 1) * 32 + (swz % 64) / 2; }
DI int perm32(int rho) { const int n = rho >> 4, i = rho & 15; return 8 * (i >> 2) + 4 * n + (i & 3); }
struct Unit { int pm, pn; };
struct Gemm { const bf16_t* A; const bf16_t* Bt; int M, N, K, lda; };
struct Order {
    int nM, nN, nwg, G, c, skip;
    DI void init(int N, int G_, int c_, int skipctx) { skip = skipctx; nM = skipctx ? 256 : 288; nN = N / BM; nwg = nM * nN; G = G_; c = c_; }
    DI bool next(int i, Unit& u) const {
        const long L = (long)i * G + c; if (L >= nwg) return false;
        int wgid = (int)L; { const int q = nwg / NXCD, r = nwg % NXCD, xcd = wgid % NXCD, off = wgid / NXCD; wgid = (xcd < r ? xcd * (q + 1) : r * (q + 1) + (xcd - r) * q) + off; }
        const int nig = WGM * nN, gid = wgid / nig, fm = gid * WGM, gsz = (nM - fm) < WGM ? (nM - fm) : WGM;
        int pm = fm + ((wgid % nig) % gsz); u.pn = (wgid % nig) / gsz;
        if (skip) pm = pm + (pm >> 3) + 1;
        u.pm = pm; return true;
    }
};

DI float* tile_res_base(float* lat, float* xc, int pm) { const int bb = pm / 9, sub = pm - bb * 9; return sub == 0 ? xc + ((size_t)bb * CTXL << 10) : lat + ((size_t)(bb * SEQ + (sub - 1) * 256) << 10); }
DI int tile_ada_row(int pm) { const int bb = pm / 9, sub = pm - bb * 9; return sub == 0 ? 32 : bb; }

struct EpiStore {
    static constexpr bool PERM = true;
    bf16_t* O; int ldc; int remap;
    DI void operator()(const f32x4 (&acc)[2][2][4][2], const Unit& u, int wr, int wc, int fr, int fq) const {
        const int row0 = u.pm * BM + wr * 64 + fr, col0 = u.pn * BM + wc * 32 + 8 * fq;
#pragma unroll
        for (int ai = 0; ai < 2; ++ai)
#pragma unroll
            for (int m = 0; m < 4; ++m) {
                bf16_t* rowp = O + (size_t)(row0 + ai * HALF + m * 16) * ldc;
#pragma unroll
                for (int bj = 0; bj < 2; ++bj) {
                    const int c = col0 + bj * HALF; const int cc = remap ? (c >> 7) * 160 + (c & 127) : c;
                    const f32x4 v0 = acc[ai][bj][m][0], v1 = acc[ai][bj][m][1];
                    *(u32x4*)(rowp + cc) = (u32x4){pk_bf16(v0[0], v0[1]), pk_bf16(v0[2], v0[3]), pk_bf16(v1[0], v1[1]), pk_bf16(v1[2], v1[3])};
                }
            }
    }
};
struct EpiSwiglu {
    static constexpr bool PERM = true;
    bf16_t* O; int ldc;
    DI void operator()(const f32x4 (&acc)[2][2][4][2], const Unit& u, int wr, int wc, int fr, int fq) const {
        const int row0 = u.pm * BM + wr * 64 + fr, col0 = u.pn * HALF + wc * 32 + 8 * fq;
#pragma unroll
        for (int ai = 0; ai < 2; ++ai)
#pragma unroll
            for (int m = 0; m < 4; ++m) {
                float v[8];
#pragma unroll
                for (int n = 0; n < 2; ++n)
#pragma unroll
                    for (int i = 0; i < 4; ++i) v[n * 4 + i] = silu_f(acc[ai][0][m][n][i]) * acc[ai][1][m][n][i];
                *(u32x4*)(O + (size_t)(row0 + ai * HALF + m * 16) * ldc + col0) = pack8(v);
            }
    }
};
struct EpiGluRes {
    static constexpr bool PERM = true;
    float* lat; float* xc; const float* ada; int gidx;
    DI void operator()(const f32x4 (&acc)[2][2][4][2], const Unit& u, int wr, int wc, int fr, int fq) const {
        float* base = tile_res_base(lat, xc, u.pm);
        const float* gate = ada + (size_t)tile_ada_row(u.pm) * 6144 + gidx * 1024;
        const int col0 = u.pn * HALF + wc * 32 + 8 * fq;
        const f32x4 g0 = *(const f32x4*)(gate + col0), g1 = *(const f32x4*)(gate + col0 + 4);
#pragma unroll
        for (int ai = 0; ai < 2; ++ai)
#pragma unroll
            for (int m = 0; m < 4; ++m) {
                float* rp = base + ((size_t)(ai * HALF + wr * 64 + m * 16 + fr) << 10) + col0;
                f32x4 x0 = *(f32x4*)rp, x1 = *(f32x4*)(rp + 4);
#pragma unroll
                for (int i = 0; i < 4; ++i) {
                    x0[i] += g0[i] * (acc[ai][0][m][0][i] * sigmoid_f(acc[ai][1][m][0][i]));
                    x1[i] += g1[i] * (acc[ai][0][m][1][i] * sigmoid_f(acc[ai][1][m][1][i]));
                }
                *(f32x4*)rp = x0; *(f32x4*)(rp + 4) = x1;
            }
    }
};
struct EpiRes {
    static constexpr bool PERM = false;
    float* lat; float* xc; const float* ada; int gidx;
    DI void operator()(const f32x4 (&acc)[2][2][4][2], const Unit& u, int wr, int wc, int fr, int fq) const {
        float* base = tile_res_base(lat, xc, u.pm);
        const float* gate = ada + (size_t)tile_ada_row(u.pm) * 6144 + gidx * 1024;
        const int col0 = u.pn * BM + wc * 32 + 4 * fq;
        f32x4 gv[2][2];
#pragma unroll
        for (int bj = 0; bj < 2; ++bj)
#pragma unroll
            for (int n = 0; n < 2; ++n) gv[bj][n] = *(const f32x4*)(gate + col0 + bj * HALF + n * 16);
#pragma unroll
        for (int ai = 0; ai < 2; ++ai)
#pragma unroll
            for (int m = 0; m < 4; ++m) {
                float* rp = base + ((size_t)(ai * HALF + wr * 64 + m * 16 + fr) << 10) + col0;
#pragma unroll
                for (int bj = 0; bj < 2; ++bj)
#pragma unroll
                    for (int n = 0; n < 2; ++n) {
                        f32x4 x = *(f32x4*)(rp + bj * HALF + n * 16);
                        x += gv[bj][n] * acc[ai][bj][m][n];
                        *(f32x4*)(rp + bj * HALF + n * 16) = x;
                    }
            }
    }
};

template <class Epi>
DI void gemm_phase(LAS unsigned char* lds, const Gemm g, const Order& S, const Epi& E) {
    const int TIDX = otid(); const int BIDX = obid(); (void)TIDX; (void)BIDX;
    const int tid = TIDX, wid = __builtin_amdgcn_readfirstlane(tid >> 6), lane = tid & 63, wr = wid >> 2, wc = wid & 3, fr = lane & 15, fq = lane >> 4;
    const int K = g.K, nt = K / BK;
    unsigned voffA[2], voffB[2];
#pragma unroll
    for (int i = 0; i < 2; ++i) { int R, C; stage_rc(tid * 16 + i * 8192, R, C); const int Rb = Epi::PERM ? ((R & ~31) + perm32(R & 31)) : R;
        voffA[i] = (unsigned)(R * g.lda + C) * 2u; voffB[i] = (unsigned)(Rb * K + C) * 2u; }
    const size_t kstep = (size_t)(BK * 2);
    const size_t hstep = (size_t)HALF * K * 2, hstepA = (size_t)HALF * g.lda * 2;
    const size_t tstep = 2 * hstep, tstepA = 2 * hstepA;
    const unsigned ldsw = (unsigned)wid * 1024u;
    const int aoff = lds_byte(wr * 64 + fr, fq * 8), boff = lds_byte(wc * 32 + fr, fq * 8);
#define PG8_SA(b, h) (((b) * 2 + (h)) * HTB)
#define PG8_SB(b, h) ((4 + (b) * 2 + (h)) * HTB)
#define PG8_STAGE(bufoff, gbase, voff) do { _Pragma("unroll") for (int _i = 0; _i < 2; ++_i) \
        __builtin_amdgcn_global_load_lds((const unsigned*)((const char*)(gbase) + (voff)[_i]), (LAS unsigned*)(lds + (bufoff) + ldsw + _i * 8192), 16, 0, 0); } while (0)
#define PG8_LDA(dst, b, h) do { _Pragma("unroll") for (int m = 0; m < 4; ++m) _Pragma("unroll") for (int k = 0; k < 2; ++k) dst[m][k] = *(const LAS bf16x8*)(lds + PG8_SA(b, h) + aoff + m * 2048 + k * 1024); } while (0)
#define PG8_LDB(dst, b, h) do { _Pragma("unroll") for (int n = 0; n < 2; ++n) _Pragma("unroll") for (int k = 0; k < 2; ++k) dst[n][k] = *(const LAS bf16x8*)(lds + PG8_SB(b, h) + boff + n * 2048 + k * 1024); } while (0)
#define PG8_MMA(ai, bj, At, Bt) do { __builtin_amdgcn_s_setprio(1); _Pragma("unroll") for (int m = 0; m < 4; ++m) _Pragma("unroll") for (int n = 0; n < 2; ++n) _Pragma("unroll") for (int k = 0; k < 2; ++k) \
        acc[ai][bj][m][n] = __builtin_amdgcn_mfma_f32_16x16x32_bf16(Bt[n][k], At[m][k], acc[ai][bj][m][n], 0, 0, 0); __builtin_amdgcn_s_setprio(0); } while (0)
#define PG8_WAIT_V(n) asm volatile("s_waitcnt vmcnt(" #n ")" ::: "memory")
#define PG8_WAIT_L(n) asm volatile("s_waitcnt lgkmcnt(" #n ")" ::: "memory")
#define PG8_BAR __builtin_amdgcn_s_barrier()
#define PG8_SCHED __builtin_amdgcn_sched_barrier(0)
    Unit cur, nxt; int ui = 0;
    if (!S.next(0, cur)) return;
    f32x4 acc[2][2][4][2];
#pragma unroll
    for (int a = 0; a < 2; ++a)
#pragma unroll
        for (int b = 0; b < 2; ++b)
#pragma unroll
            for (int m = 0; m < 4; ++m)
#pragma unroll
                for (int n = 0; n < 2; ++n) acc[a][b][m][n] = (f32x4){0.f, 0.f, 0.f, 0.f};
    bf16x8 At[4][2], B0[2][2], B1[2][2];
    const char* cA = (const char*)g.A + (size_t)cur.pm * tstepA; const char* cB = (const char*)g.Bt + (size_t)cur.pn * tstep;
    PG8_STAGE(PG8_SB(0, 0), cB, voffB); PG8_STAGE(PG8_SA(0, 0), cA, voffA); PG8_STAGE(PG8_SB(0, 1), cB + hstep, voffB); PG8_STAGE(PG8_SA(0, 1), cA + hstepA, voffA);
    if (wr == 1) PG8_BAR;
    PG8_WAIT_V(4); PG8_BAR;
    PG8_STAGE(PG8_SB(1, 0), cB + kstep, voffB); PG8_STAGE(PG8_SA(1, 0), cA + kstep, voffA); PG8_STAGE(PG8_SB(1, 1), cB + hstep + kstep, voffB);
    PG8_WAIT_V(6); PG8_BAR;
    for (;;) {
        const bool has_next = S.next(ui + 1, nxt);
        const char* nA = has_next ? (const char*)g.A + (size_t)nxt.pm * tstepA : cA; const char* nB = has_next ? (const char*)g.Bt + (size_t)nxt.pn * tstep : cB;
        for (int t = 0; t < nt; t += 2) {
            const bool last = (t == nt - 2);
            const char* a1 = cA + (size_t)(t + 1) * kstep;
            const char* a2 = last ? nA : cA + (size_t)(t + 2) * kstep; const char* b2 = last ? nB : cB + (size_t)(t + 2) * kstep;
            const char* a3 = a2 + kstep; const char* b3 = b2 + kstep;
            PG8_LDB(B0, 0, 0); PG8_SCHED; PG8_LDA(At, 0, 0); PG8_STAGE(PG8_SA(1, 1), a1 + hstepA, voffA);
            PG8_WAIT_L(8); PG8_BAR; PG8_WAIT_L(0); PG8_MMA(0, 0, At, B0); PG8_BAR; PG8_SCHED;
            PG8_LDB(B1, 0, 1); PG8_STAGE(PG8_SB(0, 0), b2, voffB);
            PG8_BAR; PG8_WAIT_L(0); PG8_MMA(0, 1, At, B1); PG8_BAR;
            PG8_LDA(At, 0, 1); PG8_STAGE(PG8_SA(0, 0), a2, voffA);
            PG8_BAR; PG8_WAIT_L(0); PG8_MMA(1, 0, At, B0); PG8_BAR; PG8_SCHED;
            PG8_STAGE(PG8_SB(0, 1), b2 + hstep, voffB);
            PG8_WAIT_V(6); PG8_BAR; PG8_MMA(1, 1, At, B1); PG8_BAR;
            PG8_LDB(B0, 1, 0); PG8_SCHED; PG8_LDA(At, 1, 0); PG8_STAGE(PG8_SA(0, 1), a2 + hstepA, voffA);
            PG8_WAIT_L(8); PG8_BAR; PG8_WAIT_L(0); PG8_MMA(0, 0, At, B0); PG8_BAR; PG8_SCHED;
            PG8_LDB(B1, 1, 1); PG8_STAGE(PG8_SB(1, 0), b3, voffB);
            PG8_BAR; PG8_WAIT_L(0); PG8_MMA(0, 1, At, B1); PG8_BAR;
            PG8_LDA(At, 1, 1); PG8_STAGE(PG8_SA(1, 0), a3, voffA);
            PG8_BAR; PG8_WAIT_L(0); PG8_MMA(1, 0, At, B0); PG8_BAR; PG8_SCHED;
            PG8_STAGE(PG8_SB(1, 1), b3 + hstep, voffB);
            PG8_WAIT_V(6); PG8_BAR; PG8_MMA(1, 1, At, B1); PG8_BAR;
        }
        E(acc, cur, wr, wc, fr, fq);
        if (!has_next) break;
#pragma unroll
        for (int a = 0; a < 2; ++a)
#pragma unroll
            for (int b = 0; b < 2; ++b)
#pragma unroll
                for (int m = 0; m < 4; ++m)
#pragma unroll
                    for (int n = 0; n < 2; ++n) acc[a][b][m][n] = (f32x4){0.f, 0.f, 0.f, 0.f};
        cur = nxt; cA = nA; cB = nB; ++ui;
    }
    PG8_WAIT_V(0);
    if (wr == 0) PG8_BAR;
    PG8_BAR;
#undef PG8_SA
#undef PG8_SB
#undef PG8_STAGE
#undef PG8_LDA
#undef PG8_LDB
#undef PG8_MMA
#undef PG8_WAIT_V
#undef PG8_WAIT_L
#undef PG8_BAR
#undef PG8_SCHED
}
}

template <class Epi>
DI void run_gemm(LAS unsigned char* lds, const bf16_t* A, int lda, const bf16_t* Bt, int N, int K, int skipctx, const Epi& E) {
    const int BIDX = obid();
    pg8::Order S; S.init(N, (int)gridDim.x, BIDX, skipctx);
    pg8::Gemm g{A, Bt, NR, N, K, lda};
    pg8::gemm_phase<Epi>(lds, g, S, E);
}

struct WDesc { const float* src; bf16_t* dst; int K, N, Nout, half; const float* kscale; };
DI WDesc wdesc_of(const Params& p, int m) {
    unsigned char* ws = p.ws;
    if (m < 4) return WDesc{p.in[I_FWIN] + (size_t)m * 1024 * 5632, (bf16_t*)(ws + OFF_WFI + m * SZ_WFI), 1024, 5632, 5632, 2816, nullptr};
    if (m < 8) return WDesc{p.in[I_FWOUT] + (size_t)(m - 4) * 2816 * 1024, (bf16_t*)(ws + OFF_WFO + (m - 4) * SZ_WFO), 2816, 1024, 1024, 0, nullptr};
    switch (m) {
        case 8: return WDesc{p.in[I_MWIN], (bf16_t*)(ws + OFF_WMI), 1024, 672, 768, 0, nullptr};
        case 9: return WDesc{p.in[I_MWUQ], (bf16_t*)(ws + OFF_WUQ), 384, 1536, 1536, 0, p.in[I_MGQ]};
        case 10: return WDesc{p.in[I_MWUKV], (bf16_t*)(ws + OFF_WUKV), 256, 2048, 2048, 0, p.in[I_MGKV]};
        case 11: return WDesc{p.in[I_MWO], (bf16_t*)(ws + OFF_WMO), 1024, 1024, 1024, 0, nullptr};
        case 12: return WDesc{p.in[I_SWGLU], (bf16_t*)(ws + OFF_WGLU), 1024, 2048, 2048, 1024, nullptr};
        case 13: return WDesc{p.in[I_NWQKV], (bf16_t*)(ws + OFF_WNQ), 1024, 3072, 3072, 0, nullptr};
        case 14: return WDesc{p.in[I_NWO], (bf16_t*)(ws + OFF_WNO), 1024, 1024, 1024, 0, nullptr};
        case 15: return WDesc{p.in[I_GWQKV], (bf16_t*)(ws + OFF_WGQ), 1024, 1536, 1536, 0, nullptr};
        default: return WDesc{p.in[I_GWO], (bf16_t*)(ws + OFF_WGO), 1024, 1024, 1024, 0, nullptr};
    }
}
DI void prep_tile(LAS float* tile, const WDesc w, int tidx, int lane) {
    const int ntk = w.K / 64;
    const int kt = tidx % ntk, nt = tidx / ntk;
    const int n0 = nt * 64;
    int scol = n0;
    if (w.half) { const int t256 = n0 >> 8, ww = n0 & 255; scol = (ww >= 128 ? w.half : 0) + t256 * 128 + (ww & 127); }
    const int c4 = (lane & 15) * 4;
    f32x4 v[16];
#pragma unroll
    for (int i = 0; i < 16; ++i) {
        const int r = (lane >> 4) + 4 * i;
        v[i] = (f32x4){0.f, 0.f, 0.f, 0.f};
        if (scol + c4 < w.N) v[i] = *(const f32x4*)(w.src + (size_t)(kt * 64 + r) * w.N + scol + c4);
    }
#pragma unroll
    for (int i = 0; i < 16; ++i) {
        const int r = (lane >> 4) + 4 * i;
        f32x4 x = v[i];
        if (w.kscale) x *= w.kscale[kt * 64 + r];
#pragma unroll
        for (int j = 0; j < 4; ++j) tile[r * 65 + c4 + j] = x[j];
    }
    bf16_t* d = w.dst + (size_t)(n0 + lane) * w.K + kt * 64;
#pragma unroll
    for (int q = 0; q < 8; ++q) {
        float f[8];
#pragma unroll
        for (int k = 0; k < 8; ++k) f[k] = tile[(q * 8 + k) * 65 + lane];
        *(u32x4*)(d + q * 8) = pack8(f);
    }
}

DI void ada_item(const Params& p, float* ADA, int item, int lane) {
    const int layer = item / 192, n0 = (item - layer * 192) * 32;
    const int r = lane & 31, kh = lane >> 5;
    const float* W = p.in[I_ADAW] + (size_t)layer * 1024 * 6144 + n0 + r;
    const float* cb = p.in[I_C] + r * 1024 + kh * 8;
    const float* cc = p.in[I_CCTX] + kh * 8;
    f32x16 acc;
#pragma unroll
    for (int i = 0; i < 16; ++i) acc[i] = 0.f;
    float accc = 0.f;
    for (int k0 = 0; k0 < 1024; k0 += 32) {
        float wv[16], cv[16], xv[16];
#pragma unroll
        for (int h2 = 0; h2 < 2; ++h2) {
            const f32x4 c0 = *(const f32x4*)(cb + k0 + h2 * 16), c1 = *(const f32x4*)(cb + k0 + h2 * 16 + 4);
            const f32x4 x0 = *(const f32x4*)(cc + k0 + h2 * 16), x1 = *(const f32x4*)(cc + k0 + h2 * 16 + 4);
#pragma unroll
            for (int u = 0; u < 4; ++u) { cv[h2 * 8 + u] = c0[u]; cv[h2 * 8 + 4 + u] = c1[u]; xv[h2 * 8 + u] = x0[u]; xv[h2 * 8 + 4 + u] = x1[u]; }
#pragma unroll
            for (int u = 0; u < 8; ++u) wv[h2 * 8 + u] = W[(size_t)(k0 + h2 * 16 + kh * 8 + u) * 6144];
        }
#pragma unroll
        for (int u = 0; u < 16; ++u) {
            acc = __builtin_amdgcn_mfma_f32_32x32x2f32(silu_f(cv[u]), wv[u], acc, 0, 0, 0);
            accc += silu_f(xv[u]) * wv[u];
        }
    }
    accc += __shfl_xor(accc, 32);
    const float bias = p.in[I_ADAB][layer * 6144 + n0 + r];
#pragma unroll
    for (int i = 0; i < 16; ++i) {
        const int v = (i & 3) + 8 * (i >> 2) + 4 * kh;
        ADA[((size_t)layer * 33 + v) * 6144 + n0 + r] = acc[i] + bias;
    }
    if (kh == 0) ADA[((size_t)layer * 33 + 32) * 6144 + n0 + r] = accc + bias;
}

DI void phase0(LAS unsigned char* lds, const Params& p, float* ADA, unsigned* counter) {
    const int TIDX = otid();
    const int wave = __builtin_amdgcn_readfirstlane(TIDX >> 6), lane = TIDX & 63;
    LAS float* tile = (LAS float*)(lds + wave * 16640);
    constexpr int NADA = 4 * 192;
    for (;;) {
        int item = 0;
        if (lane == 0) item = (int)atomicAdd(counter, 1u);
        item = __builtin_amdgcn_readfirstlane(item);
        if (item < NADA) { ada_item(p, ADA, item, lane); continue; }
        int t = item - NADA, m = 0;
        bool found = false;
        for (m = 0; m < 17; ++m) {
            const WDesc w = wdesc_of(p, m);
            const int nt = (w.K / 64) * (w.Nout / 64);
            if (t < nt) { prep_tile(tile, w, t, lane); found = true; break; }
            t -= nt;
        }
        if (!found) break;
    }
}

DI void norm_phase(const float* lat_in, const float* ctx_in, float* lat_out, float* ctx_out, bool copy, const float* g,
                   const float* ada, int shidx, bf16_t* H, bool skipctx) {
    const int TIDX = otid(); const int BIDX = obid(); (void)TIDX; (void)BIDX;
    const int wave = TIDX >> 6, lane = TIDX & 63;
    for (int row = BIDX * 8 + wave; row < NR; row += gridDim.x * 8) {
        const int b = row / TT, t = row - b * TT;
        if (skipctx && t < CTXL) continue;
        const size_t ro = t < CTXL ? ((size_t)(b * CTXL + t) << 10) : ((size_t)(b * SEQ + t - CTXL) << 10);
        const float* src = (t < CTXL ? ctx_in : lat_in) + ro;
        const float* sh = ada + (size_t)(t < CTXL ? 32 : b) * 6144 + shidx * 1024;
        const float* sc = sh + 1024;
        f32x4 a[4];
        a[0] = *(const f32x4*)(src + lane * 8); a[1] = *(const f32x4*)(src + lane * 8 + 4);
        a[2] = *(const f32x4*)(src + 512 + lane * 8); a[3] = *(const f32x4*)(src + 512 + lane * 8 + 4);
        float ss = 0.f;
#pragma unroll
        for (int i = 0; i < 4; ++i)
#pragma unroll
            for (int j = 0; j < 4; ++j) ss += a[i][j] * a[i][j];
        ss = wsum(ss);
        const float r = rsqrtf(ss * (1.f / 1024.f) + EPS);
        if (copy) {
            float* dst = (t < CTXL ? ctx_out : lat_out) + ro;
            *(f32x4*)(dst + lane * 8) = a[0]; *(f32x4*)(dst + lane * 8 + 4) = a[1];
            *(f32x4*)(dst + 512 + lane * 8) = a[2]; *(f32x4*)(dst + 512 + lane * 8 + 4) = a[3];
        }
#pragma unroll
        for (int hf = 0; hf < 2; ++hf) {
            const int c0 = hf * 512 + lane * 8;
            float y[8];
#pragma unroll
            for (int q = 0; q < 2; ++q) {
                const f32x4 gv = *(const f32x4*)(g + c0 + q * 4), sv = *(const f32x4*)(sc + c0 + q * 4), hv = *(const f32x4*)(sh + c0 + q * 4);
#pragma unroll
                for (int j = 0; j < 4; ++j) y[q * 4 + j] = a[hf * 2 + q][j] * r * gv[j] * (1.f + sv[j]) + hv[j];
            }
            *(u32x4*)(H + ((size_t)row << 10) + c0) = pack8(y);
        }
    }
}

DI void mla_rope8(float* v, int sub, int s) {
    const float pos = (float)((sub < 2) ? (s >> 6) : (s & 63));
    const bool isx2 = sub & 1;
#pragma unroll
    for (int i = 0; i < 8; ++i) {
        const float other = __shfl_xor(v[i], 1);
        const float ang = pos * fexp2(-(float)i * (L2_10000 / 8.f));
        const float c = __cosf(ang), sn = __sinf(ang);
        v[i] = isx2 ? (other * sn + v[i] * c) : (v[i] * c - other * sn);
    }
}

DI void mla_r2(bf16_t* QB, bf16_t* KV, const bf16_t* Z, const float* gqn, const float* gkn) {
    const int TIDX = otid(); const int BIDX = obid(); (void)TIDX; (void)BIDX;
    const int wave = TIDX >> 6, lane = TIDX & 63, hd = lane >> 2, sub = lane & 3;
    for (int row = BIDX * 8 + wave; row < NR; row += gridDim.x * 8) {
        const int b = row / TT, t = row - b * TT; const bool latent = t >= CTXL; const int s = t - CTXL;
        const bf16_t* z = Z + (size_t)row * 768;
        bf16_t* qp = QB + (size_t)row * 1536 + hd * 96;
        bf16_t* kp = KV + (size_t)row * 2560 + hd * 160;
        unsigned zq[3];
#pragma unroll
        for (int i = 0; i < 3; ++i) zq[i] = *(const unsigned*)(z + lane * 6 + 2 * i);
        const u32x2 zk = *(const u32x2*)(z + 384 + lane * 4);
        const u32x4 q0 = *(const u32x4*)(qp + sub * 16), q1 = *(const u32x4*)(qp + sub * 16 + 8), q2 = *(const u32x4*)(qp + 64 + sub * 8);
        const u32x4 k0 = *(const u32x4*)(kp + sub * 16), k1 = *(const u32x4*)(kp + sub * 16 + 8);
        const u32x4 v0 = *(const u32x4*)(kp + 64 + sub * 16), v1 = *(const u32x4*)(kp + 64 + sub * 16 + 8);
        const u32x4 k2 = *(const u32x4*)(z + 640 + sub * 8);
        asm volatile("s_waitcnt vmcnt(0)" ::: "memory");
        float sq0 = 0.f, sk0 = 0.f;
#pragma unroll
        for (int i = 0; i < 3; ++i) { const float a0 = bf_lo(zq[i]), a1 = bf_hi(zq[i]); sq0 += a0 * a0 + a1 * a1; }
        { const float a0 = bf_lo(zk[0]), a1 = bf_hi(zk[0]), a2 = bf_lo(zk[1]), a3 = bf_hi(zk[1]); sk0 = a0 * a0 + a1 * a1 + a2 * a2 + a3 * a3; }
        sq0 = wsum(sq0); sk0 = wsum(sk0);
        const float rq0 = rsqrtf(sq0 * (1.f / 384.f) + EPS), rk0 = rsqrtf(sk0 * (1.f / 256.f) + EPS);
        float qn[16], qr[8], kn[16], kr[8], vv[16];
        unpack8(q0, qn); unpack8(q1, qn + 8); unpack8(q2, qr);
        unpack8(k0, kn); unpack8(k1, kn + 8); unpack8(k2, kr);
        unpack8(v0, vv); unpack8(v1, vv + 8);
#pragma unroll
        for (int i = 0; i < 16; ++i) { qn[i] *= rq0; kn[i] *= rk0; vv[i] *= rk0; }
#pragma unroll
        for (int i = 0; i < 8; ++i) qr[i] *= rq0;
        float sq = 0.f, sk = 0.f;
#pragma unroll
        for (int i = 0; i < 16; ++i) { sq += qn[i] * qn[i]; sk += kn[i] * kn[i]; }
#pragma unroll
        for (int i = 0; i < 8; ++i) { sq += qr[i] * qr[i]; sk += kr[i] * kr[i]; }
        sq += __shfl_xor(sq, 1); sq += __shfl_xor(sq, 2);
        sk += __shfl_xor(sk, 1); sk += __shfl_xor(sk, 2);
        const float rq = rsqrtf(sq * (1.f / 96.f) + EPS), rk = rsqrtf(sk * (1.f / 96.f) + EPS);
#pragma unroll
        for (int i = 0; i < 16; ++i) { qn[i] *= rq * gqn[sub * 16 + i]; kn[i] *= rk * gkn[sub * 16 + i]; }
#pragma unroll
        for (int i = 0; i < 8; ++i) { qr[i] *= rq * gqn[64 + sub * 8 + i]; kr[i] *= rk * gkn[64 + sub * 8 + i]; }
        if (latent) { mla_rope8(qr, sub, s); mla_rope8(kr, sub, s); }
        *(u32x4*)(qp + sub * 16) = pack8(qn); *(u32x4*)(qp + sub * 16 + 8) = pack8(qn + 8); *(u32x4*)(qp + 64 + sub * 8) = pack8(qr);
        *(u32x4*)(kp + sub * 16) = pack8(kn); *(u32x4*)(kp + sub * 16 + 8) = pack8(kn + 8); *(u32x4*)(kp + 64 + sub * 8) = pack8(kr);
        *(u32x4*)(kp + 96 + sub * 16) = pack8(vv); *(u32x4*)(kp + 96 + sub * 16 + 8) = pack8(vv + 8);
    }
}

template <int HD, int LPH, int ROPE>
DI void headnorm_phase(bf16_t* X, int stride, int nq, int koff, int nk, const float* gq, const float* gk) {
    const int TIDX = otid(); const int BIDX = obid(); (void)TIDX; (void)BIDX;
    constexpr int HPP = 64 / LPH;
    const int wave = TIDX >> 6, lane = TIDX & 63, sub = lane % LPH, hl = lane / LPH;
    for (int row = BIDX * 8 + wave; row < NR; row += gridDim.x * 8) {
        const int b = row / TT, t = row - b * TT; const bool latent = t >= CTXL; const int s = t - CTXL;
        for (int pass = 0; pass < 2; ++pass) {
            const int nh = pass ? nk : nq, base = pass ? koff : 0; const float* g = pass ? gk : gq;
            for (int h0 = 0; h0 < nh; h0 += HPP) {
                const int hd = h0 + hl; const bool act = hd < nh;
                bf16_t* ptr = X + (size_t)row * stride + base + hd * HD + sub * 16;
                u32x4 u0 = (u32x4){0, 0, 0, 0}, u1 = (u32x4){0, 0, 0, 0};
                if (act) { u0 = *(const u32x4*)ptr; u1 = *(const u32x4*)(ptr + 8); }
                float v[16]; unpack8(u0, v); unpack8(u1, v + 8);
                float ss = 0.f;
#pragma unroll
                for (int i = 0; i < 16; ++i) ss += v[i] * v[i];
#pragma unroll
                for (int o = 1; o < LPH; o <<= 1) ss += __shfl_xor(ss, o);
                const float rr = rsqrtf(ss * (1.f / HD) + EPS);
#pragma unroll
                for (int i = 0; i < 16; ++i) v[i] *= rr * g[sub * 16 + i];
                if (ROPE) {
                    if (latent) {
                        const int axis = sub >> 2; const bool isx2 = (sub >> 1) & 1;
                        const float pos = (float)(axis ? (s & 63) : (s >> 6));
#pragma unroll
                        for (int i = 0; i < 16; ++i) {
                            const float other = __shfl_xor(v[i], 2);
                            const int fi = (sub & 1) * 16 + i;
                            const float ang = pos * fexp2(-(float)fi * (L2_10000 / 32.f));
                            const float c = __cosf(ang), sn = __sinf(ang);
                            v[i] = isx2 ? (other * sn + v[i] * c) : (v[i] * c - other * sn);
                        }
                    }
                }
                if (act) { *(u32x4*)ptr = pack8(v); *(u32x4*)(ptr + 8) = pack8(v + 8); }
            }
        }
    }
}

struct AttnArgs { const bf16_t* Q; const bf16_t* K; const bf16_t* V; bf16_t* O; int qs, qh, ks, kh, vs, vh, nheads, gshift, ctx_out; const float* rpb; float sc; };

template <int DK, int DV, int NA>
DI void attn_phase(LAS unsigned char* lds, const AttnArgs a) {
    const int TIDX = otid(); const int BIDX = obid(); (void)TIDX; (void)BIDX;
    constexpr int KROW = DK * 2 + 16, VROW = DV * 2 + 16;
    constexpr int KBUF = 64 * KROW, VBUF = 64 * VROW;
    constexpr int OFFK = 0, OFFV = 2 * KBUF, OFFR = OFFV + 2 * VBUF;
    constexpr int KCH = DK / 8, VCH = DV / 8, NKC = 64 * KCH, NVC = 64 * VCH;
    constexpr int KPT = (NKC + 511) / 512, VPT = (NVC + 511) / 512;
    constexpr int NK0 = DK / 16, NQG = NK0 / 2;
    const int tid = TIDX, wave = __builtin_amdgcn_readfirstlane(tid >> 6), lane = tid & 63, r = lane & 31, hh = lane >> 5;
    const int i16 = lane & 15, tq = i16 >> 2, tp = i16 & 3, blk = (lane >> 4) & 1;
    const int nlat = NB * a.nheads * 8, ntot = nlat + (a.ctx_out ? NB * a.nheads : 0);
    LAS float* rpbL = (LAS float*)(lds + OFFR);
    for (int item = BIDX; item < ntot; item += gridDim.x) {
        int b, h, qb = 0; const bool isctx = item >= nlat;
        if (!isctx) { const int R = item >> 8, u = item & 255; const int qp = (R * 8 + (u & 7)) * 4 + (u >> 6); qb = (u >> 3) & 7; h = qp % a.nheads; b = qp / a.nheads; }
        else { const int bh = item - nlat; h = bh % a.nheads; b = bh / a.nheads; }
        const int hk = h >> a.gshift;
        const size_t rb = (size_t)b * TT;
        const bf16_t* Kb = a.K + hk * a.kh; const bf16_t* Vb = a.V + hk * a.vh;
        int ntiles = isctx ? 4 : 36, rlo = 0, wi = 0, wr0 = 0, c0 = 0;
        if (NA) {
            if (!isctx) { const int i0 = qb * 4; rlo = clampi(i0 - 4, 0, 24); const int rhi = clampi(i0 - 1, 0, 24) + 8; ntiles = 4 + rhi - rlo;
                wi = i0 + (wave >> 1); wr0 = clampi(wi - 4, 0, 24); c0 = (wave & 1) * 32; }
            if (tid < 465) rpbL[64 + tid] = a.rpb[h * 465 + tid] * LOG2E;
        }
        const size_t qrow = rb + (isctx ? 0 : 256 + qb * 256) + wave * 32 + r;
        bf16x8 qf[DK / 16];
#pragma unroll
        for (int k0 = 0; k0 < DK / 16; ++k0) qf[k0] = *(const bf16x8*)(a.Q + qrow * a.qs + h * a.qh + k0 * 16 + hh * 8);
        u32x4 kreg[KPT], vreg[VPT];
#define ATT_TILE_ROW(j) ((NA && (j) >= 4) ? rb + 256 + (size_t)(rlo + (j) - 4) * 64 : rb + (size_t)(j) * 64)
#define ATT_GLOADK(j) do { const size_t _tr = ATT_TILE_ROW(j); \
        _Pragma("unroll") for (int _i = 0; _i < KPT; ++_i) { const int _c = tid + _i * 512; if (_c < NKC) { const int _row = _c / KCH, _cc = _c - _row * KCH; kreg[_i] = *(const u32x4*)(Kb + (_tr + _row) * a.ks + _cc * 8); } } } while (0)
#define ATT_GLOADV(j) do { const size_t _tr = ATT_TILE_ROW(j); \
        _Pragma("unroll") for (int _i = 0; _i < VPT; ++_i) { const int _c = tid + _i * 512; if (_c < NVC) { const int _row = _c / VCH, _cc = _c - _row * VCH; vreg[_i] = *(const u32x4*)(Vb + (_tr + _row) * a.vs + _cc * 8); } } } while (0)
#define ATT_LSTOREK(buf) do { \
        _Pragma("unroll") for (int _i = 0; _i < KPT; ++_i) { const int _c = tid + _i * 512; if (_c < NKC) { const int _row = _c / KCH, _cc = _c - _row * KCH; *(LAS u32x4*)(lds + OFFK + (buf) * KBUF + _row * KROW + _cc * 16) = kreg[_i]; } } } while (0)
#define ATT_LSTOREV(buf) do { \
        _Pragma("unroll") for (int _i = 0; _i < VPT; ++_i) { const int _c = tid + _i * 512; if (_c < NVC) { const int _row = _c / VCH, _cc = _c - _row * VCH; *(LAS u32x4*)(lds + OFFV + (buf) * VBUF + _row * VROW + _cc * 16) = vreg[_i]; } } } while (0)
#define ATT_KFRAG(buf, idx) (*(const LAS bf16x8*)(lds + OFFK + (buf) * KBUF + (((idx) / NK0) * 32 + r) * KROW + ((idx) % NK0) * 32 + hh * 16))
#define ATT_QK(dst, buf) do { \
        _Pragma("unroll") for (int _x = 0; _x < 2 * NK0; ++_x) { const bf16x8 kf = ATT_KFRAG(buf, _x); \
            dst[_x / NK0] = __builtin_amdgcn_mfma_f32_32x32x16_bf16(kf, qf[_x % NK0], (_x % NK0) == 0 ? zero16 : dst[_x / NK0], 0, 0, 0); } } while (0)
#define ATT_ACTIVE(j) (!(NA && (j) >= 4) || ((rlo + (j) - 4 >= wr0) && (rlo + (j) - 4 < wr0 + 8)))
#define ATT_TILE(j, S, SN) do { \
        if ((j) + 2 < ntiles) ATT_GLOADK((j) + 2); \
        if ((j) + 1 < ntiles) ATT_GLOADV((j) + 1); \
        if (ATT_ACTIVE(j)) { \
            const int nb = ((j) + 1) & 1; \
            const LAS unsigned char* Vt = lds + OFFV + ((j) & 1) * VBUF; \
            bf16x8 kfr[2][NQG]; \
            _Pragma("unroll") for (int q = 0; q < NQG; ++q) kfr[0][q] = ATT_KFRAG(nb, q); \
            float mx = m_run; \
            if (NA && (j) >= 4) { \
                const int kr = rlo + (j) - 4; \
                const int ri = kr - wi + 7, qj = c0 + r, cs = clampi(qj - 8, 0, 48); \
                const LAS float* bp = rpbL + 64 + ri * 31 + (4 * hh - qj + 15); \
                const int vb = 4 * hh - cs; \
                _Pragma("unroll") for (int kb = 0; kb < 2; ++kb) \
                    _Pragma("unroll") for (int i = 0; i < 16; ++i) { \
                        const int ci = kb * 32 + (i & 3) + 8 * (i >> 2); \
                        const bool valid = (unsigned)(vb + ci) < 16u; \
                        const float x = valid ? __builtin_fmaf(S[kb][i], a.sc, bp[ci]) : -1e30f; \
                        S[kb][i] = x; mx = fmaxf(mx, x); } \
                mx = fmaxf(mx, __shfl_xor(mx, 32)); \
            } else { \
                float mr = -1e30f; \
                _Pragma("unroll") for (int kb = 0; kb < 2; ++kb) \
                    _Pragma("unroll") for (int i = 0; i < 16; ++i) mr = fmaxf(mr, S[kb][i]); \
                mr = fmaxf(mr, __shfl_xor(mr, 32)); \
                mx = fmaxf(mx, mr * a.sc); \
            } \
            if (__any(mx != m_run)) { \
                const float alpha = fexp2(m_run - mx); \
                lsum *= alpha; \
                _Pragma("unroll") for (int d = 0; d < DV / 32; ++d) \
                    _Pragma("unroll") for (int i = 0; i < 16; ++i) o[d][i] *= alpha; \
            } \
            m_run = mx; \
            __builtin_amdgcn_sched_barrier(0); \
            _Pragma("unroll") for (int grp = 0; grp < 4; ++grp) { \
                const int kb = grp >> 1, st = grp & 1; \
                if (grp < 3) { _Pragma("unroll") for (int q = 0; q < NQG; ++q) kfr[(grp + 1) & 1][q] = ATT_KFRAG(nb, (grp + 1) * NQG + q); } \
                bf16x8 vf[DV / 32]; \
                _Pragma("unroll") for (int d = 0; d < DV / 32; ++d) { \
                    const LAS unsigned char* ad = Vt + (kb * 32 + 16 * st + 4 * hh + tq) * VROW + (d * 32 + 16 * blk + 4 * tp) * 2; \
                    const s16x4 lo = __builtin_amdgcn_ds_read_tr16_b64_v4i16((LAS s16x4*)ad); \
                    const s16x4 hi = __builtin_amdgcn_ds_read_tr16_b64_v4i16((LAS s16x4*)(ad + 8 * VROW)); \
                    vf[d] = __builtin_shufflevector(lo, hi, 0, 1, 2, 3, 4, 5, 6, 7); } \
                _Pragma("unroll") for (int q = 0; q < NQG; ++q) { const int idx = grp * NQG + q; \
                    SN[idx / NK0] = __builtin_amdgcn_mfma_f32_32x32x16_bf16(kfr[grp & 1][q], qf[idx % NK0], (idx % NK0) == 0 ? zero16 : SN[idx / NK0], 0, 0, 0); } \
                __builtin_amdgcn_sched_barrier(0); \
                float pp[8]; \
                _Pragma("unroll") for (int i = 0; i < 8; ++i) { \
                    pp[i] = (NA && (j) >= 4) ? fexp2(S[kb][8 * st + i] - mx) : fexp2(__builtin_fmaf(S[kb][8 * st + i], a.sc, -mx)); lsum += pp[i]; } \
                const bf16x8 pf = __builtin_bit_cast(bf16x8, pack8(pp)); \
                __builtin_amdgcn_sched_barrier(0); \
                _Pragma("unroll") for (int d = 0; d < DV / 32; ++d) o[d] = __builtin_amdgcn_mfma_f32_32x32x16_bf16(vf[d], pf, o[d], 0, 0, 0); \
                __builtin_amdgcn_sched_barrier(0); \
            } \
        } else { \
            ATT_QK(SN, ((j) + 1) & 1); \
        } \
        if ((j) + 2 < ntiles) ATT_LSTOREK((j) & 1); \
        if ((j) + 1 < ntiles) ATT_LSTOREV(((j) + 1) & 1); \
        __syncthreads(); } while (0)
        ATT_GLOADK(0); ATT_GLOADV(0); ATT_LSTOREK(0); ATT_LSTOREV(0);
        ATT_GLOADK(1); ATT_LSTOREK(1);
        __syncthreads();
        f32x16 o[DV / 32];
#pragma unroll
        for (int d = 0; d < DV / 32; ++d)
#pragma unroll
            for (int i = 0; i < 16; ++i) o[d][i] = 0.f;
        f32x16 zero16;
#pragma unroll
        for (int i = 0; i < 16; ++i) zero16[i] = 0.f;
        float m_run = -1e30f, lsum = 0.f;
        f32x16 s[2], sn[2];
        ATT_QK(s, 0);
        __syncthreads();
        for (int j = 0; j < ntiles; j += 2) {
            ATT_TILE(j, s, sn);
            if (j + 1 < ntiles) ATT_TILE(j + 1, sn, s);
        }
        lsum += __shfl_xor(lsum, 32);
        const float inv = frcp(lsum);
        bf16_t* orow = a.O + (qrow << 10) + h * DV;
#pragma unroll
        for (int d = 0; d < DV / 32; ++d)
#pragma unroll
            for (int g = 0; g < 4; ++g)
                *(u32x2*)(orow + d * 32 + 8 * g + 4 * hh) = (u32x2){pk_bf16(o[d][4 * g] * inv, o[d][4 * g + 1] * inv), pk_bf16(o[d][4 * g + 2] * inv, o[d][4 * g + 3] * inv)};
#undef ATT_TILE_ROW
#undef ATT_GLOADK
#undef ATT_GLOADV
#undef ATT_LSTOREK
#undef ATT_LSTOREV
#undef ATT_KFRAG
#undef ATT_QK
#undef ATT_ACTIVE
#undef ATT_TILE
    }
}

DI void s5_scan_phase(LAS unsigned char* lds, const Params& p, bf16_t* H, float* YF) {
    const int TIDX = otid(); const int BIDX = obid(); (void)TIDX; (void)BIDX;
    const int wave = __builtin_amdgcn_readfirstlane(TIDX >> 6), lane = TIDX & 63;
    LAS float* BU = (LAS float*)(lds + wave * 12800);
    LAS bf16_t* Hh = (LAS bf16_t*)(lds + wave * 12800 + 8448);
    const int l15 = lane & 15, l4 = lane >> 4;
    for (int item = BIDX * 8 + wave; item < NB * 64; item += gridDim.x * 8) {
        const int g = item & 63, b = item >> 6;
        const float dsk = p.in[I_SD][g * 16 + l15];
        for (int dir = 0; dir < 2; ++dir) {
            const int pg = dir * 64 + g;
            const float dt = __expf(p.in[I_SLDT][pg]);
            const float* are = p.in[I_SARE] + pg * 64; const float* aim = p.in[I_SAIM] + pg * 64;
            float abr, abi;
            { const float ar = are[lane], ai = aim[lane]; const float mag = __expf(dt * ar); abr = mag * __cosf(dt * ai); abi = mag * __sinf(dt * ai); }
            bf16x8 bfr[8], cfr[4];
#pragma unroll
            for (int nt = 0; nt < 8; ++nt) {
                const int st = (nt & 3) * 16 + l15;
                const float ar = are[st], ai = aim[st]; const float mag = __expf(dt * ar);
                const float er = mag * __cosf(dt * ai), ei = mag * __sinf(dt * ai);
                const float den = ar * ar + ai * ai, nr = er - 1.f;
                const float fre = (nr * ar + ei * ai) / den, fim = (ei * ar - nr * ai) / den;
                float bb[8];
#pragma unroll
                for (int j = 0; j < 8; ++j) bb[j] = 0.f;
                if (lane < 32) {
                    const float* br = p.in[I_SBRE] + ((size_t)pg * 64 + st) * 16 + l4 * 8; const float* bi = p.in[I_SBIM] + ((size_t)pg * 64 + st) * 16 + l4 * 8;
#pragma unroll
                    for (int j = 0; j < 8; ++j) bb[j] = (nt < 4) ? (fre * br[j] - fim * bi[j]) : (fre * bi[j] + fim * br[j]);
                }
                bfr[nt] = __builtin_bit_cast(bf16x8, pack8(bb));
            }
#pragma unroll
            for (int kk = 0; kk < 4; ++kk) {
                const int k = (kk & 1) * 32 + l4 * 8;
                const float* cp = (kk < 2 ? p.in[I_SCRE] : p.in[I_SCIM]) + ((size_t)pg * 16 + l15) * 64 + k;
                float cc[8];
#pragma unroll
                for (int j = 0; j < 8; ++j) cc[j] = (kk < 2) ? cp[j] : -cp[j];
                cfr[kk] = __builtin_bit_cast(bf16x8, pack8(cc));
            }
            float hr = 0.f, hi = 0.f;
            for (int j = 0; j < 144; ++j) {
                const int tb = dir ? (j < 16 ? 16 * (15 - j) : 256 + 16 * (143 - j)) : 16 * j;
                const size_t row0 = (size_t)b * TT + tb;
                bf16x8 uf = (bf16x8){0, 0, 0, 0, 0, 0, 0, 0};
                if (lane < 32) uf = *(const bf16x8*)(H + ((row0 + l15) << 10) + g * 16 + l4 * 8);
#pragma unroll
                for (int nt = 0; nt < 8; ++nt) {
                    const f32x4 acc = __builtin_amdgcn_mfma_f32_16x16x32_bf16(uf, bfr[nt], (f32x4){0.f, 0.f, 0.f, 0.f}, 0, 0, 0);
#pragma unroll
                    for (int i = 0; i < 4; ++i) BU[(l4 * 4 + i) * 132 + nt * 16 + l15] = acc[i];
                }
                float bur[16], bui[16];
#pragma unroll
                for (int tt = 0; tt < 16; ++tt) { bur[tt] = BU[tt * 132 + lane]; bui[tt] = BU[tt * 132 + 64 + lane]; }
                if (dir) {
#pragma unroll
                    for (int tt = 15; tt >= 0; --tt) {
                        const float nhr = abr * hr - abi * hi + bur[tt], nhi = abr * hi + abi * hr + bui[tt];
                        hr = nhr; hi = nhi;
                        const unsigned pr = pk_bf16(hr, hi);
                        Hh[tt * 136 + lane] = (bf16_t)(pr & 0xffffu); Hh[tt * 136 + 64 + lane] = (bf16_t)(pr >> 16);
                    }
                } else {
#pragma unroll
                    for (int tt = 0; tt < 16; ++tt) {
                        const float nhr = abr * hr - abi * hi + bur[tt], nhi = abr * hi + abi * hr + bui[tt];
                        hr = nhr; hi = nhi;
                        const unsigned pr = pk_bf16(hr, hi);
                        Hh[tt * 136 + lane] = (bf16_t)(pr & 0xffffu); Hh[tt * 136 + 64 + lane] = (bf16_t)(pr >> 16);
                    }
                }
                f32x4 ya = (f32x4){0.f, 0.f, 0.f, 0.f};
#pragma unroll
                for (int kk = 0; kk < 4; ++kk) {
                    const bf16x8 af = *(const LAS bf16x8*)(Hh + l15 * 136 + kk * 32 + l4 * 8);
                    ya = __builtin_amdgcn_mfma_f32_16x16x32_bf16(af, cfr[kk], ya, 0, 0, 0);
                }
                if (dir == 0) {
#pragma unroll
                    for (int i = 0; i < 4; ++i) YF[((row0 + l4 * 4 + i) << 10) + g * 16 + l15] = ya[i];
                } else {
#pragma unroll
                    for (int i = 0; i < 4; ++i) {
                        const size_t o = ((row0 + l4 * 4 + i) << 10) + g * 16 + l15;
                        const float u = __uint_as_float(((unsigned)H[o]) << 16);
                        const float y = gelu_tanh(dsk * u + YF[o] + ya[i]);
                        H[o] = (bf16_t)(pk_bf16(y, 0.f) & 0xffffu);
                    }
                }
            }
        }
    }
}

#define XB_TMO      128
#define XB_XCNT(j)  (256  + 64 * (j))
#define XB_XSUB(j)  (1280 + 64 * (j))
#define XB_XGEN(j)  (2304 + 64 * (j))
#define XB_TOP      3328
#define XB_TOPGEN   3392
#define XCD_BAR_WORDS 3456
#define XB_SPIN_CAP (1u << 18)
DI unsigned xb_ld(unsigned* p)              { return __hip_atomic_load(p, __ATOMIC_RELAXED, __HIP_MEMORY_SCOPE_AGENT); }
DI unsigned xb_add(unsigned* p, unsigned v) { return __hip_atomic_fetch_add(p, v, __ATOMIC_RELAXED, __HIP_MEMORY_SCOPE_AGENT); }
DI unsigned xb_xcc_id() { return (unsigned)__builtin_amdgcn_s_getreg((3 << 11) | 20) & 0xFu; }
#define XB_SPIN(cond, bar) do { unsigned _sp = 0; while (cond) { __builtin_amdgcn_s_sleep(1); \
    if ((++_sp & 255u) == 0u) { if (xb_ld(&(bar)[XB_TMO])) break; if (_sp > XB_SPIN_CAP) { atomicAdd(&(bar)[XB_TMO], 1u); break; } } } } while (0)
struct XcdBarrier { unsigned* bar; unsigned x; volatile LAS unsigned* st; };
DI XcdBarrier xcd_barrier_post(unsigned* bar, volatile LAS unsigned* st) {
    XcdBarrier b; b.bar = bar; b.x = xb_xcc_id(); b.st = st;
    if (threadIdx.x == 0) (void)xb_add(&bar[XB_XCNT(b.x)], 1u);
    return b;
}
DI void xcd_barrier_complete(unsigned* bar, unsigned x, unsigned& nloc, unsigned& nx) {
    const unsigned G = gridDim.x * gridDim.y * gridDim.z;
    unsigned sum, cnt, mine, sp = 0u;
    for (;;) {
        sum = 0u; cnt = 0u; mine = 0u;
#pragma unroll
        for (unsigned j = 0; j < 16; ++j) { const unsigned c = xb_ld(&bar[XB_XCNT(j)]); sum += c; cnt += (c > 0u) ? 1u : 0u; mine = (j == x) ? c : mine; }
        if (sum == G) break;
        __builtin_amdgcn_s_sleep(1);
        if ((++sp & 255u) == 0u) { if (xb_ld(&bar[XB_TMO])) break; if (sp > XB_SPIN_CAP) { atomicAdd(&bar[XB_TMO], 1u); break; } }
    }
    nloc = mine > 0u ? mine : 1u; nx = cnt > 0u ? cnt : 1u;
}
DI void xcd_barrier(const XcdBarrier& b) {
    asm volatile("s_waitcnt vmcnt(0)" ::: "memory");
    __syncthreads();
    if (threadIdx.x == 0) {
        unsigned* bar = b.bar;
        __builtin_amdgcn_s_waitcnt(0);
        unsigned nloc = b.st[0], nx = b.st[1];
        if (nloc == 0u) { xcd_barrier_complete(bar, b.x, nloc, nx); b.st[0] = nloc; b.st[1] = nx; }
        const unsigned old = xb_add(&bar[XB_XSUB(b.x)], 1u);
        const unsigned gen = old / nloc;
        if (old + 1u == (gen + 1u) * nloc) {
            __builtin_amdgcn_fence(__ATOMIC_RELEASE, "agent");
            asm volatile("s_waitcnt vmcnt(0)" ::: "memory");
            const unsigned og = xb_add(&bar[XB_TOP], 1u);
            const unsigned tg = og / nx;
            if (og + 1u == (tg + 1u) * nx) xb_add(&bar[XB_TOPGEN], 1u);
            else XB_SPIN(xb_ld(&bar[XB_TOPGEN]) == tg, bar);
            __builtin_amdgcn_fence(__ATOMIC_ACQUIRE, "agent");
            xb_add(&bar[XB_XGEN(b.x)], 1u);
            asm volatile("s_waitcnt vmcnt(0)" ::: "memory");
        } else {
            XB_SPIN(xb_ld(&bar[XB_XGEN(b.x)]) == gen, bar);
            __builtin_amdgcn_fence(__ATOMIC_ACQUIRE, "agent");
            asm volatile("s_waitcnt vmcnt(0)" ::: "memory");
        }
    }
    __syncthreads();
}

__global__ void __launch_bounds__(512, 2) mega(const Params p) {
    extern __shared__ __attribute__((aligned(16))) unsigned char shm[];
    LAS unsigned char* lds = (LAS unsigned char*)shm;
    cg::grid_group grid = cg::this_grid();
    LAS unsigned* xbst = (LAS unsigned*)(lds + 133120);
    if (threadIdx.x < 4) xbst[threadIdx.x] = 0u;
    __syncthreads();
    const XcdBarrier xb = xcd_barrier_post((unsigned*)(p.ws + OFF_BAR), (volatile LAS unsigned*)xbst);
    unsigned char* ws = p.ws;
    float* ADA = (float*)(ws + OFF_ADA);
    float* XC = (float*)(ws + OFF_XC);
    bf16_t* HB = (bf16_t*)(ws + OFF_HB);
    float* LAT = p.out;
    int pid = 0;
#define PH_BEGIN if (pid >= p.ph_lo && pid < p.ph_hi) {
#define PH_END if (pid + 1 < p.ph_hi) { if (pid == 0) grid.sync(); else xcd_barrier(xb); } } ++pid;

    PH_BEGIN
    {
        phase0(lds, p, ADA, (unsigned*)(ws + OFF_BAR + 14336));
    }
    PH_END

    for (int layer = 0; layer < 4; ++layer) {
        const float* ada = ADA + (size_t)layer * 33 * 6144;
        const int last = layer == 3;
        PH_BEGIN
        norm_phase(layer == 0 ? p.in[I_X] : LAT, layer == 0 ? p.in[I_CTX] : XC, LAT, XC, layer == 0, p.in[I_NMIX] + layer * 1024, ada, 0, HB, false);
        PH_END
        if (layer == 0) {
            bf16_t* Z = (bf16_t*)(ws + OFF_Z); bf16_t* KV = (bf16_t*)(ws + OFF_KV); bf16_t* QB = (bf16_t*)(ws + OFF_QB);
            PH_BEGIN
            run_gemm(lds, HB, 1024, (const bf16_t*)(ws + OFF_WMI), 768, 1024, 0, pg8::EpiStore{Z, 768, 0});
            PH_END
            PH_BEGIN
            run_gemm(lds, Z, 768, (const bf16_t*)(ws + OFF_WUQ), 1536, 384, 0, pg8::EpiStore{QB, 1536, 0});
            run_gemm(lds, Z + 384, 768, (const bf16_t*)(ws + OFF_WUKV), 2048, 256, 0, pg8::EpiStore{KV, 2560, 1});
            PH_END
            PH_BEGIN
            mla_r2(QB, KV, Z, p.in[I_MGQN], p.in[I_MGKN]);
            PH_END
            PH_BEGIN
            attn_phase<96, 64, 0>(lds, AttnArgs{QB, KV, KV + 96, HB, 1536, 96, 2560, 160, 2560, 160, 16, 0, 1, nullptr, 0.10206207261596575f * LOG2E});
            PH_END
            PH_BEGIN
            run_gemm(lds, HB, 1024, (const bf16_t*)(ws + OFF_WMO), 1024, 1024, 0, pg8::EpiRes{LAT, XC, ada, 2});
            PH_END
        } else if (layer == 1) {
            float* YF = (float*)(ws + OFF_BIG);
            PH_BEGIN
            s5_scan_phase(lds, p, HB, YF);
            PH_END
            PH_BEGIN
            run_gemm(lds, HB, 1024, (const bf16_t*)(ws + OFF_WGLU), 2048, 1024, 0, pg8::EpiGluRes{LAT, XC, ada, 2});
            PH_END
        } else if (layer == 2) {
            bf16_t* QKV = (bf16_t*)(ws + OFF_BIG);
            PH_BEGIN
            run_gemm(lds, HB, 1024, (const bf16_t*)(ws + OFF_WNQ), 3072, 1024, 0, pg8::EpiStore{QKV, 3072, 0});
            PH_END
            PH_BEGIN
            headnorm_phase<64, 4, 0>(QKV, 3072, 16, 1024, 16, p.in[I_NGQN], p.in[I_NGKN]);
            PH_END
            PH_BEGIN
            attn_phase<64, 64, 1>(lds, AttnArgs{QKV, QKV + 1024, QKV + 2048, HB, 3072, 64, 3072, 64, 3072, 64, 16, 0, 1, p.in[I_NRPB], 0.125f * LOG2E});
            PH_END
            PH_BEGIN
            run_gemm(lds, HB, 1024, (const bf16_t*)(ws + OFF_WNO), 1024, 1024, 0, pg8::EpiRes{LAT, XC, ada, 2});
            PH_END
        } else {
            bf16_t* QKV = (bf16_t*)(ws + OFF_BIG);
            PH_BEGIN
            run_gemm(lds, HB, 1024, (const bf16_t*)(ws + OFF_WGQ), 1536, 1024, 0, pg8::EpiStore{QKV, 1536, 0});
            PH_END
            PH_BEGIN
            headnorm_phase<128, 8, 1>(QKV, 1536, 8, 1024, 2, p.in[I_GGQN], p.in[I_GGKN]);
            PH_END
            PH_BEGIN
            attn_phase<128, 128, 0>(lds, AttnArgs{QKV, QKV + 1024, QKV + 1280, HB, 1536, 128, 1536, 128, 1536, 128, 8, 2, 0, nullptr, 0.08838834764831845f * LOG2E});
            PH_END
            PH_BEGIN
            run_gemm(lds, HB, 1024, (const bf16_t*)(ws + OFF_WGO), 1024, 1024, 1, pg8::EpiRes{LAT, XC, ada, 2});
            PH_END
        }
        bf16_t* ACT = (bf16_t*)(ws + OFF_BIG);
        PH_BEGIN
        norm_phase(LAT, XC, LAT, XC, false, p.in[I_NFFN] + layer * 1024, ada, 3, HB, last);
        PH_END
        PH_BEGIN
        run_gemm(lds, HB, 1024, (const bf16_t*)(ws + OFF_WFI + layer * SZ_WFI), 5632, 1024, last, pg8::EpiSwiglu{ACT, FH});
        PH_END
        PH_BEGIN
        run_gemm(lds, ACT, 2816, (const bf16_t*)(ws + OFF_WFO + layer * SZ_WFO), 1024, 2816, last, pg8::EpiRes{LAT, XC, ada, 5});
        PH_END
    }
}

extern "C" void kernel_launch(void* const* d_in, const int* in_sizes, int n_in, void* d_out, int out_size, void* d_ws, size_t ws_size, hipStream_t stream) {
    static int grid_blocks = 0;
    if (!grid_blocks) {
        hipFuncSetAttribute((const void*)mega, hipFuncAttributeMaxDynamicSharedMemorySize, LDS_BYTES);
        int dev = 0, cus = 0, per_cu = 0;
        hipGetDevice(&dev);
        hipDeviceGetAttribute(&cus, hipDeviceAttributeMultiprocessorCount, dev);
        hipOccupancyMaxActiveBlocksPerMultiprocessor(&per_cu, mega, 512, LDS_BYTES);
        if (per_cu < 1) per_cu = 1;
        grid_blocks = cus * 1;
    }
    if (ws_size < WS_NEED) fprintf(stderr, "workspace too small: %zu < %zu\n", ws_size, (size_t)WS_NEED);
    Params p; memset(&p, 0, sizeof(p));
    for (int i = 0; i < N_IN; ++i) p.in[i] = (const float*)d_in[i];
    p.out = (float*)d_out; p.ws = (unsigned char*)d_ws; p.ph_lo = 0; p.ph_hi = 1000;
    hipMemsetAsync((unsigned char*)d_ws + OFF_BAR, 0, 16384, stream);
    void* args[] = {&p};
    hipError_t e = hipLaunchCooperativeKernel((const void*)mega, dim3(grid_blocks), dim3(512), args, LDS_BYTES, stream);
    if (e != hipSuccess) fprintf(stderr, "cooperative launch failed: %s (grid %d)\n", hipGetErrorString(e), grid_blocks);
}
```

```cpp
#include <hip/hip_runtime.h>
#include <hip/hip_cooperative_groups.h>
#include <cstdio>
#include <cstring>
namespace cg = cooperative_groups;

#define DI __device__ __forceinline__
#define LAS __attribute__((address_space(3)))
typedef unsigned short bf16_t;
typedef short bf16x8 __attribute__((ext_vector_type(8)));
typedef short s16x4 __attribute__((ext_vector_type(4)));
typedef float f32x4 __attribute__((ext_vector_type(4)));
typedef float f32x16 __attribute__((ext_vector_type(16)));
typedef unsigned u32x4 __attribute__((ext_vector_type(4)));
typedef unsigned u32x2 __attribute__((ext_vector_type(2)));
typedef __bf16 bf2_t __attribute__((ext_vector_type(2)));
typedef float f2_t __attribute__((ext_vector_type(2)));

constexpr int NB = 32, SEQ = 2048, CTXL = 256, TT = 2304, NR = NB * TT, DM = 1024, FH = 2816;
constexpr float EPS = 1e-6f, LOG2E = 1.4426950408889634f, L2_10000 = 13.287712379549449f;
constexpr int LDS_BYTES = 133120 + 64;

enum { I_X, I_C, I_CTX, I_CCTX, I_ADAW, I_ADAB, I_NMIX, I_NFFN, I_FWIN, I_FWOUT,
       I_MWIN, I_MGQ, I_MGKV, I_MWUQ, I_MWUKV, I_MGQN, I_MGKN, I_MWO,
       I_SARE, I_SAIM, I_SLDT, I_SBRE, I_SBIM, I_SCRE, I_SCIM, I_SD, I_SWGLU,
       I_NWQKV, I_NGQN, I_NGKN, I_NRPB, I_NWO, I_GWQKV, I_GGQN, I_GGKN, I_GWO, N_IN };

constexpr size_t SZ_WFI = (size_t)5632 * 1024 * 2, SZ_WFO = (size_t)1024 * 2816 * 2;
constexpr size_t OFF_WFI = 0;
constexpr size_t OFF_WFO = OFF_WFI + 4 * SZ_WFI;
constexpr size_t OFF_WMI = OFF_WFO + 4 * SZ_WFO;
constexpr size_t OFF_WUQ = OFF_WMI + (size_t)768 * 1024 * 2;
constexpr size_t OFF_WUKV = OFF_WUQ + (size_t)1536 * 384 * 2;
constexpr size_t OFF_WMO = OFF_WUKV + (size_t)2048 * 256 * 2;
constexpr size_t OFF_WGLU = OFF_WMO + (size_t)1024 * 1024 * 2;
constexpr size_t OFF_WNQ = OFF_WGLU + (size_t)2048 * 1024 * 2;
constexpr size_t OFF_WNO = OFF_WNQ + (size_t)3072 * 1024 * 2;
constexpr size_t OFF_WGQ = OFF_WNO + (size_t)1024 * 1024 * 2;
constexpr size_t OFF_WGO = OFF_WGQ + (size_t)1536 * 1024 * 2;
constexpr size_t OFF_ADA = OFF_WGO + (size_t)1024 * 1024 * 2;
constexpr size_t OFF_XC = OFF_ADA + (size_t)4 * 33 * 6144 * 4;
constexpr size_t OFF_HB = OFF_XC + (size_t)NB * CTXL * 1024 * 4;
constexpr size_t OFF_BIG = OFF_HB + (size_t)NR * 1024 * 2;
constexpr size_t OFF_KV = OFF_BIG;
constexpr size_t OFF_QB = OFF_KV + (size_t)NR * 2560 * 2;
constexpr size_t OFF_Z = OFF_QB + (size_t)NR * 1536 * 2;
constexpr size_t OFF_BAR = OFF_Z + (size_t)NR * 768 * 2;
constexpr size_t WS_NEED = OFF_BAR + 16384;

struct Params {
    const float* in[N_IN];
    float* out;
    unsigned char* ws;
    int ph_lo, ph_hi;
};

DI unsigned pk_bf16(float a, float b) { f2_t v = {a, b}; bf2_t r = __builtin_convertvector(v, bf2_t); return __builtin_bit_cast(unsigned, r); }
DI float bf_lo(unsigned u) { return __uint_as_float(u << 16); }
DI float bf_hi(unsigned u) { return __uint_as_float(u & 0xffff0000u); }
DI float wsum(float v) {
#pragma unroll
    for (int o = 32; o > 0; o >>= 1) v += __shfl_xor(v, o);
    return v;
}
DI int otid() { int t = threadIdx.x; asm volatile("" : "+v"(t)); return t; }
DI int obid() { int b = blockIdx.x; asm volatile("" : "+s"(b)); return b; }
DI int clampi(int v, int lo, int hi) { return v < lo ? lo : (v > hi ? hi : v); }
DI float fexp2(float x) { return __builtin_amdgcn_exp2f(x); }
DI float frcp(float x) { return __builtin_amdgcn_rcpf(x); }
DI float silu_f(float a) { return a * frcp(1.f + __expf(-a)); }
DI float sigmoid_f(float a) { return frcp(1.f + __expf(-a)); }
DI float gelu_tanh(float y) {
    const float z = 0.7978845608028654f * (y + 0.044715f * y * y * y);
    const float t = 1.f - 2.f * frcp(__expf(2.f * z) + 1.f);
    return 0.5f * y * (1.f + t);
}
DI void unpack8(const u32x4 u, float* f) {
#pragma unroll
    for (int i = 0; i < 4; ++i) { f[2 * i] = bf_lo(u[i]); f[2 * i + 1] = bf_hi(u[i]); }
}
DI u32x4 pack8(const float* f) { return (u32x4){pk_bf16(f[0], f[1]), pk_bf16(f[2], f[3]), pk_bf16(f[4], f[5]), pk_bf16(f[6], f[7])}; }

namespace pg8 {
constexpr int BM = 256, BK = 64, HALF = 128, HTB = HALF * BK * 2, NXCD = 8, WGM = 8;
DI int lds_byte(int r, int c) { const int st = (r >> 4) * 2 + (c >> 5), rr = r & 15, cc = c & 31, ob = rr * 64 + cc * 2; return st * 1024 + (ob ^ (((ob >> 9) & 1) << 5)); }
DI void stage_rc(int b, int& R, int& C) { const int st = b / 1024, sb = b % 1024, swz = sb ^ (((sb >> 9) & 1) << 5); R = (st >> 1) * 16 + swz / 64; C = (st & 1) * 32 + (swz % 64) / 2; }
DI int perm32(int rho) { const int n = rho >> 4, i = rho & 15; return 8 * (i >> 2) + 4 * n + (i & 3); }
struct Unit { int pm, pn; };
struct Gemm { const bf16_t* A; const bf16_t* Bt; int M, N, K, lda; };
struct Order {
    int nM, nN, nwg, G, c, skip;
    DI void init(int N, int G_, int c_, int skipctx) { skip = skipctx; nM = skipctx ? 256 : 288; nN = N / BM; nwg = nM * nN; G = G_; c = c_; }
    DI bool next(int i, Unit& u) const {
        const long L = (long)i * G + c; if (L >= nwg) return false;
        int wgid = (int)L; { const int q = nwg / NXCD, r = nwg % NXCD, xcd = wgid % NXCD, off = wgid / NXCD; wgid = (xcd < r ? xcd * (q + 1) : r * (q + 1) + (xcd - r) * q) + off; }
        const int nig = WGM * nN, gid = wgid / nig, fm = gid * WGM, gsz = (nM - fm) < WGM ? (nM - fm) : WGM;
        int pm = fm + ((wgid % nig) % gsz); u.pn = (wgid % nig) / gsz;
        if (skip) pm = pm + (pm >> 3) + 1;
        u.pm = pm; return true;
    }
};

DI float* tile_res_base(float* lat, float* xc, int pm) { const int bb = pm / 9, sub = pm - bb * 9; return sub == 0 ? xc + ((size_t)bb * CTXL << 10) : lat + ((size_t)(bb * SEQ + (sub - 1) * 256) << 10); }
DI int tile_ada_row(int pm) { const int bb = pm / 9, sub = pm - bb * 9; return sub == 0 ? 32 : bb; }

struct EpiStore {
    static constexpr bool PERM = true;
    bf16_t* O; int ldc; int remap;
    DI void operator()(const f32x4 (&acc)[2][2][4][2], const Unit& u, int wr, int wc, int fr, int fq) const {
        const int row0 = u.pm * BM + wr * 64 + fr, col0 = u.pn * BM + wc * 32 + 8 * fq;
#pragma unroll
        for (int ai = 0; ai < 2; ++ai)
#pragma unroll
            for (int m = 0; m < 4; ++m) {
                bf16_t* rowp = O + (size_t)(row0 + ai * HALF + m * 16) * ldc;
#pragma unroll
                for (int bj = 0; bj < 2; ++bj) {
                    const int c = col0 + bj * HALF; const int cc = remap ? (c >> 7) * 160 + (c & 127) : c;
                    const f32x4 v0 = acc[ai][bj][m][0], v1 = acc[ai][bj][m][1];
                    *(u32x4*)(rowp + cc) = (u32x4){pk_bf16(v0[0], v0[1]), pk_bf16(v0[2], v0[3]), pk_bf16(v1[0], v1[1]), pk_bf16(v1[2], v1[3])};
                }
            }
    }
};
struct EpiSwiglu {
    static constexpr bool PERM = true;
    bf16_t* O; int ldc;
    DI void operator()(const f32x4 (&acc)[2][2][4][2], const Unit& u, int wr, int wc, int fr, int fq) const {
        const int row0 = u.pm * BM + wr * 64 + fr, col0 = u.pn * HALF + wc * 32 + 8 * fq;
#pragma unroll
        for (int ai = 0; ai < 2; ++ai)
#pragma unroll
            for (int m = 0; m < 4; ++m) {
                float v[8];
#pragma unroll
                for (int n = 0; n < 2; ++n)
#pragma unroll
                    for (int i = 0; i < 4; ++i) v[n * 4 + i] = silu_f(acc[ai][0][m][n][i]) * acc[ai][1][m][n][i];
                *(u32x4*)(O + (size_t)(row0 + ai * HALF + m * 16) * ldc + col0) = pack8(v);
            }
    }
};
struct EpiGluRes {
    static constexpr bool PERM = true;
    float* lat; float* xc; const float* ada; int gidx;
    DI void operator()(const f32x4 (&acc)[2][2][4][2], const Unit& u, int wr, int wc, int fr, int fq) const {
        float* base = tile_res_base(lat, xc, u.pm);
        const float* gate = ada + (size_t)tile_ada_row(u.pm) * 6144 + gidx * 1024;
        const int col0 = u.pn * HALF + wc * 32 + 8 * fq;
        const f32x4 g0 = *(const f32x4*)(gate + col0), g1 = *(const f32x4*)(gate + col0 + 4);
#pragma unroll
        for (int ai = 0; ai < 2; ++ai)
#pragma unroll
            for (int m = 0; m < 4; ++m) {
                float* rp = base + ((size_t)(ai * HALF + wr * 64 + m * 16 + fr) << 10) + col0;
                f32x4 x0 = *(f32x4*)rp, x1 = *(f32x4*)(rp + 4);
#pragma unroll
                for (int i = 0; i < 4; ++i) {
                    x0[i] += g0[i] * (acc[ai][0][m][0][i] * sigmoid_f(acc[ai][1][m][0][i]));
                    x1[i] += g1[i] * (acc[ai][0][m][1][i] * sigmoid_f(acc[ai][1][m][1][i]));
                }
                *(f32x4*)rp = x0; *(f32x4*)(rp + 4) = x1;
            }
    }
};
struct EpiRes {
    static constexpr bool PERM = false;
    float* lat; float* xc; const float* ada; int gidx; const float* lat_in; const float* xc_in;
    DI void operator()(const f32x4 (&acc)[2][2][4][2], const Unit& u, int wr, int wc, int fr, int fq) const {
        float* base = tile_res_base(lat, xc, u.pm);
        const float* base_in = tile_res_base((float*)lat_in, (float*)xc_in, u.pm);
        const float* gate = ada + (size_t)tile_ada_row(u.pm) * 6144 + gidx * 1024;
        const int col0 = u.pn * BM + wc * 32 + 4 * fq;
        f32x4 gv[2][2];
#pragma unroll
        for (int bj = 0; bj < 2; ++bj)
#pragma unroll
            for (int n = 0; n < 2; ++n) gv[bj][n] = *(const f32x4*)(gate + col0 + bj * HALF + n * 16);
#pragma unroll
        for (int ai = 0; ai < 2; ++ai)
#pragma unroll
            for (int m = 0; m < 4; ++m) {
                float* rp = base + ((size_t)(ai * HALF + wr * 64 + m * 16 + fr) << 10) + col0;
                const float* rpi = base_in + ((size_t)(ai * HALF + wr * 64 + m * 16 + fr) << 10) + col0;
#pragma unroll
                for (int bj = 0; bj < 2; ++bj)
#pragma unroll
                    for (int n = 0; n < 2; ++n) {
                        f32x4 x = *(const f32x4*)(rpi + bj * HALF + n * 16);
                        x += gv[bj][n] * acc[ai][bj][m][n];
                        *(f32x4*)(rp + bj * HALF + n * 16) = x;
                    }
            }
    }
};

template <class Epi>
DI void gemm_phase(LAS unsigned char* lds, const Gemm g, const Order& S, const Epi& E) {
    const int TIDX = otid(); const int BIDX = obid(); (void)TIDX; (void)BIDX;
    const int tid = TIDX, wid = __builtin_amdgcn_readfirstlane(tid >> 6), lane = tid & 63, wr = wid >> 2, wc = wid & 3, fr = lane & 15, fq = lane >> 4;
    const int K = g.K, nt = K / BK;
    unsigned voffA[2], voffB[2];
#pragma unroll
    for (int i = 0; i < 2; ++i) { int R, C; stage_rc(tid * 16 + i * 8192, R, C); const int Rb = Epi::PERM ? ((R & ~31) + perm32(R & 31)) : R;
        voffA[i] = (unsigned)(R * g.lda + C) * 2u; voffB[i] = (unsigned)(Rb * K + C) * 2u; }
    const size_t kstep = (size_t)(BK * 2);
    const size_t hstep = (size_t)HALF * K * 2, hstepA = (size_t)HALF * g.lda * 2;
    const size_t tstep = 2 * hstep, tstepA = 2 * hstepA;
    const unsigned ldsw = (unsigned)wid * 1024u;
    const int aoff = lds_byte(wr * 64 + fr, fq * 8), boff = lds_byte(wc * 32 + fr, fq * 8);
#define PG8_SA(b, h) (((b) * 2 + (h)) * HTB)
#define PG8_SB(b, h) ((4 + (b) * 2 + (h)) * HTB)
#define PG8_STAGE(bufoff, gbase, voff) do { _Pragma("unroll") for (int _i = 0; _i < 2; ++_i) \
        __builtin_amdgcn_global_load_lds((const unsigned*)((const char*)(gbase) + (voff)[_i]), (LAS unsigned*)(lds + (bufoff) + ldsw + _i * 8192), 16, 0, 0); } while (0)
#define PG8_LDA(dst, b, h) do { _Pragma("unroll") for (int m = 0; m < 4; ++m) _Pragma("unroll") for (int k = 0; k < 2; ++k) dst[m][k] = *(const LAS bf16x8*)(lds + PG8_SA(b, h) + aoff + m * 2048 + k * 1024); } while (0)
#define PG8_LDB(dst, b, h) do { _Pragma("unroll") for (int n = 0; n < 2; ++n) _Pragma("unroll") for (int k = 0; k < 2; ++k) dst[n][k] = *(const LAS bf16x8*)(lds + PG8_SB(b, h) + boff + n * 2048 + k * 1024); } while (0)
#define PG8_MMA(ai, bj, At, Bt) do { __builtin_amdgcn_s_setprio(1); _Pragma("unroll") for (int m = 0; m < 4; ++m) _Pragma("unroll") for (int n = 0; n < 2; ++n) _Pragma("unroll") for (int k = 0; k < 2; ++k) \
        acc[ai][bj][m][n] = __builtin_amdgcn_mfma_f32_16x16x32_bf16(Bt[n][k], At[m][k], acc[ai][bj][m][n], 0, 0, 0); __builtin_amdgcn_s_setprio(0); } while (0)
#define PG8_WAIT_V(n) asm volatile("s_waitcnt vmcnt(" #n ")" ::: "memory")
#define PG8_WAIT_L(n) asm volatile("s_waitcnt lgkmcnt(" #n ")" ::: "memory")
#define PG8_BAR __builtin_amdgcn_s_barrier()
#define PG8_SCHED __builtin_amdgcn_sched_barrier(0)
    Unit cur, nxt; int ui = 0;
    if (!S.next(0, cur)) return;
    f32x4 acc[2][2][4][2];
#pragma unroll
    for (int a = 0; a < 2; ++a)
#pragma unroll
        for (int b = 0; b < 2; ++b)
#pragma unroll
            for (int m = 0; m < 4; ++m)
#pragma unroll
                for (int n = 0; n < 2; ++n) acc[a][b][m][n] = (f32x4){0.f, 0.f, 0.f, 0.f};
    bf16x8 At[4][2], B0[2][2], B1[2][2];
    const char* cA = (const char*)g.A + (size_t)cur.pm * tstepA; const char* cB = (const char*)g.Bt + (size_t)cur.pn * tstep;
    PG8_STAGE(PG8_SB(0, 0), cB, voffB); PG8_STAGE(PG8_SA(0, 0), cA, voffA); PG8_STAGE(PG8_SB(0, 1), cB + hstep, voffB); PG8_STAGE(PG8_SA(0, 1), cA + hstepA, voffA);
    if (wr == 1) PG8_BAR;
    PG8_WAIT_V(4); PG8_BAR;
    PG8_STAGE(PG8_SB(1, 0), cB + kstep, voffB); PG8_STAGE(PG8_SA(1, 0), cA + kstep, voffA); PG8_STAGE(PG8_SB(1, 1), cB + hstep + kstep, voffB);
    PG8_WAIT_V(6); PG8_BAR;
    for (;;) {
        const bool has_next = S.next(ui + 1, nxt);
        const char* nA = has_next ? (const char*)g.A + (size_t)nxt.pm * tstepA : cA; const char* nB = has_next ? (const char*)g.Bt + (size_t)nxt.pn * tstep : cB;
        for (int t = 0; t < nt; t += 2) {
            const bool last = (t == nt - 2);
            const char* a1 = cA + (size_t)(t + 1) * kstep;
            const char* a2 = last ? nA : cA + (size_t)(t + 2) * kstep; const char* b2 = last ? nB : cB + (size_t)(t + 2) * kstep;
            const char* a3 = a2 + kstep; const char* b3 = b2 + kstep;
            PG8_LDB(B0, 0, 0); PG8_SCHED; PG8_LDA(At, 0, 0); PG8_STAGE(PG8_SA(1, 1), a1 + hstepA, voffA);
            PG8_WAIT_L(8); PG8_BAR; PG8_WAIT_L(0); PG8_MMA(0, 0, At, B0); PG8_BAR; PG8_SCHED;
            PG8_LDB(B1, 0, 1); PG8_STAGE(PG8_SB(0, 0), b2, voffB);
            PG8_BAR; PG8_WAIT_L(0); PG8_MMA(0, 1, At, B1); PG8_BAR;
            PG8_LDA(At, 0, 1); PG8_STAGE(PG8_SA(0, 0), a2, voffA);
            PG8_BAR; PG8_WAIT_L(0); PG8_MMA(1, 0, At, B0); PG8_BAR; PG8_SCHED;
            PG8_STAGE(PG8_SB(0, 1), b2 + hstep, voffB);
            PG8_WAIT_V(6); PG8_BAR; PG8_MMA(1, 1, At, B1); PG8_BAR;
            PG8_LDB(B0, 1, 0); PG8_SCHED; PG8_LDA(At, 1, 0); PG8_STAGE(PG8_SA(0, 1), a2 + hstepA, voffA);
            PG8_WAIT_L(8); PG8_BAR; PG8_WAIT_L(0); PG8_MMA(0, 0, At, B0); PG8_BAR; PG8_SCHED;
            PG8_LDB(B1, 1, 1); PG8_STAGE(PG8_SB(1, 0), b3, voffB);
            PG8_BAR; PG8_WAIT_L(0); PG8_MMA(0, 1, At, B1); PG8_BAR;
            PG8_LDA(At, 1, 1); PG8_STAGE(PG8_SA(1, 0), a3, voffA);
            PG8_BAR; PG8_WAIT_L(0); PG8_MMA(1, 0, At, B0); PG8_BAR; PG8_SCHED;
            PG8_STAGE(PG8_SB(1, 1), b3 + hstep, voffB);
            PG8_WAIT_V(6); PG8_BAR; PG8_MMA(1, 1, At, B1); PG8_BAR;
        }
        E(acc, cur, wr, wc, fr, fq);
        if (!has_next) break;
#pragma unroll
        for (int a = 0; a < 2; ++a)
#pragma unroll
            for (int b = 0; b < 2; ++b)
#pragma unroll
                for (int m = 0; m < 4; ++m)
#pragma unroll
                    for (int n = 0; n < 2; ++n) acc[a][b][m][n] = (f32x4){0.f, 0.f, 0.f, 0.f};
        cur = nxt; cA = nA; cB = nB; ++ui;
    }
    PG8_WAIT_V(0);
    if (wr == 0) PG8_BAR;
    PG8_BAR;
#undef PG8_SA
#undef PG8_SB
#undef PG8_STAGE
#undef PG8_LDA
#undef PG8_LDB
#undef PG8_MMA
#undef PG8_WAIT_V
#undef PG8_WAIT_L
#undef PG8_BAR
#undef PG8_SCHED
}
}

template <class Epi>
DI void run_gemm(LAS unsigned char* lds, const bf16_t* A, int lda, const bf16_t* Bt, int N, int K, int skipctx, const Epi& E) {
    const int BIDX = obid();
    pg8::Order S; S.init(N, (int)gridDim.x, BIDX, skipctx);
    pg8::Gemm g{A, Bt, NR, N, K, lda};
    pg8::gemm_phase<Epi>(lds, g, S, E);
}

struct WDesc { const float* src; bf16_t* dst; int K, N, Nout, half; const float* kscale; };
DI WDesc wdesc_of(const Params& p, int m) {
    unsigned char* ws = p.ws;
    if (m < 4) return WDesc{p.in[I_FWIN] + (size_t)m * 1024 * 5632, (bf16_t*)(ws + OFF_WFI + m * SZ_WFI), 1024, 5632, 5632, 2816, nullptr};
    if (m < 8) return WDesc{p.in[I_FWOUT] + (size_t)(m - 4) * 2816 * 1024, (bf16_t*)(ws + OFF_WFO + (m - 4) * SZ_WFO), 2816, 1024, 1024, 0, nullptr};
    switch (m) {
        case 8: return WDesc{p.in[I_MWIN], (bf16_t*)(ws + OFF_WMI), 1024, 672, 768, 0, nullptr};
        case 9: return WDesc{p.in[I_MWUQ], (bf16_t*)(ws + OFF_WUQ), 384, 1536, 1536, 0, p.in[I_MGQ]};
        case 10: return WDesc{p.in[I_MWUKV], (bf16_t*)(ws + OFF_WUKV), 256, 2048, 2048, 0, p.in[I_MGKV]};
        case 11: return WDesc{p.in[I_MWO], (bf16_t*)(ws + OFF_WMO), 1024, 1024, 1024, 0, nullptr};
        case 12: return WDesc{p.in[I_SWGLU], (bf16_t*)(ws + OFF_WGLU), 1024, 2048, 2048, 1024, nullptr};
        case 13: return WDesc{p.in[I_NWQKV], (bf16_t*)(ws + OFF_WNQ), 1024, 3072, 3072, 0, nullptr};
        case 14: return WDesc{p.in[I_NWO], (bf16_t*)(ws + OFF_WNO), 1024, 1024, 1024, 0, nullptr};
        case 15: return WDesc{p.in[I_GWQKV], (bf16_t*)(ws + OFF_WGQ), 1024, 1536, 1536, 0, nullptr};
        default: return WDesc{p.in[I_GWO], (bf16_t*)(ws + OFF_WGO), 1024, 1024, 1024, 0, nullptr};
    }
}
DI void prep_tile(LAS float* tile, const WDesc w, int tidx, int lane) {
    const int ntk = w.K / 64;
    const int kt = tidx % ntk, nt = tidx / ntk;
    const int n0 = nt * 64;
    int scol = n0;
    if (w.half) { const int t256 = n0 >> 8, ww = n0 & 255; scol = (ww >= 128 ? w.half : 0) + t256 * 128 + (ww & 127); }
    const int c4 = (lane & 15) * 4;
    f32x4 v[16];
#pragma unroll
    for (int i = 0; i < 16; ++i) {
        const int r = (lane >> 4) + 4 * i;
        v[i] = (f32x4){0.f, 0.f, 0.f, 0.f};
        if (scol + c4 < w.N) v[i] = *(const f32x4*)(w.src + (size_t)(kt * 64 + r) * w.N + scol + c4);
    }
#pragma unroll
    for (int i = 0; i < 16; ++i) {
        const int r = (lane >> 4) + 4 * i;
        f32x4 x = v[i];
        if (w.kscale) x *= w.kscale[kt * 64 + r];
#pragma unroll
        for (int j = 0; j < 4; ++j) tile[r * 65 + c4 + j] = x[j];
    }
    bf16_t* d = w.dst + (size_t)(n0 + lane) * w.K + kt * 64;
#pragma unroll
    for (int q = 0; q < 8; ++q) {
        float f[8];
#pragma unroll
        for (int k = 0; k < 8; ++k) f[k] = tile[(q * 8 + k) * 65 + lane];
        *(u32x4*)(d + q * 8) = pack8(f);
    }
}

DI void ada_item(const Params& p, float* ADA, int item, int lane) {
    const int layer = item / 192, n0 = (item - layer * 192) * 32;
    const int r = lane & 31, kh = lane >> 5;
    const float* W = p.in[I_ADAW] + (size_t)layer * 1024 * 6144 + n0 + r;
    const float* cb = p.in[I_C] + r * 1024 + kh * 8;
    const float* cc = p.in[I_CCTX] + kh * 8;
    f32x16 acc;
#pragma unroll
    for (int i = 0; i < 16; ++i) acc[i] = 0.f;
    float accc = 0.f;
    for (int k0 = 0; k0 < 1024; k0 += 32) {
        float wv[16], cv[16], xv[16];
#pragma unroll
        for (int h2 = 0; h2 < 2; ++h2) {
            const f32x4 c0 = *(const f32x4*)(cb + k0 + h2 * 16), c1 = *(const f32x4*)(cb + k0 + h2 * 16 + 4);
            const f32x4 x0 = *(const f32x4*)(cc + k0 + h2 * 16), x1 = *(const f32x4*)(cc + k0 + h2 * 16 + 4);
#pragma unroll
            for (int u = 0; u < 4; ++u) { cv[h2 * 8 + u] = c0[u]; cv[h2 * 8 + 4 + u] = c1[u]; xv[h2 * 8 + u] = x0[u]; xv[h2 * 8 + 4 + u] = x1[u]; }
#pragma unroll
            for (int u = 0; u < 8; ++u) wv[h2 * 8 + u] = W[(size_t)(k0 + h2 * 16 + kh * 8 + u) * 6144];
        }
#pragma unroll
        for (int u = 0; u < 16; ++u) {
            acc = __builtin_amdgcn_mfma_f32_32x32x2f32(silu_f(cv[u]), wv[u], acc, 0, 0, 0);
            accc += silu_f(xv[u]) * wv[u];
        }
    }
    accc += __shfl_xor(accc, 32);
    const float bias = p.in[I_ADAB][layer * 6144 + n0 + r];
#pragma unroll
    for (int i = 0; i < 16; ++i) {
        const int v = (i & 3) + 8 * (i >> 2) + 4 * kh;
        ADA[((size_t)layer * 33 + v) * 6144 + n0 + r] = acc[i] + bias;
    }
    if (kh == 0) ADA[((size_t)layer * 33 + 32) * 6144 + n0 + r] = accc + bias;
}

DI void phase0(LAS unsigned char* lds, const Params& p, float* ADA, unsigned* counter) {
    const int TIDX = otid();
    const int wave = __builtin_amdgcn_readfirstlane(TIDX >> 6), lane = TIDX & 63;
    LAS float* tile = (LAS float*)(lds + wave * 16640);
    constexpr int NADA = 4 * 192;
    for (;;) {
        int item = 0;
        if (lane == 0) item = (int)atomicAdd(counter, 1u);
        item = __builtin_amdgcn_readfirstlane(item);
        if (item < NADA) { ada_item(p, ADA, item, lane); continue; }
        int t = item - NADA, m = 0;
        bool found = false;
        for (m = 0; m < 17; ++m) {
            const WDesc w = wdesc_of(p, m);
            const int nt = (w.K / 64) * (w.Nout / 64);
            if (t < nt) { prep_tile(tile, w, t, lane); found = true; break; }
            t -= nt;
        }
        if (!found) break;
    }
}

DI void norm_phase(const float* lat_in, const float* ctx_in, float* lat_out, float* ctx_out, bool copy, const float* g,
                   const float* ada, int shidx, bf16_t* H, bool skipctx) {
    const int TIDX = otid(); const int BIDX = obid(); (void)TIDX; (void)BIDX;
    const int wave = TIDX >> 6, lane = TIDX & 63;
    for (int row = BIDX * 8 + wave; row < NR; row += gridDim.x * 8) {
        const int b = row / TT, t = row - b * TT;
        if (skipctx && t < CTXL) continue;
        const size_t ro = t < CTXL ? ((size_t)(b * CTXL + t) << 10) : ((size_t)(b * SEQ + t - CTXL) << 10);
        const float* src = (t < CTXL ? ctx_in : lat_in) + ro;
        const float* sh = ada + (size_t)(t < CTXL ? 32 : b) * 6144 + shidx * 1024;
        const float* sc = sh + 1024;
        f32x4 a[4];
        a[0] = *(const f32x4*)(src + lane * 8); a[1] = *(const f32x4*)(src + lane * 8 + 4);
        a[2] = *(const f32x4*)(src + 512 + lane * 8); a[3] = *(const f32x4*)(src + 512 + lane * 8 + 4);
        float ss = 0.f;
#pragma unroll
        for (int i = 0; i < 4; ++i)
#pragma unroll
            for (int j = 0; j < 4; ++j) ss += a[i][j] * a[i][j];
        ss = wsum(ss);
        const float r = rsqrtf(ss * (1.f / 1024.f) + EPS);
        if (copy) {
            float* dst = (t < CTXL ? ctx_out : lat_out) + ro;
            *(f32x4*)(dst + lane * 8) = a[0]; *(f32x4*)(dst + lane * 8 + 4) = a[1];
            *(f32x4*)(dst + 512 + lane * 8) = a[2]; *(f32x4*)(dst + 512 + lane * 8 + 4) = a[3];
        }
#pragma unroll
        for (int hf = 0; hf < 2; ++hf) {
            const int c0 = hf * 512 + lane * 8;
            float y[8];
#pragma unroll
            for (int q = 0; q < 2; ++q) {
                const f32x4 gv = *(const f32x4*)(g + c0 + q * 4), sv = *(const f32x4*)(sc + c0 + q * 4), hv = *(const f32x4*)(sh + c0 + q * 4);
#pragma unroll
                for (int j = 0; j < 4; ++j) y[q * 4 + j] = a[hf * 2 + q][j] * r * gv[j] * (1.f + sv[j]) + hv[j];
            }
            *(u32x4*)(H + ((size_t)row << 10) + c0) = pack8(y);
        }
    }
}

DI void mla_rope8(float* v, int sub, int s) {
    const float pos = (float)((sub < 2) ? (s >> 6) : (s & 63));
    const bool isx2 = sub & 1;
#pragma unroll
    for (int i = 0; i < 8; ++i) {
        const float other = __shfl_xor(v[i], 1);
        const float ang = pos * fexp2(-(float)i * (L2_10000 / 8.f));
        const float c = __cosf(ang), sn = __sinf(ang);
        v[i] = isx2 ? (other * sn + v[i] * c) : (v[i] * c - other * sn);
    }
}

DI void mla_r2(bf16_t* QB, bf16_t* KV, const bf16_t* Z, const float* gqn, const float* gkn) {
    const int TIDX = otid(); const int BIDX = obid(); (void)TIDX; (void)BIDX;
    const int wave = TIDX >> 6, lane = TIDX & 63, hd = lane >> 2, sub = lane & 3;
    for (int row = BIDX * 8 + wave; row < NR; row += gridDim.x * 8) {
        const int b = row / TT, t = row - b * TT; const bool latent = t >= CTXL; const int s = t - CTXL;
        const bf16_t* z = Z + (size_t)row * 768;
        bf16_t* qp = QB + (size_t)row * 1536 + hd * 96;
        bf16_t* kp = KV + (size_t)row * 2560 + hd * 160;
        unsigned zq[3];
#pragma unroll
        for (int i = 0; i < 3; ++i) zq[i] = *(const unsigned*)(z + lane * 6 + 2 * i);
        const u32x2 zk = *(const u32x2*)(z + 384 + lane * 4);
        const u32x4 q0 = *(const u32x4*)(qp + sub * 16), q1 = *(const u32x4*)(qp + sub * 16 + 8), q2 = *(const u32x4*)(qp + 64 + sub * 8);
        const u32x4 k0 = *(const u32x4*)(kp + sub * 16), k1 = *(const u32x4*)(kp + sub * 16 + 8);
        const u32x4 v0 = *(const u32x4*)(kp + 64 + sub * 16), v1 = *(const u32x4*)(kp + 64 + sub * 16 + 8);
        const u32x4 k2 = *(const u32x4*)(z + 640 + sub * 8);
        asm volatile("s_waitcnt vmcnt(0)" ::: "memory");
        float sq0 = 0.f, sk0 = 0.f;
#pragma unroll
        for (int i = 0; i < 3; ++i) { const float a0 = bf_lo(zq[i]), a1 = bf_hi(zq[i]); sq0 += a0 * a0 + a1 * a1; }
        { const float a0 = bf_lo(zk[0]), a1 = bf_hi(zk[0]), a2 = bf_lo(zk[1]), a3 = bf_hi(zk[1]); sk0 = a0 * a0 + a1 * a1 + a2 * a2 + a3 * a3; }
        sq0 = wsum(sq0); sk0 = wsum(sk0);
        const float rq0 = rsqrtf(sq0 * (1.f / 384.f) + EPS), rk0 = rsqrtf(sk0 * (1.f / 256.f) + EPS);
        float qn[16], qr[8], kn[16], kr[8], vv[16];
        unpack8(q0, qn); unpack8(q1, qn + 8); unpack8(q2, qr);
        unpack8(k0, kn); unpack8(k1, kn + 8); unpack8(k2, kr);
        unpack8(v0, vv); unpack8(v1, vv + 8);
#pragma unroll
        for (int i = 0; i < 16; ++i) { qn[i] *= rq0; kn[i] *= rk0; vv[i] *= rk0; }
#pragma unroll
        for (int i = 0; i < 8; ++i) qr[i] *= rq0;
        float sq = 0.f, sk = 0.f;
#pragma unroll
        for (int i = 0; i < 16; ++i) { sq += qn[i] * qn[i]; sk += kn[i] * kn[i]; }
#pragma unroll
        for (int i = 0; i < 8; ++i) { sq += qr[i] * qr[i]; sk += kr[i] * kr[i]; }
        sq += __shfl_xor(sq, 1); sq += __shfl_xor(sq, 2);
        sk += __shfl_xor(sk, 1); sk += __shfl_xor(sk, 2);
        const float rq = rsqrtf(sq * (1.f / 96.f) + EPS), rk = rsqrtf(sk * (1.f / 96.f) + EPS);
#pragma unroll
        for (int i = 0; i < 16; ++i) { qn[i] *= rq * gqn[sub * 16 + i]; kn[i] *= rk * gkn[sub * 16 + i]; }
#pragma unroll
        for (int i = 0; i < 8; ++i) { qr[i] *= rq * gqn[64 + sub * 8 + i]; kr[i] *= rk * gkn[64 + sub * 8 + i]; }
        if (latent) { mla_rope8(qr, sub, s); mla_rope8(kr, sub, s); }
        *(u32x4*)(qp + sub * 16) = pack8(qn); *(u32x4*)(qp + sub * 16 + 8) = pack8(qn + 8); *(u32x4*)(qp + 64 + sub * 8) = pack8(qr);
        *(u32x4*)(kp + sub * 16) = pack8(kn); *(u32x4*)(kp + sub * 16 + 8) = pack8(kn + 8); *(u32x4*)(kp + 64 + sub * 8) = pack8(kr);
        *(u32x4*)(kp + 96 + sub * 16) = pack8(vv); *(u32x4*)(kp + 96 + sub * 16 + 8) = pack8(vv + 8);
    }
}

template <int HD, int LPH, int ROPE>
DI void headnorm_phase(bf16_t* X, int stride, int nq, int koff, int nk, const float* gq, const float* gk) {
    const int TIDX = otid(); const int BIDX = obid(); (void)TIDX; (void)BIDX;
    const int wave = TIDX >> 6, lane = TIDX & 63, sub = lane % LPH, hl = lane / LPH;
    const int rstep = gridDim.x * 8;
    for (int row = BIDX * 8 + wave; row < NR; row += 2 * rstep) {
        u32x4 u[2][2][2];
#pragma unroll
        for (int rr = 0; rr < 2; ++rr)
#pragma unroll
            for (int pass = 0; pass < 2; ++pass) {
                const int r2 = row + rr * rstep;
                const bool act = (r2 < NR) && (hl < (pass ? nk : nq));
                const bf16_t* ptr = X + (size_t)r2 * stride + (pass ? koff : 0) + hl * HD + sub * 16;
                u[rr][pass][0] = (u32x4){0, 0, 0, 0}; u[rr][pass][1] = (u32x4){0, 0, 0, 0};
                if (act) { u[rr][pass][0] = *(const u32x4*)ptr; u[rr][pass][1] = *(const u32x4*)(ptr + 8); }
            }
        asm volatile("s_waitcnt vmcnt(0)" ::: "memory");
#pragma unroll
        for (int rr = 0; rr < 2; ++rr) {
            const int r2 = row + rr * rstep;
            const int b = r2 / TT, t = r2 - b * TT; const bool latent = t >= CTXL; const int s = t - CTXL;
#pragma unroll
            for (int pass = 0; pass < 2; ++pass) {
                const bool act = (r2 < NR) && (hl < (pass ? nk : nq));
                const float* g = pass ? gk : gq;
                bf16_t* ptr = X + (size_t)r2 * stride + (pass ? koff : 0) + hl * HD + sub * 16;
                float v[16]; unpack8(u[rr][pass][0], v); unpack8(u[rr][pass][1], v + 8);
                float ss = 0.f;
#pragma unroll
                for (int i = 0; i < 16; ++i) ss += v[i] * v[i];
#pragma unroll
                for (int o = 1; o < LPH; o <<= 1) ss += __shfl_xor(ss, o);
                const float rr_ = rsqrtf(ss * (1.f / HD) + EPS);
#pragma unroll
                for (int i = 0; i < 16; ++i) v[i] *= rr_ * g[sub * 16 + i];
                if (ROPE) {
                    if (latent) {
                        const int axis = sub >> 2; const bool isx2 = (sub >> 1) & 1;
                        const float pos = (float)(axis ? (s & 63) : (s >> 6));
#pragma unroll
                        for (int i = 0; i < 16; ++i) {
                            const float other = __shfl_xor(v[i], 2);
                            const int fi = (sub & 1) * 16 + i;
                            const float ang = pos * fexp2(-(float)fi * (L2_10000 / 32.f));
                            const float c = __cosf(ang), sn = __sinf(ang);
                            v[i] = isx2 ? (other * sn + v[i] * c) : (v[i] * c - other * sn);
                        }
                    }
                }
                if (act) { *(u32x4*)ptr = pack8(v); *(u32x4*)(ptr + 8) = pack8(v + 8); }
            }
        }
    }
}

struct AttnArgs { const bf16_t* Q; const bf16_t* K; const bf16_t* V; bf16_t* O; int qs, qh, ks, kh, vs, vh, nheads, gshift, ctx_out; const float* rpb; float sc; };

template <int DK, int DV, int NA>
DI void attn_phase(LAS unsigned char* lds, const AttnArgs a) {
    const int TIDX = otid(); const int BIDX = obid(); (void)TIDX; (void)BIDX;
    constexpr int KROW = DK * 2 + 16, VROW = DV * 2 + 16;
    constexpr int KBUF = 64 * KROW, VBUF = 64 * VROW;
    constexpr int OFFK = 0, OFFV = 2 * KBUF, OFFR = OFFV + 2 * VBUF;
    constexpr int KCH = DK / 8, VCH = DV / 8, NKC = 64 * KCH, NVC = 64 * VCH;
    constexpr int KPT = (NKC + 511) / 512, VPT = (NVC + 511) / 512;
    constexpr int NK0 = DK / 16, NQG = NK0 / 2;
    const int tid = TIDX, wave = __builtin_amdgcn_readfirstlane(tid >> 6), lane = tid & 63, r = lane & 31, hh = lane >> 5;
    const int i16 = lane & 15, tq = i16 >> 2, tp = i16 & 3, blk = (lane >> 4) & 1;
    const int nlat = NB * a.nheads * 8, ntot = nlat + (a.ctx_out ? NB * a.nheads : 0);
    LAS float* rpbL = (LAS float*)(lds + OFFR);
    for (int item = BIDX; item < ntot; item += gridDim.x) {
        int b, h, qb = 0; const bool isctx = item >= nlat;
        if (!isctx) { const int R = item >> 8, u = item & 255; const int qp = (R * 8 + (u & 7)) * 4 + (u >> 6); qb = (u >> 3) & 7; h = qp % a.nheads; b = qp / a.nheads; }
        else { const int bh = item - nlat; h = bh % a.nheads; b = bh / a.nheads; }
        const int hk = h >> a.gshift;
        const size_t rb = (size_t)b * TT;
        const bf16_t* Kb = a.K + hk * a.kh; const bf16_t* Vb = a.V + hk * a.vh;
        int ntiles = isctx ? 4 : 36, rlo = 0, wi = 0, wr0 = 0, c0 = 0;
        if (NA) {
            if (!isctx) { const int i0 = qb * 4; rlo = clampi(i0 - 4, 0, 24); const int rhi = clampi(i0 - 1, 0, 24) + 8; ntiles = 4 + rhi - rlo;
                wi = i0 + (wave >> 1); wr0 = clampi(wi - 4, 0, 24); c0 = (wave & 1) * 32; }
            if (tid < 465) rpbL[64 + tid] = a.rpb[h * 465 + tid] * LOG2E;
        }
        const size_t qrow = rb + (isctx ? 0 : 256 + qb * 256) + wave * 32 + r;
        bf16x8 qf[DK / 16];
#pragma unroll
        for (int k0 = 0; k0 < DK / 16; ++k0) qf[k0] = *(const bf16x8*)(a.Q + qrow * a.qs + h * a.qh + k0 * 16 + hh * 8);
        u32x4 kreg[KPT], vreg[VPT];
#define ATT_TILE_ROW(j) ((NA && (j) >= 4) ? rb + 256 + (size_t)(rlo + (j) - 4) * 64 : rb + (size_t)(j) * 64)
#define ATT_GLOADK(j) do { const size_t _tr = ATT_TILE_ROW(j); \
        _Pragma("unroll") for (int _i = 0; _i < KPT; ++_i) { const int _c = tid + _i * 512; if (_c < NKC) { const int _row = _c / KCH, _cc = _c - _row * KCH; kreg[_i] = *(const u32x4*)(Kb + (_tr + _row) * a.ks + _cc * 8); } } } while (0)
#define ATT_GLOADV(j) do { const size_t _tr = ATT_TILE_ROW(j); \
        _Pragma("unroll") for (int _i = 0; _i < VPT; ++_i) { const int _c = tid + _i * 512; if (_c < NVC) { const int _row = _c / VCH, _cc = _c - _row * VCH; vreg[_i] = *(const u32x4*)(Vb + (_tr + _row) * a.vs + _cc * 8); } } } while (0)
#define ATT_LSTOREK(buf) do { \
        _Pragma("unroll") for (int _i = 0; _i < KPT; ++_i) { const int _c = tid + _i * 512; if (_c < NKC) { const int _row = _c / KCH, _cc = _c - _row * KCH; *(LAS u32x4*)(lds + OFFK + (buf) * KBUF + _row * KROW + _cc * 16) = kreg[_i]; } } } while (0)
#define ATT_LSTOREV(buf) do { \
        _Pragma("unroll") for (int _i = 0; _i < VPT; ++_i) { const int _c = tid + _i * 512; if (_c < NVC) { const int _row = _c / VCH, _cc = _c - _row * VCH; *(LAS u32x4*)(lds + OFFV + (buf) * VBUF + _row * VROW + _cc * 16) = vreg[_i]; } } } while (0)
#define ATT_KFRAG(buf, idx) (*(const LAS bf16x8*)(lds + OFFK + (buf) * KBUF + (((idx) / NK0) * 32 + r) * KROW + ((idx) % NK0) * 32 + hh * 16))
#define ATT_QK(dst, buf) do { \
        _Pragma("unroll") for (int _x = 0; _x < 2 * NK0; ++_x) { const bf16x8 kf = ATT_KFRAG(buf, _x); \
            dst[_x / NK0] = __builtin_amdgcn_mfma_f32_32x32x16_bf16(kf, qf[_x % NK0], (_x % NK0) == 0 ? zero16 : dst[_x / NK0], 0, 0, 0); } } while (0)
#define ATT_ACTIVE(j) (!(NA && (j) >= 4) || ((rlo + (j) - 4 >= wr0) && (rlo + (j) - 4 < wr0 + 8)))
#define ATT_TILE(j, S, SN) do { \
        if ((j) + 2 < ntiles) ATT_GLOADK((j) + 2); \
        if ((j) + 1 < ntiles) ATT_GLOADV((j) + 1); \
        if (ATT_ACTIVE(j)) { \
            const int nb = ((j) + 1) & 1; \
            const LAS unsigned char* Vt = lds + OFFV + ((j) & 1) * VBUF; \
            bf16x8 kfr[2][NQG]; \
            _Pragma("unroll") for (int q = 0; q < NQG; ++q) kfr[0][q] = ATT_KFRAG(nb, q); \
            float mx = m_run; \
            if (NA && (j) >= 4) { \
                const int kr = rlo + (j) - 4; \
                const int ri = kr - wi + 7, qj = c0 + r, cs = clampi(qj - 8, 0, 48); \
                const LAS float* bp = rpbL + 64 + ri * 31 + (4 * hh - qj + 15); \
                const int vb = 4 * hh - cs; \
                _Pragma("unroll") for (int kb = 0; kb < 2; ++kb) \
                    _Pragma("unroll") for (int i = 0; i < 16; ++i) { \
                        const int ci = kb * 32 + (i & 3) + 8 * (i >> 2); \
                        const bool valid = (unsigned)(vb + ci) < 16u; \
                        const float x = valid ? __builtin_fmaf(S[kb][i], a.sc, bp[ci]) : -1e30f; \
                        S[kb][i] = x; mx = fmaxf(mx, x); } \
                mx = fmaxf(mx, __shfl_xor(mx, 32)); \
            } else { \
                float mr = -1e30f; \
                _Pragma("unroll") for (int kb = 0; kb < 2; ++kb) \
                    _Pragma("unroll") for (int i = 0; i < 16; ++i) mr = fmaxf(mr, S[kb][i]); \
                mr = fmaxf(mr, __shfl_xor(mr, 32)); \
                mx = fmaxf(mx, mr * a.sc); \
            } \
            if (__any(mx > m_run + 8.f)) {     \
                const float alpha = fexp2(m_run - mx); \
                lsum *= alpha; \
                _Pragma("unroll") for (int d = 0; d < DV / 32; ++d) \
                    _Pragma("unroll") for (int i = 0; i < 16; ++i) o[d][i] *= alpha; \
                m_run = mx; \
            } \
            mx = m_run; \
            __builtin_amdgcn_sched_barrier(0); \
            _Pragma("unroll") for (int grp = 0; grp < 4; ++grp) { \
                const int kb = grp >> 1, st = grp & 1; \
                if (grp < 3) { _Pragma("unroll") for (int q = 0; q < NQG; ++q) kfr[(grp + 1) & 1][q] = ATT_KFRAG(nb, (grp + 1) * NQG + q); } \
                bf16x8 vf[DV / 32]; \
                _Pragma("unroll") for (int d = 0; d < DV / 32; ++d) { \
                    const LAS unsigned char* ad = Vt + (kb * 32 + 16 * st + 4 * hh + tq) * VROW + (d * 32 + 16 * blk + 4 * tp) * 2; \
                    const s16x4 lo = __builtin_amdgcn_ds_read_tr16_b64_v4i16((LAS s16x4*)ad); \
                    const s16x4 hi = __builtin_amdgcn_ds_read_tr16_b64_v4i16((LAS s16x4*)(ad + 8 * VROW)); \
                    vf[d] = __builtin_shufflevector(lo, hi, 0, 1, 2, 3, 4, 5, 6, 7); } \
                _Pragma("unroll") for (int q = 0; q < NQG; ++q) { const int idx = grp * NQG + q; \
                    SN[idx / NK0] = __builtin_amdgcn_mfma_f32_32x32x16_bf16(kfr[grp & 1][q], qf[idx % NK0], (idx % NK0) == 0 ? zero16 : SN[idx / NK0], 0, 0, 0); } \
                __builtin_amdgcn_sched_barrier(0); \
                float pp[8]; \
                _Pragma("unroll") for (int i = 0; i < 8; ++i) { \
                    pp[i] = (NA && (j) >= 4) ? fexp2(S[kb][8 * st + i] - mx) : fexp2(__builtin_fmaf(S[kb][8 * st + i], a.sc, -mx)); lsum += pp[i]; } \
                const bf16x8 pf = __builtin_bit_cast(bf16x8, pack8(pp)); \
                __builtin_amdgcn_sched_barrier(0); \
                _Pragma("unroll") for (int d = 0; d < DV / 32; ++d) o[d] = __builtin_amdgcn_mfma_f32_32x32x16_bf16(vf[d], pf, o[d], 0, 0, 0); \
                __builtin_amdgcn_sched_barrier(0); \
            } \
        } else { \
            ATT_QK(SN, ((j) + 1) & 1); \
        } \
        if ((j) + 2 < ntiles) ATT_LSTOREK((j) & 1); \
        if ((j) + 1 < ntiles) ATT_LSTOREV(((j) + 1) & 1); \
        __syncthreads(); } while (0)
        ATT_GLOADK(0); ATT_GLOADV(0); ATT_LSTOREK(0); ATT_LSTOREV(0);
        ATT_GLOADK(1); ATT_LSTOREK(1);
        __syncthreads();
        f32x16 o[DV / 32];
#pragma unroll
        for (int d = 0; d < DV / 32; ++d)
#pragma unroll
            for (int i = 0; i < 16; ++i) o[d][i] = 0.f;
        f32x16 zero16;
#pragma unroll
        for (int i = 0; i < 16; ++i) zero16[i] = 0.f;
        float m_run = -1e30f, lsum = 0.f;
        f32x16 s[2], sn[2];
        ATT_QK(s, 0);
        __syncthreads();
        for (int j = 0; j < ntiles; j += 2) {
            ATT_TILE(j, s, sn);
            if (j + 1 < ntiles) ATT_TILE(j + 1, sn, s);
        }
        lsum += __shfl_xor(lsum, 32);
        const float inv = frcp(lsum);
        bf16_t* orow = a.O + (qrow << 10) + h * DV;
#pragma unroll
        for (int d = 0; d < DV / 32; ++d)
#pragma unroll
            for (int g = 0; g < 4; ++g)
                *(u32x2*)(orow + d * 32 + 8 * g + 4 * hh) = (u32x2){pk_bf16(o[d][4 * g] * inv, o[d][4 * g + 1] * inv), pk_bf16(o[d][4 * g + 2] * inv, o[d][4 * g + 3] * inv)};
#undef ATT_TILE_ROW
#undef ATT_GLOADK
#undef ATT_GLOADV
#undef ATT_LSTOREK
#undef ATT_LSTOREV
#undef ATT_KFRAG
#undef ATT_QK
#undef ATT_ACTIVE
#undef ATT_TILE
    }
}

DI void s5_scan_phase(LAS unsigned char* lds, const Params& p, bf16_t* H, bf16_t* YF) {
    const int TIDX = otid(); const int BIDX = obid(); (void)TIDX; (void)BIDX;
    const int wave = __builtin_amdgcn_readfirstlane(TIDX >> 6), lane = TIDX & 63;
    LAS float* BU = (LAS float*)(lds + wave * 12800);
    LAS bf16_t* Hh = (LAS bf16_t*)(lds + wave * 12800 + 8448);
    const int l15 = lane & 15, l4 = lane >> 4;
    for (int item = BIDX * 8 + wave; item < NB * 64; item += gridDim.x * 8) {
        const int g = item & 63, b = item >> 6;
        const float dsk = p.in[I_SD][g * 16 + l15];
        for (int dir = 0; dir < 2; ++dir) {
            const int pg = dir * 64 + g;
            const float dt = __expf(p.in[I_SLDT][pg]);
            const float* are = p.in[I_SARE] + pg * 64; const float* aim = p.in[I_SAIM] + pg * 64;
            float abr, abi;
            { const float ar = are[lane], ai = aim[lane]; const float mag = __expf(dt * ar); abr = mag * __cosf(dt * ai); abi = mag * __sinf(dt * ai); }
            bf16x8 bfr[8], cfr[4];
#pragma unroll
            for (int nt = 0; nt < 8; ++nt) {
                const int st = (nt & 3) * 16 + l15;
                const float ar = are[st], ai = aim[st]; const float mag = __expf(dt * ar);
                const float er = mag * __cosf(dt * ai), ei = mag * __sinf(dt * ai);
                const float den = ar * ar + ai * ai, nr = er - 1.f;
                const float fre = (nr * ar + ei * ai) / den, fim = (ei * ar - nr * ai) / den;
                float bb[8];
#pragma unroll
                for (int j = 0; j < 8; ++j) bb[j] = 0.f;
                if (lane < 32) {
                    const float* br = p.in[I_SBRE] + ((size_t)pg * 64 + st) * 16 + l4 * 8; const float* bi = p.in[I_SBIM] + ((size_t)pg * 64 + st) * 16 + l4 * 8;
#pragma unroll
                    for (int j = 0; j < 8; ++j) bb[j] = (nt < 4) ? (fre * br[j] - fim * bi[j]) : (fre * bi[j] + fim * br[j]);
                }
                bfr[nt] = __builtin_bit_cast(bf16x8, pack8(bb));
            }
#pragma unroll
            for (int kk = 0; kk < 4; ++kk) {
                const int k = (kk & 1) * 32 + l4 * 8;
                const float* cp = (kk < 2 ? p.in[I_SCRE] : p.in[I_SCIM]) + ((size_t)pg * 16 + l15) * 64 + k;
                float cc[8];
#pragma unroll
                for (int j = 0; j < 8; ++j) cc[j] = (kk < 2) ? cp[j] : -cp[j];
                cfr[kk] = __builtin_bit_cast(bf16x8, pack8(cc));
            }
            float hr = 0.f, hi = 0.f;
#define S5_TB(j) (dir ? ((j) < 16 ? 16 * (15 - (j)) : 256 + 16 * (143 - (j))) : 16 * (j))
            bf16x8 ufn = (bf16x8){0, 0, 0, 0, 0, 0, 0, 0};
            if (lane < 32) ufn = *(const bf16x8*)(H + (((size_t)b * TT + S5_TB(0) + l15) << 10) + g * 16 + l4 * 8);
            for (int j = 0; j < 144; ++j) {
                const int tb = S5_TB(j);
                const size_t row0 = (size_t)b * TT + tb;
                const bf16x8 uf = ufn;
                if (lane < 32 && j + 1 < 144) ufn = *(const bf16x8*)(H + (((size_t)b * TT + S5_TB(j + 1) + l15) << 10) + g * 16 + l4 * 8);
                float yfv[4], uv[4];
                if (dir) {
#pragma unroll
                    for (int i = 0; i < 4; ++i) {
                        const size_t o = ((row0 + l4 * 4 + i) << 10) + g * 16 + l15;
                        yfv[i] = __uint_as_float(((unsigned)YF[o]) << 16); uv[i] = __uint_as_float(((unsigned)H[o]) << 16);
                    }
                }
#pragma unroll
                for (int nt = 0; nt < 8; ++nt) {
                    const f32x4 acc = __builtin_amdgcn_mfma_f32_16x16x32_bf16(uf, bfr[nt], (f32x4){0.f, 0.f, 0.f, 0.f}, 0, 0, 0);
#pragma unroll
                    for (int i = 0; i < 4; ++i) BU[(l4 * 4 + i) * 132 + nt * 16 + l15] = acc[i];
                }
                float bur[16], bui[16];
#pragma unroll
                for (int tt = 0; tt < 16; ++tt) { bur[tt] = BU[tt * 132 + lane]; bui[tt] = BU[tt * 132 + 64 + lane]; }
                if (dir) {
#pragma unroll
                    for (int tt = 15; tt >= 0; --tt) {
                        const float nhr = abr * hr - abi * hi + bur[tt], nhi = abr * hi + abi * hr + bui[tt];
                        hr = nhr; hi = nhi;
                        const unsigned pr = pk_bf16(hr, hi);
                        Hh[tt * 136 + lane] = (bf16_t)(pr & 0xffffu); Hh[tt * 136 + 64 + lane] = (bf16_t)(pr >> 16);
                    }
                } else {
#pragma unroll
                    for (int tt = 0; tt < 16; ++tt) {
                        const float nhr = abr * hr - abi * hi + bur[tt], nhi = abr * hi + abi * hr + bui[tt];
                        hr = nhr; hi = nhi;
                        const unsigned pr = pk_bf16(hr, hi);
                        Hh[tt * 136 + lane] = (bf16_t)(pr & 0xffffu); Hh[tt * 136 + 64 + lane] = (bf16_t)(pr >> 16);
                    }
                }
                f32x4 ya = (f32x4){0.f, 0.f, 0.f, 0.f};
#pragma unroll
                for (int kk = 0; kk < 4; ++kk) {
                    const bf16x8 af = *(const LAS bf16x8*)(Hh + l15 * 136 + kk * 32 + l4 * 8);
                    ya = __builtin_amdgcn_mfma_f32_16x16x32_bf16(af, cfr[kk], ya, 0, 0, 0);
                }
                if (dir == 0) {
#pragma unroll
                    for (int i = 0; i < 4; ++i) YF[((row0 + l4 * 4 + i) << 10) + g * 16 + l15] = (bf16_t)(pk_bf16(ya[i], 0.f) & 0xffffu);
                } else {
#pragma unroll
                    for (int i = 0; i < 4; ++i) {
                        const size_t o = ((row0 + l4 * 4 + i) << 10) + g * 16 + l15;
                        const float y = gelu_tanh(dsk * uv[i] + yfv[i] + ya[i]);
                        H[o] = (bf16_t)(pk_bf16(y, 0.f) & 0xffffu);
                    }
                }
            }
        }
    }
}

#define XB_TMO      128
#define XB_XCNT(j)  (256  + 64 * (j))
#define XB_XSUB(j)  (1280 + 64 * (j))
#define XB_XGEN(j)  (2304 + 64 * (j))
#define XB_TOP      3328
#define XB_TOPGEN   3392
#define XCD_BAR_WORDS 3456
#define XB_SPIN_CAP (1u << 18)
DI unsigned xb_ld(unsigned* p)              { return __hip_atomic_load(p, __ATOMIC_RELAXED, __HIP_MEMORY_SCOPE_AGENT); }
DI unsigned xb_add(unsigned* p, unsigned v) { return __hip_atomic_fetch_add(p, v, __ATOMIC_RELAXED, __HIP_MEMORY_SCOPE_AGENT); }
DI unsigned xb_xcc_id() { return (unsigned)__builtin_amdgcn_s_getreg((3 << 11) | 20) & 0xFu; }
#define XB_SPIN(cond, bar) do { unsigned _sp = 0; while (cond) { __builtin_amdgcn_s_sleep(1); \
    if ((++_sp & 255u) == 0u) { if (xb_ld(&(bar)[XB_TMO])) break; if (_sp > XB_SPIN_CAP) { atomicAdd(&(bar)[XB_TMO], 1u); break; } } } } while (0)
struct XcdBarrier { unsigned* bar; unsigned x; volatile LAS unsigned* st; };
DI XcdBarrier xcd_barrier_post(unsigned* bar, volatile LAS unsigned* st) {
    XcdBarrier b; b.bar = bar; b.x = xb_xcc_id(); b.st = st;
    if (threadIdx.x == 0) (void)xb_add(&bar[XB_XCNT(b.x)], 1u);
    return b;
}
DI void xcd_barrier_complete(unsigned* bar, unsigned x, unsigned& nloc, unsigned& nx) {
    const unsigned G = gridDim.x * gridDim.y * gridDim.z;
    unsigned sum, cnt, mine, sp = 0u;
    for (;;) {
        sum = 0u; cnt = 0u; mine = 0u;
#pragma unroll
        for (unsigned j = 0; j < 16; ++j) { const unsigned c = xb_ld(&bar[XB_XCNT(j)]); sum += c; cnt += (c > 0u) ? 1u : 0u; mine = (j == x) ? c : mine; }
        if (sum == G) break;
        __builtin_amdgcn_s_sleep(1);
        if ((++sp & 255u) == 0u) { if (xb_ld(&bar[XB_TMO])) break; if (sp > XB_SPIN_CAP) { atomicAdd(&bar[XB_TMO], 1u); break; } }
    }
    nloc = mine > 0u ? mine : 1u; nx = cnt > 0u ? cnt : 1u;
}
DI void xcd_barrier(const XcdBarrier& b) {
    asm volatile("s_waitcnt vmcnt(0)" ::: "memory");
    __syncthreads();
    if (threadIdx.x == 0) {
        unsigned* bar = b.bar;
        __builtin_amdgcn_s_waitcnt(0);
        unsigned nloc = b.st[0], nx = b.st[1];
        if (nloc == 0u) { xcd_barrier_complete(bar, b.x, nloc, nx); b.st[0] = nloc; b.st[1] = nx; }
        const unsigned old = xb_add(&bar[XB_XSUB(b.x)], 1u);
        const unsigned gen = old / nloc;
        if (old + 1u == (gen + 1u) * nloc) {
            __builtin_amdgcn_fence(__ATOMIC_RELEASE, "agent");
            asm volatile("s_waitcnt vmcnt(0)" ::: "memory");
            const unsigned og = xb_add(&bar[XB_TOP], 1u);
            const unsigned tg = og / nx;
            if (og + 1u == (tg + 1u) * nx) xb_add(&bar[XB_TOPGEN], 1u);
            else XB_SPIN(xb_ld(&bar[XB_TOPGEN]) == tg, bar);
            __builtin_amdgcn_fence(__ATOMIC_ACQUIRE, "agent");
            xb_add(&bar[XB_XGEN(b.x)], 1u);
            asm volatile("s_waitcnt vmcnt(0)" ::: "memory");
        } else {
            XB_SPIN(xb_ld(&bar[XB_XGEN(b.x)]) == gen, bar);
            __builtin_amdgcn_fence(__ATOMIC_ACQUIRE, "agent");
            asm volatile("s_waitcnt vmcnt(0)" ::: "memory");
        }
    }
    __syncthreads();
}

__global__ void __launch_bounds__(512, 2) mega(const Params p) {
    extern __shared__ __attribute__((aligned(16))) unsigned char shm[];
    LAS unsigned char* lds = (LAS unsigned char*)shm;
    cg::grid_group grid = cg::this_grid();
    LAS unsigned* xbst = (LAS unsigned*)(lds + 133120);
    if (threadIdx.x < 4) xbst[threadIdx.x] = 0u;
    __syncthreads();
    const XcdBarrier xb = xcd_barrier_post((unsigned*)(p.ws + OFF_BAR), (volatile LAS unsigned*)xbst);
    unsigned char* ws = p.ws;
    float* ADA = (float*)(ws + OFF_ADA);
    float* XC = (float*)(ws + OFF_XC);
    bf16_t* HB = (bf16_t*)(ws + OFF_HB);
    float* LAT = p.out;
    int pid = 0;
#define PH_BEGIN if (pid >= p.ph_lo && pid < p.ph_hi) {
#define PH_END if (pid + 1 < p.ph_hi) { if (pid == 0) grid.sync(); else xcd_barrier(xb); } } ++pid;

    PH_BEGIN
    {
        phase0(lds, p, ADA, (unsigned*)(ws + OFF_BAR + 14336));
    }
    PH_END

    for (int layer = 0; layer < 4; ++layer) {
        const float* ada = ADA + (size_t)layer * 33 * 6144;
        const int last = layer == 3;
        PH_BEGIN
        norm_phase(layer == 0 ? p.in[I_X] : LAT, layer == 0 ? p.in[I_CTX] : XC, LAT, XC, false, p.in[I_NMIX] + layer * 1024, ada, 0, HB, false);
        PH_END
        if (layer == 0) {
            bf16_t* Z = (bf16_t*)(ws + OFF_Z); bf16_t* KV = (bf16_t*)(ws + OFF_KV); bf16_t* QB = (bf16_t*)(ws + OFF_QB);
            PH_BEGIN
            run_gemm(lds, HB, 1024, (const bf16_t*)(ws + OFF_WMI), 768, 1024, 0, pg8::EpiStore{Z, 768, 0});
            PH_END
            PH_BEGIN
            run_gemm(lds, Z, 768, (const bf16_t*)(ws + OFF_WUQ), 1536, 384, 0, pg8::EpiStore{QB, 1536, 0});
            run_gemm(lds, Z + 384, 768, (const bf16_t*)(ws + OFF_WUKV), 2048, 256, 0, pg8::EpiStore{KV, 2560, 1});
            PH_END
            PH_BEGIN
            mla_r2(QB, KV, Z, p.in[I_MGQN], p.in[I_MGKN]);
            PH_END
            PH_BEGIN
            attn_phase<96, 64, 0>(lds, AttnArgs{QB, KV, KV + 96, HB, 1536, 96, 2560, 160, 2560, 160, 16, 0, 1, nullptr, 0.10206207261596575f * LOG2E});
            PH_END
            PH_BEGIN
            run_gemm(lds, HB, 1024, (const bf16_t*)(ws + OFF_WMO), 1024, 1024, 0, pg8::EpiRes{LAT, XC, ada, 2, p.in[I_X], p.in[I_CTX]});
            PH_END
        } else if (layer == 1) {
            bf16_t* YF = (bf16_t*)(ws + OFF_BIG);
            PH_BEGIN
            s5_scan_phase(lds, p, HB, YF);
            PH_END
            PH_BEGIN
            run_gemm(lds, HB, 1024, (const bf16_t*)(ws + OFF_WGLU), 2048, 1024, 0, pg8::EpiGluRes{LAT, XC, ada, 2});
            PH_END
        } else if (layer == 2) {
            bf16_t* QKV = (bf16_t*)(ws + OFF_BIG);
            PH_BEGIN
            run_gemm(lds, HB, 1024, (const bf16_t*)(ws + OFF_WNQ), 3072, 1024, 0, pg8::EpiStore{QKV, 3072, 0});
            PH_END
            PH_BEGIN
            headnorm_phase<64, 4, 0>(QKV, 3072, 16, 1024, 16, p.in[I_NGQN], p.in[I_NGKN]);
            PH_END
            PH_BEGIN
            attn_phase<64, 64, 1>(lds, AttnArgs{QKV, QKV + 1024, QKV + 2048, HB, 3072, 64, 3072, 64, 3072, 64, 16, 0, 1, p.in[I_NRPB], 0.125f * LOG2E});
            PH_END
            PH_BEGIN
            run_gemm(lds, HB, 1024, (const bf16_t*)(ws + OFF_WNO), 1024, 1024, 0, pg8::EpiRes{LAT, XC, ada, 2, LAT, XC});
            PH_END
        } else {
            bf16_t* QKV = (bf16_t*)(ws + OFF_BIG);
            PH_BEGIN
            run_gemm(lds, HB, 1024, (const bf16_t*)(ws + OFF_WGQ), 1536, 1024, 0, pg8::EpiStore{QKV, 1536, 0});
            PH_END
            PH_BEGIN
            headnorm_phase<128, 8, 1>(QKV, 1536, 8, 1024, 2, p.in[I_GGQN], p.in[I_GGKN]);
            PH_END
            PH_BEGIN
            attn_phase<128, 128, 0>(lds, AttnArgs{QKV, QKV + 1024, QKV + 1280, HB, 1536, 128, 1536, 128, 1536, 128, 8, 2, 0, nullptr, 0.08838834764831845f * LOG2E});
            PH_END
            PH_BEGIN
            run_gemm(lds, HB, 1024, (const bf16_t*)(ws + OFF_WGO), 1024, 1024, 1, pg8::EpiRes{LAT, XC, ada, 2, LAT, XC});
            PH_END
        }
        bf16_t* ACT = (bf16_t*)(ws + OFF_BIG);
        PH_BEGIN
        norm_phase(LAT, XC, LAT, XC, false, p.in[I_NFFN] + layer * 1024, ada, 3, HB, last);
        PH_END
        PH_BEGIN
        run_gemm(lds, HB, 1024, (const bf16_t*)(ws + OFF_WFI + layer * SZ_WFI), 5632, 1024, last, pg8::EpiSwiglu{ACT, FH});
        PH_END
        PH_BEGIN
        run_gemm(lds, ACT, 2816, (const bf16_t*)(ws + OFF_WFO + layer * SZ_WFO), 1024, 2816, last, pg8::EpiRes{LAT, XC, ada, 5, LAT, XC});
        PH_END
    }
}

extern "C" void kernel_launch(void* const* d_in, const int* in_sizes, int n_in, void* d_out, int out_size, void* d_ws, size_t ws_size, hipStream_t stream) {
    static int grid_blocks = 0;
    if (!grid_blocks) {
        hipFuncSetAttribute((const void*)mega, hipFuncAttributeMaxDynamicSharedMemorySize, LDS_BYTES);
        int dev = 0, cus = 0, per_cu = 0;
        hipGetDevice(&dev);
        hipDeviceGetAttribute(&cus, hipDeviceAttributeMultiprocessorCount, dev);
        hipOccupancyMaxActiveBlocksPerMultiprocessor(&per_cu, mega, 512, LDS_BYTES);
        if (per_cu < 1) per_cu = 1;
        grid_blocks = cus * 1;
    }
    if (ws_size < WS_NEED) fprintf(stderr, "workspace too small: %zu < %zu\n", ws_size, (size_t)WS_NEED);
    Params p; memset(&p, 0, sizeof(p));
    for (int i = 0; i < N_IN; ++i) p.in[i] = (const float*)d_in[i];
    p.out = (float*)d_out; p.ws = (unsigned char*)d_ws; p.ph_lo = 0; p.ph_hi = 1000;
    hipMemsetAsync((unsigned char*)d_ws + OFF_BAR, 0, 16384, stream);
    void* args[] = {&p};
    hipError_t e = hipLaunchCooperativeKernel((const void*)mega, dim3(grid_blocks), dim3(512), args, LDS_BYTES, stream);
    if (e != hipSuccess) fprintf(stderr, "cooperative launch failed: %s (grid %d)\n", hipGetErrorString(e), grid_blocks);
}
```

```cpp
#include <hip/hip_runtime.h>
#include <hip/hip_cooperative_groups.h>
#include <cstdio>
#include <cstring>
namespace cg = cooperative_groups;

#define DI __device__ __forceinline__
#define LAS __attribute__((address_space(3)))
typedef unsigned short bf16_t;
typedef short bf16x8 __attribute__((ext_vector_type(8)));
typedef short s16x4 __attribute__((ext_vector_type(4)));
typedef float f32x4 __attribute__((ext_vector_type(4)));
typedef float f32x16 __attribute__((ext_vector_type(16)));
typedef unsigned u32x4 __attribute__((ext_vector_type(4)));
typedef unsigned u32x2 __attribute__((ext_vector_type(2)));
typedef __bf16 bf2_t __attribute__((ext_vector_type(2)));
typedef float f2_t __attribute__((ext_vector_type(2)));

constexpr int NB = 32, SEQ = 2048, CTXL = 256, TT = 2304, NR = NB * TT, DM = 1024, FH = 2816;
constexpr float EPS = 1e-6f, LOG2E = 1.4426950408889634f, L2_10000 = 13.287712379549449f;
constexpr int LDS_BYTES = 133120 + 64;

enum { I_X, I_C, I_CTX, I_CCTX, I_ADAW, I_ADAB, I_NMIX, I_NFFN, I_FWIN, I_FWOUT,
       I_MWIN, I_MGQ, I_MGKV, I_MWUQ, I_MWUKV, I_MGQN, I_MGKN, I_MWO,
       I_SARE, I_SAIM, I_SLDT, I_SBRE, I_SBIM, I_SCRE, I_SCIM, I_SD, I_SWGLU,
       I_NWQKV, I_NGQN, I_NGKN, I_NRPB, I_NWO, I_GWQKV, I_GGQN, I_GGKN, I_GWO, N_IN };

constexpr size_t SZ_WFI = (size_t)5632 * 1024 * 2, SZ_WFO = (size_t)1024 * 2816 * 2;
constexpr size_t OFF_WFI = 0;
constexpr size_t OFF_WFO = OFF_WFI + 4 * SZ_WFI;
constexpr size_t OFF_WMI = OFF_WFO + 4 * SZ_WFO;
constexpr size_t OFF_WUQ = OFF_WMI + (size_t)768 * 1024 * 2;
constexpr size_t OFF_WUKV = OFF_WUQ + (size_t)1536 * 384 * 2;
constexpr size_t OFF_WMO = OFF_WUKV + (size_t)2048 * 256 * 2;
constexpr size_t OFF_WGLU = OFF_WMO + (size_t)1024 * 1024 * 2;
constexpr size_t OFF_WNQ = OFF_WGLU + (size_t)2048 * 1024 * 2;
constexpr size_t OFF_WNO = OFF_WNQ + (size_t)3072 * 1024 * 2;
constexpr size_t OFF_WGQ = OFF_WNO + (size_t)1024 * 1024 * 2;
constexpr size_t OFF_WGO = OFF_WGQ + (size_t)1536 * 1024 * 2;
constexpr size_t OFF_ADA = OFF_WGO + (size_t)1024 * 1024 * 2;
constexpr size_t OFF_XC = OFF_ADA + (size_t)4 * 33 * 6144 * 4;
constexpr size_t OFF_HB = OFF_XC + (size_t)NB * CTXL * 1024 * 4;
constexpr size_t OFF_BIG = OFF_HB + (size_t)NR * 1024 * 2;
constexpr size_t OFF_KV = OFF_BIG;
constexpr size_t OFF_QB = OFF_KV + (size_t)NR * 2560 * 2;
constexpr size_t OFF_Z = OFF_QB + (size_t)NR * 1536 * 2;
constexpr size_t OFF_BAR = OFF_Z + (size_t)NR * 768 * 2;
constexpr size_t WS_NEED = OFF_BAR + 16384;

struct Params {
    const float* in[N_IN];
    float* out;
    unsigned char* ws;
    int ph_lo, ph_hi;
};

DI unsigned pk_bf16(float a, float b) { f2_t v = {a, b}; bf2_t r = __builtin_convertvector(v, bf2_t); return __builtin_bit_cast(unsigned, r); }
DI float bf_lo(unsigned u) { return __uint_as_float(u << 16); }
DI float bf_hi(unsigned u) { return __uint_as_float(u & 0xffff0000u); }
DI float wsum(float v) {
#pragma unroll
    for (int o = 32; o > 0; o >>= 1) v += __shfl_xor(v, o);
    return v;
}
DI int otid() { int t = threadIdx.x; asm volatile("" : "+v"(t)); return t; }
DI int obid() { int b = blockIdx.x; asm volatile("" : "+s"(b)); return b; }
DI int clampi(int v, int lo, int hi) { return v < lo ? lo : (v > hi ? hi : v); }
DI float fexp2(float x) { return __builtin_amdgcn_exp2f(x); }
DI float frcp(float x) { return __builtin_amdgcn_rcpf(x); }
DI float silu_f(float a) { return a * frcp(1.f + __expf(-a)); }
DI float sigmoid_f(float a) { return frcp(1.f + __expf(-a)); }
DI float gelu_tanh(float y) {
    const float z = 0.7978845608028654f * (y + 0.044715f * y * y * y);
    const float t = 1.f - 2.f * frcp(__expf(2.f * z) + 1.f);
    return 0.5f * y * (1.f + t);
}
DI void unpack8(const u32x4 u, float* f) {
#pragma unroll
    for (int i = 0; i < 4; ++i) { f[2 * i] = bf_lo(u[i]); f[2 * i + 1] = bf_hi(u[i]); }
}
DI u32x4 pack8(const float* f) { return (u32x4){pk_bf16(f[0], f[1]), pk_bf16(f[2], f[3]), pk_bf16(f[4], f[5]), pk_bf16(f[6], f[7])}; }

namespace pg8 {
constexpr int BM = 256, BK = 64, HALF = 128, HTB = HALF * BK * 2, NXCD = 8, WGM = 8;
DI int lds_byte(int r, int c) { const int st = (r >> 4) * 2 + (c >> 5), rr = r & 15, cc = c & 31, ob = rr * 64 + cc * 2; return st * 1024 + (ob ^ (((ob >> 9) & 1) << 5)); }
DI void stage_rc(int b, int& R, int& C) { const int st = b / 1024, sb = b % 1024, swz = sb ^ (((sb >> 9) & 1) << 5); R = (st >> 1) * 16 + swz / 64; C = (st & 1) * 32 + (swz % 64) / 2; }
DI int perm32(int rho) { const int n = rho >> 4, i = rho & 15; return 8 * (i >> 2) + 4 * n + (i & 3); }
struct Unit { int pm, pn; };
struct Gemm { const bf16_t* A; const bf16_t* Bt; int M, N, K, lda; };
struct Order {
    int nM, nN, nwg, G, c, skip;
    DI void init(int N, int G_, int c_, int skipctx) { skip = skipctx; nM = skipctx ? 256 : 288; nN = N / BM; nwg = nM * nN; G = G_; c = c_; }
    DI bool next(int i, Unit& u) const {
        const long L = (long)i * G + c; if (L >= nwg) return false;
        int wgid = (int)L; { const int q = nwg / NXCD, r = nwg % NXCD, xcd = wgid % NXCD, off = wgid / NXCD; wgid = (xcd < r ? xcd * (q + 1) : r * (q + 1) + (xcd - r) * q) + off; }
        const int nig = WGM * nN, gid = wgid / nig, fm = gid * WGM, gsz = (nM - fm) < WGM ? (nM - fm) : WGM;
        int pm = fm + ((wgid % nig) % gsz); u.pn = (wgid % nig) / gsz;
        if (skip) pm = pm + (pm >> 3) + 1;
        u.pm = pm; return true;
    }
};

DI float* tile_res_base(float* lat, float* xc, int pm) { const int bb = pm / 9, sub = pm - bb * 9; return sub == 0 ? xc + ((size_t)bb * CTXL << 10) : lat + ((size_t)(bb * SEQ + (sub - 1) * 256) << 10); }
DI int tile_ada_row(int pm) { const int bb = pm / 9, sub = pm - bb * 9; return sub == 0 ? 32 : bb; }

struct EpiStore {
    static constexpr bool PERM = true;
    bf16_t* O; int ldc; int remap;
    DI void operator()(const f32x4 (&acc)[2][2][4][2], const Unit& u, int wr, int wc, int fr, int fq) const {
        const int row0 = u.pm * BM + wr * 64 + fr, col0 = u.pn * BM + wc * 32 + 8 * fq;
#pragma unroll
        for (int ai = 0; ai < 2; ++ai)
#pragma unroll
            for (int m = 0; m < 4; ++m) {
                bf16_t* rowp = O + (size_t)(row0 + ai * HALF + m * 16) * ldc;
#pragma unroll
                for (int bj = 0; bj < 2; ++bj) {
                    const int c = col0 + bj * HALF; const int cc = remap ? (c >> 7) * 160 + (c & 127) : c;
                    const f32x4 v0 = acc[ai][bj][m][0], v1 = acc[ai][bj][m][1];
                    *(u32x4*)(rowp + cc) = (u32x4){pk_bf16(v0[0], v0[1]), pk_bf16(v0[2], v0[3]), pk_bf16(v1[0], v1[1]), pk_bf16(v1[2], v1[3])};
                }
            }
    }
};
struct EpiSwiglu {
    static constexpr bool PERM = true;
    bf16_t* O; int ldc;
    DI void operator()(const f32x4 (&acc)[2][2][4][2], const Unit& u, int wr, int wc, int fr, int fq) const {
        const int row0 = u.pm * BM + wr * 64 + fr, col0 = u.pn * HALF + wc * 32 + 8 * fq;
#pragma unroll
        for (int ai = 0; ai < 2; ++ai)
#pragma unroll
            for (int m = 0; m < 4; ++m) {
                float v[8];
#pragma unroll
                for (int n = 0; n < 2; ++n)
#pragma unroll
                    for (int i = 0; i < 4; ++i) v[n * 4 + i] = silu_f(acc[ai][0][m][n][i]) * acc[ai][1][m][n][i];
                *(u32x4*)(O + (size_t)(row0 + ai * HALF + m * 16) * ldc + col0) = pack8(v);
            }
    }
};
struct EpiGluRes {
    static constexpr bool PERM = true;
    float* lat; float* xc; const float* ada; int gidx;
    DI void operator()(const f32x4 (&acc)[2][2][4][2], const Unit& u, int wr, int wc, int fr, int fq) const {
        float* base = tile_res_base(lat, xc, u.pm);
        const float* gate = ada + (size_t)tile_ada_row(u.pm) * 6144 + gidx * 1024;
        const int col0 = u.pn * HALF + wc * 32 + 8 * fq;
        const f32x4 g0 = *(const f32x4*)(gate + col0), g1 = *(const f32x4*)(gate + col0 + 4);
#pragma unroll
        for (int ai = 0; ai < 2; ++ai)
#pragma unroll
            for (int m = 0; m < 4; ++m) {
                float* rp = base + ((size_t)(ai * HALF + wr * 64 + m * 16 + fr) << 10) + col0;
                f32x4 x0 = *(f32x4*)rp, x1 = *(f32x4*)(rp + 4);
#pragma unroll
                for (int i = 0; i < 4; ++i) {
                    x0[i] += g0[i] * (acc[ai][0][m][0][i] * sigmoid_f(acc[ai][1][m][0][i]));
                    x1[i] += g1[i] * (acc[ai][0][m][1][i] * sigmoid_f(acc[ai][1][m][1][i]));
                }
                *(f32x4*)rp = x0; *(f32x4*)(rp + 4) = x1;
            }
    }
};
struct EpiRes {
    static constexpr bool PERM = false;
    float* lat; float* xc; const float* ada; int gidx; const float* lat_in; const float* xc_in;
    DI void operator()(const f32x4 (&acc)[2][2][4][2], const Unit& u, int wr, int wc, int fr, int fq) const {
        float* base = tile_res_base(lat, xc, u.pm);
        const float* base_in = tile_res_base((float*)lat_in, (float*)xc_in, u.pm);
        const float* gate = ada + (size_t)tile_ada_row(u.pm) * 6144 + gidx * 1024;
        const int col0 = u.pn * BM + wc * 32 + 4 * fq;
        f32x4 gv[2][2];
#pragma unroll
        for (int bj = 0; bj < 2; ++bj)
#pragma unroll
            for (int n = 0; n < 2; ++n) gv[bj][n] = *(const f32x4*)(gate + col0 + bj * HALF + n * 16);
#pragma unroll
        for (int ai = 0; ai < 2; ++ai)
#pragma unroll
            for (int m = 0; m < 4; ++m) {
                float* rp = base + ((size_t)(ai * HALF + wr * 64 + m * 16 + fr) << 10) + col0;
                const float* rpi = base_in + ((size_t)(ai * HALF + wr * 64 + m * 16 + fr) << 10) + col0;
#pragma unroll
                for (int bj = 0; bj < 2; ++bj)
#pragma unroll
                    for (int n = 0; n < 2; ++n) {
                        f32x4 x = *(const f32x4*)(rpi + bj * HALF + n * 16);
                        x += gv[bj][n] * acc[ai][bj][m][n];
                        *(f32x4*)(rp + bj * HALF + n * 16) = x;
                    }
            }
    }
};

template <class Epi>
DI void gemm_phase(LAS unsigned char* lds, const Gemm g, const Order& S, const Epi& E) {
    const int TIDX = otid(); const int BIDX = obid(); (void)TIDX; (void)BIDX;
    const int tid = TIDX, wid = __builtin_amdgcn_readfirstlane(tid >> 6), lane = tid & 63, wr = wid >> 2, wc = wid & 3, fr = lane & 15, fq = lane >> 4;
    const int K = g.K, nt = K / BK;
    unsigned voffA[2], voffB[2];
#pragma unroll
    for (int i = 0; i < 2; ++i) { int R, C; stage_rc(tid * 16 + i * 8192, R, C); const int Rb = Epi::PERM ? ((R & ~31) + perm32(R & 31)) : R;
        voffA[i] = (unsigned)(R * g.lda + C) * 2u; voffB[i] = (unsigned)(Rb * K + C) * 2u; }
    const size_t kstep = (size_t)(BK * 2);
    const size_t hstep = (size_t)HALF * K * 2, hstepA = (size_t)HALF * g.lda * 2;
    const size_t tstep = 2 * hstep, tstepA = 2 * hstepA;
    const unsigned ldsw = (unsigned)wid * 1024u;
    const int aoff = lds_byte(wr * 64 + fr, fq * 8), boff = lds_byte(wc * 32 + fr, fq * 8);
#define PG8_SA(b, h) (((b) * 2 + (h)) * HTB)
#define PG8_SB(b, h) ((4 + (b) * 2 + (h)) * HTB)
#define PG8_STAGE(bufoff, gbase, voff) do { _Pragma("unroll") for (int _i = 0; _i < 2; ++_i) \
        __builtin_amdgcn_global_load_lds((const unsigned*)((const char*)(gbase) + (voff)[_i]), (LAS unsigned*)(lds + (bufoff) + ldsw + _i * 8192), 16, 0, 0); } while (0)
#define PG8_LDA(dst, b, h) do { _Pragma("unroll") for (int m = 0; m < 4; ++m) _Pragma("unroll") for (int k = 0; k < 2; ++k) dst[m][k] = *(const LAS bf16x8*)(lds + PG8_SA(b, h) + aoff + m * 2048 + k * 1024); } while (0)
#define PG8_LDB(dst, b, h) do { _Pragma("unroll") for (int n = 0; n < 2; ++n) _Pragma("unroll") for (int k = 0; k < 2; ++k) dst[n][k] = *(const LAS bf16x8*)(lds + PG8_SB(b, h) + boff + n * 2048 + k * 1024); } while (0)
#define PG8_MMA(ai, bj, At, Bt) do { __builtin_amdgcn_s_setprio(1); _Pragma("unroll") for (int m = 0; m < 4; ++m) _Pragma("unroll") for (int n = 0; n < 2; ++n) _Pragma("unroll") for (int k = 0; k < 2; ++k) \
        acc[ai][bj][m][n] = __builtin_amdgcn_mfma_f32_16x16x32_bf16(Bt[n][k], At[m][k], acc[ai][bj][m][n], 0, 0, 0); __builtin_amdgcn_s_setprio(0); } while (0)
#define PG8_WAIT_V(n) asm volatile("s_waitcnt vmcnt(" #n ")" ::: "memory")
#define PG8_WAIT_L(n) asm volatile("s_waitcnt lgkmcnt(" #n ")" ::: "memory")
#define PG8_BAR __builtin_amdgcn_s_barrier()
#define PG8_SCHED __builtin_amdgcn_sched_barrier(0)
    Unit cur, nxt; int ui = 0;
    if (!S.next(0, cur)) return;
    f32x4 acc[2][2][4][2];
#pragma unroll
    for (int a = 0; a < 2; ++a)
#pragma unroll
        for (int b = 0; b < 2; ++b)
#pragma unroll
            for (int m = 0; m < 4; ++m)
#pragma unroll
                for (int n = 0; n < 2; ++n) acc[a][b][m][n] = (f32x4){0.f, 0.f, 0.f, 0.f};
    bf16x8 At[4][2], B0[2][2], B1[2][2];
    const char* cA = (const char*)g.A + (size_t)cur.pm * tstepA; const char* cB = (const char*)g.Bt + (size_t)cur.pn * tstep;
    PG8_STAGE(PG8_SB(0, 0), cB, voffB); PG8_STAGE(PG8_SA(0, 0), cA, voffA); PG8_STAGE(PG8_SB(0, 1), cB + hstep, voffB); PG8_STAGE(PG8_SA(0, 1), cA + hstepA, voffA);
    if (wr == 1) PG8_BAR;
    PG8_WAIT_V(4); PG8_BAR;
    PG8_STAGE(PG8_SB(1, 0), cB + kstep, voffB); PG8_STAGE(PG8_SA(1, 0), cA + kstep, voffA); PG8_STAGE(PG8_SB(1, 1), cB + hstep + kstep, voffB);
    PG8_WAIT_V(6); PG8_BAR;
    for (;;) {
        const bool has_next = S.next(ui + 1, nxt);
        const char* nA = has_next ? (const char*)g.A + (size_t)nxt.pm * tstepA : cA; const char* nB = has_next ? (const char*)g.Bt + (size_t)nxt.pn * tstep : cB;
        for (int t = 0; t < nt; t += 2) {
            const bool last = (t == nt - 2);
            const char* a1 = cA + (size_t)(t + 1) * kstep;
            const char* a2 = last ? nA : cA + (size_t)(t + 2) * kstep; const char* b2 = last ? nB : cB + (size_t)(t + 2) * kstep;
            const char* a3 = a2 + kstep; const char* b3 = b2 + kstep;
            PG8_LDB(B0, 0, 0); PG8_SCHED; PG8_LDA(At, 0, 0); PG8_STAGE(PG8_SA(1, 1), a1 + hstepA, voffA);
            PG8_WAIT_L(8); PG8_BAR; PG8_WAIT_L(0); PG8_MMA(0, 0, At, B0); PG8_BAR; PG8_SCHED;
            PG8_LDB(B1, 0, 1); PG8_STAGE(PG8_SB(0, 0), b2, voffB);
            PG8_BAR; PG8_WAIT_L(0); PG8_MMA(0, 1, At, B1); PG8_BAR;
            PG8_LDA(At, 0, 1); PG8_STAGE(PG8_SA(0, 0), a2, voffA);
            PG8_BAR; PG8_WAIT_L(0); PG8_MMA(1, 0, At, B0); PG8_BAR; PG8_SCHED;
            PG8_STAGE(PG8_SB(0, 1), b2 + hstep, voffB);
            PG8_WAIT_V(6); PG8_BAR; PG8_MMA(1, 1, At, B1); PG8_BAR;
            PG8_LDB(B0, 1, 0); PG8_SCHED; PG8_LDA(At, 1, 0); PG8_STAGE(PG8_SA(0, 1), a2 + hstepA, voffA);
            PG8_WAIT_L(8); PG8_BAR; PG8_WAIT_L(0); PG8_MMA(0, 0, At, B0); PG8_BAR; PG8_SCHED;
            PG8_LDB(B1, 1, 1); PG8_STAGE(PG8_SB(1, 0), b3, voffB);
            PG8_BAR; PG8_WAIT_L(0); PG8_MMA(0, 1, At, B1); PG8_BAR;
            PG8_LDA(At, 1, 1); PG8_STAGE(PG8_SA(1, 0), a3, voffA);
            PG8_BAR; PG8_WAIT_L(0); PG8_MMA(1, 0, At, B0); PG8_BAR; PG8_SCHED;
            PG8_STAGE(PG8_SB(1, 1), b3 + hstep, voffB);
            PG8_WAIT_V(6); PG8_BAR; PG8_MMA(1, 1, At, B1); PG8_BAR;
        }
        E(acc, cur, wr, wc, fr, fq);
        if (!has_next) break;
#pragma unroll
        for (int a = 0; a < 2; ++a)
#pragma unroll
            for (int b = 0; b < 2; ++b)
#pragma unroll
                for (int m = 0; m < 4; ++m)
#pragma unroll
                    for (int n = 0; n < 2; ++n) acc[a][b][m][n] = (f32x4){0.f, 0.f, 0.f, 0.f};
        cur = nxt; cA = nA; cB = nB; ++ui;
    }
    PG8_WAIT_V(0);
    if (wr == 0) PG8_BAR;
    PG8_BAR;
#undef PG8_SA
#undef PG8_SB
#undef PG8_STAGE
#undef PG8_LDA
#undef PG8_LDB
#undef PG8_MMA
#undef PG8_WAIT_V
#undef PG8_WAIT_L
#undef PG8_BAR
#undef PG8_SCHED
}
}

template <class Epi>
DI void run_gemm(LAS unsigned char* lds, const bf16_t* A, int lda, const bf16_t* Bt, int N, int K, int skipctx, const Epi& E) {
    const int BIDX = obid();
    pg8::Order S; S.init(N, (int)gridDim.x, BIDX, skipctx);
    pg8::Gemm g{A, Bt, NR, N, K, lda};
    pg8::gemm_phase<Epi>(lds, g, S, E);
}

struct WDesc { const float* src; bf16_t* dst; int K, N, Nout, half; const float* kscale; };
DI WDesc wdesc_of(const Params& p, int m) {
    unsigned char* ws = p.ws;
    if (m < 4) return WDesc{p.in[I_FWIN] + (size_t)m * 1024 * 5632, (bf16_t*)(ws + OFF_WFI + m * SZ_WFI), 1024, 5632, 5632, 2816, nullptr};
    if (m < 8) return WDesc{p.in[I_FWOUT] + (size_t)(m - 4) * 2816 * 1024, (bf16_t*)(ws + OFF_WFO + (m - 4) * SZ_WFO), 2816, 1024, 1024, 0, nullptr};
    switch (m) {
        case 8: return WDesc{p.in[I_MWIN], (bf16_t*)(ws + OFF_WMI), 1024, 672, 768, 0, nullptr};
        case 9: return WDesc{p.in[I_MWUQ], (bf16_t*)(ws + OFF_WUQ), 384, 1536, 1536, 0, p.in[I_MGQ]};
        case 10: return WDesc{p.in[I_MWUKV], (bf16_t*)(ws + OFF_WUKV), 256, 2048, 2048, 0, p.in[I_MGKV]};
        case 11: return WDesc{p.in[I_MWO], (bf16_t*)(ws + OFF_WMO), 1024, 1024, 1024, 0, nullptr};
        case 12: return WDesc{p.in[I_SWGLU], (bf16_t*)(ws + OFF_WGLU), 1024, 2048, 2048, 1024, nullptr};
        case 13: return WDesc{p.in[I_NWQKV], (bf16_t*)(ws + OFF_WNQ), 1024, 3072, 3072, 0, nullptr};
        case 14: return WDesc{p.in[I_NWO], (bf16_t*)(ws + OFF_WNO), 1024, 1024, 1024, 0, nullptr};
        case 15: return WDesc{p.in[I_GWQKV], (bf16_t*)(ws + OFF_WGQ), 1024, 1536, 1536, 0, nullptr};
        default: return WDesc{p.in[I_GWO], (bf16_t*)(ws + OFF_WGO), 1024, 1024, 1024, 0, nullptr};
    }
}
DI void prep_tile(LAS float* tile, const WDesc w, int tidx, int lane) {
    const int ntk = w.K / 64;
    const int kt = tidx % ntk, nt = tidx / ntk;
    const int n0 = nt * 64;
    int scol = n0;
    if (w.half) { const int t256 = n0 >> 8, ww = n0 & 255; scol = (ww >= 128 ? w.half : 0) + t256 * 128 + (ww & 127); }
    const int c4 = (lane & 15) * 4;
    f32x4 v[16];
#pragma unroll
    for (int i = 0; i < 16; ++i) {
        const int r = (lane >> 4) + 4 * i;
        v[i] = (f32x4){0.f, 0.f, 0.f, 0.f};
        if (scol + c4 < w.N) v[i] = *(const f32x4*)(w.src + (size_t)(kt * 64 + r) * w.N + scol + c4);
    }
#pragma unroll
    for (int i = 0; i < 16; ++i) {
        const int r = (lane >> 4) + 4 * i;
        f32x4 x = v[i];
        if (w.kscale) x *= w.kscale[kt * 64 + r];
#pragma unroll
        for (int j = 0; j < 4; ++j) tile[r * 65 + c4 + j] = x[j];
    }
    bf16_t* d = w.dst + (size_t)(n0 + lane) * w.K + kt * 64;
#pragma unroll
    for (int q = 0; q < 8; ++q) {
        float f[8];
#pragma unroll
        for (int k = 0; k < 8; ++k) f[k] = tile[(q * 8 + k) * 65 + lane];
        *(u32x4*)(d + q * 8) = pack8(f);
    }
}

DI void ada_item(const Params& p, float* ADA, int item, int lane) {
    const int layer = item / 192, n0 = (item - layer * 192) * 32;
    const int r = lane & 31, kh = lane >> 5;
    const float* W = p.in[I_ADAW] + (size_t)layer * 1024 * 6144 + n0 + r;
    const float* cb = p.in[I_C] + r * 1024 + kh * 8;
    const float* cc = p.in[I_CCTX] + kh * 8;
    f32x16 acc;
#pragma unroll
    for (int i = 0; i < 16; ++i) acc[i] = 0.f;
    float accc = 0.f;
    for (int k0 = 0; k0 < 1024; k0 += 32) {
        float wv[16], cv[16], xv[16];
#pragma unroll
        for (int h2 = 0; h2 < 2; ++h2) {
            const f32x4 c0 = *(const f32x4*)(cb + k0 + h2 * 16), c1 = *(const f32x4*)(cb + k0 + h2 * 16 + 4);
            const f32x4 x0 = *(const f32x4*)(cc + k0 + h2 * 16), x1 = *(const f32x4*)(cc + k0 + h2 * 16 + 4);
#pragma unroll
            for (int u = 0; u < 4; ++u) { cv[h2 * 8 + u] = c0[u]; cv[h2 * 8 + 4 + u] = c1[u]; xv[h2 * 8 + u] = x0[u]; xv[h2 * 8 + 4 + u] = x1[u]; }
#pragma unroll
            for (int u = 0; u < 8; ++u) wv[h2 * 8 + u] = W[(size_t)(k0 + h2 * 16 + kh * 8 + u) * 6144];
        }
#pragma unroll
        for (int u = 0; u < 16; ++u) {
            acc = __builtin_amdgcn_mfma_f32_32x32x2f32(silu_f(cv[u]), wv[u], acc, 0, 0, 0);
            accc += silu_f(xv[u]) * wv[u];
        }
    }
    accc += __shfl_xor(accc, 32);
    const float bias = p.in[I_ADAB][layer * 6144 + n0 + r];
#pragma unroll
    for (int i = 0; i < 16; ++i) {
        const int v = (i & 3) + 8 * (i >> 2) + 4 * kh;
        ADA[((size_t)layer * 33 + v) * 6144 + n0 + r] = acc[i] + bias;
    }
    if (kh == 0) ADA[((size_t)layer * 33 + 32) * 6144 + n0 + r] = accc + bias;
}

DI void phase0(LAS unsigned char* lds, const Params& p, float* ADA, unsigned* counter) {
    const int TIDX = otid();
    const int wave = __builtin_amdgcn_readfirstlane(TIDX >> 6), lane = TIDX & 63;
    LAS float* tile = (LAS float*)(lds + wave * 16640);
    constexpr int NADA = 4 * 192;
    for (;;) {
        int item = 0;
        if (lane == 0) item = (int)atomicAdd(counter, 1u);
        item = __builtin_amdgcn_readfirstlane(item);
        if (item < NADA) { ada_item(p, ADA, item, lane); continue; }
        int t = item - NADA, m = 0;
        bool found = false;
        for (m = 0; m < 17; ++m) {
            const WDesc w = wdesc_of(p, m);
            const int nt = (w.K / 64) * (w.Nout / 64);
            if (t < nt) { prep_tile(tile, w, t, lane); found = true; break; }
            t -= nt;
        }
        if (!found) break;
    }
}

DI void norm_phase(const float* lat_in, const float* ctx_in, float* lat_out, float* ctx_out, bool copy, const float* g,
                   const float* ada, int shidx, bf16_t* H, bool skipctx) {
    const int TIDX = otid(); const int BIDX = obid(); (void)TIDX; (void)BIDX;
    const int wave = TIDX >> 6, lane = TIDX & 63;
    for (int row = BIDX * 8 + wave; row < NR; row += gridDim.x * 8) {
        const int b = row / TT, t = row - b * TT;
        if (skipctx && t < CTXL) continue;
        const size_t ro = t < CTXL ? ((size_t)(b * CTXL + t) << 10) : ((size_t)(b * SEQ + t - CTXL) << 10);
        const float* src = (t < CTXL ? ctx_in : lat_in) + ro;
        const float* sh = ada + (size_t)(t < CTXL ? 32 : b) * 6144 + shidx * 1024;
        const float* sc = sh + 1024;
        f32x4 a[4];
        a[0] = *(const f32x4*)(src + lane * 8); a[1] = *(const f32x4*)(src + lane * 8 + 4);
        a[2] = *(const f32x4*)(src + 512 + lane * 8); a[3] = *(const f32x4*)(src + 512 + lane * 8 + 4);
        float ss = 0.f;
#pragma unroll
        for (int i = 0; i < 4; ++i)
#pragma unroll
            for (int j = 0; j < 4; ++j) ss += a[i][j] * a[i][j];
        ss = wsum(ss);
        const float r = rsqrtf(ss * (1.f / 1024.f) + EPS);
        if (copy) {
            float* dst = (t < CTXL ? ctx_out : lat_out) + ro;
            *(f32x4*)(dst + lane * 8) = a[0]; *(f32x4*)(dst + lane * 8 + 4) = a[1];
            *(f32x4*)(dst + 512 + lane * 8) = a[2]; *(f32x4*)(dst + 512 + lane * 8 + 4) = a[3];
        }
#pragma unroll
        for (int hf = 0; hf < 2; ++hf) {
            const int c0 = hf * 512 + lane * 8;
            float y[8];
#pragma unroll
            for (int q = 0; q < 2; ++q) {
                const f32x4 gv = *(const f32x4*)(g + c0 + q * 4), sv = *(const f32x4*)(sc + c0 + q * 4), hv = *(const f32x4*)(sh + c0 + q * 4);
#pragma unroll
                for (int j = 0; j < 4; ++j) y[q * 4 + j] = a[hf * 2 + q][j] * r * gv[j] * (1.f + sv[j]) + hv[j];
            }
            *(u32x4*)(H + ((size_t)row << 10) + c0) = pack8(y);
        }
    }
}

DI void mla_rope8(float* v, int sub, int s) {
    const float pos = (float)((sub < 2) ? (s >> 6) : (s & 63));
    const bool isx2 = sub & 1;
#pragma unroll
    for (int i = 0; i < 8; ++i) {
        const float other = __shfl_xor(v[i], 1);
        const float ang = pos * fexp2(-(float)i * (L2_10000 / 8.f));
        const float c = __cosf(ang), sn = __sinf(ang);
        v[i] = isx2 ? (other * sn + v[i] * c) : (v[i] * c - other * sn);
    }
}

DI void mla_r2(bf16_t* QB, bf16_t* KV, const bf16_t* Z, const float* gqn, const float* gkn) {
    const int TIDX = otid(); const int BIDX = obid(); (void)TIDX; (void)BIDX;
    const int wave = TIDX >> 6, lane = TIDX & 63, hd = lane >> 2, sub = lane & 3;
    for (int row = BIDX * 8 + wave; row < NR; row += gridDim.x * 8) {
        const int b = row / TT, t = row - b * TT; const bool latent = t >= CTXL; const int s = t - CTXL;
        const bf16_t* z = Z + (size_t)row * 768;
        bf16_t* qp = QB + (size_t)row * 1536 + hd * 96;
        bf16_t* kp = KV + (size_t)row * 2560 + hd * 160;
        unsigned zq[3];
#pragma unroll
        for (int i = 0; i < 3; ++i) zq[i] = *(const unsigned*)(z + lane * 6 + 2 * i);
        const u32x2 zk = *(const u32x2*)(z + 384 + lane * 4);
        const u32x4 q0 = *(const u32x4*)(qp + sub * 16), q1 = *(const u32x4*)(qp + sub * 16 + 8), q2 = *(const u32x4*)(qp + 64 + sub * 8);
        const u32x4 k0 = *(const u32x4*)(kp + sub * 16), k1 = *(const u32x4*)(kp + sub * 16 + 8);
        const u32x4 v0 = *(const u32x4*)(kp + 64 + sub * 16), v1 = *(const u32x4*)(kp + 64 + sub * 16 + 8);
        const u32x4 k2 = *(const u32x4*)(z + 640 + sub * 8);
        asm volatile("s_waitcnt vmcnt(0)" ::: "memory");
        float sq0 = 0.f, sk0 = 0.f;
#pragma unroll
        for (int i = 0; i < 3; ++i) { const float a0 = bf_lo(zq[i]), a1 = bf_hi(zq[i]); sq0 += a0 * a0 + a1 * a1; }
        { const float a0 = bf_lo(zk[0]), a1 = bf_hi(zk[0]), a2 = bf_lo(zk[1]), a3 = bf_hi(zk[1]); sk0 = a0 * a0 + a1 * a1 + a2 * a2 + a3 * a3; }
        sq0 = wsum(sq0); sk0 = wsum(sk0);
        const float rq0 = rsqrtf(sq0 * (1.f / 384.f) + EPS), rk0 = rsqrtf(sk0 * (1.f / 256.f) + EPS);
        float qn[16], qr[8], kn[16], kr[8], vv[16];
        unpack8(q0, qn); unpack8(q1, qn + 8); unpack8(q2, qr);
        unpack8(k0, kn); unpack8(k1, kn + 8); unpack8(k2, kr);
        unpack8(v0, vv); unpack8(v1, vv + 8);
#pragma unroll
        for (int i = 0; i < 16; ++i) { qn[i] *= rq0; kn[i] *= rk0; vv[i] *= rk0; }
#pragma unroll
        for (int i = 0; i < 8; ++i) qr[i] *= rq0;
        float sq = 0.f, sk = 0.f;
#pragma unroll
        for (int i = 0; i < 16; ++i) { sq += qn[i] * qn[i]; sk += kn[i] * kn[i]; }
#pragma unroll
        for (int i = 0; i < 8; ++i) { sq += qr[i] * qr[i]; sk += kr[i] * kr[i]; }
        sq += __shfl_xor(sq, 1); sq += __shfl_xor(sq, 2);
        sk += __shfl_xor(sk, 1); sk += __shfl_xor(sk, 2);
        const float rq = rsqrtf(sq * (1.f / 96.f) + EPS), rk = rsqrtf(sk * (1.f / 96.f) + EPS);
#pragma unroll
        for (int i = 0; i < 16; ++i) { qn[i] *= rq * gqn[sub * 16 + i]; kn[i] *= rk * gkn[sub * 16 + i]; }
#pragma unroll
        for (int i = 0; i < 8; ++i) { qr[i] *= rq * gqn[64 + sub * 8 + i]; kr[i] *= rk * gkn[64 + sub * 8 + i]; }
        if (latent) { mla_rope8(qr, sub, s); mla_rope8(kr, sub, s); }
        *(u32x4*)(qp + sub * 16) = pack8(qn); *(u32x4*)(qp + sub * 16 + 8) = pack8(qn + 8); *(u32x4*)(qp + 64 + sub * 8) = pack8(qr);
        *(u32x4*)(kp + sub * 16) = pack8(kn); *(u32x4*)(kp + sub * 16 + 8) = pack8(kn + 8); *(u32x4*)(kp + 64 + sub * 8) = pack8(kr);
        *(u32x4*)(kp + 96 + sub * 16) = pack8(vv); *(u32x4*)(kp + 96 + sub * 16 + 8) = pack8(vv + 8);
    }
}

template <int HD, int LPH, int ROPE>
DI void headnorm_phase(bf16_t* X, int stride, int nq, int koff, int nk, const float* gq, const float* gk) {
    const int TIDX = otid(); const int BIDX = obid(); (void)TIDX; (void)BIDX;
    const int wave = TIDX >> 6, lane = TIDX & 63, sub = lane % LPH, hl = lane / LPH;
    const int rstep = gridDim.x * 8;
    for (int row = BIDX * 8 + wave; row < NR; row += 2 * rstep) {
        u32x4 u[2][2][2];
#pragma unroll
        for (int rr = 0; rr < 2; ++rr)
#pragma unroll
            for (int pass = 0; pass < 2; ++pass) {
                const int r2 = row + rr * rstep;
                const bool act = (r2 < NR) && (hl < (pass ? nk : nq));
                const bf16_t* ptr = X + (size_t)r2 * stride + (pass ? koff : 0) + hl * HD + sub * 16;
                u[rr][pass][0] = (u32x4){0, 0, 0, 0}; u[rr][pass][1] = (u32x4){0, 0, 0, 0};
                if (act) { u[rr][pass][0] = *(const u32x4*)ptr; u[rr][pass][1] = *(const u32x4*)(ptr + 8); }
            }
        asm volatile("s_waitcnt vmcnt(0)" ::: "memory");
#pragma unroll
        for (int rr = 0; rr < 2; ++rr) {
            const int r2 = row + rr * rstep;
            const int b = r2 / TT, t = r2 - b * TT; const bool latent = t >= CTXL; const int s = t - CTXL;
#pragma unroll
            for (int pass = 0; pass < 2; ++pass) {
                const bool act = (r2 < NR) && (hl < (pass ? nk : nq));
                const float* g = pass ? gk : gq;
                bf16_t* ptr = X + (size_t)r2 * stride + (pass ? koff : 0) + hl * HD + sub * 16;
                float v[16]; unpack8(u[rr][pass][0], v); unpack8(u[rr][pass][1], v + 8);
                float ss = 0.f;
#pragma unroll
                for (int i = 0; i < 16; ++i) ss += v[i] * v[i];
#pragma unroll
                for (int o = 1; o < LPH; o <<= 1) ss += __shfl_xor(ss, o);
                const float rr_ = rsqrtf(ss * (1.f / HD) + EPS);
#pragma unroll
                for (int i = 0; i < 16; ++i) v[i] *= rr_ * g[sub * 16 + i];
                if (ROPE) {
                    if (latent) {
                        const int axis = sub >> 2; const bool isx2 = (sub >> 1) & 1;
                        const float pos = (float)(axis ? (s & 63) : (s >> 6));
#pragma unroll
                        for (int i = 0; i < 16; ++i) {
                            const float other = __shfl_xor(v[i], 2);
                            const int fi = (sub & 1) * 16 + i;
                            const float ang = pos * fexp2(-(float)fi * (L2_10000 / 32.f));
                            const float c = __cosf(ang), sn = __sinf(ang);
                            v[i] = isx2 ? (other * sn + v[i] * c) : (v[i] * c - other * sn);
                        }
                    }
                }
                if (act) { *(u32x4*)ptr = pack8(v); *(u32x4*)(ptr + 8) = pack8(v + 8); }
            }
        }
    }
}

struct AttnArgs { const bf16_t* Q; const bf16_t* K; const bf16_t* V; bf16_t* O; int qs, qh, ks, kh, vs, vh, nheads, gshift, ctx_out; const float* rpb; float sc; };

template <int DK, int DV, int NA>
DI void attn_phase(LAS unsigned char* lds, const AttnArgs a) {
    const int TIDX = otid(); const int BIDX = obid(); (void)TIDX; (void)BIDX;
    constexpr int KROW = DK * 2 + 16, VROW = DV * 2 + 16;
    constexpr int KBUF = 64 * KROW, VBUF = 64 * VROW;
    constexpr int OFFK = 0, OFFV = 2 * KBUF, OFFR = OFFV + 2 * VBUF;
    constexpr int KCH = DK / 8, VCH = DV / 8, NKC = 64 * KCH, NVC = 64 * VCH;
    constexpr int KPT = (NKC + 511) / 512, VPT = (NVC + 511) / 512;
    constexpr int NK0 = DK / 16, NQG = NK0 / 2;
    const int tid = TIDX, wave = __builtin_amdgcn_readfirstlane(tid >> 6), lane = tid & 63, r = lane & 31, hh = lane >> 5;
    const int i16 = lane & 15, tq = i16 >> 2, tp = i16 & 3, blk = (lane >> 4) & 1;
    const int nlat = NB * a.nheads * 8, ntot = nlat + (a.ctx_out ? NB * a.nheads : 0);
    LAS float* rpbL = (LAS float*)(lds + OFFR);
    for (int item = BIDX; item < ntot; item += gridDim.x) {
        int b, h, qb = 0; const bool isctx = item >= nlat;
        if (!isctx) { const int R = item >> 8, u = item & 255; const int qp = (R * 8 + (u & 7)) * 4 + (u >> 6); qb = (u >> 3) & 7; h = qp % a.nheads; b = qp / a.nheads; }
        else { const int bh = item - nlat; h = bh % a.nheads; b = bh / a.nheads; }
        const int hk = h >> a.gshift;
        const size_t rb = (size_t)b * TT;
        const bf16_t* Kb = a.K + hk * a.kh; const bf16_t* Vb = a.V + hk * a.vh;
        int ntiles = isctx ? 4 : 36, rlo = 0, wi = 0, wr0 = 0, c0 = 0;
        if (NA) {
            if (!isctx) { const int i0 = qb * 4; rlo = clampi(i0 - 4, 0, 24); const int rhi = clampi(i0 - 1, 0, 24) + 8; ntiles = 4 + rhi - rlo;
                wi = i0 + (wave >> 1); wr0 = clampi(wi - 4, 0, 24); c0 = (wave & 1) * 32; }
            if (tid < 465) rpbL[64 + tid] = a.rpb[h * 465 + tid] * LOG2E;
        }
        const size_t qrow = rb + (isctx ? 0 : 256 + qb * 256) + wave * 32 + r;
        bf16x8 qf[DK / 16];
#pragma unroll
        for (int k0 = 0; k0 < DK / 16; ++k0) qf[k0] = *(const bf16x8*)(a.Q + qrow * a.qs + h * a.qh + k0 * 16 + hh * 8);
        u32x4 sreg[KPT > VPT ? KPT : VPT];
#define ATT_TILE_ROW(j) ((NA && (j) >= 4) ? rb + 256 + (size_t)(rlo + (j) - 4) * 64 : rb + (size_t)(j) * 64)
#define ATT_GLOADK(j) do { const size_t _tr = ATT_TILE_ROW(j); \
        _Pragma("unroll") for (int _i = 0; _i < KPT; ++_i) { const int _c = tid + _i * 512; if (_c < NKC) { const int _row = _c / KCH, _cc = _c - _row * KCH; sreg[_i] = *(const u32x4*)(Kb + (_tr + _row) * a.ks + _cc * 8); } } } while (0)
#define ATT_GLOADV(j) do { const size_t _tr = ATT_TILE_ROW(j); \
        _Pragma("unroll") for (int _i = 0; _i < VPT; ++_i) { const int _c = tid + _i * 512; if (_c < NVC) { const int _row = _c / VCH, _cc = _c - _row * VCH; sreg[_i] = *(const u32x4*)(Vb + (_tr + _row) * a.vs + _cc * 8); } } } while (0)
#define ATT_LSTOREK(buf) do { \
        _Pragma("unroll") for (int _i = 0; _i < KPT; ++_i) { const int _c = tid + _i * 512; if (_c < NKC) { const int _row = _c / KCH, _cc = _c - _row * KCH; *(LAS u32x4*)(lds + OFFK + (buf) * KBUF + _row * KROW + _cc * 16) = sreg[_i]; } } } while (0)
#define ATT_LSTOREV(buf) do { \
        _Pragma("unroll") for (int _i = 0; _i < VPT; ++_i) { const int _c = tid + _i * 512; if (_c < NVC) { const int _row = _c / VCH, _cc = _c - _row * VCH; *(LAS u32x4*)(lds + OFFV + (buf) * VBUF + _row * VROW + _cc * 16) = sreg[_i]; } } } while (0)
#define ATT_KFRAG(buf, idx) (*(const LAS bf16x8*)(lds + OFFK + (buf) * KBUF + (((idx) / NK0) * 32 + r) * KROW + ((idx) % NK0) * 32 + hh * 16))
#define ATT_QK(dst, buf) do { \
        _Pragma("unroll") for (int _x = 0; _x < 2 * NK0; ++_x) { const bf16x8 kf = ATT_KFRAG(buf, _x); \
            dst[_x / NK0] = __builtin_amdgcn_mfma_f32_32x32x16_bf16(kf, qf[_x % NK0], (_x % NK0) == 0 ? zero16 : dst[_x / NK0], 0, 0, 0); } } while (0)
#define ATT_ACTIVE(j) (!(NA && (j) >= 4) || ((rlo + (j) - 4 >= wr0) && (rlo + (j) - 4 < wr0 + 8)))
#define ATT_TILE(j, S, SN) do { \
        if ((j) + 1 < ntiles) ATT_GLOADV((j) + 1); \
        if (ATT_ACTIVE(j)) { \
            const int nb = ((j) + 1) & 1; \
            const LAS unsigned char* Vt = lds + OFFV + ((j) & 1) * VBUF; \
            bf16x8 kfr[2][NQG]; \
            _Pragma("unroll") for (int q = 0; q < NQG; ++q) kfr[0][q] = ATT_KFRAG(nb, q); \
            float mx = m_run; \
            if (NA && (j) >= 4) { \
                const int kr = rlo + (j) - 4; \
                const int ri = kr - wi + 7, qj = c0 + r, cs = clampi(qj - 8, 0, 48); \
                const LAS float* bp = rpbL + 64 + ri * 31 + (4 * hh - qj + 15); \
                const int vb = 4 * hh - cs; \
                _Pragma("unroll") for (int kb = 0; kb < 2; ++kb) \
                    _Pragma("unroll") for (int i = 0; i < 16; ++i) { \
                        const int ci = kb * 32 + (i & 3) + 8 * (i >> 2); \
                        const bool valid = (unsigned)(vb + ci) < 16u; \
                        const float x = valid ? __builtin_fmaf(S[kb][i], a.sc, bp[ci]) : -1e30f; \
                        S[kb][i] = x; mx = fmaxf(mx, x); } \
                mx = fmaxf(mx, __shfl_xor(mx, 32)); \
            } else { \
                float mr = -1e30f; \
                _Pragma("unroll") for (int kb = 0; kb < 2; ++kb) \
                    _Pragma("unroll") for (int i = 0; i < 16; ++i) mr = fmaxf(mr, S[kb][i]); \
                mr = fmaxf(mr, __shfl_xor(mr, 32)); \
                mx = fmaxf(mx, mr * a.sc); \
            } \
            if (__any(mx > m_run + 8.f)) {     \
                const float alpha = fexp2(m_run - mx); \
                lsum *= alpha; \
                _Pragma("unroll") for (int d = 0; d < DV / 32; ++d) \
                    _Pragma("unroll") for (int i = 0; i < 16; ++i) o[d][i] *= alpha; \
                m_run = mx; \
            } \
            mx = m_run; \
            __builtin_amdgcn_sched_barrier(0); \
            _Pragma("unroll") for (int grp = 0; grp < 4; ++grp) { \
                const int kb = grp >> 1, st = grp & 1; \
                if (grp < 3) { _Pragma("unroll") for (int q = 0; q < NQG; ++q) kfr[(grp + 1) & 1][q] = ATT_KFRAG(nb, (grp + 1) * NQG + q); } \
                bf16x8 vf[DV / 32]; \
                _Pragma("unroll") for (int d = 0; d < DV / 32; ++d) { \
                    const LAS unsigned char* ad = Vt + (kb * 32 + 16 * st + 4 * hh + tq) * VROW + (d * 32 + 16 * blk + 4 * tp) * 2; \
                    const s16x4 lo = __builtin_amdgcn_ds_read_tr16_b64_v4i16((LAS s16x4*)ad); \
                    const s16x4 hi = __builtin_amdgcn_ds_read_tr16_b64_v4i16((LAS s16x4*)(ad + 8 * VROW)); \
                    vf[d] = __builtin_shufflevector(lo, hi, 0, 1, 2, 3, 4, 5, 6, 7); } \
                _Pragma("unroll") for (int q = 0; q < NQG; ++q) { const int idx = grp * NQG + q; \
                    SN[idx / NK0] = __builtin_amdgcn_mfma_f32_32x32x16_bf16(kfr[grp & 1][q], qf[idx % NK0], (idx % NK0) == 0 ? zero16 : SN[idx / NK0], 0, 0, 0); } \
                __builtin_amdgcn_sched_barrier(0); \
                float pp[8]; \
                _Pragma("unroll") for (int i = 0; i < 8; ++i) { \
                    pp[i] = (NA && (j) >= 4) ? fexp2(S[kb][8 * st + i] - mx) : fexp2(__builtin_fmaf(S[kb][8 * st + i], a.sc, -mx)); lsum += pp[i]; } \
                const bf16x8 pf = __builtin_bit_cast(bf16x8, pack8(pp)); \
                __builtin_amdgcn_sched_barrier(0); \
                _Pragma("unroll") for (int d = 0; d < DV / 32; ++d) o[d] = __builtin_amdgcn_mfma_f32_32x32x16_bf16(vf[d], pf, o[d], 0, 0, 0); \
                __builtin_amdgcn_sched_barrier(0); \
                if (grp == 1) { \
                    if ((j) + 1 < ntiles) ATT_LSTOREV(((j) + 1) & 1); \
                    if ((j) + 2 < ntiles) ATT_GLOADK((j) + 2); \
                    __builtin_amdgcn_sched_barrier(0); \
                } \
            } \
        } else { \
            ATT_QK(SN, ((j) + 1) & 1); \
            if ((j) + 1 < ntiles) ATT_LSTOREV(((j) + 1) & 1); \
            if ((j) + 2 < ntiles) ATT_GLOADK((j) + 2); \
        } \
        if ((j) + 2 < ntiles) ATT_LSTOREK((j) & 1); \
        __syncthreads(); } while (0)
        ATT_GLOADK(0); ATT_LSTOREK(0); ATT_GLOADV(0); ATT_LSTOREV(0);
        ATT_GLOADK(1); ATT_LSTOREK(1);
        __syncthreads();
        f32x16 o[DV / 32];
#pragma unroll
        for (int d = 0; d < DV / 32; ++d)
#pragma unroll
            for (int i = 0; i < 16; ++i) o[d][i] = 0.f;
        f32x16 zero16;
#pragma unroll
        for (int i = 0; i < 16; ++i) zero16[i] = 0.f;
        float m_run = -1e30f, lsum = 0.f;
        f32x16 s[2], sn[2];
        ATT_QK(s, 0);
        __syncthreads();
        for (int j = 0; j < ntiles; j += 2) {
            ATT_TILE(j, s, sn);
            if (j + 1 < ntiles) ATT_TILE(j + 1, sn, s);
        }
        lsum += __shfl_xor(lsum, 32);
        const float inv = frcp(lsum);
        bf16_t* orow = a.O + (qrow << 10) + h * DV;
#pragma unroll
        for (int d = 0; d < DV / 32; ++d)
#pragma unroll
            for (int g = 0; g < 4; ++g)
                *(u32x2*)(orow + d * 32 + 8 * g + 4 * hh) = (u32x2){pk_bf16(o[d][4 * g] * inv, o[d][4 * g + 1] * inv), pk_bf16(o[d][4 * g + 2] * inv, o[d][4 * g + 3] * inv)};
#undef ATT_TILE_ROW
#undef ATT_GLOADK
#undef ATT_GLOADV
#undef ATT_LSTOREK
#undef ATT_LSTOREV
#undef ATT_KFRAG
#undef ATT_QK
#undef ATT_ACTIVE
#undef ATT_TILE
    }
}

DI void s5_scan_phase(LAS unsigned char* lds, const Params& p, bf16_t* H, bf16_t* YF) {
    const int TIDX = otid(); const int BIDX = obid(); (void)TIDX; (void)BIDX;
    const int wave = __builtin_amdgcn_readfirstlane(TIDX >> 6), lane = TIDX & 63;
    LAS float* BU = (LAS float*)(lds + wave * 14592);
    LAS bf16_t* Hh = (LAS bf16_t*)(lds + wave * 14592 + 10240);
    const int l15 = lane & 15, l4 = lane >> 4;
    for (int item = BIDX * 8 + wave; item < NB * 64; item += gridDim.x * 8) {
        const int g = item & 63, b = item >> 6;
        const float dsk = p.in[I_SD][g * 16 + l15];
        for (int dir = 0; dir < 2; ++dir) {
            const int pg = dir * 64 + g;
            const float dt = __expf(p.in[I_SLDT][pg]);
            const float* are = p.in[I_SARE] + pg * 64; const float* aim = p.in[I_SAIM] + pg * 64;
            float abr, abi;
            { const float ar = are[lane], ai = aim[lane]; const float mag = __expf(dt * ar); abr = mag * __cosf(dt * ai); abi = mag * __sinf(dt * ai); }
            bf16x8 bfr[8], cfr[4];
#pragma unroll
            for (int nt = 0; nt < 8; ++nt) {
                const int st = (nt & 3) * 16 + l15;
                const float ar = are[st], ai = aim[st]; const float mag = __expf(dt * ar);
                const float er = mag * __cosf(dt * ai), ei = mag * __sinf(dt * ai);
                const float den = ar * ar + ai * ai, nr = er - 1.f;
                const float fre = (nr * ar + ei * ai) / den, fim = (ei * ar - nr * ai) / den;
                float bb[8];
#pragma unroll
                for (int j = 0; j < 8; ++j) bb[j] = 0.f;
                if (lane < 32) {
                    const float* br = p.in[I_SBRE] + ((size_t)pg * 64 + st) * 16 + l4 * 8; const float* bi = p.in[I_SBIM] + ((size_t)pg * 64 + st) * 16 + l4 * 8;
#pragma unroll
                    for (int j = 0; j < 8; ++j) bb[j] = (nt < 4) ? (fre * br[j] - fim * bi[j]) : (fre * bi[j] + fim * br[j]);
                }
                bfr[nt] = __builtin_bit_cast(bf16x8, pack8(bb));
            }
#pragma unroll
            for (int kk = 0; kk < 4; ++kk) {
                const int st0 = kk * 16 + l4 * 4;
                const f32x4 cr4 = *(const f32x4*)(p.in[I_SCRE] + ((size_t)pg * 16 + l15) * 64 + st0);
                const f32x4 ci4 = *(const f32x4*)(p.in[I_SCIM] + ((size_t)pg * 16 + l15) * 64 + st0);
                float cc[8];
#pragma unroll
                for (int j = 0; j < 4; ++j) { cc[2 * j] = cr4[j]; cc[2 * j + 1] = -ci4[j]; }
                cfr[kk] = __builtin_bit_cast(bf16x8, pack8(cc));
            }
            float hr = 0.f, hi = 0.f;
#define S5_TB(j) (dir ? ((j) < 16 ? 16 * (15 - (j)) : 256 + 16 * (143 - (j))) : 16 * (j))
            bf16x8 ufn = (bf16x8){0, 0, 0, 0, 0, 0, 0, 0};
            if (lane < 32) ufn = *(const bf16x8*)(H + (((size_t)b * TT + S5_TB(0) + l15) << 10) + g * 16 + l4 * 8);
            for (int j = 0; j < 144; ++j) {
                const int tb = S5_TB(j);
                const size_t row0 = (size_t)b * TT + tb;
                const bf16x8 uf = ufn;
                if (lane < 32 && j + 1 < 144) ufn = *(const bf16x8*)(H + (((size_t)b * TT + S5_TB(j + 1) + l15) << 10) + g * 16 + l4 * 8);
                float yfv[4], uv[4];
                if (dir) {
#pragma unroll
                    for (int i = 0; i < 4; ++i) {
                        const size_t o = ((row0 + l4 * 4 + i) << 10) + g * 16 + l15;
                        yfv[i] = __uint_as_float(((unsigned)YF[o]) << 16); uv[i] = __uint_as_float(((unsigned)H[o]) << 16);
                    }
                }
#pragma unroll
                for (int nt = 0; nt < 8; ++nt) {
                    const f32x4 acc = __builtin_amdgcn_mfma_f32_16x16x32_bf16(uf, bfr[nt], (f32x4){0.f, 0.f, 0.f, 0.f}, 0, 0, 0);
                    *(LAS f32x4*)(BU + (nt * 16 + l15) * 20 + l4 * 4) = acc;
                }
                float bur[16], bui[16];
#pragma unroll
                for (int q = 0; q < 4; ++q) {
                    const f32x4 r4 = *(const LAS f32x4*)(BU + lane * 20 + q * 4), i4 = *(const LAS f32x4*)(BU + (64 + lane) * 20 + q * 4);
#pragma unroll
                    for (int e = 0; e < 4; ++e) { bur[q * 4 + e] = r4[e]; bui[q * 4 + e] = i4[e]; }
                }
                if (dir) {
#pragma unroll
                    for (int tt = 15; tt >= 0; --tt) {
                        const float nhr = abr * hr - abi * hi + bur[tt], nhi = abr * hi + abi * hr + bui[tt];
                        hr = nhr; hi = nhi;
                        *(LAS unsigned*)(Hh + tt * 136 + 2 * lane) = pk_bf16(hr, hi);
                    }
                } else {
#pragma unroll
                    for (int tt = 0; tt < 16; ++tt) {
                        const float nhr = abr * hr - abi * hi + bur[tt], nhi = abr * hi + abi * hr + bui[tt];
                        hr = nhr; hi = nhi;
                        *(LAS unsigned*)(Hh + tt * 136 + 2 * lane) = pk_bf16(hr, hi);
                    }
                }
                f32x4 ya = (f32x4){0.f, 0.f, 0.f, 0.f};
#pragma unroll
                for (int kk = 0; kk < 4; ++kk) {
                    const bf16x8 af = *(const LAS bf16x8*)(Hh + l15 * 136 + kk * 32 + l4 * 8);
                    ya = __builtin_amdgcn_mfma_f32_16x16x32_bf16(af, cfr[kk], ya, 0, 0, 0);
                }
                if (dir == 0) {
#pragma unroll
                    for (int i = 0; i < 4; ++i) YF[((row0 + l4 * 4 + i) << 10) + g * 16 + l15] = (bf16_t)(pk_bf16(ya[i], 0.f) & 0xffffu);
                } else {
#pragma unroll
                    for (int i = 0; i < 4; ++i) {
                        const size_t o = ((row0 + l4 * 4 + i) << 10) + g * 16 + l15;
                        const float y = gelu_tanh(dsk * uv[i] + yfv[i] + ya[i]);
                        H[o] = (bf16_t)(pk_bf16(y, 0.f) & 0xffffu);
                    }
                }
            }
        }
    }
}

#define XB_TMO      128
#define XB_XCNT(j)  (256  + 64 * (j))
#define XB_XSUB(j)  (1280 + 64 * (j))
#define XB_XGEN(j)  (2304 + 64 * (j))
#define XB_TOP      3328
#define XB_TOPGEN   3392
#define XCD_BAR_WORDS 3456
#define XB_SPIN_CAP (1u << 18)
DI unsigned xb_ld(unsigned* p)              { return __hip_atomic_load(p, __ATOMIC_RELAXED, __HIP_MEMORY_SCOPE_AGENT); }
DI unsigned xb_add(unsigned* p, unsigned v) { return __hip_atomic_fetch_add(p, v, __ATOMIC_RELAXED, __HIP_MEMORY_SCOPE_AGENT); }
DI unsigned xb_xcc_id() { return (unsigned)__builtin_amdgcn_s_getreg((3 << 11) | 20) & 0xFu; }
#define XB_SPIN(cond, bar) do { unsigned _sp = 0; while (cond) { __builtin_amdgcn_s_sleep(1); \
    if ((++_sp & 255u) == 0u) { if (xb_ld(&(bar)[XB_TMO])) break; if (_sp > XB_SPIN_CAP) { atomicAdd(&(bar)[XB_TMO], 1u); break; } } } } while (0)
struct XcdBarrier { unsigned* bar; unsigned x; volatile LAS unsigned* st; };
DI XcdBarrier xcd_barrier_post(unsigned* bar, volatile LAS unsigned* st) {
    XcdBarrier b; b.bar = bar; b.x = xb_xcc_id(); b.st = st;
    if (threadIdx.x == 0) (void)xb_add(&bar[XB_XCNT(b.x)], 1u);
    return b;
}
DI void xcd_barrier_complete(unsigned* bar, unsigned x, unsigned& nloc, unsigned& nx) {
    const unsigned G = gridDim.x * gridDim.y * gridDim.z;
    unsigned sum, cnt, mine, sp = 0u;
    for (;;) {
        sum = 0u; cnt = 0u; mine = 0u;
#pragma unroll
        for (unsigned j = 0; j < 16; ++j) { const unsigned c = xb_ld(&bar[XB_XCNT(j)]); sum += c; cnt += (c > 0u) ? 1u : 0u; mine = (j == x) ? c : mine; }
        if (sum == G) break;
        __builtin_amdgcn_s_sleep(1);
        if ((++sp & 255u) == 0u) { if (xb_ld(&bar[XB_TMO])) break; if (sp > XB_SPIN_CAP) { atomicAdd(&bar[XB_TMO], 1u); break; } }
    }
    nloc = mine > 0u ? mine : 1u; nx = cnt > 0u ? cnt : 1u;
}
DI void xcd_barrier(const XcdBarrier& b) {
    asm volatile("s_waitcnt vmcnt(0)" ::: "memory");
    __syncthreads();
    if (threadIdx.x == 0) {
        unsigned* bar = b.bar;
        __builtin_amdgcn_s_waitcnt(0);
        unsigned nloc = b.st[0], nx = b.st[1];
        if (nloc == 0u) { xcd_barrier_complete(bar, b.x, nloc, nx); b.st[0] = nloc; b.st[1] = nx; }
        const unsigned old = xb_add(&bar[XB_XSUB(b.x)], 1u);
        const unsigned gen = old / nloc;
        if (old + 1u == (gen + 1u) * nloc) {
            __builtin_amdgcn_fence(__ATOMIC_RELEASE, "agent");
            asm volatile("s_waitcnt vmcnt(0)" ::: "memory");
            const unsigned og = xb_add(&bar[XB_TOP], 1u);
            const unsigned tg = og / nx;
            if (og + 1u == (tg + 1u) * nx) xb_add(&bar[XB_TOPGEN], 1u);
            else XB_SPIN(xb_ld(&bar[XB_TOPGEN]) == tg, bar);
            __builtin_amdgcn_fence(__ATOMIC_ACQUIRE, "agent");
            xb_add(&bar[XB_XGEN(b.x)], 1u);
            asm volatile("s_waitcnt vmcnt(0)" ::: "memory");
        } else {
            XB_SPIN(xb_ld(&bar[XB_XGEN(b.x)]) == gen, bar);
            __builtin_amdgcn_fence(__ATOMIC_ACQUIRE, "agent");
            asm volatile("s_waitcnt vmcnt(0)" ::: "memory");
        }
    }
    __syncthreads();
}

__global__ void __launch_bounds__(512, 2) mega(const Params p) {
    extern __shared__ __attribute__((aligned(16))) unsigned char shm[];
    LAS unsigned char* lds = (LAS unsigned char*)shm;
    cg::grid_group grid = cg::this_grid();
    LAS unsigned* xbst = (LAS unsigned*)(lds + 133120);
    if (threadIdx.x < 4) xbst[threadIdx.x] = 0u;
    __syncthreads();
    const XcdBarrier xb = xcd_barrier_post((unsigned*)(p.ws + OFF_BAR), (volatile LAS unsigned*)xbst);
    unsigned char* ws = p.ws;
    float* ADA = (float*)(ws + OFF_ADA);
    float* XC = (float*)(ws + OFF_XC);
    bf16_t* HB = (bf16_t*)(ws + OFF_HB);
    float* LAT = p.out;
    int pid = 0;
#define PH_BEGIN if (pid >= p.ph_lo && pid < p.ph_hi) {
#define PH_END if (pid + 1 < p.ph_hi) { if (pid == 0) grid.sync(); else xcd_barrier(xb); } } ++pid;

    PH_BEGIN
    {
        phase0(lds, p, ADA, (unsigned*)(ws + OFF_BAR + 14336));
    }
    PH_END

    for (int layer = 0; layer < 4; ++layer) {
        const float* ada = ADA + (size_t)layer * 33 * 6144;
        const int last = layer == 3;
        PH_BEGIN
        norm_phase(layer == 0 ? p.in[I_X] : LAT, layer == 0 ? p.in[I_CTX] : XC, LAT, XC, false, p.in[I_NMIX] + layer * 1024, ada, 0, HB, false);
        PH_END
        if (layer == 0) {
            bf16_t* Z = (bf16_t*)(ws + OFF_Z); bf16_t* KV = (bf16_t*)(ws + OFF_KV); bf16_t* QB = (bf16_t*)(ws + OFF_QB);
            PH_BEGIN
            run_gemm(lds, HB, 1024, (const bf16_t*)(ws + OFF_WMI), 768, 1024, 0, pg8::EpiStore{Z, 768, 0});
            PH_END
            PH_BEGIN
            run_gemm(lds, Z, 768, (const bf16_t*)(ws + OFF_WUQ), 1536, 384, 0, pg8::EpiStore{QB, 1536, 0});
            run_gemm(lds, Z + 384, 768, (const bf16_t*)(ws + OFF_WUKV), 2048, 256, 0, pg8::EpiStore{KV, 2560, 1});
            PH_END
            PH_BEGIN
            mla_r2(QB, KV, Z, p.in[I_MGQN], p.in[I_MGKN]);
            PH_END
            PH_BEGIN
            attn_phase<96, 64, 0>(lds, AttnArgs{QB, KV, KV + 96, HB, 1536, 96, 2560, 160, 2560, 160, 16, 0, 1, nullptr, 0.10206207261596575f * LOG2E});
            PH_END
            PH_BEGIN
            run_gemm(lds, HB, 1024, (const bf16_t*)(ws + OFF_WMO), 1024, 1024, 0, pg8::EpiRes{LAT, XC, ada, 2, p.in[I_X], p.in[I_CTX]});
            PH_END
        } else if (layer == 1) {
            bf16_t* YF = (bf16_t*)(ws + OFF_BIG);
            PH_BEGIN
            s5_scan_phase(lds, p, HB, YF);
            PH_END
            PH_BEGIN
            run_gemm(lds, HB, 1024, (const bf16_t*)(ws + OFF_WGLU), 2048, 1024, 0, pg8::EpiGluRes{LAT, XC, ada, 2});
            PH_END
        } else if (layer == 2) {
            bf16_t* QKV = (bf16_t*)(ws + OFF_BIG);
            PH_BEGIN
            run_gemm(lds, HB, 1024, (const bf16_t*)(ws + OFF_WNQ), 3072, 1024, 0, pg8::EpiStore{QKV, 3072, 0});
            PH_END
            PH_BEGIN
            headnorm_phase<64, 4, 0>(QKV, 3072, 16, 1024, 16, p.in[I_NGQN], p.in[I_NGKN]);
            PH_END
            PH_BEGIN
            attn_phase<64, 64, 1>(lds, AttnArgs{QKV, QKV + 1024, QKV + 2048, HB, 3072, 64, 3072, 64, 3072, 64, 16, 0, 1, p.in[I_NRPB], 0.125f * LOG2E});
            PH_END
            PH_BEGIN
            run_gemm(lds, HB, 1024, (const bf16_t*)(ws + OFF_WNO), 1024, 1024, 0, pg8::EpiRes{LAT, XC, ada, 2, LAT, XC});
            PH_END
        } else {
            bf16_t* QKV = (bf16_t*)(ws + OFF_BIG);
            PH_BEGIN
            run_gemm(lds, HB, 1024, (const bf16_t*)(ws + OFF_WGQ), 1536, 1024, 0, pg8::EpiStore{QKV, 1536, 0});
            PH_END
            PH_BEGIN
            headnorm_phase<128, 8, 1>(QKV, 1536, 8, 1024, 2, p.in[I_GGQN], p.in[I_GGKN]);
            PH_END
            PH_BEGIN
            attn_phase<128, 128, 0>(lds, AttnArgs{QKV, QKV + 1024, QKV + 1280, HB, 1536, 128, 1536, 128, 1536, 128, 8, 2, 0, nullptr, 0.08838834764831845f * LOG2E});
            PH_END
            PH_BEGIN
            run_gemm(lds, HB, 1024, (const bf16_t*)(ws + OFF_WGO), 1024, 1024, 1, pg8::EpiRes{LAT, XC, ada, 2, LAT, XC});
            PH_END
        }
        bf16_t* ACT = (bf16_t*)(ws + OFF_BIG);
        PH_BEGIN
        norm_phase(LAT, XC, LAT, XC, false, p.in[I_NFFN] + layer * 1024, ada, 3, HB, last);
        PH_END
        PH_BEGIN
        run_gemm(lds, HB, 1024, (const bf16_t*)(ws + OFF_WFI + layer * SZ_WFI), 5632, 1024, last, pg8::EpiSwiglu{ACT, FH});
        PH_END
        PH_BEGIN
        run_gemm(lds, ACT, 2816, (const bf16_t*)(ws + OFF_WFO + layer * SZ_WFO), 1024, 2816, last, pg8::EpiRes{LAT, XC, ada, 5, LAT, XC});
        PH_END
    }
}

extern "C" void kernel_launch(void* const* d_in, const int* in_sizes, int n_in, void* d_out, int out_size, void* d_ws, size_t ws_size, hipStream_t stream) {
    static int grid_blocks = 0;
    if (!grid_blocks) {
        hipFuncSetAttribute((const void*)mega, hipFuncAttributeMaxDynamicSharedMemorySize, LDS_BYTES);
        int dev = 0, cus = 0, per_cu = 0;
        hipGetDevice(&dev);
        hipDeviceGetAttribute(&cus, hipDeviceAttributeMultiprocessorCount, dev);
        hipOccupancyMaxActiveBlocksPerMultiprocessor(&per_cu, mega, 512, LDS_BYTES);
        if (per_cu < 1) per_cu = 1;
        grid_blocks = cus * 1;
    }
    if (ws_size < WS_NEED) fprintf(stderr, "workspace too small: %zu < %zu\n", ws_size, (size_t)WS_NEED);
    Params p; memset(&p, 0, sizeof(p));
    for (int i = 0; i < N_IN; ++i) p.in[i] = (const float*)d_in[i];
    p.out = (float*)d_out; p.ws = (unsigned char*)d_ws; p.ph_lo = 0; p.ph_hi = 1000;
    hipMemsetAsync((unsigned char*)d_ws + OFF_BAR, 0, 16384, stream);
    void* args[] = {&p};
    hipError_t e = hipLaunchCooperativeKernel((const void*)mega, dim3(grid_blocks), dim3(512), args, LDS_BYTES, stream);
    if (e != hipSuccess) fprintf(stderr, "cooperative launch failed: %s (grid %d)\n", hipGetErrorString(e), grid_blocks);
}
```

```cpp
#include <hip/hip_runtime.h>
#include <hip/hip_cooperative_groups.h>
#include <cstdio>
#include <cstring>
namespace cg = cooperative_groups;

#define DI __device__ __forceinline__
#define LAS __attribute__((address_space(3)))
typedef unsigned short bf16_t;
typedef short bf16x8 __attribute__((ext_vector_type(8)));
typedef short s16x4 __attribute__((ext_vector_type(4)));
typedef float f32x4 __attribute__((ext_vector_type(4)));
typedef float f32x16 __attribute__((ext_vector_type(16)));
typedef unsigned u32x4 __attribute__((ext_vector_type(4)));
typedef unsigned u32x2 __attribute__((ext_vector_type(2)));
typedef __bf16 bf2_t __attribute__((ext_vector_type(2)));
typedef float f2_t __attribute__((ext_vector_type(2)));

constexpr int NB = 32, SEQ = 2048, CTXL = 256, TT = 2304, NR = NB * TT, DM = 1024, FH = 2816;
constexpr float EPS = 1e-6f, LOG2E = 1.4426950408889634f, L2_10000 = 13.287712379549449f;
constexpr int LDS_BYTES = 133120 + 64 + 8192;

enum { I_X, I_C, I_CTX, I_CCTX, I_ADAW, I_ADAB, I_NMIX, I_NFFN, I_FWIN, I_FWOUT,
       I_MWIN, I_MGQ, I_MGKV, I_MWUQ, I_MWUKV, I_MGQN, I_MGKN, I_MWO,
       I_SARE, I_SAIM, I_SLDT, I_SBRE, I_SBIM, I_SCRE, I_SCIM, I_SD, I_SWGLU,
       I_NWQKV, I_NGQN, I_NGKN, I_NRPB, I_NWO, I_GWQKV, I_GGQN, I_GGKN, I_GWO, N_IN };

constexpr size_t SZ_WFI = (size_t)5632 * 1024 * 2, SZ_WFO = (size_t)1024 * 2816 * 2;
constexpr size_t OFF_WFI = 0;
constexpr size_t OFF_WFO = OFF_WFI + 4 * SZ_WFI;
constexpr size_t OFF_WMI = OFF_WFO + 4 * SZ_WFO;
constexpr size_t OFF_WUQ = OFF_WMI + (size_t)768 * 1024 * 2;
constexpr size_t OFF_WUKV = OFF_WUQ + (size_t)1536 * 384 * 2;
constexpr size_t OFF_WMO = OFF_WUKV + (size_t)2048 * 256 * 2;
constexpr size_t OFF_WGLU = OFF_WMO + (size_t)1024 * 1024 * 2;
constexpr size_t OFF_WNQ = OFF_WGLU + (size_t)2048 * 1024 * 2;
constexpr size_t OFF_WNO = OFF_WNQ + (size_t)3072 * 1024 * 2;
constexpr size_t OFF_WGQ = OFF_WNO + (size_t)1024 * 1024 * 2;
constexpr size_t OFF_WGO = OFF_WGQ + (size_t)1536 * 1024 * 2;
constexpr size_t OFF_ADA = OFF_WGO + (size_t)1024 * 1024 * 2;
constexpr size_t OFF_XC = OFF_ADA + (size_t)4 * 33 * 6144 * 4;
constexpr size_t OFF_HB = OFF_XC + (size_t)NB * CTXL * 1024 * 4;
constexpr size_t OFF_BIG = OFF_HB + (size_t)NR * 1024 * 2;
constexpr size_t OFF_KV = OFF_BIG;
constexpr size_t OFF_QB = OFF_KV + (size_t)NR * 2560 * 2;
constexpr size_t OFF_Z = OFF_QB + (size_t)NR * 1536 * 2;
constexpr size_t OFF_BAR = OFF_Z + (size_t)NR * 768 * 2;
constexpr size_t WS_NEED = OFF_BAR + 16384;

struct Params {
    const float* in[N_IN];
    float* out;
    unsigned char* ws;
    int ph_lo, ph_hi;
};

DI unsigned pk_bf16(float a, float b) { f2_t v = {a, b}; bf2_t r = __builtin_convertvector(v, bf2_t); return __builtin_bit_cast(unsigned, r); }
DI float bf_lo(unsigned u) { return __uint_as_float(u << 16); }
DI float bf_hi(unsigned u) { return __uint_as_float(u & 0xffff0000u); }
DI float wsum(float v) {
#pragma unroll
    for (int o = 32; o > 0; o >>= 1) v += __shfl_xor(v, o);
    return v;
}
DI int otid() { int t = threadIdx.x; asm volatile("" : "+v"(t)); return t; }
DI int obid() { int b = blockIdx.x; asm volatile("" : "+s"(b)); return b; }
DI int gqa_dim_of_pos(int pos) { return (pos >> 6) * 64 + ((pos & 63) >> 1) + 32 * (pos & 1); }
DI int clampi(int v, int lo, int hi) { return v < lo ? lo : (v > hi ? hi : v); }
DI float fexp2(float x) { return __builtin_amdgcn_exp2f(x); }
DI float frcp(float x) { return __builtin_amdgcn_rcpf(x); }
DI float silu_f(float a) { return a * frcp(1.f + __expf(-a)); }
DI float sigmoid_f(float a) { return frcp(1.f + __expf(-a)); }
DI float gelu_tanh(float y) {
    const float z = 0.7978845608028654f * (y + 0.044715f * y * y * y);
    const float t = 1.f - 2.f * frcp(__expf(2.f * z) + 1.f);
    return 0.5f * y * (1.f + t);
}
DI void unpack8(const u32x4 u, float* f) {
#pragma unroll
    for (int i = 0; i < 4; ++i) { f[2 * i] = bf_lo(u[i]); f[2 * i + 1] = bf_hi(u[i]); }
}
DI u32x4 pack8(const float* f) { return (u32x4){pk_bf16(f[0], f[1]), pk_bf16(f[2], f[3]), pk_bf16(f[4], f[5]), pk_bf16(f[6], f[7])}; }

namespace pg8 {
constexpr int BM = 256, BK = 64, HALF = 128, HTB = HALF * BK * 2, NXCD = 8, WGM = 8;
DI int lds_byte(int r, int c) { const int st = (r >> 4) * 2 + (c >> 5), rr = r & 15, cc = c & 31, ob = rr * 64 + cc * 2; return st * 1024 + (ob ^ (((ob >> 9) & 1) << 5)); }
DI void stage_rc(int b, int& R, int& C) { const int st = b / 1024, sb = b % 1024, swz = sb ^ (((sb >> 9) & 1) << 5); R = (st >> 1) * 16 + swz / 64; C = (st & 1) * 32 + (swz % 64) / 2; }
DI int perm32(int rho) { const int n = rho >> 4, i = rho & 15; return 8 * (i >> 2) + 4 * n + (i & 3); }
struct Unit { int pm, pn; };
struct Gemm { const bf16_t* A; const bf16_t* Bt; int M, N, K, lda; };
struct Order {
    int nM, nN, nwg, G, c, skip;
    DI void init(int N, int G_, int c_, int skipctx) { skip = skipctx; nM = skipctx ? 256 : 288; nN = N / BM; nwg = nM * nN; G = G_; c = c_; }
    DI bool next(int i, Unit& u) const {
        const long L = (long)i * G + c; if (L >= nwg) return false;
        int wgid = (int)L; { const int q = nwg / NXCD, r = nwg % NXCD, xcd = wgid % NXCD, off = wgid / NXCD; wgid = (xcd < r ? xcd * (q + 1) : r * (q + 1) + (xcd - r) * q) + off; }
        const int nig = WGM * nN, gid = wgid / nig, fm = gid * WGM, gsz = (nM - fm) < WGM ? (nM - fm) : WGM;
        int pm = fm + ((wgid % nig) % gsz); u.pn = (wgid % nig) / gsz;
        if (skip) pm = pm + (pm >> 3) + 1;
        u.pm = pm; return true;
    }
};

DI float* tile_res_base(float* lat, float* xc, int pm) { const int bb = pm / 9, sub = pm - bb * 9; return sub == 0 ? xc + ((size_t)bb * CTXL << 10) : lat + ((size_t)(bb * SEQ + (sub - 1) * 256) << 10); }
DI int tile_ada_row(int pm) { const int bb = pm / 9, sub = pm - bb * 9; return sub == 0 ? 32 : bb; }

struct EpiStore {
    static constexpr bool PERM = true;
    bf16_t* O; int ldc; int remap;
    DI void operator()(const f32x4 (&acc)[2][2][4][2], const Unit& u, int wr, int wc, int fr, int fq) const {
        const int row0 = u.pm * BM + wr * 64 + fr, col0 = u.pn * BM + wc * 32 + 8 * fq;
#pragma unroll
        for (int ai = 0; ai < 2; ++ai)
#pragma unroll
            for (int m = 0; m < 4; ++m) {
                bf16_t* rowp = O + (size_t)(row0 + ai * HALF + m * 16) * ldc;
#pragma unroll
                for (int bj = 0; bj < 2; ++bj) {
                    const int c = col0 + bj * HALF; const int cc = remap ? (c >> 7) * 160 + (c & 127) : c;
                    const f32x4 v0 = acc[ai][bj][m][0], v1 = acc[ai][bj][m][1];
                    *(u32x4*)(rowp + cc) = (u32x4){pk_bf16(v0[0], v0[1]), pk_bf16(v0[2], v0[3]), pk_bf16(v1[0], v1[1]), pk_bf16(v1[2], v1[3])};
                }
            }
    }
};
struct EpiStoreHN64 {
    static constexpr bool PERM = true;
    bf16_t* O; int ldc; const float* gq; const float* gk; LAS float* X;
    DI void operator()(const f32x4 (&acc)[2][2][4][2], const Unit& u, int wr, int wc, int fr, int fq) const {
        const int wid = wr * 4 + wc;
        const int kind = u.pn < 4 ? 0 : (u.pn < 8 ? 1 : 2);
        float part[2][2][4];
#pragma unroll
        for (int ai = 0; ai < 2; ++ai)
#pragma unroll
            for (int bj = 0; bj < 2; ++bj)
#pragma unroll
                for (int m = 0; m < 4; ++m) {
                    float ss = 0.f;
#pragma unroll
                    for (int n = 0; n < 2; ++n)
#pragma unroll
                        for (int i = 0; i < 4; ++i) ss += acc[ai][bj][m][n][i] * acc[ai][bj][m][n][i];
                    ss += __shfl_xor(ss, 16); ss += __shfl_xor(ss, 32);
                    part[ai][bj][m] = ss;
                    if (fq == 0) X[(wid * 16 + ai * 8 + bj * 4 + m) * 16 + fr] = ss;
                }
        asm volatile("s_waitcnt lgkmcnt(0)" ::: "memory");
        __builtin_amdgcn_s_barrier();
        asm volatile("" ::: "memory");
        const float* g = kind == 0 ? gq : gk;
        const int gc0 = 32 * (wc & 1) + 8 * fq;
        float gv[8];
#pragma unroll
        for (int i = 0; i < 8; ++i) gv[i] = g[gc0 + i];
        const int row0 = u.pm * BM + wr * 64 + fr, col0 = u.pn * BM + wc * 32 + 8 * fq;
#pragma unroll
        for (int ai = 0; ai < 2; ++ai)
#pragma unroll
            for (int m = 0; m < 4; ++m) {
                bf16_t* rowp = O + (size_t)(row0 + ai * HALF + m * 16) * ldc;
#pragma unroll
                for (int bj = 0; bj < 2; ++bj) {
                    const float tot = part[ai][bj][m] + X[((wid ^ 1) * 16 + ai * 8 + bj * 4 + m) * 16 + fr];
                    const float r = rsqrtf(tot * (1.f / 64.f) + EPS);
                    float v[8];
#pragma unroll
                    for (int n = 0; n < 2; ++n)
#pragma unroll
                        for (int i = 0; i < 4; ++i) v[n * 4 + i] = kind == 2 ? acc[ai][bj][m][n][i] : acc[ai][bj][m][n][i] * r * gv[n * 4 + i];
                    *(u32x4*)(rowp + col0 + bj * HALF) = pack8(v);
                }
            }
    }
};
struct EpiStoreHN128 {
    static constexpr bool PERM = true;
    bf16_t* O; int ldc; const float* gq; const float* gk; LAS float* X;
    DI void operator()(const f32x4 (&acc)[2][2][4][2], const Unit& u, int wr, int wc, int fr, int fq) const {
        const int wid = wr * 4 + wc;
        const int kind = u.pn < 4 ? 0 : (u.pn < 5 ? 1 : 2);
        float part[2][2][4];
#pragma unroll
        for (int ai = 0; ai < 2; ++ai)
#pragma unroll
            for (int bj = 0; bj < 2; ++bj)
#pragma unroll
                for (int m = 0; m < 4; ++m) {
                    float ss = 0.f;
#pragma unroll
                    for (int n = 0; n < 2; ++n)
#pragma unroll
                        for (int i = 0; i < 4; ++i) ss += acc[ai][bj][m][n][i] * acc[ai][bj][m][n][i];
                    ss += __shfl_xor(ss, 16); ss += __shfl_xor(ss, 32);
                    part[ai][bj][m] = ss;
                    if (fq == 0) X[(wid * 16 + ai * 8 + bj * 4 + m) * 16 + fr] = ss;
                }
        asm volatile("s_waitcnt lgkmcnt(0)" ::: "memory");
        __builtin_amdgcn_s_barrier();
        asm volatile("" ::: "memory");
        const float* g = kind == 0 ? gq : gk;
        const int pos0 = 32 * wc + 8 * fq;
        float gv[8];
#pragma unroll
        for (int i = 0; i < 8; ++i) gv[i] = g[gqa_dim_of_pos(pos0 + i)];
        const int axis = wc >> 1, f0 = 16 * (wc & 1) + 4 * fq;
        float invf[4];
#pragma unroll
        for (int j = 0; j < 4; ++j) invf[j] = fexp2(-(float)(f0 + j) * (L2_10000 / 32.f));
        const int bb = u.pm / 9, sub = u.pm - bb * 9;
        const bool latent = sub != 0;
        const int row0 = u.pm * BM + wr * 64 + fr, col0 = u.pn * BM + wc * 32 + 8 * fq;
        const int wb = wr * 4;
#pragma unroll
        for (int ai = 0; ai < 2; ++ai)
#pragma unroll
            for (int m = 0; m < 4; ++m) {
                bf16_t* rowp = O + (size_t)(row0 + ai * HALF + m * 16) * ldc;
                const int sidx = (sub - 1) * 256 + ai * HALF + wr * 64 + m * 16 + fr;
                const float posv = (float)(axis ? (sidx & 63) : (sidx >> 6));
                float cs[4], sn[4];
#pragma unroll
                for (int j = 0; j < 4; ++j) { const float ang = posv * invf[j]; cs[j] = __cosf(ang); sn[j] = __sinf(ang); }
#pragma unroll
                for (int bj = 0; bj < 2; ++bj) {
                    const int cb = ai * 8 + bj * 4 + m;
                    const float tot = X[((wb + 0) * 16 + cb) * 16 + fr] + X[((wb + 1) * 16 + cb) * 16 + fr] + X[((wb + 2) * 16 + cb) * 16 + fr] + X[((wb + 3) * 16 + cb) * 16 + fr];
                    const float r = rsqrtf(tot * (1.f / 128.f) + EPS);
                    float v[8];
#pragma unroll
                    for (int n = 0; n < 2; ++n)
#pragma unroll
                        for (int i = 0; i < 4; ++i) v[n * 4 + i] = kind == 2 ? acc[ai][bj][m][n][i] : acc[ai][bj][m][n][i] * r * gv[n * 4 + i];
                    if (kind != 2 && latent) {
#pragma unroll
                        for (int j = 0; j < 4; ++j) { const float x1 = v[2 * j], x2 = v[2 * j + 1]; v[2 * j] = x1 * cs[j] - x2 * sn[j]; v[2 * j + 1] = x1 * sn[j] + x2 * cs[j]; }
                    }
                    *(u32x4*)(rowp + col0 + bj * HALF) = pack8(v);
                }
            }
    }
};
struct EpiSwiglu {
    static constexpr bool PERM = true;
    bf16_t* O; int ldc;
    DI void operator()(const f32x4 (&acc)[2][2][4][2], const Unit& u, int wr, int wc, int fr, int fq) const {
        const int row0 = u.pm * BM + wr * 64 + fr, col0 = u.pn * HALF + wc * 32 + 8 * fq;
#pragma unroll
        for (int ai = 0; ai < 2; ++ai)
#pragma unroll
            for (int m = 0; m < 4; ++m) {
                float v[8];
#pragma unroll
                for (int n = 0; n < 2; ++n)
#pragma unroll
                    for (int i = 0; i < 4; ++i) v[n * 4 + i] = silu_f(acc[ai][0][m][n][i]) * acc[ai][1][m][n][i];
                *(u32x4*)(O + (size_t)(row0 + ai * HALF + m * 16) * ldc + col0) = pack8(v);
            }
    }
};
struct EpiGluRes {
    static constexpr bool PERM = true;
    float* lat; float* xc; const float* ada; int gidx;
    DI void operator()(const f32x4 (&acc)[2][2][4][2], const Unit& u, int wr, int wc, int fr, int fq) const {
        float* base = tile_res_base(lat, xc, u.pm);
        const float* gate = ada + (size_t)tile_ada_row(u.pm) * 6144 + gidx * 1024;
        const int col0 = u.pn * HALF + wc * 32 + 8 * fq;
        const f32x4 g0 = *(const f32x4*)(gate + col0), g1 = *(const f32x4*)(gate + col0 + 4);
#pragma unroll
        for (int ai = 0; ai < 2; ++ai)
#pragma unroll
            for (int m = 0; m < 4; ++m) {
                float* rp = base + ((size_t)(ai * HALF + wr * 64 + m * 16 + fr) << 10) + col0;
                f32x4 x0 = *(f32x4*)rp, x1 = *(f32x4*)(rp + 4);
#pragma unroll
                for (int i = 0; i < 4; ++i) {
                    x0[i] += g0[i] * (acc[ai][0][m][0][i] * sigmoid_f(acc[ai][1][m][0][i]));
                    x1[i] += g1[i] * (acc[ai][0][m][1][i] * sigmoid_f(acc[ai][1][m][1][i]));
                }
                *(f32x4*)rp = x0; *(f32x4*)(rp + 4) = x1;
            }
    }
};
struct EpiRes {
    static constexpr bool PERM = false;
    float* lat; float* xc; const float* ada; int gidx; const float* lat_in; const float* xc_in;
    DI void operator()(const f32x4 (&acc)[2][2][4][2], const Unit& u, int wr, int wc, int fr, int fq) const {
        float* base = tile_res_base(lat, xc, u.pm);
        const float* base_in = tile_res_base((float*)lat_in, (float*)xc_in, u.pm);
        const float* gate = ada + (size_t)tile_ada_row(u.pm) * 6144 + gidx * 1024;
        const int col0 = u.pn * BM + wc * 32 + 4 * fq;
        f32x4 gv[2][2];
#pragma unroll
        for (int bj = 0; bj < 2; ++bj)
#pragma unroll
            for (int n = 0; n < 2; ++n) gv[bj][n] = *(const f32x4*)(gate + col0 + bj * HALF + n * 16);
#pragma unroll
        for (int ai = 0; ai < 2; ++ai)
#pragma unroll
            for (int m = 0; m < 4; ++m) {
                float* rp = base + ((size_t)(ai * HALF + wr * 64 + m * 16 + fr) << 10) + col0;
                const float* rpi = base_in + ((size_t)(ai * HALF + wr * 64 + m * 16 + fr) << 10) + col0;
#pragma unroll
                for (int bj = 0; bj < 2; ++bj)
#pragma unroll
                    for (int n = 0; n < 2; ++n) {
                        f32x4 x = *(const f32x4*)(rpi + bj * HALF + n * 16);
                        x += gv[bj][n] * acc[ai][bj][m][n];
                        *(f32x4*)(rp + bj * HALF + n * 16) = x;
                    }
            }
    }
};

template <class Epi>
DI void gemm_phase(LAS unsigned char* lds, const Gemm g, const Order& S, const Epi& E) {
    const int TIDX = otid(); const int BIDX = obid(); (void)TIDX; (void)BIDX;
    const int tid = TIDX, wid = __builtin_amdgcn_readfirstlane(tid >> 6), lane = tid & 63, wr = wid >> 2, wc = wid & 3, fr = lane & 15, fq = lane >> 4;
    const int K = g.K, nt = K / BK;
    unsigned voffA[2], voffB[2];
#pragma unroll
    for (int i = 0; i < 2; ++i) { int R, C; stage_rc(tid * 16 + i * 8192, R, C); const int Rb = Epi::PERM ? ((R & ~31) + perm32(R & 31)) : R;
        voffA[i] = (unsigned)(R * g.lda + C) * 2u; voffB[i] = (unsigned)(Rb * K + C) * 2u; }
    const size_t kstep = (size_t)(BK * 2);
    const size_t hstep = (size_t)HALF * K * 2, hstepA = (size_t)HALF * g.lda * 2;
    const size_t tstep = 2 * hstep, tstepA = 2 * hstepA;
    const unsigned ldsw = (unsigned)wid * 1024u;
    const int aoff = lds_byte(wr * 64 + fr, fq * 8), boff = lds_byte(wc * 32 + fr, fq * 8);
#define PG8_SA(b, h) (((b) * 2 + (h)) * HTB)
#define PG8_SB(b, h) ((4 + (b) * 2 + (h)) * HTB)
#define PG8_STAGE(bufoff, gbase, voff) do { _Pragma("unroll") for (int _i = 0; _i < 2; ++_i) \
        __builtin_amdgcn_global_load_lds((const unsigned*)((const char*)(gbase) + (voff)[_i]), (LAS unsigned*)(lds + (bufoff) + ldsw + _i * 8192), 16, 0, 0); } while (0)
#define PG8_LDA(dst, b, h) do { _Pragma("unroll") for (int m = 0; m < 4; ++m) _Pragma("unroll") for (int k = 0; k < 2; ++k) dst[m][k] = *(const LAS bf16x8*)(lds + PG8_SA(b, h) + aoff + m * 2048 + k * 1024); } while (0)
#define PG8_LDB(dst, b, h) do { _Pragma("unroll") for (int n = 0; n < 2; ++n) _Pragma("unroll") for (int k = 0; k < 2; ++k) dst[n][k] = *(const LAS bf16x8*)(lds + PG8_SB(b, h) + boff + n * 2048 + k * 1024); } while (0)
#define PG8_MMA(ai, bj, At, Bt) do { __builtin_amdgcn_s_setprio(1); _Pragma("unroll") for (int m = 0; m < 4; ++m) _Pragma("unroll") for (int n = 0; n < 2; ++n) _Pragma("unroll") for (int k = 0; k < 2; ++k) \
        acc[ai][bj][m][n] = __builtin_amdgcn_mfma_f32_16x16x32_bf16(Bt[n][k], At[m][k], acc[ai][bj][m][n], 0, 0, 0); __builtin_amdgcn_s_setprio(0); } while (0)
#define PG8_WAIT_V(n) asm volatile("s_waitcnt vmcnt(" #n ")" ::: "memory")
#define PG8_WAIT_L(n) asm volatile("s_waitcnt lgkmcnt(" #n ")" ::: "memory")
#define PG8_BAR __builtin_amdgcn_s_barrier()
#define PG8_SCHED __builtin_amdgcn_sched_barrier(0)
    Unit cur, nxt; int ui = 0;
    if (!S.next(0, cur)) return;
    f32x4 acc[2][2][4][2];
#pragma unroll
    for (int a = 0; a < 2; ++a)
#pragma unroll
        for (int b = 0; b < 2; ++b)
#pragma unroll
            for (int m = 0; m < 4; ++m)
#pragma unroll
                for (int n = 0; n < 2; ++n) acc[a][b][m][n] = (f32x4){0.f, 0.f, 0.f, 0.f};
    bf16x8 At[4][2], B0[2][2], B1[2][2];
    const char* cA = (const char*)g.A + (size_t)cur.pm * tstepA; const char* cB = (const char*)g.Bt + (size_t)cur.pn * tstep;
    PG8_STAGE(PG8_SB(0, 0), cB, voffB); PG8_STAGE(PG8_SA(0, 0), cA, voffA); PG8_STAGE(PG8_SB(0, 1), cB + hstep, voffB); PG8_STAGE(PG8_SA(0, 1), cA + hstepA, voffA);
    if (wr == 1) PG8_BAR;
    PG8_WAIT_V(4); PG8_BAR;
    PG8_STAGE(PG8_SB(1, 0), cB + kstep, voffB); PG8_STAGE(PG8_SA(1, 0), cA + kstep, voffA); PG8_STAGE(PG8_SB(1, 1), cB + hstep + kstep, voffB);
    PG8_WAIT_V(6); PG8_BAR;
    for (;;) {
        const bool has_next = S.next(ui + 1, nxt);
        const char* nA = has_next ? (const char*)g.A + (size_t)nxt.pm * tstepA : cA; const char* nB = has_next ? (const char*)g.Bt + (size_t)nxt.pn * tstep : cB;
        for (int t = 0; t < nt; t += 2) {
            const bool last = (t == nt - 2);
            const char* a1 = cA + (size_t)(t + 1) * kstep;
            const char* a2 = last ? nA : cA + (size_t)(t + 2) * kstep; const char* b2 = last ? nB : cB + (size_t)(t + 2) * kstep;
            const char* a3 = a2 + kstep; const char* b3 = b2 + kstep;
            PG8_LDB(B0, 0, 0); PG8_SCHED; PG8_LDA(At, 0, 0); PG8_STAGE(PG8_SA(1, 1), a1 + hstepA, voffA);
            PG8_WAIT_L(8); PG8_BAR; PG8_WAIT_L(0); PG8_MMA(0, 0, At, B0); PG8_BAR; PG8_SCHED;
            PG8_LDB(B1, 0, 1); PG8_STAGE(PG8_SB(0, 0), b2, voffB);
            PG8_BAR; PG8_WAIT_L(0); PG8_MMA(0, 1, At, B1); PG8_BAR;
            PG8_LDA(At, 0, 1); PG8_STAGE(PG8_SA(0, 0), a2, voffA);
            PG8_BAR; PG8_WAIT_L(0); PG8_MMA(1, 0, At, B0); PG8_BAR; PG8_SCHED;
            PG8_STAGE(PG8_SB(0, 1), b2 + hstep, voffB);
            PG8_WAIT_V(6); PG8_BAR; PG8_MMA(1, 1, At, B1); PG8_BAR;
            PG8_LDB(B0, 1, 0); PG8_SCHED; PG8_LDA(At, 1, 0); PG8_STAGE(PG8_SA(0, 1), a2 + hstepA, voffA);
            PG8_WAIT_L(8); PG8_BAR; PG8_WAIT_L(0); PG8_MMA(0, 0, At, B0); PG8_BAR; PG8_SCHED;
            PG8_LDB(B1, 1, 1); PG8_STAGE(PG8_SB(1, 0), b3, voffB);
            PG8_BAR; PG8_WAIT_L(0); PG8_MMA(0, 1, At, B1); PG8_BAR;
            PG8_LDA(At, 1, 1); PG8_STAGE(PG8_SA(1, 0), a3, voffA);
            PG8_BAR; PG8_WAIT_L(0); PG8_MMA(1, 0, At, B0); PG8_BAR; PG8_SCHED;
            PG8_STAGE(PG8_SB(1, 1), b3 + hstep, voffB);
            PG8_WAIT_V(6); PG8_BAR; PG8_MMA(1, 1, At, B1); PG8_BAR;
        }
        E(acc, cur, wr, wc, fr, fq);
        if (!has_next) break;
#pragma unroll
        for (int a = 0; a < 2; ++a)
#pragma unroll
            for (int b = 0; b < 2; ++b)
#pragma unroll
                for (int m = 0; m < 4; ++m)
#pragma unroll
                    for (int n = 0; n < 2; ++n) acc[a][b][m][n] = (f32x4){0.f, 0.f, 0.f, 0.f};
        cur = nxt; cA = nA; cB = nB; ++ui;
    }
    PG8_WAIT_V(0);
    if (wr == 0) PG8_BAR;
    PG8_BAR;
#undef PG8_SA
#undef PG8_SB
#undef PG8_STAGE
#undef PG8_LDA
#undef PG8_LDB
#undef PG8_MMA
#undef PG8_WAIT_V
#undef PG8_WAIT_L
#undef PG8_BAR
#undef PG8_SCHED
}
}

template <class Epi>
DI void run_gemm(LAS unsigned char* lds, const bf16_t* A, int lda, const bf16_t* Bt, int N, int K, int skipctx, const Epi& E) {
    const int BIDX = obid();
    pg8::Order S; S.init(N, (int)gridDim.x, BIDX, skipctx);
    pg8::Gemm g{A, Bt, NR, N, K, lda};
    pg8::gemm_phase<Epi>(lds, g, S, E);
}

struct WDesc { const float* src; bf16_t* dst; int K, N, Nout, half; const float* kscale; int perm; };

DI WDesc wdesc_of(const Params& p, int m) {
    unsigned char* ws = p.ws;
    if (m < 4) return WDesc{p.in[I_FWIN] + (size_t)m * 1024 * 5632, (bf16_t*)(ws + OFF_WFI + m * SZ_WFI), 1024, 5632, 5632, 2816, nullptr, 0};
    if (m < 8) return WDesc{p.in[I_FWOUT] + (size_t)(m - 4) * 2816 * 1024, (bf16_t*)(ws + OFF_WFO + (m - 4) * SZ_WFO), 2816, 1024, 1024, 0, nullptr, 0};
    switch (m) {
        case 8: return WDesc{p.in[I_MWIN], (bf16_t*)(ws + OFF_WMI), 1024, 672, 768, 0, nullptr, 0};
        case 9: return WDesc{p.in[I_MWUQ], (bf16_t*)(ws + OFF_WUQ), 384, 1536, 1536, 0, p.in[I_MGQ], 0};
        case 10: return WDesc{p.in[I_MWUKV], (bf16_t*)(ws + OFF_WUKV), 256, 2048, 2048, 0, p.in[I_MGKV], 0};
        case 11: return WDesc{p.in[I_MWO], (bf16_t*)(ws + OFF_WMO), 1024, 1024, 1024, 0, nullptr, 0};
        case 12: return WDesc{p.in[I_SWGLU], (bf16_t*)(ws + OFF_WGLU), 1024, 2048, 2048, 1024, nullptr, 0};
        case 13: return WDesc{p.in[I_NWQKV], (bf16_t*)(ws + OFF_WNQ), 1024, 3072, 3072, 0, nullptr, 0};
        case 14: return WDesc{p.in[I_NWO], (bf16_t*)(ws + OFF_WNO), 1024, 1024, 1024, 0, nullptr, 0};
        case 15: return WDesc{p.in[I_GWQKV], (bf16_t*)(ws + OFF_WGQ), 1024, 1536, 1536, 0, nullptr, 1};
        default: return WDesc{p.in[I_GWO], (bf16_t*)(ws + OFF_WGO), 1024, 1024, 1024, 0, nullptr, 0};
    }
}
DI void prep_tile(LAS float* tile, const WDesc w, int tidx, int lane) {
    const int ntk = w.K / 64;
    const int kt = tidx % ntk, nt = tidx / ntk;
    const int n0 = nt * 64;
    int scol = n0;
    if (w.half) { const int t256 = n0 >> 8, ww = n0 & 255; scol = (ww >= 128 ? w.half : 0) + t256 * 128 + (ww & 127); }
    const int c4 = (lane & 15) * 4;
    f32x4 v[16];
#pragma unroll
    for (int i = 0; i < 16; ++i) {
        const int r = (lane >> 4) + 4 * i;
        v[i] = (f32x4){0.f, 0.f, 0.f, 0.f};
        if (w.perm && n0 < 1280) {
            const float* rp = w.src + (size_t)(kt * 64 + r) * w.N + (n0 & ~127);
#pragma unroll
            for (int j = 0; j < 4; ++j) v[i][j] = rp[gqa_dim_of_pos((n0 & 127) + c4 + j)];
        } else if (scol + c4 < w.N) v[i] = *(const f32x4*)(w.src + (size_t)(kt * 64 + r) * w.N + scol + c4);
    }
#pragma unroll
    for (int i = 0; i < 16; ++i) {
        const int r = (lane >> 4) + 4 * i;
        f32x4 x = v[i];
        if (w.kscale) x *= w.kscale[kt * 64 + r];
#pragma unroll
        for (int j = 0; j < 4; ++j) tile[r * 65 + c4 + j] = x[j];
    }
    bf16_t* d = w.dst + (size_t)(n0 + lane) * w.K + kt * 64;
#pragma unroll
    for (int q = 0; q < 8; ++q) {
        float f[8];
#pragma unroll
        for (int k = 0; k < 8; ++k) f[k] = tile[(q * 8 + k) * 65 + lane];
        *(u32x4*)(d + q * 8) = pack8(f);
    }
}

DI void ada_item(const Params& p, float* ADA, int item, int lane) {
    const int layer = item / 192, n0 = (item - layer * 192) * 32;
    const int r = lane & 31, kh = lane >> 5;
    const float* W = p.in[I_ADAW] + (size_t)layer * 1024 * 6144 + n0 + r;
    const float* cb = p.in[I_C] + r * 1024 + kh * 8;
    const float* cc = p.in[I_CCTX] + kh * 8;
    f32x16 acc;
#pragma unroll
    for (int i = 0; i < 16; ++i) acc[i] = 0.f;
    float accc = 0.f;
    for (int k0 = 0; k0 < 1024; k0 += 32) {
        float wv[16], cv[16], xv[16];
#pragma unroll
        for (int h2 = 0; h2 < 2; ++h2) {
            const f32x4 c0 = *(const f32x4*)(cb + k0 + h2 * 16), c1 = *(const f32x4*)(cb + k0 + h2 * 16 + 4);
            const f32x4 x0 = *(const f32x4*)(cc + k0 + h2 * 16), x1 = *(const f32x4*)(cc + k0 + h2 * 16 + 4);
#pragma unroll
            for (int u = 0; u < 4; ++u) { cv[h2 * 8 + u] = c0[u]; cv[h2 * 8 + 4 + u] = c1[u]; xv[h2 * 8 + u] = x0[u]; xv[h2 * 8 + 4 + u] = x1[u]; }
#pragma unroll
            for (int u = 0; u < 8; ++u) wv[h2 * 8 + u] = W[(size_t)(k0 + h2 * 16 + kh * 8 + u) * 6144];
        }
#pragma unroll
        for (int u = 0; u < 16; ++u) {
            acc = __builtin_amdgcn_mfma_f32_32x32x2f32(silu_f(cv[u]), wv[u], acc, 0, 0, 0);
            accc += silu_f(xv[u]) * wv[u];
        }
    }
    accc += __shfl_xor(accc, 32);
    const float bias = p.in[I_ADAB][layer * 6144 + n0 + r];
#pragma unroll
    for (int i = 0; i < 16; ++i) {
        const int v = (i & 3) + 8 * (i >> 2) + 4 * kh;
        ADA[((size_t)layer * 33 + v) * 6144 + n0 + r] = acc[i] + bias;
    }
    if (kh == 0) ADA[((size_t)layer * 33 + 32) * 6144 + n0 + r] = accc + bias;
}

DI void phase0(LAS unsigned char* lds, const Params& p, float* ADA, unsigned* counter) {
    const int TIDX = otid();
    const int wave = __builtin_amdgcn_readfirstlane(TIDX >> 6), lane = TIDX & 63;
    LAS float* tile = (LAS float*)(lds + wave * 16640);
    constexpr int NADA = 4 * 192;
    for (;;) {
        int item = 0;
        if (lane == 0) item = (int)atomicAdd(counter, 1u);
        item = __builtin_amdgcn_readfirstlane(item);
        if (item < NADA) { ada_item(p, ADA, item, lane); continue; }
        int t = item - NADA, m = 0;
        bool found = false;
        for (m = 0; m < 17; ++m) {
            const WDesc w = wdesc_of(p, m);
            const int nt = (w.K / 64) * (w.Nout / 64);
            if (t < nt) { prep_tile(tile, w, t, lane); found = true; break; }
            t -= nt;
        }
        if (!found) break;
    }
}

DI void norm_phase(const float* lat_in, const float* ctx_in, float* lat_out, float* ctx_out, bool copy, const float* g,
                   const float* ada, int shidx, bf16_t* H, bool skipctx) {
    const int TIDX = otid(); const int BIDX = obid(); (void)TIDX; (void)BIDX;
    const int wave = TIDX >> 6, lane = TIDX & 63;
    for (int row = BIDX * 8 + wave; row < NR; row += gridDim.x * 8) {
        const int b = row / TT, t = row - b * TT;
        if (skipctx && t < CTXL) continue;
        const size_t ro = t < CTXL ? ((size_t)(b * CTXL + t) << 10) : ((size_t)(b * SEQ + t - CTXL) << 10);
        const float* src = (t < CTXL ? ctx_in : lat_in) + ro;
        const float* sh = ada + (size_t)(t < CTXL ? 32 : b) * 6144 + shidx * 1024;
        const float* sc = sh + 1024;
        f32x4 a[4];
        a[0] = *(const f32x4*)(src + lane * 8); a[1] = *(const f32x4*)(src + lane * 8 + 4);
        a[2] = *(const f32x4*)(src + 512 + lane * 8); a[3] = *(const f32x4*)(src + 512 + lane * 8 + 4);
        float ss = 0.f;
#pragma unroll
        for (int i = 0; i < 4; ++i)
#pragma unroll
            for (int j = 0; j < 4; ++j) ss += a[i][j] * a[i][j];
        ss = wsum(ss);
        const float r = rsqrtf(ss * (1.f / 1024.f) + EPS);
        if (copy) {
            float* dst = (t < CTXL ? ctx_out : lat_out) + ro;
            *(f32x4*)(dst + lane * 8) = a[0]; *(f32x4*)(dst + lane * 8 + 4) = a[1];
            *(f32x4*)(dst + 512 + lane * 8) = a[2]; *(f32x4*)(dst + 512 + lane * 8 + 4) = a[3];
        }
#pragma unroll
        for (int hf = 0; hf < 2; ++hf) {
            const int c0 = hf * 512 + lane * 8;
            float y[8];
#pragma unroll
            for (int q = 0; q < 2; ++q) {
                const f32x4 gv = *(const f32x4*)(g + c0 + q * 4), sv = *(const f32x4*)(sc + c0 + q * 4), hv = *(const f32x4*)(sh + c0 + q * 4);
#pragma unroll
                for (int j = 0; j < 4; ++j) y[q * 4 + j] = a[hf * 2 + q][j] * r * gv[j] * (1.f + sv[j]) + hv[j];
            }
            *(u32x4*)(H + ((size_t)row << 10) + c0) = pack8(y);
        }
    }
}

DI void mla_rope8(float* v, int sub, int s) {
    const float pos = (float)((sub < 2) ? (s >> 6) : (s & 63));
    const bool isx2 = sub & 1;
#pragma unroll
    for (int i = 0; i < 8; ++i) {
        const float other = __shfl_xor(v[i], 1);
        const float ang = pos * fexp2(-(float)i * (L2_10000 / 8.f));
        const float c = __cosf(ang), sn = __sinf(ang);
        v[i] = isx2 ? (other * sn + v[i] * c) : (v[i] * c - other * sn);
    }
}

DI void mla_r2(bf16_t* QB, bf16_t* KV, const bf16_t* Z, const float* gqn, const float* gkn) {
    const int TIDX = otid(); const int BIDX = obid(); (void)TIDX; (void)BIDX;
    const int wave = TIDX >> 6, lane = TIDX & 63, hd = lane >> 2, sub = lane & 3;
    for (int row = BIDX * 8 + wave; row < NR; row += gridDim.x * 8) {
        const int b = row / TT, t = row - b * TT; const bool latent = t >= CTXL; const int s = t - CTXL;
        const bf16_t* z = Z + (size_t)row * 768;
        bf16_t* qp = QB + (size_t)row * 1536 + hd * 96;
        bf16_t* kp = KV + (size_t)row * 2560 + hd * 160;
        unsigned zq[3];
#pragma unroll
        for (int i = 0; i < 3; ++i) zq[i] = *(const unsigned*)(z + lane * 6 + 2 * i);
        const u32x2 zk = *(const u32x2*)(z + 384 + lane * 4);
        const u32x4 q0 = *(const u32x4*)(qp + sub * 16), q1 = *(const u32x4*)(qp + sub * 16 + 8), q2 = *(const u32x4*)(qp + 64 + sub * 8);
        const u32x4 k0 = *(const u32x4*)(kp + sub * 16), k1 = *(const u32x4*)(kp + sub * 16 + 8);
        const u32x4 v0 = *(const u32x4*)(kp + 64 + sub * 16), v1 = *(const u32x4*)(kp + 64 + sub * 16 + 8);
        const u32x4 k2 = *(const u32x4*)(z + 640 + sub * 8);
        asm volatile("s_waitcnt vmcnt(0)" ::: "memory");
        float sq0 = 0.f, sk0 = 0.f;
#pragma unroll
        for (int i = 0; i < 3; ++i) { const float a0 = bf_lo(zq[i]), a1 = bf_hi(zq[i]); sq0 += a0 * a0 + a1 * a1; }
        { const float a0 = bf_lo(zk[0]), a1 = bf_hi(zk[0]), a2 = bf_lo(zk[1]), a3 = bf_hi(zk[1]); sk0 = a0 * a0 + a1 * a1 + a2 * a2 + a3 * a3; }
        sq0 = wsum(sq0); sk0 = wsum(sk0);
        const float rq0 = rsqrtf(sq0 * (1.f / 384.f) + EPS), rk0 = rsqrtf(sk0 * (1.f / 256.f) + EPS);
        float qn[16], qr[8], kn[16], kr[8], vv[16];
        unpack8(q0, qn); unpack8(q1, qn + 8); unpack8(q2, qr);
        unpack8(k0, kn); unpack8(k1, kn + 8); unpack8(k2, kr);
        unpack8(v0, vv); unpack8(v1, vv + 8);
#pragma unroll
        for (int i = 0; i < 16; ++i) { qn[i] *= rq0; kn[i] *= rk0; vv[i] *= rk0; }
#pragma unroll
        for (int i = 0; i < 8; ++i) qr[i] *= rq0;
        float sq = 0.f, sk = 0.f;
#pragma unroll
        for (int i = 0; i < 16; ++i) { sq += qn[i] * qn[i]; sk += kn[i] * kn[i]; }
#pragma unroll
        for (int i = 0; i < 8; ++i) { sq += qr[i] * qr[i]; sk += kr[i] * kr[i]; }
        sq += __shfl_xor(sq, 1); sq += __shfl_xor(sq, 2);
        sk += __shfl_xor(sk, 1); sk += __shfl_xor(sk, 2);
        const float rq = rsqrtf(sq * (1.f / 96.f) + EPS), rk = rsqrtf(sk * (1.f / 96.f) + EPS);
#pragma unroll
        for (int i = 0; i < 16; ++i) { qn[i] *= rq * gqn[sub * 16 + i]; kn[i] *= rk * gkn[sub * 16 + i]; }
#pragma unroll
        for (int i = 0; i < 8; ++i) { qr[i] *= rq * gqn[64 + sub * 8 + i]; kr[i] *= rk * gkn[64 + sub * 8 + i]; }
        if (latent) { mla_rope8(qr, sub, s); mla_rope8(kr, sub, s); }
        *(u32x4*)(qp + sub * 16) = pack8(qn); *(u32x4*)(qp + sub * 16 + 8) = pack8(qn + 8); *(u32x4*)(qp + 64 + sub * 8) = pack8(qr);
        *(u32x4*)(kp + sub * 16) = pack8(kn); *(u32x4*)(kp + sub * 16 + 8) = pack8(kn + 8); *(u32x4*)(kp + 64 + sub * 8) = pack8(kr);
        *(u32x4*)(kp + 96 + sub * 16) = pack8(vv); *(u32x4*)(kp + 96 + sub * 16 + 8) = pack8(vv + 8);
    }
}

template <int HD, int LPH, int ROPE>
DI void headnorm_phase(bf16_t* X, int stride, int nq, int koff, int nk, const float* gq, const float* gk) {
    const int TIDX = otid(); const int BIDX = obid(); (void)TIDX; (void)BIDX;
    const int wave = TIDX >> 6, lane = TIDX & 63, sub = lane % LPH, hl = lane / LPH;
    const int rstep = gridDim.x * 8;
    for (int row = BIDX * 8 + wave; row < NR; row += 2 * rstep) {
        u32x4 u[2][2][2];
#pragma unroll
        for (int rr = 0; rr < 2; ++rr)
#pragma unroll
            for (int pass = 0; pass < 2; ++pass) {
                const int r2 = row + rr * rstep;
                const bool act = (r2 < NR) && (hl < (pass ? nk : nq));
                const bf16_t* ptr = X + (size_t)r2 * stride + (pass ? koff : 0) + hl * HD + sub * 16;
                u[rr][pass][0] = (u32x4){0, 0, 0, 0}; u[rr][pass][1] = (u32x4){0, 0, 0, 0};
                if (act) { u[rr][pass][0] = *(const u32x4*)ptr; u[rr][pass][1] = *(const u32x4*)(ptr + 8); }
            }
        asm volatile("s_waitcnt vmcnt(0)" ::: "memory");
#pragma unroll
        for (int rr = 0; rr < 2; ++rr) {
            const int r2 = row + rr * rstep;
            const int b = r2 / TT, t = r2 - b * TT; const bool latent = t >= CTXL; const int s = t - CTXL;
#pragma unroll
            for (int pass = 0; pass < 2; ++pass) {
                const bool act = (r2 < NR) && (hl < (pass ? nk : nq));
                const float* g = pass ? gk : gq;
                bf16_t* ptr = X + (size_t)r2 * stride + (pass ? koff : 0) + hl * HD + sub * 16;
                float v[16]; unpack8(u[rr][pass][0], v); unpack8(u[rr][pass][1], v + 8);
                float ss = 0.f;
#pragma unroll
                for (int i = 0; i < 16; ++i) ss += v[i] * v[i];
#pragma unroll
                for (int o = 1; o < LPH; o <<= 1) ss += __shfl_xor(ss, o);
                const float rr_ = rsqrtf(ss * (1.f / HD) + EPS);
#pragma unroll
                for (int i = 0; i < 16; ++i) v[i] *= rr_ * g[sub * 16 + i];
                if (ROPE) {
                    if (latent) {
                        const int axis = sub >> 2; const bool isx2 = (sub >> 1) & 1;
                        const float pos = (float)(axis ? (s & 63) : (s >> 6));
#pragma unroll
                        for (int i = 0; i < 16; ++i) {
                            const float other = __shfl_xor(v[i], 2);
                            const int fi = (sub & 1) * 16 + i;
                            const float ang = pos * fexp2(-(float)fi * (L2_10000 / 32.f));
                            const float c = __cosf(ang), sn = __sinf(ang);
                            v[i] = isx2 ? (other * sn + v[i] * c) : (v[i] * c - other * sn);
                        }
                    }
                }
                if (act) { *(u32x4*)ptr = pack8(v); *(u32x4*)(ptr + 8) = pack8(v + 8); }
            }
        }
    }
}

struct AttnArgs { const bf16_t* Q; const bf16_t* K; const bf16_t* V; bf16_t* O; int qs, qh, ks, kh, vs, vh, nheads, gshift, ctx_out; const float* rpb; float sc; };

template <int DK, int DV, int NA>
DI void attn_phase(LAS unsigned char* lds, const AttnArgs a) {
    const int TIDX = otid(); const int BIDX = obid(); (void)TIDX; (void)BIDX;
    constexpr int KROW = DK * 2 + 16, VROW = DV * 2 + 16;
    constexpr int KBUF = 64 * KROW, VBUF = 64 * VROW;
    constexpr int OFFK = 0, OFFV = 2 * KBUF, OFFR = OFFV + 2 * VBUF;
    constexpr int KCH = DK / 8, VCH = DV / 8, NKC = 64 * KCH, NVC = 64 * VCH;
    constexpr int KPT = (NKC + 511) / 512, VPT = (NVC + 511) / 512;
    constexpr int NK0 = DK / 16, NQG = NK0 / 2;
    const int tid = TIDX, wave = __builtin_amdgcn_readfirstlane(tid >> 6), lane = tid & 63, r = lane & 31, hh = lane >> 5;
    const int i16 = lane & 15, tq = i16 >> 2, tp = i16 & 3, blk = (lane >> 4) & 1;
    const int nlat = NB * a.nheads * 8, ntot = nlat + (a.ctx_out ? NB * a.nheads : 0);
    LAS float* rpbL = (LAS float*)(lds + OFFR);
    for (int item = BIDX; item < ntot; item += gridDim.x) {
        int b, h, qb = 0; const bool isctx = item >= nlat;
        if (!isctx) { const int R = item >> 8, u = item & 255; const int qp = (R * 8 + (u & 7)) * 4 + (u >> 6); qb = (u >> 3) & 7; h = qp % a.nheads; b = qp / a.nheads; }
        else { const int bh = item - nlat; h = bh % a.nheads; b = bh / a.nheads; }
        const int hk = h >> a.gshift;
        const size_t rb = (size_t)b * TT;
        const bf16_t* Kb = a.K + hk * a.kh; const bf16_t* Vb = a.V + hk * a.vh;
        int ntiles = isctx ? 4 : 36, rlo = 0, wi = 0, wr0 = 0, c0 = 0;
        if (NA) {
            if (!isctx) { const int i0 = qb * 4; rlo = clampi(i0 - 4, 0, 24); const int rhi = clampi(i0 - 1, 0, 24) + 8; ntiles = 4 + rhi - rlo;
                wi = i0 + (wave >> 1); wr0 = clampi(wi - 4, 0, 24); c0 = (wave & 1) * 32; }
            if (tid < 465) rpbL[64 + tid] = a.rpb[h * 465 + tid] * LOG2E;
        }
        const size_t qrow = rb + (isctx ? 0 : 256 + qb * 256) + wave * 32 + r;
        bf16x8 qf[DK / 16];
#pragma unroll
        for (int k0 = 0; k0 < DK / 16; ++k0) qf[k0] = *(const bf16x8*)(a.Q + qrow * a.qs + h * a.qh + k0 * 16 + hh * 8);
        u32x4 sreg[KPT > VPT ? KPT : VPT];
#define ATT_TILE_ROW(j) ((NA && (j) >= 4) ? rb + 256 + (size_t)(rlo + (j) - 4) * 64 : rb + (size_t)(j) * 64)
#define ATT_GLOADK(j) do { const size_t _tr = ATT_TILE_ROW(j); \
        _Pragma("unroll") for (int _i = 0; _i < KPT; ++_i) { const int _c = tid + _i * 512; if (_c < NKC) { const int _row = _c / KCH, _cc = _c - _row * KCH; sreg[_i] = *(const u32x4*)(Kb + (_tr + _row) * a.ks + _cc * 8); } } } while (0)
#define ATT_GLOADV(j) do { const size_t _tr = ATT_TILE_ROW(j); \
        _Pragma("unroll") for (int _i = 0; _i < VPT; ++_i) { const int _c = tid + _i * 512; if (_c < NVC) { const int _row = _c / VCH, _cc = _c - _row * VCH; sreg[_i] = *(const u32x4*)(Vb + (_tr + _row) * a.vs + _cc * 8); } } } while (0)
#define ATT_LSTOREK(buf) do { \
        _Pragma("unroll") for (int _i = 0; _i < KPT; ++_i) { const int _c = tid + _i * 512; if (_c < NKC) { const int _row = _c / KCH, _cc = _c - _row * KCH; *(LAS u32x4*)(lds + OFFK + (buf) * KBUF + _row * KROW + _cc * 16) = sreg[_i]; } } } while (0)
#define ATT_LSTOREV(buf) do { \
        _Pragma("unroll") for (int _i = 0; _i < VPT; ++_i) { const int _c = tid + _i * 512; if (_c < NVC) { const int _row = _c / VCH, _cc = _c - _row * VCH; *(LAS u32x4*)(lds + OFFV + (buf) * VBUF + _row * VROW + _cc * 16) = sreg[_i]; } } } while (0)
#define ATT_KFRAG(buf, idx) (*(const LAS bf16x8*)(lds + OFFK + (buf) * KBUF + (((idx) / NK0) * 32 + r) * KROW + ((idx) % NK0) * 32 + hh * 16))
#define ATT_QK(dst, buf) do { \
        _Pragma("unroll") for (int _x = 0; _x < 2 * NK0; ++_x) { const bf16x8 kf = ATT_KFRAG(buf, _x); \
            dst[_x / NK0] = __builtin_amdgcn_mfma_f32_32x32x16_bf16(kf, qf[_x % NK0], (_x % NK0) == 0 ? zero16 : dst[_x / NK0], 0, 0, 0); } } while (0)
#define ATT_ACTIVE(j) (!(NA && (j) >= 4) || ((rlo + (j) - 4 >= wr0) && (rlo + (j) - 4 < wr0 + 8)))
#define ATT_TILE(j, S, SN) do { \
        if ((j) + 1 < ntiles) ATT_GLOADV((j) + 1); \
        if (ATT_ACTIVE(j)) { \
            const int nb = ((j) + 1) & 1; \
            const LAS unsigned char* Vt = lds + OFFV + ((j) & 1) * VBUF; \
            bf16x8 kfr[2][NQG]; \
            _Pragma("unroll") for (int q = 0; q < NQG; ++q) kfr[0][q] = ATT_KFRAG(nb, q); \
            float mx = m_run; \
            if (NA && (j) >= 4) { \
                const int kr = rlo + (j) - 4; \
                const int ri = kr - wi + 7, qj = c0 + r, cs = clampi(qj - 8, 0, 48); \
                const LAS float* bp = rpbL + 64 + ri * 31 + (4 * hh - qj + 15); \
                const int vb = 4 * hh - cs; \
                _Pragma("unroll") for (int kb = 0; kb < 2; ++kb) \
                    _Pragma("unroll") for (int i = 0; i < 16; ++i) { \
                        const int ci = kb * 32 + (i & 3) + 8 * (i >> 2); \
                        const bool valid = (unsigned)(vb + ci) < 16u; \
                        const float x = valid ? __builtin_fmaf(S[kb][i], a.sc, bp[ci]) : -1e30f; \
                        S[kb][i] = x; mx = fmaxf(mx, x); } \
                mx = fmaxf(mx, __shfl_xor(mx, 32)); \
            } else { \
                float mr = -1e30f; \
                _Pragma("unroll") for (int kb = 0; kb < 2; ++kb) \
                    _Pragma("unroll") for (int i = 0; i < 16; ++i) mr = fmaxf(mr, S[kb][i]); \
                mr = fmaxf(mr, __shfl_xor(mr, 32)); \
                mx = fmaxf(mx, mr * a.sc); \
            } \
            if (__any(mx > m_run + 8.f)) {     \
                const float alpha = fexp2(m_run - mx); \
                lsum *= alpha; \
                _Pragma("unroll") for (int d = 0; d < DV / 32; ++d) \
                    _Pragma("unroll") for (int i = 0; i < 16; ++i) o[d][i] *= alpha; \
                m_run = mx; \
            } \
            mx = m_run; \
            __builtin_amdgcn_sched_barrier(0); \
            _Pragma("unroll") for (int grp = 0; grp < 4; ++grp) { \
                const int kb = grp >> 1, st = grp & 1; \
                if (grp < 3) { _Pragma("unroll") for (int q = 0; q < NQG; ++q) kfr[(grp + 1) & 1][q] = ATT_KFRAG(nb, (grp + 1) * NQG + q); } \
                bf16x8 vf[DV / 32]; \
                _Pragma("unroll") for (int d = 0; d < DV / 32; ++d) { \
                    const LAS unsigned char* ad = Vt + (kb * 32 + 16 * st + 4 * hh + tq) * VROW + (d * 32 + 16 * blk + 4 * tp) * 2; \
                    const s16x4 lo = __builtin_amdgcn_ds_read_tr16_b64_v4i16((LAS s16x4*)ad); \
                    const s16x4 hi = __builtin_amdgcn_ds_read_tr16_b64_v4i16((LAS s16x4*)(ad + 8 * VROW)); \
                    vf[d] = __builtin_shufflevector(lo, hi, 0, 1, 2, 3, 4, 5, 6, 7); } \
                _Pragma("unroll") for (int q = 0; q < NQG; ++q) { const int idx = grp * NQG + q; \
                    SN[idx / NK0] = __builtin_amdgcn_mfma_f32_32x32x16_bf16(kfr[grp & 1][q], qf[idx % NK0], (idx % NK0) == 0 ? zero16 : SN[idx / NK0], 0, 0, 0); } \
                __builtin_amdgcn_sched_barrier(0); \
                float pp[8]; \
                _Pragma("unroll") for (int i = 0; i < 8; ++i) { \
                    pp[i] = (NA && (j) >= 4) ? fexp2(S[kb][8 * st + i] - mx) : fexp2(__builtin_fmaf(S[kb][8 * st + i], a.sc, -mx)); lsum += pp[i]; } \
                const bf16x8 pf = __builtin_bit_cast(bf16x8, pack8(pp)); \
                __builtin_amdgcn_sched_barrier(0); \
                _Pragma("unroll") for (int d = 0; d < DV / 32; ++d) o[d] = __builtin_amdgcn_mfma_f32_32x32x16_bf16(vf[d], pf, o[d], 0, 0, 0); \
                __builtin_amdgcn_sched_barrier(0); \
                if (grp == 1) { \
                    if ((j) + 1 < ntiles) ATT_LSTOREV(((j) + 1) & 1); \
                    if ((j) + 2 < ntiles) ATT_GLOADK((j) + 2); \
                    __builtin_amdgcn_sched_barrier(0); \
                } \
            } \
        } else { \
            ATT_QK(SN, ((j) + 1) & 1); \
            if ((j) + 1 < ntiles) ATT_LSTOREV(((j) + 1) & 1); \
            if ((j) + 2 < ntiles) ATT_GLOADK((j) + 2); \
        } \
        if ((j) + 2 < ntiles) ATT_LSTOREK((j) & 1); \
        __syncthreads(); } while (0)
        ATT_GLOADK(0); ATT_LSTOREK(0); ATT_GLOADV(0); ATT_LSTOREV(0);
        ATT_GLOADK(1); ATT_LSTOREK(1);
        __syncthreads();
        f32x16 o[DV / 32];
#pragma unroll
        for (int d = 0; d < DV / 32; ++d)
#pragma unroll
            for (int i = 0; i < 16; ++i) o[d][i] = 0.f;
        f32x16 zero16;
#pragma unroll
        for (int i = 0; i < 16; ++i) zero16[i] = 0.f;
        float m_run = -1e30f, lsum = 0.f;
        f32x16 s[2], sn[2];
        ATT_QK(s, 0);
        __syncthreads();
        for (int j = 0; j < ntiles; j += 2) {
            ATT_TILE(j, s, sn);
            if (j + 1 < ntiles) ATT_TILE(j + 1, sn, s);
        }
        lsum += __shfl_xor(lsum, 32);
        const float inv = frcp(lsum);
        bf16_t* orow = a.O + (qrow << 10) + h * DV;
#pragma unroll
        for (int d = 0; d < DV / 32; ++d)
#pragma unroll
            for (int g = 0; g < 4; ++g)
                *(u32x2*)(orow + d * 32 + 8 * g + 4 * hh) = (u32x2){pk_bf16(o[d][4 * g] * inv, o[d][4 * g + 1] * inv), pk_bf16(o[d][4 * g + 2] * inv, o[d][4 * g + 3] * inv)};
#undef ATT_TILE_ROW
#undef ATT_GLOADK
#undef ATT_GLOADV
#undef ATT_LSTOREK
#undef ATT_LSTOREV
#undef ATT_KFRAG
#undef ATT_QK
#undef ATT_ACTIVE
#undef ATT_TILE
    }
}

DI void s5_scan_phase(LAS unsigned char* lds, const Params& p, bf16_t* H, bf16_t* YF) {
    const int TIDX = otid(); const int BIDX = obid(); (void)TIDX; (void)BIDX;
    const int wave = __builtin_amdgcn_readfirstlane(TIDX >> 6), lane = TIDX & 63;
    LAS float* BU = (LAS float*)(lds + wave * 14592);
    LAS bf16_t* Hh = (LAS bf16_t*)(lds + wave * 14592 + 10240);
    const int l15 = lane & 15, l4 = lane >> 4;
    for (int item = BIDX * 8 + wave; item < NB * 64; item += gridDim.x * 8) {
        const int g = item & 63, b = item >> 6;
        const float dsk = p.in[I_SD][g * 16 + l15];
        for (int dir = 0; dir < 2; ++dir) {
            const int pg = dir * 64 + g;
            const float dt = __expf(p.in[I_SLDT][pg]);
            const float* are = p.in[I_SARE] + pg * 64; const float* aim = p.in[I_SAIM] + pg * 64;
            float abr, abi;
            { const float ar = are[lane], ai = aim[lane]; const float mag = __expf(dt * ar); abr = mag * __cosf(dt * ai); abi = mag * __sinf(dt * ai); }
            bf16x8 bfr[8], cfr[4];
#pragma unroll
            for (int nt = 0; nt < 8; ++nt) {
                const int st = (nt & 3) * 16 + l15;
                const float ar = are[st], ai = aim[st]; const float mag = __expf(dt * ar);
                const float er = mag * __cosf(dt * ai), ei = mag * __sinf(dt * ai);
                const float den = ar * ar + ai * ai, nr = er - 1.f;
                const float fre = (nr * ar + ei * ai) / den, fim = (ei * ar - nr * ai) / den;
                float bb[8];
#pragma unroll
                for (int j = 0; j < 8; ++j) bb[j] = 0.f;
                if (lane < 32) {
                    const float* br = p.in[I_SBRE] + ((size_t)pg * 64 + st) * 16 + l4 * 8; const float* bi = p.in[I_SBIM] + ((size_t)pg * 64 + st) * 16 + l4 * 8;
#pragma unroll
                    for (int j = 0; j < 8; ++j) bb[j] = (nt < 4) ? (fre * br[j] - fim * bi[j]) : (fre * bi[j] + fim * br[j]);
                }
                bfr[nt] = __builtin_bit_cast(bf16x8, pack8(bb));
            }
#pragma unroll
            for (int kk = 0; kk < 4; ++kk) {
                const int st0 = kk * 16 + l4 * 4;
                const f32x4 cr4 = *(const f32x4*)(p.in[I_SCRE] + ((size_t)pg * 16 + l15) * 64 + st0);
                const f32x4 ci4 = *(const f32x4*)(p.in[I_SCIM] + ((size_t)pg * 16 + l15) * 64 + st0);
                float cc[8];
#pragma unroll
                for (int j = 0; j < 4; ++j) { cc[2 * j] = cr4[j]; cc[2 * j + 1] = -ci4[j]; }
                cfr[kk] = __builtin_bit_cast(bf16x8, pack8(cc));
            }
            float hr = 0.f, hi = 0.f;
#define S5_TB(j) (dir ? ((j) < 16 ? 16 * (15 - (j)) : 256 + 16 * (143 - (j))) : 16 * (j))
            bf16x8 ufn = (bf16x8){0, 0, 0, 0, 0, 0, 0, 0};
            if (lane < 32) ufn = *(const bf16x8*)(H + (((size_t)b * TT + S5_TB(0) + l15) << 10) + g * 16 + l4 * 8);
            for (int j = 0; j < 144; ++j) {
                const int tb = S5_TB(j);
                const size_t row0 = (size_t)b * TT + tb;
                const bf16x8 uf = ufn;
                if (lane < 32 && j + 1 < 144) ufn = *(const bf16x8*)(H + (((size_t)b * TT + S5_TB(j + 1) + l15) << 10) + g * 16 + l4 * 8);
                float yfv[4], uv[4];
                if (dir) {
#pragma unroll
                    for (int i = 0; i < 4; ++i) {
                        const size_t o = ((row0 + l4 * 4 + i) << 10) + g * 16 + l15;
                        yfv[i] = __uint_as_float(((unsigned)YF[o]) << 16); uv[i] = __uint_as_float(((unsigned)H[o]) << 16);
                    }
                }
#pragma unroll
                for (int nt = 0; nt < 8; ++nt) {
                    const f32x4 acc = __builtin_amdgcn_mfma_f32_16x16x32_bf16(uf, bfr[nt], (f32x4){0.f, 0.f, 0.f, 0.f}, 0, 0, 0);
                    *(LAS f32x4*)(BU + (nt * 16 + l15) * 20 + l4 * 4) = acc;
                }
                float bur[16], bui[16];
#pragma unroll
                for (int q = 0; q < 4; ++q) {
                    const f32x4 r4 = *(const LAS f32x4*)(BU + lane * 20 + q * 4), i4 = *(const LAS f32x4*)(BU + (64 + lane) * 20 + q * 4);
#pragma unroll
                    for (int e = 0; e < 4; ++e) { bur[q * 4 + e] = r4[e]; bui[q * 4 + e] = i4[e]; }
                }
                if (dir) {
#pragma unroll
                    for (int tt = 15; tt >= 0; --tt) {
                        const float nhr = abr * hr - abi * hi + bur[tt], nhi = abr * hi + abi * hr + bui[tt];
                        hr = nhr; hi = nhi;
                        *(LAS unsigned*)(Hh + tt * 136 + 2 * lane) = pk_bf16(hr, hi);
                    }
                } else {
#pragma unroll
                    for (int tt = 0; tt < 16; ++tt) {
                        const float nhr = abr * hr - abi * hi + bur[tt], nhi = abr * hi + abi * hr + bui[tt];
                        hr = nhr; hi = nhi;
                        *(LAS unsigned*)(Hh + tt * 136 + 2 * lane) = pk_bf16(hr, hi);
                    }
                }
                f32x4 ya = (f32x4){0.f, 0.f, 0.f, 0.f};
#pragma unroll
                for (int kk = 0; kk < 4; ++kk) {
                    const bf16x8 af = *(const LAS bf16x8*)(Hh + l15 * 136 + kk * 32 + l4 * 8);
                    ya = __builtin_amdgcn_mfma_f32_16x16x32_bf16(af, cfr[kk], ya, 0, 0, 0);
                }
                if (dir == 0) {
#pragma unroll
                    for (int i = 0; i < 4; ++i) YF[((row0 + l4 * 4 + i) << 10) + g * 16 + l15] = (bf16_t)(pk_bf16(ya[i], 0.f) & 0xffffu);
                } else {
#pragma unroll
                    for (int i = 0; i < 4; ++i) {
                        const size_t o = ((row0 + l4 * 4 + i) << 10) + g * 16 + l15;
                        const float y = gelu_tanh(dsk * uv[i] + yfv[i] + ya[i]);
                        H[o] = (bf16_t)(pk_bf16(y, 0.f) & 0xffffu);
                    }
                }
            }
        }
    }
}

#define XB_TMO      128
#define XB_XCNT(j)  (256  + 64 * (j))
#define XB_XSUB(j)  (1280 + 64 * (j))
#define XB_XGEN(j)  (2304 + 64 * (j))
#define XB_TOP      3328
#define XB_TOPGEN   3392
#define XCD_BAR_WORDS 3456
#define XB_SPIN_CAP (1u << 18)
DI unsigned xb_ld(unsigned* p)              { return __hip_atomic_load(p, __ATOMIC_RELAXED, __HIP_MEMORY_SCOPE_AGENT); }
DI unsigned xb_add(unsigned* p, unsigned v) { return __hip_atomic_fetch_add(p, v, __ATOMIC_RELAXED, __HIP_MEMORY_SCOPE_AGENT); }
DI unsigned xb_xcc_id() { return (unsigned)__builtin_amdgcn_s_getreg((3 << 11) | 20) & 0xFu; }
#define XB_SPIN(cond, bar) do { unsigned _sp = 0; while (cond) { __builtin_amdgcn_s_sleep(1); \
    if ((++_sp & 255u) == 0u) { if (xb_ld(&(bar)[XB_TMO])) break; if (_sp > XB_SPIN_CAP) { atomicAdd(&(bar)[XB_TMO], 1u); break; } } } } while (0)
struct XcdBarrier { unsigned* bar; unsigned x; volatile LAS unsigned* st; };
DI XcdBarrier xcd_barrier_post(unsigned* bar, volatile LAS unsigned* st) {
    XcdBarrier b; b.bar = bar; b.x = xb_xcc_id(); b.st = st;
    if (threadIdx.x == 0) (void)xb_add(&bar[XB_XCNT(b.x)], 1u);
    return b;
}
DI void xcd_barrier_complete(unsigned* bar, unsigned x, unsigned& nloc, unsigned& nx) {
    const unsigned G = gridDim.x * gridDim.y * gridDim.z;
    unsigned sum, cnt, mine, sp = 0u;
    for (;;) {
        sum = 0u; cnt = 0u; mine = 0u;
#pragma unroll
        for (unsigned j = 0; j < 16; ++j) { const unsigned c = xb_ld(&bar[XB_XCNT(j)]); sum += c; cnt += (c > 0u) ? 1u : 0u; mine = (j == x) ? c : mine; }
        if (sum == G) break;
        __builtin_amdgcn_s_sleep(1);
        if ((++sp & 255u) == 0u) { if (xb_ld(&bar[XB_TMO])) break; if (sp > XB_SPIN_CAP) { atomicAdd(&bar[XB_TMO], 1u); break; } }
    }
    nloc = mine > 0u ? mine : 1u; nx = cnt > 0u ? cnt : 1u;
}
DI void xcd_barrier(const XcdBarrier& b) {
    asm volatile("s_waitcnt vmcnt(0)" ::: "memory");
    __syncthreads();
    if (threadIdx.x == 0) {
        unsigned* bar = b.bar;
        __builtin_amdgcn_s_waitcnt(0);
        unsigned nloc = b.st[0], nx = b.st[1];
        if (nloc == 0u) { xcd_barrier_complete(bar, b.x, nloc, nx); b.st[0] = nloc; b.st[1] = nx; }
        const unsigned old = xb_add(&bar[XB_XSUB(b.x)], 1u);
        const unsigned gen = old / nloc;
        if (old + 1u == (gen + 1u) * nloc) {
            __builtin_amdgcn_fence(__ATOMIC_RELEASE, "agent");
            asm volatile("s_waitcnt vmcnt(0)" ::: "memory");
            const unsigned og = xb_add(&bar[XB_TOP], 1u);
            const unsigned tg = og / nx;
            if (og + 1u == (tg + 1u) * nx) xb_add(&bar[XB_TOPGEN], 1u);
            else XB_SPIN(xb_ld(&bar[XB_TOPGEN]) == tg, bar);
            __builtin_amdgcn_fence(__ATOMIC_ACQUIRE, "agent");
            xb_add(&bar[XB_XGEN(b.x)], 1u);
            asm volatile("s_waitcnt vmcnt(0)" ::: "memory");
        } else {
            XB_SPIN(xb_ld(&bar[XB_XGEN(b.x)]) == gen, bar);
            __builtin_amdgcn_fence(__ATOMIC_ACQUIRE, "agent");
            asm volatile("s_waitcnt vmcnt(0)" ::: "memory");
        }
    }
    __syncthreads();
}

__global__ void __launch_bounds__(512, 2) mega(const Params p) {
    extern __shared__ __attribute__((aligned(16))) unsigned char shm[];
    LAS unsigned char* lds = (LAS unsigned char*)shm;
    cg::grid_group grid = cg::this_grid();
    LAS unsigned* xbst = (LAS unsigned*)(lds + 133120);
    if (threadIdx.x < 4) xbst[threadIdx.x] = 0u;
    __syncthreads();
    const XcdBarrier xb = xcd_barrier_post((unsigned*)(p.ws + OFF_BAR), (volatile LAS unsigned*)xbst);
    unsigned char* ws = p.ws;
    float* ADA = (float*)(ws + OFF_ADA);
    float* XC = (float*)(ws + OFF_XC);
    bf16_t* HB = (bf16_t*)(ws + OFF_HB);
    float* LAT = p.out;
    int pid = 0;
#define PH_BEGIN if (pid >= p.ph_lo && pid < p.ph_hi) {
#define PH_END if (pid + 1 < p.ph_hi) { if (pid == 0) grid.sync(); else xcd_barrier(xb); } } ++pid;

    PH_BEGIN
    {
        phase0(lds, p, ADA, (unsigned*)(ws + OFF_BAR + 14336));
    }
    PH_END

    for (int layer = 0; layer < 4; ++layer) {
        const float* ada = ADA + (size_t)layer * 33 * 6144;
        const int last = layer == 3;
        PH_BEGIN
        norm_phase(layer == 0 ? p.in[I_X] : LAT, layer == 0 ? p.in[I_CTX] : XC, LAT, XC, false, p.in[I_NMIX] + layer * 1024, ada, 0, HB, false);
        PH_END
        if (layer == 0) {
            bf16_t* Z = (bf16_t*)(ws + OFF_Z); bf16_t* KV = (bf16_t*)(ws + OFF_KV); bf16_t* QB = (bf16_t*)(ws + OFF_QB);
            PH_BEGIN
            run_gemm(lds, HB, 1024, (const bf16_t*)(ws + OFF_WMI), 768, 1024, 0, pg8::EpiStore{Z, 768, 0});
            PH_END
            PH_BEGIN
            run_gemm(lds, Z, 768, (const bf16_t*)(ws + OFF_WUQ), 1536, 384, 0, pg8::EpiStore{QB, 1536, 0});
            run_gemm(lds, Z + 384, 768, (const bf16_t*)(ws + OFF_WUKV), 2048, 256, 0, pg8::EpiStore{KV, 2560, 1});
            PH_END
            PH_BEGIN
            mla_r2(QB, KV, Z, p.in[I_MGQN], p.in[I_MGKN]);
            PH_END
            PH_BEGIN
            attn_phase<96, 64, 0>(lds, AttnArgs{QB, KV, KV + 96, HB, 1536, 96, 2560, 160, 2560, 160, 16, 0, 1, nullptr, 0.10206207261596575f * LOG2E});
            PH_END
            PH_BEGIN
            run_gemm(lds, HB, 1024, (const bf16_t*)(ws + OFF_WMO), 1024, 1024, 0, pg8::EpiRes{LAT, XC, ada, 2, p.in[I_X], p.in[I_CTX]});
            PH_END
        } else if (layer == 1) {
            bf16_t* YF = (bf16_t*)(ws + OFF_BIG);
            PH_BEGIN
            s5_scan_phase(lds, p, HB, YF);
            PH_END
            PH_BEGIN
            run_gemm(lds, HB, 1024, (const bf16_t*)(ws + OFF_WGLU), 2048, 1024, 0, pg8::EpiGluRes{LAT, XC, ada, 2});
            PH_END
        } else if (layer == 2) {
            bf16_t* QKV = (bf16_t*)(ws + OFF_BIG);
            PH_BEGIN
            run_gemm(lds, HB, 1024, (const bf16_t*)(ws + OFF_WNQ), 3072, 1024, 0, pg8::EpiStoreHN64{QKV, 3072, p.in[I_NGQN], p.in[I_NGKN], (LAS float*)(lds + 133120 + 64)});
            PH_END
            PH_BEGIN
            attn_phase<64, 64, 1>(lds, AttnArgs{QKV, QKV + 1024, QKV + 2048, HB, 3072, 64, 3072, 64, 3072, 64, 16, 0, 1, p.in[I_NRPB], 0.125f * LOG2E});
            PH_END
            PH_BEGIN
            run_gemm(lds, HB, 1024, (const bf16_t*)(ws + OFF_WNO), 1024, 1024, 0, pg8::EpiRes{LAT, XC, ada, 2, LAT, XC});
            PH_END
        } else {
            bf16_t* QKV = (bf16_t*)(ws + OFF_BIG);
            PH_BEGIN
            run_gemm(lds, HB, 1024, (const bf16_t*)(ws + OFF_WGQ), 1536, 1024, 0, pg8::EpiStoreHN128{QKV, 1536, p.in[I_GGQN], p.in[I_GGKN], (LAS float*)(lds + 133120 + 64)});
            PH_END
            PH_BEGIN
            attn_phase<128, 128, 0>(lds, AttnArgs{QKV, QKV + 1024, QKV + 1280, HB, 1536, 128, 1536, 128, 1536, 128, 8, 2, 0, nullptr, 0.08838834764831845f * LOG2E});
            PH_END
            PH_BEGIN
            run_gemm(lds, HB, 1024, (const bf16_t*)(ws + OFF_WGO), 1024, 1024, 1, pg8::EpiRes{LAT, XC, ada, 2, LAT, XC});
            PH_END
        }
        bf16_t* ACT = (bf16_t*)(ws + OFF_BIG);
        PH_BEGIN
        norm_phase(LAT, XC, LAT, XC, false, p.in[I_NFFN] + layer * 1024, ada, 3, HB, last);
        PH_END
        PH_BEGIN
        run_gemm(lds, HB, 1024, (const bf16_t*)(ws + OFF_WFI + layer * SZ_WFI), 5632, 1024, last, pg8::EpiSwiglu{ACT, FH});
        PH_END
        PH_BEGIN
        run_gemm(lds, ACT, 2816, (const bf16_t*)(ws + OFF_WFO + layer * SZ_WFO), 1024, 2816, last, pg8::EpiRes{LAT, XC, ada, 5, LAT, XC});
        PH_END
    }
}

extern "C" void kernel_launch(void* const* d_in, const int* in_sizes, int n_in, void* d_out, int out_size, void* d_ws, size_t ws_size, hipStream_t stream) {
    static int grid_blocks = 0;
    if (!grid_blocks) {
        hipFuncSetAttribute((const void*)mega, hipFuncAttributeMaxDynamicSharedMemorySize, LDS_BYTES);
        int dev = 0, cus = 0, per_cu = 0;
        hipGetDevice(&dev);
        hipDeviceGetAttribute(&cus, hipDeviceAttributeMultiprocessorCount, dev);
        hipOccupancyMaxActiveBlocksPerMultiprocessor(&per_cu, mega, 512, LDS_BYTES);
        if (per_cu < 1) per_cu = 1;
        grid_blocks = cus * 1;
    }
    if (ws_size < WS_NEED) fprintf(stderr, "workspace too small: %zu < %zu\n", ws_size, (size_t)WS_NEED);
    Params p; memset(&p, 0, sizeof(p));
    for (int i = 0; i < N_IN; ++i) p.in[i] = (const float*)d_in[i];
    p.out = (float*)d_out; p.ws = (unsigned char*)d_ws; p.ph_lo = 0; p.ph_hi = 1000;
    hipMemsetAsync((unsigned char*)d_ws + OFF_BAR, 0, 16384, stream);
    void* args[] = {&p};
    hipError_t e = hipLaunchCooperativeKernel((const void*)mega, dim3(grid_blocks), dim3(512), args, LDS_BYTES, stream);
    if (e != hipSuccess) fprintf(stderr, "cooperative launch failed: %s (grid %d)\n", hipGetErrorString(e), grid_blocks);
}
```

```cpp
#include <hip/hip_runtime.h>
#include <hip/hip_cooperative_groups.h>
#include <cstdio>
#include <cstring>
namespace cg = cooperative_groups;

#define DI __device__ __forceinline__
#define LAS __attribute__((address_space(3)))
typedef unsigned short bf16_t;
typedef short bf16x8 __attribute__((ext_vector_type(8)));
typedef short s16x4 __attribute__((ext_vector_type(4)));
typedef float f32x4 __attribute__((ext_vector_type(4)));
typedef float f32x16 __attribute__((ext_vector_type(16)));
typedef unsigned u32x4 __attribute__((ext_vector_type(4)));
typedef unsigned u32x2 __attribute__((ext_vector_type(2)));
typedef __bf16 bf2_t __attribute__((ext_vector_type(2)));
typedef float f2_t __attribute__((ext_vector_type(2)));

constexpr int NB = 32, SEQ = 2048, CTXL = 256, TT = 2304, NR = NB * TT, DM = 1024, FH = 2816;
constexpr float EPS = 1e-6f, LOG2E = 1.4426950408889634f, L2_10000 = 13.287712379549449f;
constexpr int LDS_BYTES = 133120 + 64 + 8192;

enum { I_X, I_C, I_CTX, I_CCTX, I_ADAW, I_ADAB, I_NMIX, I_NFFN, I_FWIN, I_FWOUT,
       I_MWIN, I_MGQ, I_MGKV, I_MWUQ, I_MWUKV, I_MGQN, I_MGKN, I_MWO,
       I_SARE, I_SAIM, I_SLDT, I_SBRE, I_SBIM, I_SCRE, I_SCIM, I_SD, I_SWGLU,
       I_NWQKV, I_NGQN, I_NGKN, I_NRPB, I_NWO, I_GWQKV, I_GGQN, I_GGKN, I_GWO, N_IN };

constexpr size_t SZ_WFI = (size_t)5632 * 1024 * 2, SZ_WFO = (size_t)1024 * 2816 * 2;
constexpr size_t OFF_WFI = 0;
constexpr size_t OFF_WFO = OFF_WFI + 4 * SZ_WFI;
constexpr size_t OFF_WMI = OFF_WFO + 4 * SZ_WFO;
constexpr size_t OFF_WUQ = OFF_WMI + (size_t)768 * 1024 * 2;
constexpr size_t OFF_WUKV = OFF_WUQ + (size_t)2048 * 384 * 2;
constexpr size_t OFF_WMO = OFF_WUKV + (size_t)2048 * 256 * 2;
constexpr size_t OFF_WGLU = OFF_WMO + (size_t)1024 * 1024 * 2;
constexpr size_t OFF_WNQ = OFF_WGLU + (size_t)2048 * 1024 * 2;
constexpr size_t OFF_WNO = OFF_WNQ + (size_t)3072 * 1024 * 2;
constexpr size_t OFF_WGQ = OFF_WNO + (size_t)1024 * 1024 * 2;
constexpr size_t OFF_WGO = OFF_WGQ + (size_t)1536 * 1024 * 2;
constexpr size_t OFF_ADA = OFF_WGO + (size_t)1024 * 1024 * 2;
constexpr size_t OFF_XC = OFF_ADA + (size_t)4 * 33 * 6144 * 4;
constexpr size_t OFF_HB = OFF_XC + (size_t)NB * CTXL * 1024 * 4;
constexpr size_t OFF_BIG = OFF_HB + (size_t)NR * 1024 * 2;
constexpr size_t OFF_KV = OFF_BIG;
constexpr size_t OFF_QB = OFF_KV + (size_t)NR * 2560 * 2;
constexpr size_t OFF_Z = OFF_QB + (size_t)NR * 1536 * 2;
constexpr size_t OFF_BAR = OFF_Z + (size_t)NR * 768 * 2;
constexpr size_t OFF_SSQ = OFF_BAR + 16384;
constexpr size_t WS_NEED = OFF_SSQ + (size_t)NR * 16;

struct Params {
    const float* in[N_IN];
    float* out;
    unsigned char* ws;
    int ph_lo, ph_hi;
};

DI unsigned pk_bf16(float a, float b) { f2_t v = {a, b}; bf2_t r = __builtin_convertvector(v, bf2_t); return __builtin_bit_cast(unsigned, r); }
DI float bf_lo(unsigned u) { return __uint_as_float(u << 16); }
DI float bf_hi(unsigned u) { return __uint_as_float(u & 0xffff0000u); }
DI float wsum(float v) {
#pragma unroll
    for (int o = 32; o > 0; o >>= 1) v += __shfl_xor(v, o);
    return v;
}
DI int otid() { int t = threadIdx.x; asm volatile("" : "+v"(t)); return t; }
DI int obid() { int b = blockIdx.x; asm volatile("" : "+s"(b)); return b; }
DI int mla_dim_of_pos(int pos) { if (pos < 64) return pos; const int p = pos - 64, a = p >> 4, w = p & 15; return 64 + 16 * a + (w >> 1) + 8 * (w & 1); }
DI int gqa_dim_of_pos(int pos) { return (pos >> 6) * 64 + ((pos & 63) >> 1) + 32 * (pos & 1); }
DI int clampi(int v, int lo, int hi) { return v < lo ? lo : (v > hi ? hi : v); }
DI float fexp2(float x) { return __builtin_amdgcn_exp2f(x); }
DI float frcp(float x) { return __builtin_amdgcn_rcpf(x); }
DI float silu_f(float a) { return a * frcp(1.f + __expf(-a)); }
DI float sigmoid_f(float a) { return frcp(1.f + __expf(-a)); }
DI float gelu_tanh(float y) {
    const float z = 0.7978845608028654f * (y + 0.044715f * y * y * y);
    const float t = 1.f - 2.f * frcp(__expf(2.f * z) + 1.f);
    return 0.5f * y * (1.f + t);
}
DI void unpack8(const u32x4 u, float* f) {
#pragma unroll
    for (int i = 0; i < 4; ++i) { f[2 * i] = bf_lo(u[i]); f[2 * i + 1] = bf_hi(u[i]); }
}
DI u32x4 pack8(const float* f) { return (u32x4){pk_bf16(f[0], f[1]), pk_bf16(f[2], f[3]), pk_bf16(f[4], f[5]), pk_bf16(f[6], f[7])}; }

namespace pg8 {
constexpr int BM = 256, BK = 64, HALF = 128, HTB = HALF * BK * 2, NXCD = 8, WGM = 8;
DI int lds_byte(int r, int c) { const int st = (r >> 4) * 2 + (c >> 5), rr = r & 15, cc = c & 31, ob = rr * 64 + cc * 2; return st * 1024 + (ob ^ (((ob >> 9) & 1) << 5)); }
DI void stage_rc(int b, int& R, int& C) { const int st = b / 1024, sb = b % 1024, swz = sb ^ (((sb >> 9) & 1) << 5); R = (st >> 1) * 16 + swz / 64; C = (st & 1) * 32 + (swz % 64) / 2; }
DI int perm32(int rho) { const int n = rho >> 4, i = rho & 15; return 8 * (i >> 2) + 4 * n + (i & 3); }
struct Unit { int pm, pn; };
struct Gemm { const bf16_t* A; const bf16_t* Bt; int M, N, K, lda; };
struct Order {
    int nM, nN, nwg, G, c, skip;
    DI void init(int N, int G_, int c_, int skipctx) { skip = skipctx; nM = skipctx ? 256 : 288; nN = N / BM; nwg = nM * nN; G = G_; c = c_; }
    DI bool next(int i, Unit& u) const {
        const long L = (long)i * G + c; if (L >= nwg) return false;
        int wgid = (int)L; { const int q = nwg / NXCD, r = nwg % NXCD, xcd = wgid % NXCD, off = wgid / NXCD; wgid = (xcd < r ? xcd * (q + 1) : r * (q + 1) + (xcd - r) * q) + off; }
        const int nig = WGM * nN, gid = wgid / nig, fm = gid * WGM, gsz = (nM - fm) < WGM ? (nM - fm) : WGM;
        int pm = fm + ((wgid % nig) % gsz); u.pn = (wgid % nig) / gsz;
        if (skip) pm = pm + (pm >> 3) + 1;
        u.pm = pm; return true;
    }
};

DI float* tile_res_base(float* lat, float* xc, int pm) { const int bb = pm / 9, sub = pm - bb * 9; return sub == 0 ? xc + ((size_t)bb * CTXL << 10) : lat + ((size_t)(bb * SEQ + (sub - 1) * 256) << 10); }
DI int tile_ada_row(int pm) { const int bb = pm / 9, sub = pm - bb * 9; return sub == 0 ? 32 : bb; }

struct EpiStore {
    static constexpr bool PERM = true;
    bf16_t* O; int ldc; int remap;
    DI void operator()(const f32x4 (&acc)[2][2][4][2], const Unit& u, int wr, int wc, int fr, int fq) const {
        const int row0 = u.pm * BM + wr * 64 + fr, col0 = u.pn * BM + wc * 32 + 8 * fq;
#pragma unroll
        for (int ai = 0; ai < 2; ++ai)
#pragma unroll
            for (int m = 0; m < 4; ++m) {
                bf16_t* rowp = O + (size_t)(row0 + ai * HALF + m * 16) * ldc;
#pragma unroll
                for (int bj = 0; bj < 2; ++bj) {
                    const int c = col0 + bj * HALF; const int cc = remap ? (c >> 7) * 160 + (c & 127) : c;
                    const f32x4 v0 = acc[ai][bj][m][0], v1 = acc[ai][bj][m][1];
                    *(u32x4*)(rowp + cc) = (u32x4){pk_bf16(v0[0], v0[1]), pk_bf16(v0[2], v0[3]), pk_bf16(v1[0], v1[1]), pk_bf16(v1[2], v1[3])};
                }
            }
    }
};
struct EpiStoreHN64 {
    static constexpr bool PERM = true;
    bf16_t* O; int ldc; const float* gq; const float* gk; LAS float* X;
    DI void operator()(const f32x4 (&acc)[2][2][4][2], const Unit& u, int wr_, int wc_, int fr_, int fq_) const {
        int wr = wr_, wc = wc_, fr = fr_, fq = fq_; asm volatile("" : "+s"(wr), "+s"(wc), "+v"(fr), "+v"(fq));
        const int wid = wr * 4 + wc;
        const int kind = u.pn < 4 ? 0 : (u.pn < 8 ? 1 : 2);
        float part[2][2][4];
#pragma unroll
        for (int ai = 0; ai < 2; ++ai)
#pragma unroll
            for (int bj = 0; bj < 2; ++bj)
#pragma unroll
                for (int m = 0; m < 4; ++m) {
                    float ss = 0.f;
#pragma unroll
                    for (int n = 0; n < 2; ++n)
#pragma unroll
                        for (int i = 0; i < 4; ++i) ss += acc[ai][bj][m][n][i] * acc[ai][bj][m][n][i];
                    ss += __shfl_xor(ss, 16); ss += __shfl_xor(ss, 32);
                    part[ai][bj][m] = ss;
                    if (fq == 0) X[(wid * 16 + ai * 8 + bj * 4 + m) * 16 + fr] = ss;
                }
        asm volatile("s_waitcnt lgkmcnt(0)" ::: "memory");
        __builtin_amdgcn_s_barrier();
        asm volatile("" ::: "memory");
        const float* g = kind == 0 ? gq : gk;
        const int gc0 = 32 * (wc & 1) + 8 * fq;
        float gv[8];
#pragma unroll
        for (int i = 0; i < 8; ++i) gv[i] = g[gc0 + i];
        const int row0 = u.pm * BM + wr * 64 + fr, col0 = u.pn * BM + wc * 32 + 8 * fq;
#pragma unroll
        for (int ai = 0; ai < 2; ++ai)
#pragma unroll
            for (int m = 0; m < 4; ++m) {
                bf16_t* rowp = O + (size_t)(row0 + ai * HALF + m * 16) * ldc;
#pragma unroll
                for (int bj = 0; bj < 2; ++bj) {
                    const float tot = part[ai][bj][m] + X[((wid ^ 1) * 16 + ai * 8 + bj * 4 + m) * 16 + fr];
                    const float r = rsqrtf(tot * (1.f / 64.f) + EPS);
                    float v[8];
#pragma unroll
                    for (int n = 0; n < 2; ++n)
#pragma unroll
                        for (int i = 0; i < 4; ++i) v[n * 4 + i] = kind == 2 ? acc[ai][bj][m][n][i] : acc[ai][bj][m][n][i] * r * gv[n * 4 + i];
                    *(u32x4*)(rowp + col0 + bj * HALF) = pack8(v);
                }
            }
    }
};
struct EpiStoreHN128 {
    static constexpr bool PERM = true;
    bf16_t* O; int ldc; const float* gq; const float* gk; LAS float* X;
    DI void operator()(const f32x4 (&acc)[2][2][4][2], const Unit& u, int wr_, int wc_, int fr_, int fq_) const {
        int wr = wr_, wc = wc_, fr = fr_, fq = fq_; asm volatile("" : "+s"(wr), "+s"(wc), "+v"(fr), "+v"(fq));
        const int wid = wr * 4 + wc;
        const int kind = u.pn < 4 ? 0 : (u.pn < 5 ? 1 : 2);
        float part[2][2][4];
#pragma unroll
        for (int ai = 0; ai < 2; ++ai)
#pragma unroll
            for (int bj = 0; bj < 2; ++bj)
#pragma unroll
                for (int m = 0; m < 4; ++m) {
                    float ss = 0.f;
#pragma unroll
                    for (int n = 0; n < 2; ++n)
#pragma unroll
                        for (int i = 0; i < 4; ++i) ss += acc[ai][bj][m][n][i] * acc[ai][bj][m][n][i];
                    ss += __shfl_xor(ss, 16); ss += __shfl_xor(ss, 32);
                    part[ai][bj][m] = ss;
                    if (fq == 0) X[(wid * 16 + ai * 8 + bj * 4 + m) * 16 + fr] = ss;
                }
        asm volatile("s_waitcnt lgkmcnt(0)" ::: "memory");
        __builtin_amdgcn_s_barrier();
        asm volatile("" ::: "memory");
        const float* g = kind == 0 ? gq : gk;
        const int pos0 = 32 * wc + 8 * fq;
        float gv[8];
#pragma unroll
        for (int i = 0; i < 8; ++i) gv[i] = g[gqa_dim_of_pos(pos0 + i)];
        const int axis = wc >> 1, f0 = 16 * (wc & 1) + 4 * fq;
        float invf[4];
#pragma unroll
        for (int j = 0; j < 4; ++j) invf[j] = fexp2(-(float)(f0 + j) * (L2_10000 / 32.f));
        const int bb = u.pm / 9, sub = u.pm - bb * 9;
        const bool latent = sub != 0;
        const int row0 = u.pm * BM + wr * 64 + fr, col0 = u.pn * BM + wc * 32 + 8 * fq;
        const int wb = wr * 4;
#pragma unroll
        for (int ai = 0; ai < 2; ++ai)
#pragma unroll
            for (int m = 0; m < 4; ++m) {
                bf16_t* rowp = O + (size_t)(row0 + ai * HALF + m * 16) * ldc;
                const int sidx = (sub - 1) * 256 + ai * HALF + wr * 64 + m * 16 + fr;
                const float posv = (float)(axis ? (sidx & 63) : (sidx >> 6));
                float cs[4], sn[4];
#pragma unroll
                for (int j = 0; j < 4; ++j) { const float ang = posv * invf[j]; cs[j] = __cosf(ang); sn[j] = __sinf(ang); }
#pragma unroll
                for (int bj = 0; bj < 2; ++bj) {
                    const int cb = ai * 8 + bj * 4 + m;
                    const float tot = X[((wb + 0) * 16 + cb) * 16 + fr] + X[((wb + 1) * 16 + cb) * 16 + fr] + X[((wb + 2) * 16 + cb) * 16 + fr] + X[((wb + 3) * 16 + cb) * 16 + fr];
                    const float r = rsqrtf(tot * (1.f / 128.f) + EPS);
                    float v[8];
#pragma unroll
                    for (int n = 0; n < 2; ++n)
#pragma unroll
                        for (int i = 0; i < 4; ++i) v[n * 4 + i] = kind == 2 ? acc[ai][bj][m][n][i] : acc[ai][bj][m][n][i] * r * gv[n * 4 + i];
                    if (kind != 2 && latent) {
#pragma unroll
                        for (int j = 0; j < 4; ++j) { const float x1 = v[2 * j], x2 = v[2 * j + 1]; v[2 * j] = x1 * cs[j] - x2 * sn[j]; v[2 * j + 1] = x1 * sn[j] + x2 * cs[j]; }
                    }
                    *(u32x4*)(rowp + col0 + bj * HALF) = pack8(v);
                }
            }
    }
};
struct EpiMlaZ {
    static constexpr bool PERM = true;
    bf16_t* O; float* SSQ;
    DI void operator()(const f32x4 (&acc)[2][2][4][2], const Unit& u, int wr_, int wc_, int fr_, int fq_) const {
        int wr = wr_, wc = wc_, fr = fr_, fq = fq_; asm volatile("" : "+s"(wr), "+s"(wc), "+v"(fr), "+v"(fq));
        const int row0 = u.pm * BM + wr * 64 + fr, col0 = u.pn * BM + wc * 32 + 8 * fq;
#pragma unroll
        for (int ai = 0; ai < 2; ++ai)
#pragma unroll
            for (int m = 0; m < 4; ++m) {
                const int row = row0 + ai * HALF + m * 16;
                bf16_t* rowp = O + (size_t)row * 768;
#pragma unroll
                for (int bj = 0; bj < 2; ++bj) {
                    const f32x4 v0 = acc[ai][bj][m][0], v1 = acc[ai][bj][m][1];
                    *(u32x4*)(rowp + col0 + bj * HALF) = (u32x4){pk_bf16(v0[0], v0[1]), pk_bf16(v0[2], v0[3]), pk_bf16(v1[0], v1[1]), pk_bf16(v1[2], v1[3])};
                    float ss = 0.f;
#pragma unroll
                    for (int i = 0; i < 4; ++i) ss += v0[i] * v0[i] + v1[i] * v1[i];
                    ss += __shfl_xor(ss, 16); ss += __shfl_xor(ss, 32);
                    const int cbase = u.pn * BM + bj * HALF + wc * 32;
                    const int cat = cbase < 384 ? 0 : (cbase < 640 ? 1 : (cbase < 672 ? 2 : 3));
                    if (fq == 0 && cat < 3) atomicAdd(SSQ + (size_t)row * 4 + cat, ss);
                }
            }
    }
};
struct EpiMlaQ {
    static constexpr bool PERM = true;
    bf16_t* O; const float* SSQ; const float* gqn; LAS float* X;
    DI void operator()(const f32x4 (&acc)[2][2][4][2], const Unit& u, int wr_, int wc_, int fr_, int fq_) const {
        int wr = wr_, wc = wc_, fr = fr_, fq = fq_; asm volatile("" : "+s"(wr), "+s"(wc), "+v"(fr), "+v"(fq));
        const int wid = wr * 4 + wc, wb = wr * 4;
#pragma unroll
        for (int ai = 0; ai < 2; ++ai)
#pragma unroll
            for (int bj = 0; bj < 2; ++bj)
#pragma unroll
                for (int m = 0; m < 4; ++m) {
                    float ss = 0.f;
#pragma unroll
                    for (int n = 0; n < 2; ++n)
#pragma unroll
                        for (int i = 0; i < 4; ++i) ss += acc[ai][bj][m][n][i] * acc[ai][bj][m][n][i];
                    ss += __shfl_xor(ss, 16); ss += __shfl_xor(ss, 32);
                    if (fq == 0) X[(wid * 16 + ai * 8 + bj * 4 + m) * 16 + fr] = ss;
                }
        asm volatile("s_waitcnt lgkmcnt(0)" ::: "memory");
        __builtin_amdgcn_s_barrier();
        asm volatile("" ::: "memory");
        const int pos0 = 32 * wc + 8 * fq;
        const int axis = fq >> 1;
        const int bb = u.pm / 9, sub = u.pm - bb * 9;
        const bool latent = sub != 0;
        const int row0 = u.pm * BM + wr * 64 + fr;
#pragma unroll
        for (int ai = 0; ai < 2; ++ai)
#pragma unroll
            for (int m = 0; m < 4; ++m) {
                int pz = pos0; asm volatile("" : "+v"(pz));
                float gv[8];
#pragma unroll
                for (int i = 0; i < 8; ++i) gv[i] = pz < 96 ? gqn[mla_dim_of_pos(pz + i)] : 0.f;
                float invf[4];
#pragma unroll
                for (int j = 0; j < 4; ++j) invf[j] = fexp2(-(float)(((pz >> 3) & 1) * 4 + j) * (L2_10000 / 8.f));
                const int row = row0 + ai * HALF + m * 16;
                const float rq0 = rsqrtf(SSQ[(size_t)row * 4 + 0] * (1.f / 384.f) + EPS);
                const int sidx = (sub - 1) * 256 + ai * HALF + wr * 64 + m * 16 + fr;
                const float posv = (float)(axis ? (sidx & 63) : (sidx >> 6));
                float cs[4], sn[4];
#pragma unroll
                for (int j = 0; j < 4; ++j) { cs[j] = 1.f; sn[j] = 0.f; }
                if (wc == 2 && latent) {
#pragma unroll
                    for (int j = 0; j < 4; ++j) { const float ang = posv * invf[j]; cs[j] = __cosf(ang); sn[j] = __sinf(ang); }
                }
#pragma unroll
                for (int bj = 0; bj < 2; ++bj) {
                    const int cb = ai * 8 + bj * 4 + m;
                    const float tot = X[((wb + 0) * 16 + cb) * 16 + fr] + X[((wb + 1) * 16 + cb) * 16 + fr] + X[((wb + 2) * 16 + cb) * 16 + fr];
                    const float r = rq0 * rsqrtf(rq0 * rq0 * tot * (1.f / 96.f) + EPS);
                    float v[8];
#pragma unroll
                    for (int n = 0; n < 2; ++n)
#pragma unroll
                        for (int i = 0; i < 4; ++i) v[n * 4 + i] = acc[ai][bj][m][n][i] * r * gv[n * 4 + i];
                    if (wc == 2 && latent) {
#pragma unroll
                        for (int j = 0; j < 4; ++j) { const float x1 = v[2 * j], x2 = v[2 * j + 1]; v[2 * j] = x1 * cs[j] - x2 * sn[j]; v[2 * j + 1] = x1 * sn[j] + x2 * cs[j]; }
                    }
                    if (wc < 3) *(u32x4*)(O + (size_t)row * 1536 + (u.pn * 2 + bj) * 96 + pos0) = pack8(v);
                }
                __builtin_amdgcn_sched_barrier(0);
            }
    }
};
struct EpiMlaKV {
    static constexpr bool PERM = true;
    bf16_t* O; const float* SSQ; const bf16_t* Z; const float* gkn; LAS float* X;
    DI void operator()(const f32x4 (&acc)[2][2][4][2], const Unit& u, int wr_, int wc_, int fr_, int fq_) const {
        int wr = wr_, wc = wc_, fr = fr_, fq = fq_; asm volatile("" : "+s"(wr), "+s"(wc), "+v"(fr), "+v"(fq));
        const int wid = wr * 4 + wc, wb = wr * 4;
#pragma unroll
        for (int ai = 0; ai < 2; ++ai)
#pragma unroll
            for (int bj = 0; bj < 2; ++bj)
#pragma unroll
                for (int m = 0; m < 4; ++m) {
                    float ss = 0.f;
#pragma unroll
                    for (int n = 0; n < 2; ++n)
#pragma unroll
                        for (int i = 0; i < 4; ++i) ss += acc[ai][bj][m][n][i] * acc[ai][bj][m][n][i];
                    ss += __shfl_xor(ss, 16); ss += __shfl_xor(ss, 32);
                    if (fq == 0) X[(wid * 16 + ai * 8 + bj * 4 + m) * 16 + fr] = ss;
                }
        asm volatile("s_waitcnt lgkmcnt(0)" ::: "memory");
        __builtin_amdgcn_s_barrier();
        asm volatile("" ::: "memory");
        const int pos0 = 32 * (wc & 1) + 8 * fq;
        const int axis = fq >> 1;
        const int bb = u.pm / 9, sub = u.pm - bb * 9;
        const bool latent = sub != 0;
        const int row0 = u.pm * BM + wr * 64 + fr;
#pragma unroll
        for (int ai = 0; ai < 2; ++ai)
#pragma unroll
            for (int m = 0; m < 4; ++m) {
                int pz = pos0; asm volatile("" : "+v"(pz));
                const int i0 = ((pz >> 3) & 1) * 4;
                float gv[8];
#pragma unroll
                for (int i = 0; i < 8; ++i) gv[i] = gkn[pz + i];
                float invf[4], g1[4], g2[4];
#pragma unroll
                for (int j = 0; j < 4; ++j) { invf[j] = fexp2(-(float)(i0 + j) * (L2_10000 / 8.f)); g1[j] = gkn[64 + 16 * axis + i0 + j]; g2[j] = gkn[64 + 16 * axis + i0 + j + 8]; }
                const int row = row0 + ai * HALF + m * 16;
                const float rkv0 = rsqrtf(SSQ[(size_t)row * 4 + 1] * (1.f / 256.f) + EPS);
                const float ssr = SSQ[(size_t)row * 4 + 2];
                float x1[4], x2[4], cs[4], sn[4];
                if (wc == 2) {
                    const bf16_t* zr = Z + (size_t)row * 768 + 640 + 16 * axis + i0;
                    const u32x2 a1 = *(const u32x2*)zr, a2 = *(const u32x2*)(zr + 8);
                    x1[0] = bf_lo(a1[0]); x1[1] = bf_hi(a1[0]); x1[2] = bf_lo(a1[1]); x1[3] = bf_hi(a1[1]);
                    x2[0] = bf_lo(a2[0]); x2[1] = bf_hi(a2[0]); x2[2] = bf_lo(a2[1]); x2[3] = bf_hi(a2[1]);
                    const int sidx = (sub - 1) * 256 + ai * HALF + wr * 64 + m * 16 + fr;
                    const float posv = (float)(axis ? (sidx & 63) : (sidx >> 6));
#pragma unroll
                    for (int j = 0; j < 4; ++j) { const float ang = posv * invf[j]; cs[j] = latent ? __cosf(ang) : 1.f; sn[j] = latent ? __sinf(ang) : 0.f; }
                }
#pragma unroll
                for (int bj = 0; bj < 2; ++bj) {
                    const int cb = ai * 8 + bj * 4 + m;
                    const float ssn = X[((wb + 0) * 16 + cb) * 16 + fr] + X[((wb + 1) * 16 + cb) * 16 + fr];
                    const float rk = rsqrtf((rkv0 * rkv0 * ssn + ssr) * (1.f / 96.f) + EPS);
                    bf16_t* hp = O + (size_t)row * 2560 + (u.pn * 2 + bj) * 160;
                    float v[8];
                    if (wc < 2) {
#pragma unroll
                        for (int n = 0; n < 2; ++n)
#pragma unroll
                            for (int i = 0; i < 4; ++i) v[n * 4 + i] = acc[ai][bj][m][n][i] * (rkv0 * rk) * gv[n * 4 + i];
                        *(u32x4*)(hp + pos0) = pack8(v);
                    } else {
#pragma unroll
                        for (int n = 0; n < 2; ++n)
#pragma unroll
                            for (int i = 0; i < 4; ++i) v[n * 4 + i] = acc[ai][bj][m][n][i] * rkv0;
                        *(u32x4*)(hp + 96 + pos0) = pack8(v);
                        if (wc == 2) {
                            float w[8];
#pragma unroll
                            for (int j = 0; j < 4; ++j) {
                                const float y1 = x1[j] * rk * g1[j], y2 = x2[j] * rk * g2[j];
                                w[2 * j] = y1 * cs[j] - y2 * sn[j]; w[2 * j + 1] = y1 * sn[j] + y2 * cs[j];
                            }
                            *(u32x4*)(hp + 64 + 8 * fq) = pack8(w);
                        }
                    }
                }
                __builtin_amdgcn_sched_barrier(0);
            }
    }
};
struct EpiSwiglu {
    static constexpr bool PERM = true;
    bf16_t* O; int ldc;
    DI void operator()(const f32x4 (&acc)[2][2][4][2], const Unit& u, int wr, int wc, int fr, int fq) const {
        const int row0 = u.pm * BM + wr * 64 + fr, col0 = u.pn * HALF + wc * 32 + 8 * fq;
#pragma unroll
        for (int ai = 0; ai < 2; ++ai)
#pragma unroll
            for (int m = 0; m < 4; ++m) {
                float v[8];
#pragma unroll
                for (int n = 0; n < 2; ++n)
#pragma unroll
                    for (int i = 0; i < 4; ++i) v[n * 4 + i] = silu_f(acc[ai][0][m][n][i]) * acc[ai][1][m][n][i];
                *(u32x4*)(O + (size_t)(row0 + ai * HALF + m * 16) * ldc + col0) = pack8(v);
            }
    }
};
struct EpiGluRes {
    static constexpr bool PERM = true;
    float* lat; float* xc; const float* ada; int gidx;
    DI void operator()(const f32x4 (&acc)[2][2][4][2], const Unit& u, int wr, int wc, int fr, int fq) const {
        float* base = tile_res_base(lat, xc, u.pm);
        const float* gate = ada + (size_t)tile_ada_row(u.pm) * 6144 + gidx * 1024;
        const int col0 = u.pn * HALF + wc * 32 + 8 * fq;
        const f32x4 g0 = *(const f32x4*)(gate + col0), g1 = *(const f32x4*)(gate + col0 + 4);
#pragma unroll
        for (int ai = 0; ai < 2; ++ai)
#pragma unroll
            for (int m = 0; m < 4; ++m) {
                float* rp = base + ((size_t)(ai * HALF + wr * 64 + m * 16 + fr) << 10) + col0;
                f32x4 x0 = *(f32x4*)rp, x1 = *(f32x4*)(rp + 4);
#pragma unroll
                for (int i = 0; i < 4; ++i) {
                    x0[i] += g0[i] * (acc[ai][0][m][0][i] * sigmoid_f(acc[ai][1][m][0][i]));
                    x1[i] += g1[i] * (acc[ai][0][m][1][i] * sigmoid_f(acc[ai][1][m][1][i]));
                }
                *(f32x4*)rp = x0; *(f32x4*)(rp + 4) = x1;
            }
    }
};
struct EpiRes {
    static constexpr bool PERM = false;
    float* lat; float* xc; const float* ada; int gidx; const float* lat_in; const float* xc_in;
    DI void operator()(const f32x4 (&acc)[2][2][4][2], const Unit& u, int wr, int wc, int fr, int fq) const {
        float* base = tile_res_base(lat, xc, u.pm);
        const float* base_in = tile_res_base((float*)lat_in, (float*)xc_in, u.pm);
        const float* gate = ada + (size_t)tile_ada_row(u.pm) * 6144 + gidx * 1024;
        const int col0 = u.pn * BM + wc * 32 + 4 * fq;
        f32x4 gv[2][2];
#pragma unroll
        for (int bj = 0; bj < 2; ++bj)
#pragma unroll
            for (int n = 0; n < 2; ++n) gv[bj][n] = *(const f32x4*)(gate + col0 + bj * HALF + n * 16);
#pragma unroll
        for (int ai = 0; ai < 2; ++ai)
#pragma unroll
            for (int m = 0; m < 4; ++m) {
                float* rp = base + ((size_t)(ai * HALF + wr * 64 + m * 16 + fr) << 10) + col0;
                const float* rpi = base_in + ((size_t)(ai * HALF + wr * 64 + m * 16 + fr) << 10) + col0;
#pragma unroll
                for (int bj = 0; bj < 2; ++bj)
#pragma unroll
                    for (int n = 0; n < 2; ++n) {
                        f32x4 x = *(const f32x4*)(rpi + bj * HALF + n * 16);
                        x += gv[bj][n] * acc[ai][bj][m][n];
                        *(f32x4*)(rp + bj * HALF + n * 16) = x;
                    }
            }
    }
};

template <class Epi>
DI void gemm_phase(LAS unsigned char* lds, const Gemm g, const Order& S, const Epi& E) {
    const int TIDX = otid(); const int BIDX = obid(); (void)TIDX; (void)BIDX;
    const int tid = TIDX, wid = __builtin_amdgcn_readfirstlane(tid >> 6), lane = tid & 63, wr = wid >> 2, wc = wid & 3, fr = lane & 15, fq = lane >> 4;
    const int K = g.K, nt = K / BK;
    unsigned voffA[2], voffB[2];
#pragma unroll
    for (int i = 0; i < 2; ++i) { int R, C; stage_rc(tid * 16 + i * 8192, R, C); const int Rb = Epi::PERM ? ((R & ~31) + perm32(R & 31)) : R;
        voffA[i] = (unsigned)(R * g.lda + C) * 2u; voffB[i] = (unsigned)(Rb * K + C) * 2u; }
    const size_t kstep = (size_t)(BK * 2);
    const size_t hstep = (size_t)HALF * K * 2, hstepA = (size_t)HALF * g.lda * 2;
    const size_t tstep = 2 * hstep, tstepA = 2 * hstepA;
    const unsigned ldsw = (unsigned)wid * 1024u;
    const int aoff = lds_byte(wr * 64 + fr, fq * 8), boff = lds_byte(wc * 32 + fr, fq * 8);
#define PG8_SA(b, h) (((b) * 2 + (h)) * HTB)
#define PG8_SB(b, h) ((4 + (b) * 2 + (h)) * HTB)
#define PG8_STAGE(bufoff, gbase, voff) do { _Pragma("unroll") for (int _i = 0; _i < 2; ++_i) \
        __builtin_amdgcn_global_load_lds((const unsigned*)((const char*)(gbase) + (voff)[_i]), (LAS unsigned*)(lds + (bufoff) + ldsw + _i * 8192), 16, 0, 0); } while (0)
#define PG8_LDA(dst, b, h) do { _Pragma("unroll") for (int m = 0; m < 4; ++m) _Pragma("unroll") for (int k = 0; k < 2; ++k) dst[m][k] = *(const LAS bf16x8*)(lds + PG8_SA(b, h) + aoff + m * 2048 + k * 1024); } while (0)
#define PG8_LDB(dst, b, h) do { _Pragma("unroll") for (int n = 0; n < 2; ++n) _Pragma("unroll") for (int k = 0; k < 2; ++k) dst[n][k] = *(const LAS bf16x8*)(lds + PG8_SB(b, h) + boff + n * 2048 + k * 1024); } while (0)
#define PG8_MMA(ai, bj, At, Bt) do { __builtin_amdgcn_s_setprio(1); _Pragma("unroll") for (int m = 0; m < 4; ++m) _Pragma("unroll") for (int n = 0; n < 2; ++n) _Pragma("unroll") for (int k = 0; k < 2; ++k) \
        acc[ai][bj][m][n] = __builtin_amdgcn_mfma_f32_16x16x32_bf16(Bt[n][k], At[m][k], acc[ai][bj][m][n], 0, 0, 0); __builtin_amdgcn_s_setprio(0); } while (0)
#define PG8_WAIT_V(n) asm volatile("s_waitcnt vmcnt(" #n ")" ::: "memory")
#define PG8_WAIT_L(n) asm volatile("s_waitcnt lgkmcnt(" #n ")" ::: "memory")
#define PG8_BAR __builtin_amdgcn_s_barrier()
#define PG8_SCHED __builtin_amdgcn_sched_barrier(0)
    Unit cur, nxt; int ui = 0;
    if (!S.next(0, cur)) return;
    f32x4 acc[2][2][4][2];
#pragma unroll
    for (int a = 0; a < 2; ++a)
#pragma unroll
        for (int b = 0; b < 2; ++b)
#pragma unroll
            for (int m = 0; m < 4; ++m)
#pragma unroll
                for (int n = 0; n < 2; ++n) acc[a][b][m][n] = (f32x4){0.f, 0.f, 0.f, 0.f};
    bf16x8 At[4][2], B0[2][2], B1[2][2];
    const char* cA = (const char*)g.A + (size_t)cur.pm * tstepA; const char* cB = (const char*)g.Bt + (size_t)cur.pn * tstep;
    PG8_STAGE(PG8_SB(0, 0), cB, voffB); PG8_STAGE(PG8_SA(0, 0), cA, voffA); PG8_STAGE(PG8_SB(0, 1), cB + hstep, voffB); PG8_STAGE(PG8_SA(0, 1), cA + hstepA, voffA);
    if (wr == 1) PG8_BAR;
    PG8_WAIT_V(4); PG8_BAR;
    PG8_STAGE(PG8_SB(1, 0), cB + kstep, voffB); PG8_STAGE(PG8_SA(1, 0), cA + kstep, voffA); PG8_STAGE(PG8_SB(1, 1), cB + hstep + kstep, voffB);
    PG8_WAIT_V(6); PG8_BAR;
    for (;;) {
        const bool has_next = S.next(ui + 1, nxt);
        const char* nA = has_next ? (const char*)g.A + (size_t)nxt.pm * tstepA : cA; const char* nB = has_next ? (const char*)g.Bt + (size_t)nxt.pn * tstep : cB;
        for (int t = 0; t < nt; t += 2) {
            const bool last = (t == nt - 2);
            const char* a1 = cA + (size_t)(t + 1) * kstep;
            const char* a2 = last ? nA : cA + (size_t)(t + 2) * kstep; const char* b2 = last ? nB : cB + (size_t)(t + 2) * kstep;
            const char* a3 = a2 + kstep; const char* b3 = b2 + kstep;
            PG8_LDB(B0, 0, 0); PG8_SCHED; PG8_LDA(At, 0, 0); PG8_STAGE(PG8_SA(1, 1), a1 + hstepA, voffA);
            PG8_WAIT_L(8); PG8_BAR; PG8_WAIT_L(0); PG8_MMA(0, 0, At, B0); PG8_BAR; PG8_SCHED;
            PG8_LDB(B1, 0, 1); PG8_STAGE(PG8_SB(0, 0), b2, voffB);
            PG8_BAR; PG8_WAIT_L(0); PG8_MMA(0, 1, At, B1); PG8_BAR;
            PG8_LDA(At, 0, 1); PG8_STAGE(PG8_SA(0, 0), a2, voffA);
            PG8_BAR; PG8_WAIT_L(0); PG8_MMA(1, 0, At, B0); PG8_BAR; PG8_SCHED;
            PG8_STAGE(PG8_SB(0, 1), b2 + hstep, voffB);
            PG8_WAIT_V(6); PG8_BAR; PG8_MMA(1, 1, At, B1); PG8_BAR;
            PG8_LDB(B0, 1, 0); PG8_SCHED; PG8_LDA(At, 1, 0); PG8_STAGE(PG8_SA(0, 1), a2 + hstepA, voffA);
            PG8_WAIT_L(8); PG8_BAR; PG8_WAIT_L(0); PG8_MMA(0, 0, At, B0); PG8_BAR; PG8_SCHED;
            PG8_LDB(B1, 1, 1); PG8_STAGE(PG8_SB(1, 0), b3, voffB);
            PG8_BAR; PG8_WAIT_L(0); PG8_MMA(0, 1, At, B1); PG8_BAR;
            PG8_LDA(At, 1, 1); PG8_STAGE(PG8_SA(1, 0), a3, voffA);
            PG8_BAR; PG8_WAIT_L(0); PG8_MMA(1, 0, At, B0); PG8_BAR; PG8_SCHED;
            PG8_STAGE(PG8_SB(1, 1), b3 + hstep, voffB);
            PG8_WAIT_V(6); PG8_BAR; PG8_MMA(1, 1, At, B1); PG8_BAR;
        }
        E(acc, cur, wr, wc, fr, fq);
        if (!has_next) break;
#pragma unroll
        for (int a = 0; a < 2; ++a)
#pragma unroll
            for (int b = 0; b < 2; ++b)
#pragma unroll
                for (int m = 0; m < 4; ++m)
#pragma unroll
                    for (int n = 0; n < 2; ++n) acc[a][b][m][n] = (f32x4){0.f, 0.f, 0.f, 0.f};
        cur = nxt; cA = nA; cB = nB; ++ui;
    }
    PG8_WAIT_V(0);
    if (wr == 0) PG8_BAR;
    PG8_BAR;
#undef PG8_SA
#undef PG8_SB
#undef PG8_STAGE
#undef PG8_LDA
#undef PG8_LDB
#undef PG8_MMA
#undef PG8_WAIT_V
#undef PG8_WAIT_L
#undef PG8_BAR
#undef PG8_SCHED
}
}

template <class Epi>
DI void run_gemm(LAS unsigned char* lds, const bf16_t* A, int lda, const bf16_t* Bt, int N, int K, int skipctx, const Epi& E) {
    const int BIDX = obid();
    asm volatile("" : "+s"(K));
    pg8::Order S; S.init(N, (int)gridDim.x, BIDX, skipctx);
    pg8::Gemm g{A, Bt, NR, N, K, lda};
    pg8::gemm_phase<Epi>(lds, g, S, E);
}

struct WDesc { const float* src; bf16_t* dst; int K, N, Nout, half; const float* kscale; int perm; };

DI WDesc wdesc_of(const Params& p, int m) {
    unsigned char* ws = p.ws;
    if (m < 4) return WDesc{p.in[I_FWIN] + (size_t)m * 1024 * 5632, (bf16_t*)(ws + OFF_WFI + m * SZ_WFI), 1024, 5632, 5632, 2816, nullptr, 0};
    if (m < 8) return WDesc{p.in[I_FWOUT] + (size_t)(m - 4) * 2816 * 1024, (bf16_t*)(ws + OFF_WFO + (m - 4) * SZ_WFO), 2816, 1024, 1024, 0, nullptr, 0};
    switch (m) {
        case 8: return WDesc{p.in[I_MWIN], (bf16_t*)(ws + OFF_WMI), 1024, 672, 768, 0, nullptr, 0};
        case 9: return WDesc{p.in[I_MWUQ], (bf16_t*)(ws + OFF_WUQ), 384, 1536, 2048, 0, p.in[I_MGQ], 2};
        case 10: return WDesc{p.in[I_MWUKV], (bf16_t*)(ws + OFF_WUKV), 256, 2048, 2048, 0, p.in[I_MGKV], 0};
        case 11: return WDesc{p.in[I_MWO], (bf16_t*)(ws + OFF_WMO), 1024, 1024, 1024, 0, nullptr, 0};
        case 12: return WDesc{p.in[I_SWGLU], (bf16_t*)(ws + OFF_WGLU), 1024, 2048, 2048, 1024, nullptr, 0};
        case 13: return WDesc{p.in[I_NWQKV], (bf16_t*)(ws + OFF_WNQ), 1024, 3072, 3072, 0, nullptr, 0};
        case 14: return WDesc{p.in[I_NWO], (bf16_t*)(ws + OFF_WNO), 1024, 1024, 1024, 0, nullptr, 0};
        case 15: return WDesc{p.in[I_GWQKV], (bf16_t*)(ws + OFF_WGQ), 1024, 1536, 1536, 0, nullptr, 1};
        default: return WDesc{p.in[I_GWO], (bf16_t*)(ws + OFF_WGO), 1024, 1024, 1024, 0, nullptr, 0};
    }
}
DI void prep_tile(LAS float* tile, const WDesc w, int tidx, int lane) {
    const int ntk = w.K / 64;
    const int kt = tidx % ntk, nt = tidx / ntk;
    const int n0 = nt * 64;
    int scol = n0;
    if (w.half) { const int t256 = n0 >> 8, ww = n0 & 255; scol = (ww >= 128 ? w.half : 0) + t256 * 128 + (ww & 127); }
    const int c4 = (lane & 15) * 4;
    f32x4 v[16];
#pragma unroll
    for (int i = 0; i < 16; ++i) {
        const int r = (lane >> 4) + 4 * i;
        v[i] = (f32x4){0.f, 0.f, 0.f, 0.f};
        if (w.perm == 2) {
            const float* rp = w.src + (size_t)(kt * 64 + r) * w.N + (n0 >> 7) * 96;
#pragma unroll
            for (int j = 0; j < 4; ++j) { const int pos = (n0 & 127) + c4 + j; v[i][j] = pos < 96 ? rp[mla_dim_of_pos(pos)] : 0.f; }
        } else if (w.perm == 1 && n0 < 1280) {
            const float* rp = w.src + (size_t)(kt * 64 + r) * w.N + (n0 & ~127);
#pragma unroll
            for (int j = 0; j < 4; ++j) v[i][j] = rp[gqa_dim_of_pos((n0 & 127) + c4 + j)];
        } else if (scol + c4 < w.N) v[i] = *(const f32x4*)(w.src + (size_t)(kt * 64 + r) * w.N + scol + c4);
    }
#pragma unroll
    for (int i = 0; i < 16; ++i) {
        const int r = (lane >> 4) + 4 * i;
        f32x4 x = v[i];
        if (w.kscale) x *= w.kscale[kt * 64 + r];
#pragma unroll
        for (int j = 0; j < 4; ++j) tile[r * 65 + c4 + j] = x[j];
    }
    bf16_t* d = w.dst + (size_t)(n0 + lane) * w.K + kt * 64;
#pragma unroll
    for (int q = 0; q < 8; ++q) {
        float f[8];
#pragma unroll
        for (int k = 0; k < 8; ++k) f[k] = tile[(q * 8 + k) * 65 + lane];
        *(u32x4*)(d + q * 8) = pack8(f);
    }
}

DI void ada_item(const Params& p, float* ADA, int item, int lane) {
    const int layer = item / 192, n0 = (item - layer * 192) * 32;
    const int r = lane & 31, kh = lane >> 5;
    const float* W = p.in[I_ADAW] + (size_t)layer * 1024 * 6144 + n0 + r;
    const float* cb = p.in[I_C] + r * 1024 + kh * 8;
    const float* cc = p.in[I_CCTX] + kh * 8;
    f32x16 acc;
#pragma unroll
    for (int i = 0; i < 16; ++i) acc[i] = 0.f;
    float accc = 0.f;
    for (int k0 = 0; k0 < 1024; k0 += 32) {
        float wv[16], cv[16], xv[16];
#pragma unroll
        for (int h2 = 0; h2 < 2; ++h2) {
            const f32x4 c0 = *(const f32x4*)(cb + k0 + h2 * 16), c1 = *(const f32x4*)(cb + k0 + h2 * 16 + 4);
            const f32x4 x0 = *(const f32x4*)(cc + k0 + h2 * 16), x1 = *(const f32x4*)(cc + k0 + h2 * 16 + 4);
#pragma unroll
            for (int u = 0; u < 4; ++u) { cv[h2 * 8 + u] = c0[u]; cv[h2 * 8 + 4 + u] = c1[u]; xv[h2 * 8 + u] = x0[u]; xv[h2 * 8 + 4 + u] = x1[u]; }
#pragma unroll
            for (int u = 0; u < 8; ++u) wv[h2 * 8 + u] = W[(size_t)(k0 + h2 * 16 + kh * 8 + u) * 6144];
        }
#pragma unroll
        for (int u = 0; u < 16; ++u) {
            acc = __builtin_amdgcn_mfma_f32_32x32x2f32(silu_f(cv[u]), wv[u], acc, 0, 0, 0);
            accc += silu_f(xv[u]) * wv[u];
        }
    }
    accc += __shfl_xor(accc, 32);
    const float bias = p.in[I_ADAB][layer * 6144 + n0 + r];
#pragma unroll
    for (int i = 0; i < 16; ++i) {
        const int v = (i & 3) + 8 * (i >> 2) + 4 * kh;
        ADA[((size_t)layer * 33 + v) * 6144 + n0 + r] = acc[i] + bias;
    }
    if (kh == 0) ADA[((size_t)layer * 33 + 32) * 6144 + n0 + r] = accc + bias;
}

DI void phase0(LAS unsigned char* lds, const Params& p, float* ADA, unsigned* counter) {
    const int TIDX = otid();
    const int wave = __builtin_amdgcn_readfirstlane(TIDX >> 6), lane = TIDX & 63;
    LAS float* tile = (LAS float*)(lds + wave * 16640);
    constexpr int NADA = 4 * 192;
    for (;;) {
        int item = 0;
        if (lane == 0) item = (int)atomicAdd(counter, 1u);
        item = __builtin_amdgcn_readfirstlane(item);
        if (item < NADA) { ada_item(p, ADA, item, lane); continue; }
        int t = item - NADA, m = 0;
        bool found = false;
        for (m = 0; m < 17; ++m) {
            const WDesc w = wdesc_of(p, m);
            const int nt = (w.K / 64) * (w.Nout / 64);
            if (t < nt) { prep_tile(tile, w, t, lane); found = true; break; }
            t -= nt;
        }
        if (!found) break;
    }
}

DI void norm_phase(const float* lat_in, const float* ctx_in, float* lat_out, float* ctx_out, bool copy, const float* g,
                   const float* ada, int shidx, bf16_t* H, bool skipctx, float* ssq_zero = nullptr) {
    const int TIDX = otid(); const int BIDX = obid(); (void)TIDX; (void)BIDX;
    const int wave = TIDX >> 6, lane = TIDX & 63;
    for (int row = BIDX * 8 + wave; row < NR; row += gridDim.x * 8) {
        const int b = row / TT, t = row - b * TT;
        if (skipctx && t < CTXL) continue;
        if (ssq_zero && lane < 4) ssq_zero[(size_t)row * 4 + lane] = 0.f;
        const size_t ro = t < CTXL ? ((size_t)(b * CTXL + t) << 10) : ((size_t)(b * SEQ + t - CTXL) << 10);
        const float* src = (t < CTXL ? ctx_in : lat_in) + ro;
        const float* sh = ada + (size_t)(t < CTXL ? 32 : b) * 6144 + shidx * 1024;
        const float* sc = sh + 1024;
        f32x4 a[4];
        a[0] = *(const f32x4*)(src + lane * 8); a[1] = *(const f32x4*)(src + lane * 8 + 4);
        a[2] = *(const f32x4*)(src + 512 + lane * 8); a[3] = *(const f32x4*)(src + 512 + lane * 8 + 4);
        float ss = 0.f;
#pragma unroll
        for (int i = 0; i < 4; ++i)
#pragma unroll
            for (int j = 0; j < 4; ++j) ss += a[i][j] * a[i][j];
        ss = wsum(ss);
        const float r = rsqrtf(ss * (1.f / 1024.f) + EPS);
        if (copy) {
            float* dst = (t < CTXL ? ctx_out : lat_out) + ro;
            *(f32x4*)(dst + lane * 8) = a[0]; *(f32x4*)(dst + lane * 8 + 4) = a[1];
            *(f32x4*)(dst + 512 + lane * 8) = a[2]; *(f32x4*)(dst + 512 + lane * 8 + 4) = a[3];
        }
#pragma unroll
        for (int hf = 0; hf < 2; ++hf) {
            const int c0 = hf * 512 + lane * 8;
            float y[8];
#pragma unroll
            for (int q = 0; q < 2; ++q) {
                const f32x4 gv = *(const f32x4*)(g + c0 + q * 4), sv = *(const f32x4*)(sc + c0 + q * 4), hv = *(const f32x4*)(sh + c0 + q * 4);
#pragma unroll
                for (int j = 0; j < 4; ++j) y[q * 4 + j] = a[hf * 2 + q][j] * r * gv[j] * (1.f + sv[j]) + hv[j];
            }
            *(u32x4*)(H + ((size_t)row << 10) + c0) = pack8(y);
        }
    }
}

DI void mla_rope8(float* v, int sub, int s) {
    const float pos = (float)((sub < 2) ? (s >> 6) : (s & 63));
    const bool isx2 = sub & 1;
#pragma unroll
    for (int i = 0; i < 8; ++i) {
        const float other = __shfl_xor(v[i], 1);
        const float ang = pos * fexp2(-(float)i * (L2_10000 / 8.f));
        const float c = __cosf(ang), sn = __sinf(ang);
        v[i] = isx2 ? (other * sn + v[i] * c) : (v[i] * c - other * sn);
    }
}

DI void mla_r2(bf16_t* QB, bf16_t* KV, const bf16_t* Z, const float* gqn, const float* gkn) {
    const int TIDX = otid(); const int BIDX = obid(); (void)TIDX; (void)BIDX;
    const int wave = TIDX >> 6, lane = TIDX & 63, hd = lane >> 2, sub = lane & 3;
    for (int row = BIDX * 8 + wave; row < NR; row += gridDim.x * 8) {
        const int b = row / TT, t = row - b * TT; const bool latent = t >= CTXL; const int s = t - CTXL;
        const bf16_t* z = Z + (size_t)row * 768;
        bf16_t* qp = QB + (size_t)row * 1536 + hd * 96;
        bf16_t* kp = KV + (size_t)row * 2560 + hd * 160;
        unsigned zq[3];
#pragma unroll
        for (int i = 0; i < 3; ++i) zq[i] = *(const unsigned*)(z + lane * 6 + 2 * i);
        const u32x2 zk = *(const u32x2*)(z + 384 + lane * 4);
        const u32x4 q0 = *(const u32x4*)(qp + sub * 16), q1 = *(const u32x4*)(qp + sub * 16 + 8), q2 = *(const u32x4*)(qp + 64 + sub * 8);
        const u32x4 k0 = *(const u32x4*)(kp + sub * 16), k1 = *(const u32x4*)(kp + sub * 16 + 8);
        const u32x4 v0 = *(const u32x4*)(kp + 64 + sub * 16), v1 = *(const u32x4*)(kp + 64 + sub * 16 + 8);
        const u32x4 k2 = *(const u32x4*)(z + 640 + sub * 8);
        asm volatile("s_waitcnt vmcnt(0)" ::: "memory");
        float sq0 = 0.f, sk0 = 0.f;
#pragma unroll
        for (int i = 0; i < 3; ++i) { const float a0 = bf_lo(zq[i]), a1 = bf_hi(zq[i]); sq0 += a0 * a0 + a1 * a1; }
        { const float a0 = bf_lo(zk[0]), a1 = bf_hi(zk[0]), a2 = bf_lo(zk[1]), a3 = bf_hi(zk[1]); sk0 = a0 * a0 + a1 * a1 + a2 * a2 + a3 * a3; }
        sq0 = wsum(sq0); sk0 = wsum(sk0);
        const float rq0 = rsqrtf(sq0 * (1.f / 384.f) + EPS), rk0 = rsqrtf(sk0 * (1.f / 256.f) + EPS);
        float qn[16], qr[8], kn[16], kr[8], vv[16];
        unpack8(q0, qn); unpack8(q1, qn + 8); unpack8(q2, qr);
        unpack8(k0, kn); unpack8(k1, kn + 8); unpack8(k2, kr);
        unpack8(v0, vv); unpack8(v1, vv + 8);
#pragma unroll
        for (int i = 0; i < 16; ++i) { qn[i] *= rq0; kn[i] *= rk0; vv[i] *= rk0; }
#pragma unroll
        for (int i = 0; i < 8; ++i) qr[i] *= rq0;
        float sq = 0.f, sk = 0.f;
#pragma unroll
        for (int i = 0; i < 16; ++i) { sq += qn[i] * qn[i]; sk += kn[i] * kn[i]; }
#pragma unroll
        for (int i = 0; i < 8; ++i) { sq += qr[i] * qr[i]; sk += kr[i] * kr[i]; }
        sq += __shfl_xor(sq, 1); sq += __shfl_xor(sq, 2);
        sk += __shfl_xor(sk, 1); sk += __shfl_xor(sk, 2);
        const float rq = rsqrtf(sq * (1.f / 96.f) + EPS), rk = rsqrtf(sk * (1.f / 96.f) + EPS);
#pragma unroll
        for (int i = 0; i < 16; ++i) { qn[i] *= rq * gqn[sub * 16 + i]; kn[i] *= rk * gkn[sub * 16 + i]; }
#pragma unroll
        for (int i = 0; i < 8; ++i) { qr[i] *= rq * gqn[64 + sub * 8 + i]; kr[i] *= rk * gkn[64 + sub * 8 + i]; }
        if (latent) { mla_rope8(qr, sub, s); mla_rope8(kr, sub, s); }
        *(u32x4*)(qp + sub * 16) = pack8(qn); *(u32x4*)(qp + sub * 16 + 8) = pack8(qn + 8); *(u32x4*)(qp + 64 + sub * 8) = pack8(qr);
        *(u32x4*)(kp + sub * 16) = pack8(kn); *(u32x4*)(kp + sub * 16 + 8) = pack8(kn + 8); *(u32x4*)(kp + 64 + sub * 8) = pack8(kr);
        *(u32x4*)(kp + 96 + sub * 16) = pack8(vv); *(u32x4*)(kp + 96 + sub * 16 + 8) = pack8(vv + 8);
    }
}

template <int HD, int LPH, int ROPE>
DI void headnorm_phase(bf16_t* X, int stride, int nq, int koff, int nk, const float* gq, const float* gk) {
    const int TIDX = otid(); const int BIDX = obid(); (void)TIDX; (void)BIDX;
    const int wave = TIDX >> 6, lane = TIDX & 63, sub = lane % LPH, hl = lane / LPH;
    const int rstep = gridDim.x * 8;
    for (int row = BIDX * 8 + wave; row < NR; row += 2 * rstep) {
        u32x4 u[2][2][2];
#pragma unroll
        for (int rr = 0; rr < 2; ++rr)
#pragma unroll
            for (int pass = 0; pass < 2; ++pass) {
                const int r2 = row + rr * rstep;
                const bool act = (r2 < NR) && (hl < (pass ? nk : nq));
                const bf16_t* ptr = X + (size_t)r2 * stride + (pass ? koff : 0) + hl * HD + sub * 16;
                u[rr][pass][0] = (u32x4){0, 0, 0, 0}; u[rr][pass][1] = (u32x4){0, 0, 0, 0};
                if (act) { u[rr][pass][0] = *(const u32x4*)ptr; u[rr][pass][1] = *(const u32x4*)(ptr + 8); }
            }
        asm volatile("s_waitcnt vmcnt(0)" ::: "memory");
#pragma unroll
        for (int rr = 0; rr < 2; ++rr) {
            const int r2 = row + rr * rstep;
            const int b = r2 / TT, t = r2 - b * TT; const bool latent = t >= CTXL; const int s = t - CTXL;
#pragma unroll
            for (int pass = 0; pass < 2; ++pass) {
                const bool act = (r2 < NR) && (hl < (pass ? nk : nq));
                const float* g = pass ? gk : gq;
                bf16_t* ptr = X + (size_t)r2 * stride + (pass ? koff : 0) + hl * HD + sub * 16;
                float v[16]; unpack8(u[rr][pass][0], v); unpack8(u[rr][pass][1], v + 8);
                float ss = 0.f;
#pragma unroll
                for (int i = 0; i < 16; ++i) ss += v[i] * v[i];
#pragma unroll
                for (int o = 1; o < LPH; o <<= 1) ss += __shfl_xor(ss, o);
                const float rr_ = rsqrtf(ss * (1.f / HD) + EPS);
#pragma unroll
                for (int i = 0; i < 16; ++i) v[i] *= rr_ * g[sub * 16 + i];
                if (ROPE) {
                    if (latent) {
                        const int axis = sub >> 2; const bool isx2 = (sub >> 1) & 1;
                        const float pos = (float)(axis ? (s & 63) : (s >> 6));
#pragma unroll
                        for (int i = 0; i < 16; ++i) {
                            const float other = __shfl_xor(v[i], 2);
                            const int fi = (sub & 1) * 16 + i;
                            const float ang = pos * fexp2(-(float)fi * (L2_10000 / 32.f));
                            const float c = __cosf(ang), sn = __sinf(ang);
                            v[i] = isx2 ? (other * sn + v[i] * c) : (v[i] * c - other * sn);
                        }
                    }
                }
                if (act) { *(u32x4*)ptr = pack8(v); *(u32x4*)(ptr + 8) = pack8(v + 8); }
            }
        }
    }
}

struct AttnArgs { const bf16_t* Q; const bf16_t* K; const bf16_t* V; bf16_t* O; int qs, qh, ks, kh, vs, vh, nheads, gshift, ctx_out; const float* rpb; float sc; };

template <int DK, int DV, int NA>
DI void attn_phase(LAS unsigned char* lds, const AttnArgs a) {
    const int TIDX = otid(); const int BIDX = obid(); (void)TIDX; (void)BIDX;
    constexpr int KROW = DK * 2 + 16, VROW = DV * 2 + 16;
    constexpr int KBUF = 64 * KROW, VBUF = 64 * VROW;
    constexpr int OFFK = 0, OFFV = 2 * KBUF, OFFR = OFFV + 2 * VBUF;
    constexpr int KCH = DK / 8, VCH = DV / 8, NKC = 64 * KCH, NVC = 64 * VCH;
    constexpr int KPT = (NKC + 511) / 512, VPT = (NVC + 511) / 512;
    constexpr int NK0 = DK / 16, NQG = NK0 / 2;
    const int tid = TIDX, wave = __builtin_amdgcn_readfirstlane(tid >> 6), lane = tid & 63, r = lane & 31, hh = lane >> 5;
    const int i16 = lane & 15, tq = i16 >> 2, tp = i16 & 3, blk = (lane >> 4) & 1;
    const int nlat = NB * a.nheads * 8, ntot = nlat + (a.ctx_out ? NB * a.nheads : 0);
    LAS float* rpbL = (LAS float*)(lds + OFFR);
    for (int item = BIDX; item < ntot; item += gridDim.x) {
        int b, h, qb = 0; const bool isctx = item >= nlat;
        if (!isctx) { const int R = item >> 8, u = item & 255; const int qp = (R * 8 + (u & 7)) * 4 + (u >> 6); qb = (u >> 3) & 7; h = qp % a.nheads; b = qp / a.nheads; }
        else { const int bh = item - nlat; h = bh % a.nheads; b = bh / a.nheads; }
        const int hk = h >> a.gshift;
        const size_t rb = (size_t)b * TT;
        const bf16_t* Kb = a.K + hk * a.kh; const bf16_t* Vb = a.V + hk * a.vh;
        int ntiles = isctx ? 4 : 36, rlo = 0, wi = 0, wr0 = 0, c0 = 0;
        if (NA) {
            if (!isctx) { const int i0 = qb * 4; rlo = clampi(i0 - 4, 0, 24); const int rhi = clampi(i0 - 1, 0, 24) + 8; ntiles = 4 + rhi - rlo;
                wi = i0 + (wave >> 1); wr0 = clampi(wi - 4, 0, 24); c0 = (wave & 1) * 32; }
            if (tid < 465) rpbL[64 + tid] = a.rpb[h * 465 + tid] * LOG2E;
        }
        const size_t qrow = rb + (isctx ? 0 : 256 + qb * 256) + wave * 32 + r;
        bf16x8 qf[DK / 16];
#pragma unroll
        for (int k0 = 0; k0 < DK / 16; ++k0) qf[k0] = *(const bf16x8*)(a.Q + qrow * a.qs + h * a.qh + k0 * 16 + hh * 8);
        u32x4 sreg[KPT > VPT ? KPT : VPT];
#define ATT_TILE_ROW(j) ((NA && (j) >= 4) ? rb + 256 + (size_t)(rlo + (j) - 4) * 64 : rb + (size_t)(j) * 64)
#define ATT_GLOADK(j) do { const size_t _tr = ATT_TILE_ROW(j); \
        _Pragma("unroll") for (int _i = 0; _i < KPT; ++_i) { const int _c = tid + _i * 512; if (_c < NKC) { const int _row = _c / KCH, _cc = _c - _row * KCH; sreg[_i] = *(const u32x4*)(Kb + (_tr + _row) * a.ks + _cc * 8); } } } while (0)
#define ATT_GLOADV(j) do { const size_t _tr = ATT_TILE_ROW(j); \
        _Pragma("unroll") for (int _i = 0; _i < VPT; ++_i) { const int _c = tid + _i * 512; if (_c < NVC) { const int _row = _c / VCH, _cc = _c - _row * VCH; sreg[_i] = *(const u32x4*)(Vb + (_tr + _row) * a.vs + _cc * 8); } } } while (0)
#define ATT_LSTOREK(buf) do { \
        _Pragma("unroll") for (int _i = 0; _i < KPT; ++_i) { const int _c = tid + _i * 512; if (_c < NKC) { const int _row = _c / KCH, _cc = _c - _row * KCH; *(LAS u32x4*)(lds + OFFK + (buf) * KBUF + _row * KROW + _cc * 16) = sreg[_i]; } } } while (0)
#define ATT_LSTOREV(buf) do { \
        _Pragma("unroll") for (int _i = 0; _i < VPT; ++_i) { const int _c = tid + _i * 512; if (_c < NVC) { const int _row = _c / VCH, _cc = _c - _row * VCH; *(LAS u32x4*)(lds + OFFV + (buf) * VBUF + _row * VROW + _cc * 16) = sreg[_i]; } } } while (0)
#define ATT_KFRAG(buf, idx) (*(const LAS bf16x8*)(lds + OFFK + (buf) * KBUF + (((idx) / NK0) * 32 + r) * KROW + ((idx) % NK0) * 32 + hh * 16))
#define ATT_QK(dst, buf) do { \
        _Pragma("unroll") for (int _x = 0; _x < 2 * NK0; ++_x) { const bf16x8 kf = ATT_KFRAG(buf, _x); \
            dst[_x / NK0] = __builtin_amdgcn_mfma_f32_32x32x16_bf16(kf, qf[_x % NK0], (_x % NK0) == 0 ? zero16 : dst[_x / NK0], 0, 0, 0); } } while (0)
#define ATT_ACTIVE(j) (!(NA && (j) >= 4) || ((rlo + (j) - 4 >= wr0) && (rlo + (j) - 4 < wr0 + 8)))
#define ATT_TILE(j, S, SN) do { \
        if ((j) + 1 < ntiles) ATT_GLOADV((j) + 1); \
        if (ATT_ACTIVE(j)) { \
            const int nb = ((j) + 1) & 1; \
            const LAS unsigned char* Vt = lds + OFFV + ((j) & 1) * VBUF; \
            bf16x8 kfr[2][NQG]; \
            _Pragma("unroll") for (int q = 0; q < NQG; ++q) kfr[0][q] = ATT_KFRAG(nb, q); \
            float mx = m_run; \
            if (NA && (j) >= 4) { \
                const int kr = rlo + (j) - 4; \
                const int ri = kr - wi + 7, qj = c0 + r, cs = clampi(qj - 8, 0, 48); \
                const LAS float* bp = rpbL + 64 + ri * 31 + (4 * hh - qj + 15); \
                const int vb = 4 * hh - cs; \
                _Pragma("unroll") for (int kb = 0; kb < 2; ++kb) \
                    _Pragma("unroll") for (int i = 0; i < 16; ++i) { \
                        const int ci = kb * 32 + (i & 3) + 8 * (i >> 2); \
                        const bool valid = (unsigned)(vb + ci) < 16u; \
                        const float x = valid ? __builtin_fmaf(S[kb][i], a.sc, bp[ci]) : -1e30f; \
                        S[kb][i] = x; mx = fmaxf(mx, x); } \
                mx = fmaxf(mx, __shfl_xor(mx, 32)); \
            } else { \
                float mr = -1e30f; \
                _Pragma("unroll") for (int kb = 0; kb < 2; ++kb) \
                    _Pragma("unroll") for (int i = 0; i < 16; ++i) mr = fmaxf(mr, S[kb][i]); \
                mr = fmaxf(mr, __shfl_xor(mr, 32)); \
                mx = fmaxf(mx, mr * a.sc); \
            } \
            if (__any(mx > m_run + 8.f)) {     \
                const float alpha = fexp2(m_run - mx); \
                lsum *= alpha; \
                _Pragma("unroll") for (int d = 0; d < DV / 32; ++d) \
                    _Pragma("unroll") for (int i = 0; i < 16; ++i) o[d][i] *= alpha; \
                m_run = mx; \
            } \
            mx = m_run; \
            __builtin_amdgcn_sched_barrier(0); \
            _Pragma("unroll") for (int grp = 0; grp < 4; ++grp) { \
                const int kb = grp >> 1, st = grp & 1; \
                if (grp < 3) { _Pragma("unroll") for (int q = 0; q < NQG; ++q) kfr[(grp + 1) & 1][q] = ATT_KFRAG(nb, (grp + 1) * NQG + q); } \
                bf16x8 vf[DV / 32]; \
                _Pragma("unroll") for (int d = 0; d < DV / 32; ++d) { \
                    const LAS unsigned char* ad = Vt + (kb * 32 + 16 * st + 4 * hh + tq) * VROW + (d * 32 + 16 * blk + 4 * tp) * 2; \
                    const s16x4 lo = __builtin_amdgcn_ds_read_tr16_b64_v4i16((LAS s16x4*)ad); \
                    const s16x4 hi = __builtin_amdgcn_ds_read_tr16_b64_v4i16((LAS s16x4*)(ad + 8 * VROW)); \
                    vf[d] = __builtin_shufflevector(lo, hi, 0, 1, 2, 3, 4, 5, 6, 7); } \
                _Pragma("unroll") for (int q = 0; q < NQG; ++q) { const int idx = grp * NQG + q; \
                    SN[idx / NK0] = __builtin_amdgcn_mfma_f32_32x32x16_bf16(kfr[grp & 1][q], qf[idx % NK0], (idx % NK0) == 0 ? zero16 : SN[idx / NK0], 0, 0, 0); } \
                __builtin_amdgcn_sched_barrier(0); \
                float pp[8]; \
                _Pragma("unroll") for (int i = 0; i < 8; ++i) { \
                    pp[i] = (NA && (j) >= 4) ? fexp2(S[kb][8 * st + i] - mx) : fexp2(__builtin_fmaf(S[kb][8 * st + i], a.sc, -mx)); lsum += pp[i]; } \
                const bf16x8 pf = __builtin_bit_cast(bf16x8, pack8(pp)); \
                __builtin_amdgcn_sched_barrier(0); \
                _Pragma("unroll") for (int d = 0; d < DV / 32; ++d) o[d] = __builtin_amdgcn_mfma_f32_32x32x16_bf16(vf[d], pf, o[d], 0, 0, 0); \
                __builtin_amdgcn_sched_barrier(0); \
                if (grp == 1) { \
                    if ((j) + 1 < ntiles) ATT_LSTOREV(((j) + 1) & 1); \
                    if ((j) + 2 < ntiles) ATT_GLOADK((j) + 2); \
                    __builtin_amdgcn_sched_barrier(0); \
                } \
            } \
        } else { \
            ATT_QK(SN, ((j) + 1) & 1); \
            if ((j) + 1 < ntiles) ATT_LSTOREV(((j) + 1) & 1); \
            if ((j) + 2 < ntiles) ATT_GLOADK((j) + 2); \
        } \
        if ((j) + 2 < ntiles) ATT_LSTOREK((j) & 1); \
        __syncthreads(); } while (0)
        ATT_GLOADK(0); ATT_LSTOREK(0); ATT_GLOADV(0); ATT_LSTOREV(0);
        ATT_GLOADK(1); ATT_LSTOREK(1);
        __syncthreads();
        f32x16 o[DV / 32];
#pragma unroll
        for (int d = 0; d < DV / 32; ++d)
#pragma unroll
            for (int i = 0; i < 16; ++i) o[d][i] = 0.f;
        f32x16 zero16;
#pragma unroll
        for (int i = 0; i < 16; ++i) zero16[i] = 0.f;
        float m_run = -1e30f, lsum = 0.f;
        f32x16 s[2], sn[2];
        ATT_QK(s, 0);
        __syncthreads();
        for (int j = 0; j < ntiles; j += 2) {
            ATT_TILE(j, s, sn);
            if (j + 1 < ntiles) ATT_TILE(j + 1, sn, s);
        }
        lsum += __shfl_xor(lsum, 32);
        const float inv = frcp(lsum);
        bf16_t* orow = a.O + (qrow << 10) + h * DV;
#pragma unroll
        for (int d = 0; d < DV / 32; ++d)
#pragma unroll
            for (int g = 0; g < 4; ++g)
                *(u32x2*)(orow + d * 32 + 8 * g + 4 * hh) = (u32x2){pk_bf16(o[d][4 * g] * inv, o[d][4 * g + 1] * inv), pk_bf16(o[d][4 * g + 2] * inv, o[d][4 * g + 3] * inv)};
#undef ATT_TILE_ROW
#undef ATT_GLOADK
#undef ATT_GLOADV
#undef ATT_LSTOREK
#undef ATT_LSTOREV
#undef ATT_KFRAG
#undef ATT_QK
#undef ATT_ACTIVE
#undef ATT_TILE
    }
}

DI void s5_scan_phase(LAS unsigned char* lds, const Params& p, bf16_t* H, bf16_t* YF) {
    const int TIDX = otid(); const int BIDX = obid(); (void)TIDX; (void)BIDX;
    const int wave = __builtin_amdgcn_readfirstlane(TIDX >> 6), lane = TIDX & 63;
    LAS float* BU = (LAS float*)(lds + wave * 14592);
    LAS bf16_t* Hh = (LAS bf16_t*)(lds + wave * 14592 + 10240);
    const int l15 = lane & 15, l4 = lane >> 4;
    for (int item = BIDX * 8 + wave; item < NB * 64; item += gridDim.x * 8) {
        const int g = item & 63, b = item >> 6;
        const float dsk = p.in[I_SD][g * 16 + l15];
        for (int dir = 0; dir < 2; ++dir) {
            const int pg = dir * 64 + g;
            const float dt = __expf(p.in[I_SLDT][pg]);
            const float* are = p.in[I_SARE] + pg * 64; const float* aim = p.in[I_SAIM] + pg * 64;
            float abr, abi;
            { const float ar = are[lane], ai = aim[lane]; const float mag = __expf(dt * ar); abr = mag * __cosf(dt * ai); abi = mag * __sinf(dt * ai); }
            bf16x8 bfr[8], cfr[4];
#pragma unroll
            for (int nt = 0; nt < 8; ++nt) {
                const int st = (nt & 3) * 16 + l15;
                const float ar = are[st], ai = aim[st]; const float mag = __expf(dt * ar);
                const float er = mag * __cosf(dt * ai), ei = mag * __sinf(dt * ai);
                const float den = ar * ar + ai * ai, nr = er - 1.f;
                const float fre = (nr * ar + ei * ai) / den, fim = (ei * ar - nr * ai) / den;
                float bb[8];
#pragma unroll
                for (int j = 0; j < 8; ++j) bb[j] = 0.f;
                if (lane < 32) {
                    const float* br = p.in[I_SBRE] + ((size_t)pg * 64 + st) * 16 + l4 * 8; const float* bi = p.in[I_SBIM] + ((size_t)pg * 64 + st) * 16 + l4 * 8;
#pragma unroll
                    for (int j = 0; j < 8; ++j) bb[j] = (nt < 4) ? (fre * br[j] - fim * bi[j]) : (fre * bi[j] + fim * br[j]);
                }
                bfr[nt] = __builtin_bit_cast(bf16x8, pack8(bb));
            }
#pragma unroll
            for (int kk = 0; kk < 4; ++kk) {
                const int st0 = kk * 16 + l4 * 4;
                const f32x4 cr4 = *(const f32x4*)(p.in[I_SCRE] + ((size_t)pg * 16 + l15) * 64 + st0);
                const f32x4 ci4 = *(const f32x4*)(p.in[I_SCIM] + ((size_t)pg * 16 + l15) * 64 + st0);
                float cc[8];
#pragma unroll
                for (int j = 0; j < 4; ++j) { cc[2 * j] = cr4[j]; cc[2 * j + 1] = -ci4[j]; }
                cfr[kk] = __builtin_bit_cast(bf16x8, pack8(cc));
            }
            float hr = 0.f, hi = 0.f;
#define S5_TB(j) (dir ? ((j) < 16 ? 16 * (15 - (j)) : 256 + 16 * (143 - (j))) : 16 * (j))
            bf16x8 ufn = (bf16x8){0, 0, 0, 0, 0, 0, 0, 0};
            if (lane < 32) ufn = *(const bf16x8*)(H + (((size_t)b * TT + S5_TB(0) + l15) << 10) + g * 16 + l4 * 8);
            for (int j = 0; j < 144; ++j) {
                const int tb = S5_TB(j);
                const size_t row0 = (size_t)b * TT + tb;
                const bf16x8 uf = ufn;
                if (lane < 32 && j + 1 < 144) ufn = *(const bf16x8*)(H + (((size_t)b * TT + S5_TB(j + 1) + l15) << 10) + g * 16 + l4 * 8);
                float yfv[4], uv[4];
                if (dir) {
#pragma unroll
                    for (int i = 0; i < 4; ++i) {
                        const size_t o = ((row0 + l4 * 4 + i) << 10) + g * 16 + l15;
                        yfv[i] = __uint_as_float(((unsigned)YF[o]) << 16); uv[i] = __uint_as_float(((unsigned)H[o]) << 16);
                    }
                }
#pragma unroll
                for (int nt = 0; nt < 8; ++nt) {
                    const f32x4 acc = __builtin_amdgcn_mfma_f32_16x16x32_bf16(uf, bfr[nt], (f32x4){0.f, 0.f, 0.f, 0.f}, 0, 0, 0);
                    *(LAS f32x4*)(BU + (nt * 16 + l15) * 20 + l4 * 4) = acc;
                }
                float bur[16], bui[16];
#pragma unroll
                for (int q = 0; q < 4; ++q) {
                    const f32x4 r4 = *(const LAS f32x4*)(BU + lane * 20 + q * 4), i4 = *(const LAS f32x4*)(BU + (64 + lane) * 20 + q * 4);
#pragma unroll
                    for (int e = 0; e < 4; ++e) { bur[q * 4 + e] = r4[e]; bui[q * 4 + e] = i4[e]; }
                }
                if (dir) {
#pragma unroll
                    for (int tt = 15; tt >= 0; --tt) {
                        const float nhr = abr * hr - abi * hi + bur[tt], nhi = abr * hi + abi * hr + bui[tt];
                        hr = nhr; hi = nhi;
                        *(LAS unsigned*)(Hh + tt * 136 + 2 * lane) = pk_bf16(hr, hi);
                    }
                } else {
#pragma unroll
                    for (int tt = 0; tt < 16; ++tt) {
                        const float nhr = abr * hr - abi * hi + bur[tt], nhi = abr * hi + abi * hr + bui[tt];
                        hr = nhr; hi = nhi;
                        *(LAS unsigned*)(Hh + tt * 136 + 2 * lane) = pk_bf16(hr, hi);
                    }
                }
                f32x4 ya = (f32x4){0.f, 0.f, 0.f, 0.f};
#pragma unroll
                for (int kk = 0; kk < 4; ++kk) {
                    const bf16x8 af = *(const LAS bf16x8*)(Hh + l15 * 136 + kk * 32 + l4 * 8);
                    ya = __builtin_amdgcn_mfma_f32_16x16x32_bf16(af, cfr[kk], ya, 0, 0, 0);
                }
                if (dir == 0) {
#pragma unroll
                    for (int i = 0; i < 4; ++i) YF[((row0 + l4 * 4 + i) << 10) + g * 16 + l15] = (bf16_t)(pk_bf16(ya[i], 0.f) & 0xffffu);
                } else {
#pragma unroll
                    for (int i = 0; i < 4; ++i) {
                        const size_t o = ((row0 + l4 * 4 + i) << 10) + g * 16 + l15;
                        const float y = gelu_tanh(dsk * uv[i] + yfv[i] + ya[i]);
                        H[o] = (bf16_t)(pk_bf16(y, 0.f) & 0xffffu);
                    }
                }
            }
        }
    }
}

#define XB_TMO      128
#define XB_XCNT(j)  (256  + 64 * (j))
#define XB_XSUB(j)  (1280 + 64 * (j))
#define XB_XGEN(j)  (2304 + 64 * (j))
#define XB_TOP      3328
#define XB_TOPGEN   3392
#define XCD_BAR_WORDS 3456
#define XB_SPIN_CAP (1u << 18)
DI unsigned xb_ld(unsigned* p)              { return __hip_atomic_load(p, __ATOMIC_RELAXED, __HIP_MEMORY_SCOPE_AGENT); }
DI unsigned xb_add(unsigned* p, unsigned v) { return __hip_atomic_fetch_add(p, v, __ATOMIC_RELAXED, __HIP_MEMORY_SCOPE_AGENT); }
DI unsigned xb_xcc_id() { return (unsigned)__builtin_amdgcn_s_getreg((3 << 11) | 20) & 0xFu; }
#define XB_SPIN(cond, bar) do { unsigned _sp = 0; while (cond) { __builtin_amdgcn_s_sleep(1); \
    if ((++_sp & 255u) == 0u) { if (xb_ld(&(bar)[XB_TMO])) break; if (_sp > XB_SPIN_CAP) { atomicAdd(&(bar)[XB_TMO], 1u); break; } } } } while (0)
struct XcdBarrier { unsigned* bar; unsigned x; volatile LAS unsigned* st; };
DI XcdBarrier xcd_barrier_post(unsigned* bar, volatile LAS unsigned* st) {
    XcdBarrier b; b.bar = bar; b.x = xb_xcc_id(); b.st = st;
    if (threadIdx.x == 0) (void)xb_add(&bar[XB_XCNT(b.x)], 1u);
    return b;
}
DI void xcd_barrier_complete(unsigned* bar, unsigned x, unsigned& nloc, unsigned& nx) {
    const unsigned G = gridDim.x * gridDim.y * gridDim.z;
    unsigned sum, cnt, mine, sp = 0u;
    for (;;) {
        sum = 0u; cnt = 0u; mine = 0u;
#pragma unroll
        for (unsigned j = 0; j < 16; ++j) { const unsigned c = xb_ld(&bar[XB_XCNT(j)]); sum += c; cnt += (c > 0u) ? 1u : 0u; mine = (j == x) ? c : mine; }
        if (sum == G) break;
        __builtin_amdgcn_s_sleep(1);
        if ((++sp & 255u) == 0u) { if (xb_ld(&bar[XB_TMO])) break; if (sp > XB_SPIN_CAP) { atomicAdd(&bar[XB_TMO], 1u); break; } }
    }
    nloc = mine > 0u ? mine : 1u; nx = cnt > 0u ? cnt : 1u;
}
DI void xcd_barrier(const XcdBarrier& b) {
    asm volatile("s_waitcnt vmcnt(0)" ::: "memory");
    __syncthreads();
    if (threadIdx.x == 0) {
        unsigned* bar = b.bar;
        __builtin_amdgcn_s_waitcnt(0);
        unsigned nloc = b.st[0], nx = b.st[1];
        if (nloc == 0u) { xcd_barrier_complete(bar, b.x, nloc, nx); b.st[0] = nloc; b.st[1] = nx; }
        const unsigned old = xb_add(&bar[XB_XSUB(b.x)], 1u);
        const unsigned gen = old / nloc;
        if (old + 1u == (gen + 1u) * nloc) {
            __builtin_amdgcn_fence(__ATOMIC_RELEASE, "agent");
            asm volatile("s_waitcnt vmcnt(0)" ::: "memory");
            const unsigned og = xb_add(&bar[XB_TOP], 1u);
            const unsigned tg = og / nx;
            if (og + 1u == (tg + 1u) * nx) xb_add(&bar[XB_TOPGEN], 1u);
            else XB_SPIN(xb_ld(&bar[XB_TOPGEN]) == tg, bar);
            __builtin_amdgcn_fence(__ATOMIC_ACQUIRE, "agent");
            xb_add(&bar[XB_XGEN(b.x)], 1u);
            asm volatile("s_waitcnt vmcnt(0)" ::: "memory");
        } else {
            XB_SPIN(xb_ld(&bar[XB_XGEN(b.x)]) == gen, bar);
            __builtin_amdgcn_fence(__ATOMIC_ACQUIRE, "agent");
            asm volatile("s_waitcnt vmcnt(0)" ::: "memory");
        }
    }
    __syncthreads();
}

__global__ void __launch_bounds__(512, 2) mega(const Params p) {
    extern __shared__ __attribute__((aligned(16))) unsigned char shm[];
    LAS unsigned char* lds = (LAS unsigned char*)shm;
    cg::grid_group grid = cg::this_grid();
    LAS unsigned* xbst = (LAS unsigned*)(lds + 133120);
    if (threadIdx.x < 4) xbst[threadIdx.x] = 0u;
    __syncthreads();
    const XcdBarrier xb = xcd_barrier_post((unsigned*)(p.ws + OFF_BAR), (volatile LAS unsigned*)xbst);
    unsigned char* ws = p.ws;
    float* ADA = (float*)(ws + OFF_ADA);
    float* XC = (float*)(ws + OFF_XC);
    bf16_t* HB = (bf16_t*)(ws + OFF_HB);
    float* LAT = p.out;
    int pid = 0;
#define PH_BEGIN if (pid >= p.ph_lo && pid < p.ph_hi) {
#define PH_END if (pid + 1 < p.ph_hi) { if (pid == 0) grid.sync(); else xcd_barrier(xb); } } ++pid;

    PH_BEGIN
    {
        phase0(lds, p, ADA, (unsigned*)(ws + OFF_BAR + 14336));
    }
    PH_END

    for (int layer = 0; layer < 4; ++layer) {
        const float* ada = ADA + (size_t)layer * 33 * 6144;
        const int last = layer == 3;
        PH_BEGIN
        norm_phase(layer == 0 ? p.in[I_X] : LAT, layer == 0 ? p.in[I_CTX] : XC, LAT, XC, false, p.in[I_NMIX] + layer * 1024, ada, 0, HB, false, layer == 0 ? (float*)(ws + OFF_SSQ) : nullptr);
        PH_END
        if (layer == 0) {
            bf16_t* Z = (bf16_t*)(ws + OFF_Z); bf16_t* KV = (bf16_t*)(ws + OFF_KV); bf16_t* QB = (bf16_t*)(ws + OFF_QB);
            float* SSQ = (float*)(ws + OFF_SSQ); LAS float* XX = (LAS float*)(lds + 133120 + 64);
            PH_BEGIN
            run_gemm(lds, HB, 1024, (const bf16_t*)(ws + OFF_WMI), 768, 1024, 0, pg8::EpiMlaZ{Z, SSQ});
            PH_END
            PH_BEGIN
            run_gemm(lds, Z, 768, (const bf16_t*)(ws + OFF_WUQ), 2048, 384, 0, pg8::EpiMlaQ{QB, SSQ, p.in[I_MGQN], XX});
            run_gemm(lds, Z + 384, 768, (const bf16_t*)(ws + OFF_WUKV), 2048, 256, 0, pg8::EpiMlaKV{KV, SSQ, Z, p.in[I_MGKN], XX});
            PH_END
            PH_BEGIN
            attn_phase<96, 64, 0>(lds, AttnArgs{QB, KV, KV + 96, HB, 1536, 96, 2560, 160, 2560, 160, 16, 0, 1, nullptr, 0.10206207261596575f * LOG2E});
            PH_END
            PH_BEGIN
            run_gemm(lds, HB, 1024, (const bf16_t*)(ws + OFF_WMO), 1024, 1024, 0, pg8::EpiRes{LAT, XC, ada, 2, p.in[I_X], p.in[I_CTX]});
            PH_END
        } else if (layer == 1) {
            bf16_t* YF = (bf16_t*)(ws + OFF_BIG);
            PH_BEGIN
            s5_scan_phase(lds, p, HB, YF);
            PH_END
            PH_BEGIN
            run_gemm(lds, HB, 1024, (const bf16_t*)(ws + OFF_WGLU), 2048, 1024, 0, pg8::EpiGluRes{LAT, XC, ada, 2});
            PH_END
        } else if (layer == 2) {
            bf16_t* QKV = (bf16_t*)(ws + OFF_BIG);
            PH_BEGIN
            run_gemm(lds, HB, 1024, (const bf16_t*)(ws + OFF_WNQ), 3072, 1024, 0, pg8::EpiStoreHN64{QKV, 3072, p.in[I_NGQN], p.in[I_NGKN], (LAS float*)(lds + 133120 + 64)});
            PH_END
            PH_BEGIN
            attn_phase<64, 64, 1>(lds, AttnArgs{QKV, QKV + 1024, QKV + 2048, HB, 3072, 64, 3072, 64, 3072, 64, 16, 0, 1, p.in[I_NRPB], 0.125f * LOG2E});
            PH_END
            PH_BEGIN
            run_gemm(lds, HB, 1024, (const bf16_t*)(ws + OFF_WNO), 1024, 1024, 0, pg8::EpiRes{LAT, XC, ada, 2, LAT, XC});
            PH_END
        } else {
            bf16_t* QKV = (bf16_t*)(ws + OFF_BIG);
            PH_BEGIN
            run_gemm(lds, HB, 1024, (const bf16_t*)(ws + OFF_WGQ), 1536, 1024, 0, pg8::EpiStoreHN128{QKV, 1536, p.in[I_GGQN], p.in[I_GGKN], (LAS float*)(lds + 133120 + 64)});
            PH_END
            PH_BEGIN
            attn_phase<128, 128, 0>(lds, AttnArgs{QKV, QKV + 1024, QKV + 1280, HB, 1536, 128, 1536, 128, 1536, 128, 8, 2, 0, nullptr, 0.08838834764831845f * LOG2E});
            PH_END
            PH_BEGIN
            run_gemm(lds, HB, 1024, (const bf16_t*)(ws + OFF_WGO), 1024, 1024, 1, pg8::EpiRes{LAT, XC, ada, 2, LAT, XC});
            PH_END
        }
        bf16_t* ACT = (bf16_t*)(ws + OFF_BIG);
        PH_BEGIN
        norm_phase(LAT, XC, LAT, XC, false, p.in[I_NFFN] + layer * 1024, ada, 3, HB, last);
        PH_END
        PH_BEGIN
        run_gemm(lds, HB, 1024, (const bf16_t*)(ws + OFF_WFI + layer * SZ_WFI), 5632, 1024, last, pg8::EpiSwiglu{ACT, FH});
        PH_END
        PH_BEGIN
        run_gemm(lds, ACT, 2816, (const bf16_t*)(ws + OFF_WFO + layer * SZ_WFO), 1024, 2816, last, pg8::EpiRes{LAT, XC, ada, 5, LAT, XC});
        PH_END
    }
}

extern "C" void kernel_launch(void* const* d_in, const int* in_sizes, int n_in, void* d_out, int out_size, void* d_ws, size_t ws_size, hipStream_t stream) {
    static int grid_blocks = 0;
    if (!grid_blocks) {
        hipFuncSetAttribute((const void*)mega, hipFuncAttributeMaxDynamicSharedMemorySize, LDS_BYTES);
        int dev = 0, cus = 0, per_cu = 0;
        hipGetDevice(&dev);
        hipDeviceGetAttribute(&cus, hipDeviceAttributeMultiprocessorCount, dev);
        hipOccupancyMaxActiveBlocksPerMultiprocessor(&per_cu, mega, 512, LDS_BYTES);
        if (per_cu < 1) per_cu = 1;
        grid_blocks = cus * 1;
    }
    if (ws_size < WS_NEED) fprintf(stderr, "workspace too small: %zu < %zu\n", ws_size, (size_t)WS_NEED);
    Params p; memset(&p, 0, sizeof(p));
    for (int i = 0; i < N_IN; ++i) p.in[i] = (const float*)d_in[i];
    p.out = (float*)d_out; p.ws = (unsigned char*)d_ws; p.ph_lo = 0; p.ph_hi = 1000;
    hipMemsetAsync((unsigned char*)d_ws + OFF_BAR, 0, 16384, stream);
    void* args[] = {&p};
    hipError_t e = hipLaunchCooperativeKernel((const void*)mega, dim3(grid_blocks), dim3(512), args, LDS_BYTES, stream);
    if (e != hipSuccess) fprintf(stderr, "cooperative launch failed: %s (grid %d)\n", hipGetErrorString(e), grid_blocks);
}
```

```cpp
#include <hip/hip_runtime.h>
#include <hip/hip_cooperative_groups.h>
#include <cstdio>
#include <cstring>
namespace cg = cooperative_groups;

#define DI __device__ __forceinline__
#define LAS __attribute__((address_space(3)))
typedef unsigned short bf16_t;
typedef short bf16x8 __attribute__((ext_vector_type(8)));
typedef short s16x4 __attribute__((ext_vector_type(4)));
typedef float f32x4 __attribute__((ext_vector_type(4)));
typedef float f32x16 __attribute__((ext_vector_type(16)));
typedef unsigned u32x4 __attribute__((ext_vector_type(4)));
typedef unsigned u32x2 __attribute__((ext_vector_type(2)));
typedef __bf16 bf2_t __attribute__((ext_vector_type(2)));
typedef float f2_t __attribute__((ext_vector_type(2)));

constexpr int NB = 32, SEQ = 2048, CTXL = 256, TT = 2304, NR = NB * TT, DM = 1024, FH = 2816;
constexpr float EPS = 1e-6f, LOG2E = 1.4426950408889634f, L2_10000 = 13.287712379549449f;
constexpr int LDS_BYTES = 133120 + 64 + 8192;

enum { I_X, I_C, I_CTX, I_CCTX, I_ADAW, I_ADAB, I_NMIX, I_NFFN, I_FWIN, I_FWOUT,
       I_MWIN, I_MGQ, I_MGKV, I_MWUQ, I_MWUKV, I_MGQN, I_MGKN, I_MWO,
       I_SARE, I_SAIM, I_SLDT, I_SBRE, I_SBIM, I_SCRE, I_SCIM, I_SD, I_SWGLU,
       I_NWQKV, I_NGQN, I_NGKN, I_NRPB, I_NWO, I_GWQKV, I_GGQN, I_GGKN, I_GWO, N_IN };

constexpr size_t SZ_WFI = (size_t)5632 * 1024 * 2, SZ_WFO = (size_t)1024 * 2816 * 2;
constexpr size_t OFF_WFI = 0;
constexpr size_t OFF_WFO = OFF_WFI + 4 * SZ_WFI;
constexpr size_t OFF_WMI = OFF_WFO + 4 * SZ_WFO;
constexpr size_t OFF_WUQ = OFF_WMI + (size_t)768 * 1024 * 2;
constexpr size_t OFF_WUKV = OFF_WUQ + (size_t)2048 * 384 * 2;
constexpr size_t OFF_WMO = OFF_WUKV + (size_t)2048 * 256 * 2;
constexpr size_t OFF_WGLU = OFF_WMO + (size_t)1024 * 1024 * 2;
constexpr size_t OFF_WNQ = OFF_WGLU + (size_t)2048 * 1024 * 2;
constexpr size_t OFF_WNO = OFF_WNQ + (size_t)3072 * 1024 * 2;
constexpr size_t OFF_WGQ = OFF_WNO + (size_t)1024 * 1024 * 2;
constexpr size_t OFF_WGO = OFF_WGQ + (size_t)1536 * 1024 * 2;
constexpr size_t OFF_ADA = OFF_WGO + (size_t)1024 * 1024 * 2;
constexpr size_t OFF_XC = OFF_ADA + (size_t)4 * 33 * 6144 * 4;
constexpr size_t OFF_HB = OFF_XC + (size_t)NB * CTXL * 1024 * 4;
constexpr size_t OFF_BIG = OFF_HB + (size_t)NR * 1024 * 2;
constexpr size_t OFF_KV = OFF_BIG;
constexpr size_t OFF_QB = OFF_KV + (size_t)NR * 2560 * 2;
constexpr size_t OFF_Z = OFF_QB + (size_t)NR * 1536 * 2;
constexpr size_t OFF_BAR = OFF_Z + (size_t)NR * 768 * 2;
constexpr size_t OFF_SSQ = OFF_BAR + 16384;
constexpr size_t WS_NEED = OFF_SSQ + (size_t)NR * 16;

struct Params {
    const float* in[N_IN];
    float* out;
    unsigned char* ws;
    int ph_lo, ph_hi;
};

DI unsigned pk_bf16(float a, float b) { f2_t v = {a, b}; bf2_t r = __builtin_convertvector(v, bf2_t); return __builtin_bit_cast(unsigned, r); }
DI float bf_lo(unsigned u) { return __uint_as_float(u << 16); }
DI float bf_hi(unsigned u) { return __uint_as_float(u & 0xffff0000u); }
DI float wsum(float v) {
#pragma unroll
    for (int o = 32; o > 0; o >>= 1) v += __shfl_xor(v, o);
    return v;
}
DI int otid() { int t = threadIdx.x; asm volatile("" : "+v"(t)); return t; }
DI int obid() { int b = blockIdx.x; asm volatile("" : "+s"(b)); return b; }
DI int mla_dim_of_pos(int pos) { if (pos < 64) return pos; const int p = pos - 64, a = p >> 4, w = p & 15; return 64 + 16 * a + (w >> 1) + 8 * (w & 1); }
DI int gqa_dim_of_pos(int pos) { return (pos >> 6) * 64 + ((pos & 63) >> 1) + 32 * (pos & 1); }
DI int clampi(int v, int lo, int hi) { return v < lo ? lo : (v > hi ? hi : v); }
DI float fexp2(float x) { return __builtin_amdgcn_exp2f(x); }
DI float frcp(float x) { return __builtin_amdgcn_rcpf(x); }
DI float silu_f(float a) { return a * frcp(1.f + __expf(-a)); }
DI float sigmoid_f(float a) { return frcp(1.f + __expf(-a)); }
DI float gelu_tanh(float y) {
    const float z = 0.7978845608028654f * (y + 0.044715f * y * y * y);
    const float t = 1.f - 2.f * frcp(__expf(2.f * z) + 1.f);
    return 0.5f * y * (1.f + t);
}
DI void unpack8(const u32x4 u, float* f) {
#pragma unroll
    for (int i = 0; i < 4; ++i) { f[2 * i] = bf_lo(u[i]); f[2 * i + 1] = bf_hi(u[i]); }
}
DI u32x4 pack8(const float* f) { return (u32x4){pk_bf16(f[0], f[1]), pk_bf16(f[2], f[3]), pk_bf16(f[4], f[5]), pk_bf16(f[6], f[7])}; }

namespace pg8 {
constexpr int BM = 256, BK = 64, HALF = 128, HTB = HALF * BK * 2, NXCD = 8, WGM = 8;
DI int lds_byte(int r, int c) { const int st = (r >> 4) * 2 + (c >> 5), rr = r & 15, cc = c & 31, ob = rr * 64 + cc * 2; return st * 1024 + (ob ^ (((ob >> 9) & 1) << 5)); }
DI void stage_rc(int b, int& R, int& C) { const int st = b / 1024, sb = b % 1024, swz = sb ^ (((sb >> 9) & 1) << 5); R = (st >> 1) * 16 + swz / 64; C = (st & 1) * 32 + (swz % 64) / 2; }
DI int perm32(int rho) { const int n = rho >> 4, i = rho & 15; return 8 * (i >> 2) + 4 * n + (i & 3); }
struct Unit { int pm, pn; };
struct Gemm { const bf16_t* A; const bf16_t* Bt; int M, N, K, lda; };
struct Order {
    int nM, nN, nwg, G, c, skip;
    DI void init(int N, int G_, int c_, int skipctx) { skip = skipctx; nM = skipctx ? 256 : 288; nN = N / BM; nwg = nM * nN; G = G_; c = c_; }
    DI bool next(int i, Unit& u) const {
        const long L = (long)i * G + c; if (L >= nwg) return false;
        int wgid = (int)L; { const int q = nwg / NXCD, r = nwg % NXCD, xcd = wgid % NXCD, off = wgid / NXCD; wgid = (xcd < r ? xcd * (q + 1) : r * (q + 1) + (xcd - r) * q) + off; }
        const int nig = WGM * nN, gid = wgid / nig, fm = gid * WGM, gsz = (nM - fm) < WGM ? (nM - fm) : WGM;
        int pm = fm + ((wgid % nig) % gsz); u.pn = (wgid % nig) / gsz;
        if (skip) pm = pm + (pm >> 3) + 1;
        u.pm = pm; return true;
    }
};

DI float* tile_res_base(float* lat, float* xc, int pm) { const int bb = pm / 9, sub = pm - bb * 9; return sub == 0 ? xc + ((size_t)bb * CTXL << 10) : lat + ((size_t)(bb * SEQ + (sub - 1) * 256) << 10); }
DI int tile_ada_row(int pm) { const int bb = pm / 9, sub = pm - bb * 9; return sub == 0 ? 32 : bb; }

struct EpiStore {
    static constexpr bool PERM = true;
    bf16_t* O; int ldc; int remap;
    DI void operator()(const f32x4 (&acc)[2][2][4][2], const Unit& u, int wr, int wc, int fr, int fq) const {
        const int row0 = u.pm * BM + wr * 64 + fr, col0 = u.pn * BM + wc * 32 + 8 * fq;
#pragma unroll
        for (int ai = 0; ai < 2; ++ai)
#pragma unroll
            for (int m = 0; m < 4; ++m) {
                bf16_t* rowp = O + (size_t)(row0 + ai * HALF + m * 16) * ldc;
#pragma unroll
                for (int bj = 0; bj < 2; ++bj) {
                    const int c = col0 + bj * HALF; const int cc = remap ? (c >> 7) * 160 + (c & 127) : c;
                    const f32x4 v0 = acc[ai][bj][m][0], v1 = acc[ai][bj][m][1];
                    *(u32x4*)(rowp + cc) = (u32x4){pk_bf16(v0[0], v0[1]), pk_bf16(v0[2], v0[3]), pk_bf16(v1[0], v1[1]), pk_bf16(v1[2], v1[3])};
                }
            }
    }
};
struct EpiStoreHN64 {
    static constexpr bool PERM = true;
    bf16_t* O; int ldc; const float* gq; const float* gk; LAS float* X;
    DI void operator()(const f32x4 (&acc)[2][2][4][2], const Unit& u, int wr_, int wc_, int fr_, int fq_) const {
        int wr = wr_, wc = wc_, fr = fr_, fq = fq_; asm volatile("" : "+s"(wr), "+s"(wc), "+v"(fr), "+v"(fq));
        const int wid = wr * 4 + wc;
        const int kind = u.pn < 4 ? 0 : (u.pn < 8 ? 1 : 2);
        float part[2][2][4];
#pragma unroll
        for (int ai = 0; ai < 2; ++ai)
#pragma unroll
            for (int bj = 0; bj < 2; ++bj)
#pragma unroll
                for (int m = 0; m < 4; ++m) {
                    float ss = 0.f;
#pragma unroll
                    for (int n = 0; n < 2; ++n)
#pragma unroll
                        for (int i = 0; i < 4; ++i) ss += acc[ai][bj][m][n][i] * acc[ai][bj][m][n][i];
                    ss += __shfl_xor(ss, 16); ss += __shfl_xor(ss, 32);
                    part[ai][bj][m] = ss;
                    if (fq == 0) X[(wid * 16 + ai * 8 + bj * 4 + m) * 16 + fr] = ss;
                }
        asm volatile("s_waitcnt lgkmcnt(0)" ::: "memory");
        __builtin_amdgcn_s_barrier();
        asm volatile("" ::: "memory");
        const float* g = kind == 0 ? gq : gk;
        const int gc0 = 32 * (wc & 1) + 8 * fq;
        float gv[8];
#pragma unroll
        for (int i = 0; i < 8; ++i) gv[i] = g[gc0 + i];
        const int row0 = u.pm * BM + wr * 64 + fr, col0 = u.pn * BM + wc * 32 + 8 * fq;
#pragma unroll
        for (int ai = 0; ai < 2; ++ai)
#pragma unroll
            for (int m = 0; m < 4; ++m) {
                bf16_t* rowp = O + (size_t)(row0 + ai * HALF + m * 16) * ldc;
#pragma unroll
                for (int bj = 0; bj < 2; ++bj) {
                    const float tot = part[ai][bj][m] + X[((wid ^ 1) * 16 + ai * 8 + bj * 4 + m) * 16 + fr];
                    const float r = rsqrtf(tot * (1.f / 64.f) + EPS);
                    float v[8];
#pragma unroll
                    for (int n = 0; n < 2; ++n)
#pragma unroll
                        for (int i = 0; i < 4; ++i) v[n * 4 + i] = kind == 2 ? acc[ai][bj][m][n][i] : acc[ai][bj][m][n][i] * r * gv[n * 4 + i];
                    *(u32x4*)(rowp + col0 + bj * HALF) = pack8(v);
                }
            }
    }
};
struct EpiStoreHN128 {
    static constexpr bool PERM = true;
    bf16_t* O; int ldc; const float* gq; const float* gk; LAS float* X;
    DI void operator()(const f32x4 (&acc)[2][2][4][2], const Unit& u, int wr_, int wc_, int fr_, int fq_) const {
        int wr = wr_, wc = wc_, fr = fr_, fq = fq_; asm volatile("" : "+s"(wr), "+s"(wc), "+v"(fr), "+v"(fq));
        const int wid = wr * 4 + wc;
        const int kind = u.pn < 4 ? 0 : (u.pn < 5 ? 1 : 2);
        float part[2][2][4];
#pragma unroll
        for (int ai = 0; ai < 2; ++ai)
#pragma unroll
            for (int bj = 0; bj < 2; ++bj)
#pragma unroll
                for (int m = 0; m < 4; ++m) {
                    float ss = 0.f;
#pragma unroll
                    for (int n = 0; n < 2; ++n)
#pragma unroll
                        for (int i = 0; i < 4; ++i) ss += acc[ai][bj][m][n][i] * acc[ai][bj][m][n][i];
                    ss += __shfl_xor(ss, 16); ss += __shfl_xor(ss, 32);
                    part[ai][bj][m] = ss;
                    if (fq == 0) X[(wid * 16 + ai * 8 + bj * 4 + m) * 16 + fr] = ss;
                }
        asm volatile("s_waitcnt lgkmcnt(0)" ::: "memory");
        __builtin_amdgcn_s_barrier();
        asm volatile("" ::: "memory");
        const float* g = kind == 0 ? gq : gk;
        const int pos0 = 32 * wc + 8 * fq;
        float gv[8];
#pragma unroll
        for (int i = 0; i < 8; ++i) gv[i] = g[gqa_dim_of_pos(pos0 + i)];
        const int axis = wc >> 1, f0 = 16 * (wc & 1) + 4 * fq;
        float invf[4];
#pragma unroll
        for (int j = 0; j < 4; ++j) invf[j] = fexp2(-(float)(f0 + j) * (L2_10000 / 32.f));
        const int bb = u.pm / 9, sub = u.pm - bb * 9;
        const bool latent = sub != 0;
        const int row0 = u.pm * BM + wr * 64 + fr, col0 = u.pn * BM + wc * 32 + 8 * fq;
        const int wb = wr * 4;
#pragma unroll
        for (int ai = 0; ai < 2; ++ai)
#pragma unroll
            for (int m = 0; m < 4; ++m) {
                bf16_t* rowp = O + (size_t)(row0 + ai * HALF + m * 16) * ldc;
                const int sidx = (sub - 1) * 256 + ai * HALF + wr * 64 + m * 16 + fr;
                const float posv = (float)(axis ? (sidx & 63) : (sidx >> 6));
                float cs[4], sn[4];
#pragma unroll
                for (int j = 0; j < 4; ++j) { const float ang = posv * invf[j]; cs[j] = __cosf(ang); sn[j] = __sinf(ang); }
#pragma unroll
                for (int bj = 0; bj < 2; ++bj) {
                    const int cb = ai * 8 + bj * 4 + m;
                    const float tot = X[((wb + 0) * 16 + cb) * 16 + fr] + X[((wb + 1) * 16 + cb) * 16 + fr] + X[((wb + 2) * 16 + cb) * 16 + fr] + X[((wb + 3) * 16 + cb) * 16 + fr];
                    const float r = rsqrtf(tot * (1.f / 128.f) + EPS);
                    float v[8];
#pragma unroll
                    for (int n = 0; n < 2; ++n)
#pragma unroll
                        for (int i = 0; i < 4; ++i) v[n * 4 + i] = kind == 2 ? acc[ai][bj][m][n][i] : acc[ai][bj][m][n][i] * r * gv[n * 4 + i];
                    if (kind != 2 && latent) {
#pragma unroll
                        for (int j = 0; j < 4; ++j) { const float x1 = v[2 * j], x2 = v[2 * j + 1]; v[2 * j] = x1 * cs[j] - x2 * sn[j]; v[2 * j + 1] = x1 * sn[j] + x2 * cs[j]; }
                    }
                    *(u32x4*)(rowp + col0 + bj * HALF) = pack8(v);
                }
            }
    }
};
struct EpiMlaZ {
    static constexpr bool PERM = true;
    bf16_t* O; float* SSQ;
    DI void operator()(const f32x4 (&acc)[2][2][4][2], const Unit& u, int wr_, int wc_, int fr_, int fq_) const {
        int wr = wr_, wc = wc_, fr = fr_, fq = fq_; asm volatile("" : "+s"(wr), "+s"(wc), "+v"(fr), "+v"(fq));
        const int row0 = u.pm * BM + wr * 64 + fr, col0 = u.pn * BM + wc * 32 + 8 * fq;
#pragma unroll
        for (int ai = 0; ai < 2; ++ai)
#pragma unroll
            for (int m = 0; m < 4; ++m) {
                const int row = row0 + ai * HALF + m * 16;
                bf16_t* rowp = O + (size_t)row * 768;
#pragma unroll
                for (int bj = 0; bj < 2; ++bj) {
                    const f32x4 v0 = acc[ai][bj][m][0], v1 = acc[ai][bj][m][1];
                    *(u32x4*)(rowp + col0 + bj * HALF) = (u32x4){pk_bf16(v0[0], v0[1]), pk_bf16(v0[2], v0[3]), pk_bf16(v1[0], v1[1]), pk_bf16(v1[2], v1[3])};
                    float ss = 0.f;
#pragma unroll
                    for (int i = 0; i < 4; ++i) ss += v0[i] * v0[i] + v1[i] * v1[i];
                    ss += __shfl_xor(ss, 16); ss += __shfl_xor(ss, 32);
                    const int cbase = u.pn * BM + bj * HALF + wc * 32;
                    const int cat = cbase < 384 ? 0 : (cbase < 640 ? 1 : (cbase < 672 ? 2 : 3));
                    if (fq == 0 && cat < 3) atomicAdd(SSQ + (size_t)row * 4 + cat, ss);
                }
            }
    }
};
struct EpiMlaQ {
    static constexpr bool PERM = true;
    bf16_t* O; const float* SSQ; const float* gqn; LAS float* X;
    DI void operator()(const f32x4 (&acc)[2][2][4][2], const Unit& u, int wr_, int wc_, int fr_, int fq_) const {
        int wr = wr_, wc = wc_, fr = fr_, fq = fq_; asm volatile("" : "+s"(wr), "+s"(wc), "+v"(fr), "+v"(fq));
        const int wid = wr * 4 + wc, wb = wr * 4;
#pragma unroll
        for (int ai = 0; ai < 2; ++ai)
#pragma unroll
            for (int bj = 0; bj < 2; ++bj)
#pragma unroll
                for (int m = 0; m < 4; ++m) {
                    float ss = 0.f;
#pragma unroll
                    for (int n = 0; n < 2; ++n)
#pragma unroll
                        for (int i = 0; i < 4; ++i) ss += acc[ai][bj][m][n][i] * acc[ai][bj][m][n][i];
                    ss += __shfl_xor(ss, 16); ss += __shfl_xor(ss, 32);
                    if (fq == 0) X[(wid * 16 + ai * 8 + bj * 4 + m) * 16 + fr] = ss;
                }
        asm volatile("s_waitcnt lgkmcnt(0)" ::: "memory");
        __builtin_amdgcn_s_barrier();
        asm volatile("" ::: "memory");
        const int pos0 = 32 * wc + 8 * fq;
        const int axis = fq >> 1;
        const int bb = u.pm / 9, sub = u.pm - bb * 9;
        const bool latent = sub != 0;
        const int row0 = u.pm * BM + wr * 64 + fr;
#pragma unroll
        for (int ai = 0; ai < 2; ++ai)
#pragma unroll
            for (int m = 0; m < 4; ++m) {
                int pz = pos0; asm volatile("" : "+v"(pz));
                float gv[8];
#pragma unroll
                for (int i = 0; i < 8; ++i) gv[i] = pz < 96 ? gqn[mla_dim_of_pos(pz + i)] : 0.f;
                float invf[4];
#pragma unroll
                for (int j = 0; j < 4; ++j) invf[j] = fexp2(-(float)(((pz >> 3) & 1) * 4 + j) * (L2_10000 / 8.f));
                const int row = row0 + ai * HALF + m * 16;
                const float rq0 = rsqrtf(SSQ[(size_t)row * 4 + 0] * (1.f / 384.f) + EPS);
                const int sidx = (sub - 1) * 256 + ai * HALF + wr * 64 + m * 16 + fr;
                const float posv = (float)(axis ? (sidx & 63) : (sidx >> 6));
                float cs[4], sn[4];
#pragma unroll
                for (int j = 0; j < 4; ++j) { cs[j] = 1.f; sn[j] = 0.f; }
                if (wc == 2 && latent) {
#pragma unroll
                    for (int j = 0; j < 4; ++j) { const float ang = posv * invf[j]; cs[j] = __cosf(ang); sn[j] = __sinf(ang); }
                }
#pragma unroll
                for (int bj = 0; bj < 2; ++bj) {
                    const int cb = ai * 8 + bj * 4 + m;
                    const float tot = X[((wb + 0) * 16 + cb) * 16 + fr] + X[((wb + 1) * 16 + cb) * 16 + fr] + X[((wb + 2) * 16 + cb) * 16 + fr];
                    const float r = rq0 * rsqrtf(rq0 * rq0 * tot * (1.f / 96.f) + EPS);
                    float v[8];
#pragma unroll
                    for (int n = 0; n < 2; ++n)
#pragma unroll
                        for (int i = 0; i < 4; ++i) v[n * 4 + i] = acc[ai][bj][m][n][i] * r * gv[n * 4 + i];
                    if (wc == 2 && latent) {
#pragma unroll
                        for (int j = 0; j < 4; ++j) { const float x1 = v[2 * j], x2 = v[2 * j + 1]; v[2 * j] = x1 * cs[j] - x2 * sn[j]; v[2 * j + 1] = x1 * sn[j] + x2 * cs[j]; }
                    }
                    if (wc < 3) *(u32x4*)(O + (size_t)row * 1536 + (u.pn * 2 + bj) * 96 + pos0) = pack8(v);
                }
                __builtin_amdgcn_sched_barrier(0);
            }
    }
};
struct EpiMlaKV {
    static constexpr bool PERM = true;
    bf16_t* O; const float* SSQ; const bf16_t* Z; const float* gkn; LAS float* X;
    DI void operator()(const f32x4 (&acc)[2][2][4][2], const Unit& u, int wr_, int wc_, int fr_, int fq_) const {
        int wr = wr_, wc = wc_, fr = fr_, fq = fq_; asm volatile("" : "+s"(wr), "+s"(wc), "+v"(fr), "+v"(fq));
        const int wid = wr * 4 + wc, wb = wr * 4;
#pragma unroll
        for (int ai = 0; ai < 2; ++ai)
#pragma unroll
            for (int bj = 0; bj < 2; ++bj)
#pragma unroll
                for (int m = 0; m < 4; ++m) {
                    float ss = 0.f;
#pragma unroll
                    for (int n = 0; n < 2; ++n)
#pragma unroll
                        for (int i = 0; i < 4; ++i) ss += acc[ai][bj][m][n][i] * acc[ai][bj][m][n][i];
                    ss += __shfl_xor(ss, 16); ss += __shfl_xor(ss, 32);
                    if (fq == 0) X[(wid * 16 + ai * 8 + bj * 4 + m) * 16 + fr] = ss;
                }
        asm volatile("s_waitcnt lgkmcnt(0)" ::: "memory");
        __builtin_amdgcn_s_barrier();
        asm volatile("" ::: "memory");
        const int pos0 = 32 * (wc & 1) + 8 * fq;
        const int axis = fq >> 1;
        const int bb = u.pm / 9, sub = u.pm - bb * 9;
        const bool latent = sub != 0;
        const int row0 = u.pm * BM + wr * 64 + fr;
#pragma unroll
        for (int ai = 0; ai < 2; ++ai)
#pragma unroll
            for (int m = 0; m < 4; ++m) {
                int pz = pos0; asm volatile("" : "+v"(pz));
                const int i0 = ((pz >> 3) & 1) * 4;
                float gv[8];
#pragma unroll
                for (int i = 0; i < 8; ++i) gv[i] = gkn[pz + i];
                float invf[4], g1[4], g2[4];
#pragma unroll
                for (int j = 0; j < 4; ++j) { invf[j] = fexp2(-(float)(i0 + j) * (L2_10000 / 8.f)); g1[j] = gkn[64 + 16 * axis + i0 + j]; g2[j] = gkn[64 + 16 * axis + i0 + j + 8]; }
                const int row = row0 + ai * HALF + m * 16;
                const float rkv0 = rsqrtf(SSQ[(size_t)row * 4 + 1] * (1.f / 256.f) + EPS);
                const float ssr = SSQ[(size_t)row * 4 + 2];
                float x1[4], x2[4], cs[4], sn[4];
                if (wc == 2) {
                    const bf16_t* zr = Z + (size_t)row * 768 + 640 + 16 * axis + i0;
                    const u32x2 a1 = *(const u32x2*)zr, a2 = *(const u32x2*)(zr + 8);
                    x1[0] = bf_lo(a1[0]); x1[1] = bf_hi(a1[0]); x1[2] = bf_lo(a1[1]); x1[3] = bf_hi(a1[1]);
                    x2[0] = bf_lo(a2[0]); x2[1] = bf_hi(a2[0]); x2[2] = bf_lo(a2[1]); x2[3] = bf_hi(a2[1]);
                    const int sidx = (sub - 1) * 256 + ai * HALF + wr * 64 + m * 16 + fr;
                    const float posv = (float)(axis ? (sidx & 63) : (sidx >> 6));
#pragma unroll
                    for (int j = 0; j < 4; ++j) { const float ang = posv * invf[j]; cs[j] = latent ? __cosf(ang) : 1.f; sn[j] = latent ? __sinf(ang) : 0.f; }
                }
#pragma unroll
                for (int bj = 0; bj < 2; ++bj) {
                    const int cb = ai * 8 + bj * 4 + m;
                    const float ssn = X[((wb + 0) * 16 + cb) * 16 + fr] + X[((wb + 1) * 16 + cb) * 16 + fr];
                    const float rk = rsqrtf((rkv0 * rkv0 * ssn + ssr) * (1.f / 96.f) + EPS);
                    bf16_t* hp = O + (size_t)row * 2560 + (u.pn * 2 + bj) * 160;
                    float v[8];
                    if (wc < 2) {
#pragma unroll
                        for (int n = 0; n < 2; ++n)
#pragma unroll
                            for (int i = 0; i < 4; ++i) v[n * 4 + i] = acc[ai][bj][m][n][i] * (rkv0 * rk) * gv[n * 4 + i];
                        *(u32x4*)(hp + pos0) = pack8(v);
                    } else {
#pragma unroll
                        for (int n = 0; n < 2; ++n)
#pragma unroll
                            for (int i = 0; i < 4; ++i) v[n * 4 + i] = acc[ai][bj][m][n][i] * rkv0;
                        *(u32x4*)(hp + 96 + pos0) = pack8(v);
                        if (wc == 2) {
                            float w[8];
#pragma unroll
                            for (int j = 0; j < 4; ++j) {
                                const float y1 = x1[j] * rk * g1[j], y2 = x2[j] * rk * g2[j];
                                w[2 * j] = y1 * cs[j] - y2 * sn[j]; w[2 * j + 1] = y1 * sn[j] + y2 * cs[j];
                            }
                            *(u32x4*)(hp + 64 + 8 * fq) = pack8(w);
                        }
                    }
                }
                __builtin_amdgcn_sched_barrier(0);
            }
    }
};
struct EpiSwiglu {
    static constexpr bool PERM = true;
    bf16_t* O; int ldc;
    DI void operator()(const f32x4 (&acc)[2][2][4][2], const Unit& u, int wr, int wc, int fr, int fq) const {
        const int row0 = u.pm * BM + wr * 64 + fr, col0 = u.pn * HALF + wc * 32 + 8 * fq;
#pragma unroll
        for (int ai = 0; ai < 2; ++ai)
#pragma unroll
            for (int m = 0; m < 4; ++m) {
                float v[8];
#pragma unroll
                for (int n = 0; n < 2; ++n)
#pragma unroll
                    for (int i = 0; i < 4; ++i) v[n * 4 + i] = silu_f(acc[ai][0][m][n][i]) * acc[ai][1][m][n][i];
                *(u32x4*)(O + (size_t)(row0 + ai * HALF + m * 16) * ldc + col0) = pack8(v);
            }
    }
};
struct EpiGluRes {
    static constexpr bool PERM = true;
    float* lat; float* xc; const float* ada; int gidx;
    DI void operator()(const f32x4 (&acc)[2][2][4][2], const Unit& u, int wr, int wc, int fr, int fq) const {
        float* base = tile_res_base(lat, xc, u.pm);
        const float* gate = ada + (size_t)tile_ada_row(u.pm) * 6144 + gidx * 1024;
        const int col0 = u.pn * HALF + wc * 32 + 8 * fq;
        const f32x4 g0 = *(const f32x4*)(gate + col0), g1 = *(const f32x4*)(gate + col0 + 4);
#pragma unroll
        for (int ai = 0; ai < 2; ++ai)
#pragma unroll
            for (int m = 0; m < 4; ++m) {
                float* rp = base + ((size_t)(ai * HALF + wr * 64 + m * 16 + fr) << 10) + col0;
                f32x4 x0 = *(f32x4*)rp, x1 = *(f32x4*)(rp + 4);
#pragma unroll
                for (int i = 0; i < 4; ++i) {
                    x0[i] += g0[i] * (acc[ai][0][m][0][i] * sigmoid_f(acc[ai][1][m][0][i]));
                    x1[i] += g1[i] * (acc[ai][0][m][1][i] * sigmoid_f(acc[ai][1][m][1][i]));
                }
                *(f32x4*)rp = x0; *(f32x4*)(rp + 4) = x1;
            }
    }
};
struct EpiRes {
    static constexpr bool PERM = true;
    float* lat; float* xc; const float* ada; int gidx; const float* lat_in; const float* xc_in;
    DI void operator()(const f32x4 (&acc)[2][2][4][2], const Unit& u, int wr, int wc, int fr, int fq) const {
        float* base = tile_res_base(lat, xc, u.pm);
        const float* base_in = tile_res_base((float*)lat_in, (float*)xc_in, u.pm);
        const float* gate = ada + (size_t)tile_ada_row(u.pm) * 6144 + gidx * 1024;
        const int col0 = u.pn * BM + wc * 32 + 8 * fq;
        f32x4 gv[2][2];
#pragma unroll
        for (int bj = 0; bj < 2; ++bj)
#pragma unroll
            for (int n = 0; n < 2; ++n) gv[bj][n] = *(const f32x4*)(gate + col0 + bj * HALF + n * 4);
#pragma unroll
        for (int ai = 0; ai < 2; ++ai)
#pragma unroll
            for (int m = 0; m < 4; ++m) {
                float* rp = base + ((size_t)(ai * HALF + wr * 64 + m * 16 + fr) << 10) + col0;
                const float* rpi = base_in + ((size_t)(ai * HALF + wr * 64 + m * 16 + fr) << 10) + col0;
#pragma unroll
                for (int bj = 0; bj < 2; ++bj)
#pragma unroll
                    for (int n = 0; n < 2; ++n) {
                        f32x4 x = *(const f32x4*)(rpi + bj * HALF + n * 4);
                        x += gv[bj][n] * acc[ai][bj][m][n];
                        *(f32x4*)(rp + bj * HALF + n * 4) = x;
                    }
            }
    }
};

template <class Epi>
DI void gemm_phase(LAS unsigned char* lds, const Gemm g, const Order& S, const Epi& E) {
    const int TIDX = otid(); const int BIDX = obid(); (void)TIDX; (void)BIDX;
    const int tid = TIDX, wid = __builtin_amdgcn_readfirstlane(tid >> 6), lane = tid & 63, wr = wid >> 2, wc = wid & 3, fr = lane & 15, fq = lane >> 4;
    const int K = g.K, nt = K / BK;
    unsigned voffA[2], voffB[2];
#pragma unroll
    for (int i = 0; i < 2; ++i) { int R, C; stage_rc(tid * 16 + i * 8192, R, C); const int Rb = Epi::PERM ? ((R & ~31) + perm32(R & 31)) : R;
        voffA[i] = (unsigned)(R * g.lda + C) * 2u; voffB[i] = (unsigned)(Rb * K + C) * 2u; }
    const size_t kstep = (size_t)(BK * 2);
    const size_t hstep = (size_t)HALF * K * 2, hstepA = (size_t)HALF * g.lda * 2;
    const size_t tstep = 2 * hstep, tstepA = 2 * hstepA;
    const unsigned ldsw = (unsigned)wid * 1024u;
    const int aoff = lds_byte(wr * 64 + fr, fq * 8), boff = lds_byte(wc * 32 + fr, fq * 8);
#define PG8_SA(b, h) (((b) * 2 + (h)) * HTB)
#define PG8_SB(b, h) ((4 + (b) * 2 + (h)) * HTB)
#define PG8_STAGE(bufoff, gbase, voff) do { _Pragma("unroll") for (int _i = 0; _i < 2; ++_i) \
        __builtin_amdgcn_global_load_lds((const unsigned*)((const char*)(gbase) + (voff)[_i]), (LAS unsigned*)(lds + (bufoff) + ldsw + _i * 8192), 16, 0, 0); } while (0)
#define PG8_LDA(dst, b, h) do { _Pragma("unroll") for (int m = 0; m < 4; ++m) _Pragma("unroll") for (int k = 0; k < 2; ++k) dst[m][k] = *(const LAS bf16x8*)(lds + PG8_SA(b, h) + aoff + m * 2048 + k * 1024); } while (0)
#define PG8_LDB(dst, b, h) do { _Pragma("unroll") for (int n = 0; n < 2; ++n) _Pragma("unroll") for (int k = 0; k < 2; ++k) dst[n][k] = *(const LAS bf16x8*)(lds + PG8_SB(b, h) + boff + n * 2048 + k * 1024); } while (0)
#define PG8_MMA(ai, bj, At, Bt) do { __builtin_amdgcn_s_setprio(1); _Pragma("unroll") for (int m = 0; m < 4; ++m) _Pragma("unroll") for (int n = 0; n < 2; ++n) _Pragma("unroll") for (int k = 0; k < 2; ++k) \
        acc[ai][bj][m][n] = __builtin_amdgcn_mfma_f32_16x16x32_bf16(Bt[n][k], At[m][k], acc[ai][bj][m][n], 0, 0, 0); __builtin_amdgcn_s_setprio(0); } while (0)
#define PG8_WAIT_V(n) asm volatile("s_waitcnt vmcnt(" #n ")" ::: "memory")
#define PG8_WAIT_L(n) asm volatile("s_waitcnt lgkmcnt(" #n ")" ::: "memory")
#define PG8_BAR __builtin_amdgcn_s_barrier()
#define PG8_SCHED __builtin_amdgcn_sched_barrier(0)
    Unit cur, nxt; int ui = 0;
    if (!S.next(0, cur)) return;
    f32x4 acc[2][2][4][2];
#pragma unroll
    for (int a = 0; a < 2; ++a)
#pragma unroll
        for (int b = 0; b < 2; ++b)
#pragma unroll
            for (int m = 0; m < 4; ++m)
#pragma unroll
                for (int n = 0; n < 2; ++n) acc[a][b][m][n] = (f32x4){0.f, 0.f, 0.f, 0.f};
    bf16x8 At[4][2], B0[2][2], B1[2][2];
    const char* cA = (const char*)g.A + (size_t)cur.pm * tstepA; const char* cB = (const char*)g.Bt + (size_t)cur.pn * tstep;
    PG8_STAGE(PG8_SB(0, 0), cB, voffB); PG8_STAGE(PG8_SA(0, 0), cA, voffA); PG8_STAGE(PG8_SB(0, 1), cB + hstep, voffB); PG8_STAGE(PG8_SA(0, 1), cA + hstepA, voffA);
    if (wr == 1) PG8_BAR;
    PG8_WAIT_V(4); PG8_BAR;
    PG8_STAGE(PG8_SB(1, 0), cB + kstep, voffB); PG8_STAGE(PG8_SA(1, 0), cA + kstep, voffA); PG8_STAGE(PG8_SB(1, 1), cB + hstep + kstep, voffB);
    PG8_WAIT_V(6); PG8_BAR;
    for (;;) {
        const bool has_next = S.next(ui + 1, nxt);
        const char* nA = has_next ? (const char*)g.A + (size_t)nxt.pm * tstepA : cA; const char* nB = has_next ? (const char*)g.Bt + (size_t)nxt.pn * tstep : cB;
        for (int t = 0; t < nt; t += 2) {
            const bool last = (t == nt - 2);
            const char* a1 = cA + (size_t)(t + 1) * kstep;
            const char* a2 = last ? nA : cA + (size_t)(t + 2) * kstep; const char* b2 = last ? nB : cB + (size_t)(t + 2) * kstep;
            const char* a3 = a2 + kstep; const char* b3 = b2 + kstep;
            PG8_LDB(B0, 0, 0); PG8_SCHED; PG8_LDA(At, 0, 0); PG8_STAGE(PG8_SA(1, 1), a1 + hstepA, voffA);
            PG8_WAIT_L(8); PG8_BAR; PG8_WAIT_L(0); PG8_MMA(0, 0, At, B0); PG8_BAR; PG8_SCHED;
            PG8_LDB(B1, 0, 1); PG8_STAGE(PG8_SB(0, 0), b2, voffB);
            PG8_BAR; PG8_WAIT_L(0); PG8_MMA(0, 1, At, B1); PG8_BAR;
            PG8_LDA(At, 0, 1); PG8_STAGE(PG8_SA(0, 0), a2, voffA);
            PG8_BAR; PG8_WAIT_L(0); PG8_MMA(1, 0, At, B0); PG8_BAR; PG8_SCHED;
            PG8_STAGE(PG8_SB(0, 1), b2 + hstep, voffB);
            PG8_WAIT_V(6); PG8_BAR; PG8_MMA(1, 1, At, B1); PG8_BAR;
            PG8_LDB(B0, 1, 0); PG8_SCHED; PG8_LDA(At, 1, 0); PG8_STAGE(PG8_SA(0, 1), a2 + hstepA, voffA);
            PG8_WAIT_L(8); PG8_BAR; PG8_WAIT_L(0); PG8_MMA(0, 0, At, B0); PG8_BAR; PG8_SCHED;
            PG8_LDB(B1, 1, 1); PG8_STAGE(PG8_SB(1, 0), b3, voffB);
            PG8_BAR; PG8_WAIT_L(0); PG8_MMA(0, 1, At, B1); PG8_BAR;
            PG8_LDA(At, 1, 1); PG8_STAGE(PG8_SA(1, 0), a3, voffA);
            PG8_BAR; PG8_WAIT_L(0); PG8_MMA(1, 0, At, B0); PG8_BAR; PG8_SCHED;
            PG8_STAGE(PG8_SB(1, 1), b3 + hstep, voffB);
            PG8_WAIT_V(6); PG8_BAR; PG8_MMA(1, 1, At, B1); PG8_BAR;
        }
        E(acc, cur, wr, wc, fr, fq);
        if (!has_next) break;
#pragma unroll
        for (int a = 0; a < 2; ++a)
#pragma unroll
            for (int b = 0; b < 2; ++b)
#pragma unroll
                for (int m = 0; m < 4; ++m)
#pragma unroll
                    for (int n = 0; n < 2; ++n) acc[a][b][m][n] = (f32x4){0.f, 0.f, 0.f, 0.f};
        cur = nxt; cA = nA; cB = nB; ++ui;
    }
    PG8_WAIT_V(0);
    if (wr == 0) PG8_BAR;
    PG8_BAR;
#undef PG8_SA
#undef PG8_SB
#undef PG8_STAGE
#undef PG8_LDA
#undef PG8_LDB
#undef PG8_MMA
#undef PG8_WAIT_V
#undef PG8_WAIT_L
#undef PG8_BAR
#undef PG8_SCHED
}
}

template <class Epi>
DI void run_gemm(LAS unsigned char* lds, const bf16_t* A, int lda, const bf16_t* Bt, int N, int K, int skipctx, const Epi& E) {
    const int BIDX = obid();
    asm volatile("" : "+s"(K));
    pg8::Order S; S.init(N, (int)gridDim.x, BIDX, skipctx);
    pg8::Gemm g{A, Bt, NR, N, K, lda};
    pg8::gemm_phase<Epi>(lds, g, S, E);
}

struct WDesc { const float* src; bf16_t* dst; int K, N, Nout, half; const float* kscale; int perm; };

DI WDesc wdesc_of(const Params& p, int m) {
    unsigned char* ws = p.ws;
    if (m < 4) return WDesc{p.in[I_FWIN] + (size_t)m * 1024 * 5632, (bf16_t*)(ws + OFF_WFI + m * SZ_WFI), 1024, 5632, 5632, 2816, nullptr, 0};
    if (m < 8) return WDesc{p.in[I_FWOUT] + (size_t)(m - 4) * 2816 * 1024, (bf16_t*)(ws + OFF_WFO + (m - 4) * SZ_WFO), 2816, 1024, 1024, 0, nullptr, 0};
    switch (m) {
        case 8: return WDesc{p.in[I_MWIN], (bf16_t*)(ws + OFF_WMI), 1024, 672, 768, 0, nullptr, 0};
        case 9: return WDesc{p.in[I_MWUQ], (bf16_t*)(ws + OFF_WUQ), 384, 1536, 2048, 0, p.in[I_MGQ], 2};
        case 10: return WDesc{p.in[I_MWUKV], (bf16_t*)(ws + OFF_WUKV), 256, 2048, 2048, 0, p.in[I_MGKV], 0};
        case 11: return WDesc{p.in[I_MWO], (bf16_t*)(ws + OFF_WMO), 1024, 1024, 1024, 0, nullptr, 0};
        case 12: return WDesc{p.in[I_SWGLU], (bf16_t*)(ws + OFF_WGLU), 1024, 2048, 2048, 1024, nullptr, 0};
        case 13: return WDesc{p.in[I_NWQKV], (bf16_t*)(ws + OFF_WNQ), 1024, 3072, 3072, 0, nullptr, 0};
        case 14: return WDesc{p.in[I_NWO], (bf16_t*)(ws + OFF_WNO), 1024, 1024, 1024, 0, nullptr, 0};
        case 15: return WDesc{p.in[I_GWQKV], (bf16_t*)(ws + OFF_WGQ), 1024, 1536, 1536, 0, nullptr, 1};
        default: return WDesc{p.in[I_GWO], (bf16_t*)(ws + OFF_WGO), 1024, 1024, 1024, 0, nullptr, 0};
    }
}
DI void prep_tile(LAS float* tile, const WDesc w, int tidx, int lane) {
    const int ntk = w.K / 64;
    const int kt = tidx % ntk, nt = tidx / ntk;
    const int n0 = nt * 64;
    int scol = n0;
    if (w.half) { const int t256 = n0 >> 8, ww = n0 & 255; scol = (ww >= 128 ? w.half : 0) + t256 * 128 + (ww & 127); }
    const int c4 = (lane & 15) * 4;
    f32x4 v[16];
#pragma unroll
    for (int i = 0; i < 16; ++i) {
        const int r = (lane >> 4) + 4 * i;
        v[i] = (f32x4){0.f, 0.f, 0.f, 0.f};
        if (w.perm == 2) {
            const float* rp = w.src + (size_t)(kt * 64 + r) * w.N + (n0 >> 7) * 96;
#pragma unroll
            for (int j = 0; j < 4; ++j) { const int pos = (n0 & 127) + c4 + j; v[i][j] = pos < 96 ? rp[mla_dim_of_pos(pos)] : 0.f; }
        } else if (w.perm == 1 && n0 < 1280) {
            const float* rp = w.src + (size_t)(kt * 64 + r) * w.N + (n0 & ~127);
#pragma unroll
            for (int j = 0; j < 4; ++j) v[i][j] = rp[gqa_dim_of_pos((n0 & 127) + c4 + j)];
        } else if (scol + c4 < w.N) v[i] = *(const f32x4*)(w.src + (size_t)(kt * 64 + r) * w.N + scol + c4);
    }
#pragma unroll
    for (int i = 0; i < 16; ++i) {
        const int r = (lane >> 4) + 4 * i;
        f32x4 x = v[i];
        if (w.kscale) x *= w.kscale[kt * 64 + r];
#pragma unroll
        for (int j = 0; j < 4; ++j) tile[r * 65 + c4 + j] = x[j];
    }
    bf16_t* d = w.dst + (size_t)(n0 + lane) * w.K + kt * 64;
#pragma unroll
    for (int q = 0; q < 8; ++q) {
        float f[8];
#pragma unroll
        for (int k = 0; k < 8; ++k) f[k] = tile[(q * 8 + k) * 65 + lane];
        *(u32x4*)(d + q * 8) = pack8(f);
    }
}

DI void ada_item(const Params& p, float* ADA, int item, int lane) {
    const int layer = item / 192, n0 = (item - layer * 192) * 32;
    const int r = lane & 31, kh = lane >> 5;
    const float* W = p.in[I_ADAW] + (size_t)layer * 1024 * 6144 + n0 + r;
    const float* cb = p.in[I_C] + r * 1024 + kh * 8;
    const float* cc = p.in[I_CCTX] + kh * 8;
    f32x16 acc;
#pragma unroll
    for (int i = 0; i < 16; ++i) acc[i] = 0.f;
    float accc = 0.f;
    for (int k0 = 0; k0 < 1024; k0 += 32) {
        float wv[16], cv[16], xv[16];
#pragma unroll
        for (int h2 = 0; h2 < 2; ++h2) {
            const f32x4 c0 = *(const f32x4*)(cb + k0 + h2 * 16), c1 = *(const f32x4*)(cb + k0 + h2 * 16 + 4);
            const f32x4 x0 = *(const f32x4*)(cc + k0 + h2 * 16), x1 = *(const f32x4*)(cc + k0 + h2 * 16 + 4);
#pragma unroll
            for (int u = 0; u < 4; ++u) { cv[h2 * 8 + u] = c0[u]; cv[h2 * 8 + 4 + u] = c1[u]; xv[h2 * 8 + u] = x0[u]; xv[h2 * 8 + 4 + u] = x1[u]; }
#pragma unroll
            for (int u = 0; u < 8; ++u) wv[h2 * 8 + u] = W[(size_t)(k0 + h2 * 16 + kh * 8 + u) * 6144];
        }
#pragma unroll
        for (int u = 0; u < 16; ++u) {
            acc = __builtin_amdgcn_mfma_f32_32x32x2f32(silu_f(cv[u]), wv[u], acc, 0, 0, 0);
            accc += silu_f(xv[u]) * wv[u];
        }
    }
    accc += __shfl_xor(accc, 32);
    const float bias = p.in[I_ADAB][layer * 6144 + n0 + r];
#pragma unroll
    for (int i = 0; i < 16; ++i) {
        const int v = (i & 3) + 8 * (i >> 2) + 4 * kh;
        ADA[((size_t)layer * 33 + v) * 6144 + n0 + r] = acc[i] + bias;
    }
    if (kh == 0) ADA[((size_t)layer * 33 + 32) * 6144 + n0 + r] = accc + bias;
}

DI void phase0(LAS unsigned char* lds, const Params& p, float* ADA, unsigned* counter) {
    const int TIDX = otid();
    const int wave = __builtin_amdgcn_readfirstlane(TIDX >> 6), lane = TIDX & 63;
    LAS float* tile = (LAS float*)(lds + wave * 16640);
    constexpr int NADA = 4 * 192;
    for (;;) {
        int item = 0;
        if (lane == 0) item = (int)atomicAdd(counter, 1u);
        item = __builtin_amdgcn_readfirstlane(item);
        if (item < NADA) { ada_item(p, ADA, item, lane); continue; }
        int t = item - NADA, m = 0;
        bool found = false;
        for (m = 0; m < 17; ++m) {
            const WDesc w = wdesc_of(p, m);
            const int nt = (w.K / 64) * (w.Nout / 64);
            if (t < nt) { prep_tile(tile, w, t, lane); found = true; break; }
            t -= nt;
        }
        if (!found) break;
    }
}

DI void norm_phase(const float* lat_in, const float* ctx_in, float* lat_out, float* ctx_out, bool copy, const float* g,
                   const float* ada, int shidx, bf16_t* H, bool skipctx, float* ssq_zero = nullptr) {
    const int TIDX = otid(); const int BIDX = obid(); (void)TIDX; (void)BIDX;
    const int wave = TIDX >> 6, lane = TIDX & 63;
    for (int row = BIDX * 8 + wave; row < NR; row += gridDim.x * 8) {
        const int b = row / TT, t = row - b * TT;
        if (skipctx && t < CTXL) continue;
        if (ssq_zero && lane < 4) ssq_zero[(size_t)row * 4 + lane] = 0.f;
        const size_t ro = t < CTXL ? ((size_t)(b * CTXL + t) << 10) : ((size_t)(b * SEQ + t - CTXL) << 10);
        const float* src = (t < CTXL ? ctx_in : lat_in) + ro;
        const float* sh = ada + (size_t)(t < CTXL ? 32 : b) * 6144 + shidx * 1024;
        const float* sc = sh + 1024;
        f32x4 a[4];
        a[0] = *(const f32x4*)(src + lane * 8); a[1] = *(const f32x4*)(src + lane * 8 + 4);
        a[2] = *(const f32x4*)(src + 512 + lane * 8); a[3] = *(const f32x4*)(src + 512 + lane * 8 + 4);
        float ss = 0.f;
#pragma unroll
        for (int i = 0; i < 4; ++i)
#pragma unroll
            for (int j = 0; j < 4; ++j) ss += a[i][j] * a[i][j];
        ss = wsum(ss);
        const float r = rsqrtf(ss * (1.f / 1024.f) + EPS);
        if (copy) {
            float* dst = (t < CTXL ? ctx_out : lat_out) + ro;
            *(f32x4*)(dst + lane * 8) = a[0]; *(f32x4*)(dst + lane * 8 + 4) = a[1];
            *(f32x4*)(dst + 512 + lane * 8) = a[2]; *(f32x4*)(dst + 512 + lane * 8 + 4) = a[3];
        }
#pragma unroll
        for (int hf = 0; hf < 2; ++hf) {
            const int c0 = hf * 512 + lane * 8;
            float y[8];
#pragma unroll
            for (int q = 0; q < 2; ++q) {
                const f32x4 gv = *(const f32x4*)(g + c0 + q * 4), sv = *(const f32x4*)(sc + c0 + q * 4), hv = *(const f32x4*)(sh + c0 + q * 4);
#pragma unroll
                for (int j = 0; j < 4; ++j) y[q * 4 + j] = a[hf * 2 + q][j] * r * gv[j] * (1.f + sv[j]) + hv[j];
            }
            *(u32x4*)(H + ((size_t)row << 10) + c0) = pack8(y);
        }
    }
}

DI void mla_rope8(float* v, int sub, int s) {
    const float pos = (float)((sub < 2) ? (s >> 6) : (s & 63));
    const bool isx2 = sub & 1;
#pragma unroll
    for (int i = 0; i < 8; ++i) {
        const float other = __shfl_xor(v[i], 1);
        const float ang = pos * fexp2(-(float)i * (L2_10000 / 8.f));
        const float c = __cosf(ang), sn = __sinf(ang);
        v[i] = isx2 ? (other * sn + v[i] * c) : (v[i] * c - other * sn);
    }
}

DI void mla_r2(bf16_t* QB, bf16_t* KV, const bf16_t* Z, const float* gqn, const float* gkn) {
    const int TIDX = otid(); const int BIDX = obid(); (void)TIDX; (void)BIDX;
    const int wave = TIDX >> 6, lane = TIDX & 63, hd = lane >> 2, sub = lane & 3;
    for (int row = BIDX * 8 + wave; row < NR; row += gridDim.x * 8) {
        const int b = row / TT, t = row - b * TT; const bool latent = t >= CTXL; const int s = t - CTXL;
        const bf16_t* z = Z + (size_t)row * 768;
        bf16_t* qp = QB + (size_t)row * 1536 + hd * 96;
        bf16_t* kp = KV + (size_t)row * 2560 + hd * 160;
        unsigned zq[3];
#pragma unroll
        for (int i = 0; i < 3; ++i) zq[i] = *(const unsigned*)(z + lane * 6 + 2 * i);
        const u32x2 zk = *(const u32x2*)(z + 384 + lane * 4);
        const u32x4 q0 = *(const u32x4*)(qp + sub * 16), q1 = *(const u32x4*)(qp + sub * 16 + 8), q2 = *(const u32x4*)(qp + 64 + sub * 8);
        const u32x4 k0 = *(const u32x4*)(kp + sub * 16), k1 = *(const u32x4*)(kp + sub * 16 + 8);
        const u32x4 v0 = *(const u32x4*)(kp + 64 + sub * 16), v1 = *(const u32x4*)(kp + 64 + sub * 16 + 8);
        const u32x4 k2 = *(const u32x4*)(z + 640 + sub * 8);
        asm volatile("s_waitcnt vmcnt(0)" ::: "memory");
        float sq0 = 0.f, sk0 = 0.f;
#pragma unroll
        for (int i = 0; i < 3; ++i) { const float a0 = bf_lo(zq[i]), a1 = bf_hi(zq[i]); sq0 += a0 * a0 + a1 * a1; }
        { const float a0 = bf_lo(zk[0]), a1 = bf_hi(zk[0]), a2 = bf_lo(zk[1]), a3 = bf_hi(zk[1]); sk0 = a0 * a0 + a1 * a1 + a2 * a2 + a3 * a3; }
        sq0 = wsum(sq0); sk0 = wsum(sk0);
        const float rq0 = rsqrtf(sq0 * (1.f / 384.f) + EPS), rk0 = rsqrtf(sk0 * (1.f / 256.f) + EPS);
        float qn[16], qr[8], kn[16], kr[8], vv[16];
        unpack8(q0, qn); unpack8(q1, qn + 8); unpack8(q2, qr);
        unpack8(k0, kn); unpack8(k1, kn + 8); unpack8(k2, kr);
        unpack8(v0, vv); unpack8(v1, vv + 8);
#pragma unroll
        for (int i = 0; i < 16; ++i) { qn[i] *= rq0; kn[i] *= rk0; vv[i] *= rk0; }
#pragma unroll
        for (int i = 0; i < 8; ++i) qr[i] *= rq0;
        float sq = 0.f, sk = 0.f;
#pragma unroll
        for (int i = 0; i < 16; ++i) { sq += qn[i] * qn[i]; sk += kn[i] * kn[i]; }
#pragma unroll
        for (int i = 0; i < 8; ++i) { sq += qr[i] * qr[i]; sk += kr[i] * kr[i]; }
        sq += __shfl_xor(sq, 1); sq += __shfl_xor(sq, 2);
        sk += __shfl_xor(sk, 1); sk += __shfl_xor(sk, 2);
        const float rq = rsqrtf(sq * (1.f / 96.f) + EPS), rk = rsqrtf(sk * (1.f / 96.f) + EPS);
#pragma unroll
        for (int i = 0; i < 16; ++i) { qn[i] *= rq * gqn[sub * 16 + i]; kn[i] *= rk * gkn[sub * 16 + i]; }
#pragma unroll
        for (int i = 0; i < 8; ++i) { qr[i] *= rq * gqn[64 + sub * 8 + i]; kr[i] *= rk * gkn[64 + sub * 8 + i]; }
        if (latent) { mla_rope8(qr, sub, s); mla_rope8(kr, sub, s); }
        *(u32x4*)(qp + sub * 16) = pack8(qn); *(u32x4*)(qp + sub * 16 + 8) = pack8(qn + 8); *(u32x4*)(qp + 64 + sub * 8) = pack8(qr);
        *(u32x4*)(kp + sub * 16) = pack8(kn); *(u32x4*)(kp + sub * 16 + 8) = pack8(kn + 8); *(u32x4*)(kp + 64 + sub * 8) = pack8(kr);
        *(u32x4*)(kp + 96 + sub * 16) = pack8(vv); *(u32x4*)(kp + 96 + sub * 16 + 8) = pack8(vv + 8);
    }
}

template <int HD, int LPH, int ROPE>
DI void headnorm_phase(bf16_t* X, int stride, int nq, int koff, int nk, const float* gq, const float* gk) {
    const int TIDX = otid(); const int BIDX = obid(); (void)TIDX; (void)BIDX;
    const int wave = TIDX >> 6, lane = TIDX & 63, sub = lane % LPH, hl = lane / LPH;
    const int rstep = gridDim.x * 8;
    for (int row = BIDX * 8 + wave; row < NR; row += 2 * rstep) {
        u32x4 u[2][2][2];
#pragma unroll
        for (int rr = 0; rr < 2; ++rr)
#pragma unroll
            for (int pass = 0; pass < 2; ++pass) {
                const int r2 = row + rr * rstep;
                const bool act = (r2 < NR) && (hl < (pass ? nk : nq));
                const bf16_t* ptr = X + (size_t)r2 * stride + (pass ? koff : 0) + hl * HD + sub * 16;
                u[rr][pass][0] = (u32x4){0, 0, 0, 0}; u[rr][pass][1] = (u32x4){0, 0, 0, 0};
                if (act) { u[rr][pass][0] = *(const u32x4*)ptr; u[rr][pass][1] = *(const u32x4*)(ptr + 8); }
            }
        asm volatile("s_waitcnt vmcnt(0)" ::: "memory");
#pragma unroll
        for (int rr = 0; rr < 2; ++rr) {
            const int r2 = row + rr * rstep;
            const int b = r2 / TT, t = r2 - b * TT; const bool latent = t >= CTXL; const int s = t - CTXL;
#pragma unroll
            for (int pass = 0; pass < 2; ++pass) {
                const bool act = (r2 < NR) && (hl < (pass ? nk : nq));
                const float* g = pass ? gk : gq;
                bf16_t* ptr = X + (size_t)r2 * stride + (pass ? koff : 0) + hl * HD + sub * 16;
                float v[16]; unpack8(u[rr][pass][0], v); unpack8(u[rr][pass][1], v + 8);
                float ss = 0.f;
#pragma unroll
                for (int i = 0; i < 16; ++i) ss += v[i] * v[i];
#pragma unroll
                for (int o = 1; o < LPH; o <<= 1) ss += __shfl_xor(ss, o);
                const float rr_ = rsqrtf(ss * (1.f / HD) + EPS);
#pragma unroll
                for (int i = 0; i < 16; ++i) v[i] *= rr_ * g[sub * 16 + i];
                if (ROPE) {
                    if (latent) {
                        const int axis = sub >> 2; const bool isx2 = (sub >> 1) & 1;
                        const float pos = (float)(axis ? (s & 63) : (s >> 6));
#pragma unroll
                        for (int i = 0; i < 16; ++i) {
                            const float other = __shfl_xor(v[i], 2);
                            const int fi = (sub & 1) * 16 + i;
                            const float ang = pos * fexp2(-(float)fi * (L2_10000 / 32.f));
                            const float c = __cosf(ang), sn = __sinf(ang);
                            v[i] = isx2 ? (other * sn + v[i] * c) : (v[i] * c - other * sn);
                        }
                    }
                }
                if (act) { *(u32x4*)ptr = pack8(v); *(u32x4*)(ptr + 8) = pack8(v + 8); }
            }
        }
    }
}

struct AttnArgs { const bf16_t* Q; const bf16_t* K; const bf16_t* V; bf16_t* O; int qs, qh, ks, kh, vs, vh, nheads, gshift, ctx_out; const float* rpb; float sc; };

template <int DK, int DV, int NA>
DI void attn_phase(LAS unsigned char* lds, const AttnArgs a) {
    const int TIDX = otid(); const int BIDX = obid(); (void)TIDX; (void)BIDX;
    constexpr int KROW = DK * 2 + 16, VROW = DV * 2 + 16;
    constexpr int KBUF = 64 * KROW, VBUF = 64 * VROW;
    constexpr int OFFK = 0, OFFV = 2 * KBUF, OFFR = OFFV + 2 * VBUF;
    constexpr int KCH = DK / 8, VCH = DV / 8, NKC = 64 * KCH, NVC = 64 * VCH;
    constexpr int KPT = (NKC + 511) / 512, VPT = (NVC + 511) / 512;
    constexpr int NK0 = DK / 16, NQG = NK0 / 2;
    const int tid = TIDX, wave = __builtin_amdgcn_readfirstlane(tid >> 6), lane = tid & 63, r = lane & 31, hh = lane >> 5;
    const int i16 = lane & 15, tq = i16 >> 2, tp = i16 & 3, blk = (lane >> 4) & 1;
    const int nlat = NB * a.nheads * 8, ntot = nlat + (a.ctx_out ? NB * a.nheads : 0);
    LAS float* rpbL = (LAS float*)(lds + OFFR);
    for (int item = BIDX; item < ntot; item += gridDim.x) {
        int b, h, qb = 0; const bool isctx = item >= nlat;
        if (!isctx) { const int R = item >> 8, u = item & 255; const int qp = (R * 8 + (u & 7)) * 4 + (u >> 6); qb = (u >> 3) & 7; h = qp % a.nheads; b = qp / a.nheads; }
        else { const int bh = item - nlat; h = bh % a.nheads; b = bh / a.nheads; }
        const int hk = h >> a.gshift;
        const size_t rb = (size_t)b * TT;
        const bf16_t* Kb = a.K + hk * a.kh; const bf16_t* Vb = a.V + hk * a.vh;
        int ntiles = isctx ? 4 : 36, rlo = 0, wi = 0, wr0 = 0, c0 = 0;
        if (NA) {
            if (!isctx) { const int i0 = qb * 4; rlo = clampi(i0 - 4, 0, 24); const int rhi = clampi(i0 - 1, 0, 24) + 8; ntiles = 4 + rhi - rlo;
                wi = i0 + (wave >> 1); wr0 = clampi(wi - 4, 0, 24); c0 = (wave & 1) * 32; }
            if (tid < 465) rpbL[64 + tid] = a.rpb[h * 465 + tid] * LOG2E;
        }
        const size_t qrow = rb + (isctx ? 0 : 256 + qb * 256) + wave * 32 + r;
        bf16x8 qf[DK / 16];
#pragma unroll
        for (int k0 = 0; k0 < DK / 16; ++k0) qf[k0] = *(const bf16x8*)(a.Q + qrow * a.qs + h * a.qh + k0 * 16 + hh * 8);
        u32x4 sreg[KPT > VPT ? KPT : VPT];
#define ATT_TILE_ROW(j) ((NA && (j) >= 4) ? rb + 256 + (size_t)(rlo + (j) - 4) * 64 : rb + (size_t)(j) * 64)
#define ATT_GLOADK(j) do { const size_t _tr = ATT_TILE_ROW(j); \
        _Pragma("unroll") for (int _i = 0; _i < KPT; ++_i) { const int _c = tid + _i * 512; if (_c < NKC) { const int _row = _c / KCH, _cc = _c - _row * KCH; sreg[_i] = *(const u32x4*)(Kb + (_tr + _row) * a.ks + _cc * 8); } } } while (0)
#define ATT_GLOADV(j) do { const size_t _tr = ATT_TILE_ROW(j); \
        _Pragma("unroll") for (int _i = 0; _i < VPT; ++_i) { const int _c = tid + _i * 512; if (_c < NVC) { const int _row = _c / VCH, _cc = _c - _row * VCH; sreg[_i] = *(const u32x4*)(Vb + (_tr + _row) * a.vs + _cc * 8); } } } while (0)
#define ATT_LSTOREK(buf) do { \
        _Pragma("unroll") for (int _i = 0; _i < KPT; ++_i) { const int _c = tid + _i * 512; if (_c < NKC) { const int _row = _c / KCH, _cc = _c - _row * KCH; *(LAS u32x4*)(lds + OFFK + (buf) * KBUF + _row * KROW + _cc * 16) = sreg[_i]; } } } while (0)
#define ATT_LSTOREV(buf) do { \
        _Pragma("unroll") for (int _i = 0; _i < VPT; ++_i) { const int _c = tid + _i * 512; if (_c < NVC) { const int _row = _c / VCH, _cc = _c - _row * VCH; *(LAS u32x4*)(lds + OFFV + (buf) * VBUF + _row * VROW + _cc * 16) = sreg[_i]; } } } while (0)
#define ATT_KFRAG(buf, idx) (*(const LAS bf16x8*)(lds + OFFK + (buf) * KBUF + (((idx) / NK0) * 32 + r) * KROW + ((idx) % NK0) * 32 + hh * 16))
#define ATT_QK(dst, buf) do { \
        _Pragma("unroll") for (int _x = 0; _x < 2 * NK0; ++_x) { const bf16x8 kf = ATT_KFRAG(buf, _x); \
            dst[_x / NK0] = __builtin_amdgcn_mfma_f32_32x32x16_bf16(kf, qf[_x % NK0], (_x % NK0) == 0 ? zero16 : dst[_x / NK0], 0, 0, 0); } } while (0)
#define ATT_ACTIVE(j) (!(NA && (j) >= 4) || ((rlo + (j) - 4 >= wr0) && (rlo + (j) - 4 < wr0 + 8)))
#define ATT_TILE(j, S, SN) do { \
        if ((j) + 1 < ntiles) ATT_GLOADV((j) + 1); \
        if (ATT_ACTIVE(j)) { \
            const int nb = ((j) + 1) & 1; \
            const LAS unsigned char* Vt = lds + OFFV + ((j) & 1) * VBUF; \
            bf16x8 kfr[2][NQG]; \
            _Pragma("unroll") for (int q = 0; q < NQG; ++q) kfr[0][q] = ATT_KFRAG(nb, q); \
            float mx = m_run; \
            if (NA && (j) >= 4) { \
                const int kr = rlo + (j) - 4; \
                const int ri = kr - wi + 7, qj = c0 + r, cs = clampi(qj - 8, 0, 48); \
                const LAS float* bp = rpbL + 64 + ri * 31 + (4 * hh - qj + 15); \
                const int vb = 4 * hh - cs; \
                _Pragma("unroll") for (int kb = 0; kb < 2; ++kb) \
                    _Pragma("unroll") for (int i = 0; i < 16; ++i) { \
                        const int ci = kb * 32 + (i & 3) + 8 * (i >> 2); \
                        const bool valid = (unsigned)(vb + ci) < 16u; \
                        const float x = valid ? __builtin_fmaf(S[kb][i], a.sc, bp[ci]) : -1e30f; \
                        S[kb][i] = x; mx = fmaxf(mx, x); } \
                mx = fmaxf(mx, __shfl_xor(mx, 32)); \
            } else { \
                float mr = -1e30f; \
                _Pragma("unroll") for (int kb = 0; kb < 2; ++kb) \
                    _Pragma("unroll") for (int i = 0; i < 16; ++i) mr = fmaxf(mr, S[kb][i]); \
                mr = fmaxf(mr, __shfl_xor(mr, 32)); \
                mx = fmaxf(mx, mr * a.sc); \
            } \
            if (__any(mx > m_run + 8.f)) {     \
                const float alpha = fexp2(m_run - mx); \
                lsum *= alpha; \
                _Pragma("unroll") for (int d = 0; d < DV / 32; ++d) \
                    _Pragma("unroll") for (int i = 0; i < 16; ++i) o[d][i] *= alpha; \
                m_run = mx; \
            } \
            mx = m_run; \
            __builtin_amdgcn_sched_barrier(0); \
            _Pragma("unroll") for (int grp = 0; grp < 4; ++grp) { \
                const int kb = grp >> 1, st = grp & 1; \
                if (grp < 3) { _Pragma("unroll") for (int q = 0; q < NQG; ++q) kfr[(grp + 1) & 1][q] = ATT_KFRAG(nb, (grp + 1) * NQG + q); } \
                bf16x8 vf[DV / 32]; \
                _Pragma("unroll") for (int d = 0; d < DV / 32; ++d) { \
                    const LAS unsigned char* ad = Vt + (kb * 32 + 16 * st + 4 * hh + tq) * VROW + (d * 32 + 16 * blk + 4 * tp) * 2; \
                    const s16x4 lo = __builtin_amdgcn_ds_read_tr16_b64_v4i16((LAS s16x4*)ad); \
                    const s16x4 hi = __builtin_amdgcn_ds_read_tr16_b64_v4i16((LAS s16x4*)(ad + 8 * VROW)); \
                    vf[d] = __builtin_shufflevector(lo, hi, 0, 1, 2, 3, 4, 5, 6, 7); } \
                _Pragma("unroll") for (int q = 0; q < NQG; ++q) { const int idx = grp * NQG + q; \
                    SN[idx / NK0] = __builtin_amdgcn_mfma_f32_32x32x16_bf16(kfr[grp & 1][q], qf[idx % NK0], (idx % NK0) == 0 ? zero16 : SN[idx / NK0], 0, 0, 0); } \
                __builtin_amdgcn_sched_barrier(0); \
                float pp[8]; \
                _Pragma("unroll") for (int i = 0; i < 8; ++i) { \
                    pp[i] = (NA && (j) >= 4) ? fexp2(S[kb][8 * st + i] - mx) : fexp2(__builtin_fmaf(S[kb][8 * st + i], a.sc, -mx)); lsum += pp[i]; } \
                const bf16x8 pf = __builtin_bit_cast(bf16x8, pack8(pp)); \
                __builtin_amdgcn_sched_barrier(0); \
                _Pragma("unroll") for (int d = 0; d < DV / 32; ++d) o[d] = __builtin_amdgcn_mfma_f32_32x32x16_bf16(vf[d], pf, o[d], 0, 0, 0); \
                __builtin_amdgcn_sched_barrier(0); \
                if (grp == 1) { \
                    if ((j) + 1 < ntiles) ATT_LSTOREV(((j) + 1) & 1); \
                    if ((j) + 2 < ntiles) ATT_GLOADK((j) + 2); \
                    __builtin_amdgcn_sched_barrier(0); \
                } \
            } \
        } else { \
            ATT_QK(SN, ((j) + 1) & 1); \
            if ((j) + 1 < ntiles) ATT_LSTOREV(((j) + 1) & 1); \
            if ((j) + 2 < ntiles) ATT_GLOADK((j) + 2); \
        } \
        if ((j) + 2 < ntiles) ATT_LSTOREK((j) & 1); \
        __syncthreads(); } while (0)
        ATT_GLOADK(0); ATT_LSTOREK(0); ATT_GLOADV(0); ATT_LSTOREV(0);
        ATT_GLOADK(1); ATT_LSTOREK(1);
        __syncthreads();
        f32x16 o[DV / 32];
#pragma unroll
        for (int d = 0; d < DV / 32; ++d)
#pragma unroll
            for (int i = 0; i < 16; ++i) o[d][i] = 0.f;
        f32x16 zero16;
#pragma unroll
        for (int i = 0; i < 16; ++i) zero16[i] = 0.f;
        float m_run = -1e30f, lsum = 0.f;
        f32x16 s[2], sn[2];
        ATT_QK(s, 0);
        __syncthreads();
        for (int j = 0; j < ntiles; j += 2) {
            ATT_TILE(j, s, sn);
            if (j + 1 < ntiles) ATT_TILE(j + 1, sn, s);
        }
        lsum += __shfl_xor(lsum, 32);
        const float inv = frcp(lsum);
        bf16_t* orow = a.O + (qrow << 10) + h * DV;
#pragma unroll
        for (int d = 0; d < DV / 32; ++d)
#pragma unroll
            for (int g = 0; g < 4; ++g)
                *(u32x2*)(orow + d * 32 + 8 * g + 4 * hh) = (u32x2){pk_bf16(o[d][4 * g] * inv, o[d][4 * g + 1] * inv), pk_bf16(o[d][4 * g + 2] * inv, o[d][4 * g + 3] * inv)};
#undef ATT_TILE_ROW
#undef ATT_GLOADK
#undef ATT_GLOADV
#undef ATT_LSTOREK
#undef ATT_LSTOREV
#undef ATT_KFRAG
#undef ATT_QK
#undef ATT_ACTIVE
#undef ATT_TILE
    }
}

DI void s5_scan_phase(LAS unsigned char* lds, const Params& p, bf16_t* H, bf16_t* YF) {
    const int TIDX = otid(); const int BIDX = obid(); (void)TIDX; (void)BIDX;
    const int wave = __builtin_amdgcn_readfirstlane(TIDX >> 6), lane = TIDX & 63;
    LAS float* BU = (LAS float*)(lds + wave * 14592);
    LAS bf16_t* Hh = (LAS bf16_t*)(lds + wave * 14592 + 10240);
    const int l15 = lane & 15, l4 = lane >> 4;
    for (int item = BIDX * 8 + wave; item < NB * 64; item += gridDim.x * 8) {
        const int g = item & 63, b = item >> 6;
        const float dsk = p.in[I_SD][g * 16 + l15];
        for (int dir = 0; dir < 2; ++dir) {
            const int pg = dir * 64 + g;
            const float dt = __expf(p.in[I_SLDT][pg]);
            const float* are = p.in[I_SARE] + pg * 64; const float* aim = p.in[I_SAIM] + pg * 64;
            float abr, abi;
            { const float ar = are[lane], ai = aim[lane]; const float mag = __expf(dt * ar); abr = mag * __cosf(dt * ai); abi = mag * __sinf(dt * ai); }
            bf16x8 bfr[8], cfr[4];
#pragma unroll
            for (int nt = 0; nt < 8; ++nt) {
                const int st = (nt & 3) * 16 + l15;
                const float ar = are[st], ai = aim[st]; const float mag = __expf(dt * ar);
                const float er = mag * __cosf(dt * ai), ei = mag * __sinf(dt * ai);
                const float den = ar * ar + ai * ai, nr = er - 1.f;
                const float fre = (nr * ar + ei * ai) / den, fim = (ei * ar - nr * ai) / den;
                float bb[8];
#pragma unroll
                for (int j = 0; j < 8; ++j) bb[j] = 0.f;
                if (lane < 32) {
                    const float* br = p.in[I_SBRE] + ((size_t)pg * 64 + st) * 16 + l4 * 8; const float* bi = p.in[I_SBIM] + ((size_t)pg * 64 + st) * 16 + l4 * 8;
#pragma unroll
                    for (int j = 0; j < 8; ++j) bb[j] = (nt < 4) ? (fre * br[j] - fim * bi[j]) : (fre * bi[j] + fim * br[j]);
                }
                bfr[nt] = __builtin_bit_cast(bf16x8, pack8(bb));
            }
#pragma unroll
            for (int kk = 0; kk < 4; ++kk) {
                const int st0 = kk * 16 + l4 * 4;
                const f32x4 cr4 = *(const f32x4*)(p.in[I_SCRE] + ((size_t)pg * 16 + l15) * 64 + st0);
                const f32x4 ci4 = *(const f32x4*)(p.in[I_SCIM] + ((size_t)pg * 16 + l15) * 64 + st0);
                float cc[8];
#pragma unroll
                for (int j = 0; j < 4; ++j) { cc[2 * j] = cr4[j]; cc[2 * j + 1] = -ci4[j]; }
                cfr[kk] = __builtin_bit_cast(bf16x8, pack8(cc));
            }
            float hr = 0.f, hi = 0.f;
#define S5_TB(j) (dir ? ((j) < 16 ? 16 * (15 - (j)) : 256 + 16 * (143 - (j))) : 16 * (j))
            bf16x8 ufn = (bf16x8){0, 0, 0, 0, 0, 0, 0, 0};
            if (lane < 32) ufn = *(const bf16x8*)(H + (((size_t)b * TT + S5_TB(0) + l15) << 10) + g * 16 + l4 * 8);
            for (int j = 0; j < 144; ++j) {
                const int tb = S5_TB(j);
                const size_t row0 = (size_t)b * TT + tb;
                const bf16x8 uf = ufn;
                if (lane < 32 && j + 1 < 144) ufn = *(const bf16x8*)(H + (((size_t)b * TT + S5_TB(j + 1) + l15) << 10) + g * 16 + l4 * 8);
                float yfv[4], uv[4];
                if (dir) {
#pragma unroll
                    for (int i = 0; i < 4; ++i) {
                        const size_t o = ((row0 + l4 * 4 + i) << 10) + g * 16 + l15;
                        yfv[i] = __uint_as_float(((unsigned)YF[o]) << 16); uv[i] = __uint_as_float(((unsigned)H[o]) << 16);
                    }
                }
#pragma unroll
                for (int nt = 0; nt < 8; ++nt) {
                    const f32x4 acc = __builtin_amdgcn_mfma_f32_16x16x32_bf16(uf, bfr[nt], (f32x4){0.f, 0.f, 0.f, 0.f}, 0, 0, 0);
                    *(LAS f32x4*)(BU + (nt * 16 + l15) * 20 + l4 * 4) = acc;
                }
                float bur[16], bui[16];
#pragma unroll
                for (int q = 0; q < 4; ++q) {
                    const f32x4 r4 = *(const LAS f32x4*)(BU + lane * 20 + q * 4), i4 = *(const LAS f32x4*)(BU + (64 + lane) * 20 + q * 4);
#pragma unroll
                    for (int e = 0; e < 4; ++e) { bur[q * 4 + e] = r4[e]; bui[q * 4 + e] = i4[e]; }
                }
                if (dir) {
#pragma unroll
                    for (int tt = 15; tt >= 0; --tt) {
                        const float nhr = abr * hr - abi * hi + bur[tt], nhi = abr * hi + abi * hr + bui[tt];
                        hr = nhr; hi = nhi;
                        *(LAS unsigned*)(Hh + tt * 136 + 2 * lane) = pk_bf16(hr, hi);
                    }
                } else {
#pragma unroll
                    for (int tt = 0; tt < 16; ++tt) {
                        const float nhr = abr * hr - abi * hi + bur[tt], nhi = abr * hi + abi * hr + bui[tt];
                        hr = nhr; hi = nhi;
                        *(LAS unsigned*)(Hh + tt * 136 + 2 * lane) = pk_bf16(hr, hi);
                    }
                }
                f32x4 ya = (f32x4){0.f, 0.f, 0.f, 0.f};
#pragma unroll
                for (int kk = 0; kk < 4; ++kk) {
                    const bf16x8 af = *(const LAS bf16x8*)(Hh + l15 * 136 + kk * 32 + l4 * 8);
                    ya = __builtin_amdgcn_mfma_f32_16x16x32_bf16(af, cfr[kk], ya, 0, 0, 0);
                }
                if (dir == 0) {
#pragma unroll
                    for (int i = 0; i < 4; ++i) YF[((row0 + l4 * 4 + i) << 10) + g * 16 + l15] = (bf16_t)(pk_bf16(ya[i], 0.f) & 0xffffu);
                } else {
#pragma unroll
                    for (int i = 0; i < 4; ++i) {
                        const size_t o = ((row0 + l4 * 4 + i) << 10) + g * 16 + l15;
                        const float y = gelu_tanh(dsk * uv[i] + yfv[i] + ya[i]);
                        H[o] = (bf16_t)(pk_bf16(y, 0.f) & 0xffffu);
                    }
                }
            }
        }
    }
}

#define XB_TMO      128
#define XB_XCNT(j)  (256  + 64 * (j))
#define XB_XSUB(j)  (1280 + 64 * (j))
#define XB_XGEN(j)  (2304 + 64 * (j))
#define XB_TOP      3328
#define XB_TOPGEN   3392
#define XCD_BAR_WORDS 3456
#define XB_SPIN_CAP (1u << 18)
DI unsigned xb_ld(unsigned* p)              { return __hip_atomic_load(p, __ATOMIC_RELAXED, __HIP_MEMORY_SCOPE_AGENT); }
DI unsigned xb_add(unsigned* p, unsigned v) { return __hip_atomic_fetch_add(p, v, __ATOMIC_RELAXED, __HIP_MEMORY_SCOPE_AGENT); }
DI unsigned xb_xcc_id() { return (unsigned)__builtin_amdgcn_s_getreg((3 << 11) | 20) & 0xFu; }
#define XB_SPIN(cond, bar) do { unsigned _sp = 0; while (cond) { __builtin_amdgcn_s_sleep(1); \
    if ((++_sp & 255u) == 0u) { if (xb_ld(&(bar)[XB_TMO])) break; if (_sp > XB_SPIN_CAP) { atomicAdd(&(bar)[XB_TMO], 1u); break; } } } } while (0)
struct XcdBarrier { unsigned* bar; unsigned x; volatile LAS unsigned* st; };
DI XcdBarrier xcd_barrier_post(unsigned* bar, volatile LAS unsigned* st) {
    XcdBarrier b; b.bar = bar; b.x = xb_xcc_id(); b.st = st;
    if (threadIdx.x == 0) (void)xb_add(&bar[XB_XCNT(b.x)], 1u);
    return b;
}
DI void xcd_barrier_complete(unsigned* bar, unsigned x, unsigned& nloc, unsigned& nx) {
    const unsigned G = gridDim.x * gridDim.y * gridDim.z;
    unsigned sum, cnt, mine, sp = 0u;
    for (;;) {
        sum = 0u; cnt = 0u; mine = 0u;
#pragma unroll
        for (unsigned j = 0; j < 16; ++j) { const unsigned c = xb_ld(&bar[XB_XCNT(j)]); sum += c; cnt += (c > 0u) ? 1u : 0u; mine = (j == x) ? c : mine; }
        if (sum == G) break;
        __builtin_amdgcn_s_sleep(1);
        if ((++sp & 255u) == 0u) { if (xb_ld(&bar[XB_TMO])) break; if (sp > XB_SPIN_CAP) { atomicAdd(&bar[XB_TMO], 1u); break; } }
    }
    nloc = mine > 0u ? mine : 1u; nx = cnt > 0u ? cnt : 1u;
}
DI void xcd_barrier(const XcdBarrier& b) {
    asm volatile("s_waitcnt vmcnt(0)" ::: "memory");
    __syncthreads();
    if (threadIdx.x == 0) {
        unsigned* bar = b.bar;
        __builtin_amdgcn_s_waitcnt(0);
        unsigned nloc = b.st[0], nx = b.st[1];
        if (nloc == 0u) { xcd_barrier_complete(bar, b.x, nloc, nx); b.st[0] = nloc; b.st[1] = nx; }
        const unsigned old = xb_add(&bar[XB_XSUB(b.x)], 1u);
        const unsigned gen = old / nloc;
        if (old + 1u == (gen + 1u) * nloc) {
            __builtin_amdgcn_fence(__ATOMIC_RELEASE, "agent");
            asm volatile("s_waitcnt vmcnt(0)" ::: "memory");
            const unsigned og = xb_add(&bar[XB_TOP], 1u);
            const unsigned tg = og / nx;
            if (og + 1u == (tg + 1u) * nx) xb_add(&bar[XB_TOPGEN], 1u);
            else XB_SPIN(xb_ld(&bar[XB_TOPGEN]) == tg, bar);
            __builtin_amdgcn_fence(__ATOMIC_ACQUIRE, "agent");
            xb_add(&bar[XB_XGEN(b.x)], 1u);
            asm volatile("s_waitcnt vmcnt(0)" ::: "memory");
        } else {
            XB_SPIN(xb_ld(&bar[XB_XGEN(b.x)]) == gen, bar);
            __builtin_amdgcn_fence(__ATOMIC_ACQUIRE, "agent");
            asm volatile("s_waitcnt vmcnt(0)" ::: "memory");
        }
    }
    __syncthreads();
}

__global__ void __launch_bounds__(512, 2) mega(const Params p) {
    extern __shared__ __attribute__((aligned(16))) unsigned char shm[];
    LAS unsigned char* lds = (LAS unsigned char*)shm;
    cg::grid_group grid = cg::this_grid();
    LAS unsigned* xbst = (LAS unsigned*)(lds + 133120);
    if (threadIdx.x < 4) xbst[threadIdx.x] = 0u;
    __syncthreads();
    const XcdBarrier xb = xcd_barrier_post((unsigned*)(p.ws + OFF_BAR), (volatile LAS unsigned*)xbst);
    unsigned char* ws = p.ws;
    float* ADA = (float*)(ws + OFF_ADA);
    float* XC = (float*)(ws + OFF_XC);
    bf16_t* HB = (bf16_t*)(ws + OFF_HB);
    float* LAT = p.out;
    int pid = 0;
#define PH_BEGIN if (pid >= p.ph_lo && pid < p.ph_hi) {
#define PH_END if (pid + 1 < p.ph_hi) { if (pid == 0) grid.sync(); else xcd_barrier(xb); } } ++pid;

    PH_BEGIN
    {
        phase0(lds, p, ADA, (unsigned*)(ws + OFF_BAR + 14336));
    }
    PH_END

    for (int layer = 0; layer < 4; ++layer) {
        const float* ada = ADA + (size_t)layer * 33 * 6144;
        const int last = layer == 3;
        PH_BEGIN
        norm_phase(layer == 0 ? p.in[I_X] : LAT, layer == 0 ? p.in[I_CTX] : XC, LAT, XC, false, p.in[I_NMIX] + layer * 1024, ada, 0, HB, false, layer == 0 ? (float*)(ws + OFF_SSQ) : nullptr);
        PH_END
        if (layer == 0) {
            bf16_t* Z = (bf16_t*)(ws + OFF_Z); bf16_t* KV = (bf16_t*)(ws + OFF_KV); bf16_t* QB = (bf16_t*)(ws + OFF_QB);
            float* SSQ = (float*)(ws + OFF_SSQ); LAS float* XX = (LAS float*)(lds + 133120 + 64);
            PH_BEGIN
            run_gemm(lds, HB, 1024, (const bf16_t*)(ws + OFF_WMI), 768, 1024, 0, pg8::EpiMlaZ{Z, SSQ});
            PH_END
            PH_BEGIN
            run_gemm(lds, Z, 768, (const bf16_t*)(ws + OFF_WUQ), 2048, 384, 0, pg8::EpiMlaQ{QB, SSQ, p.in[I_MGQN], XX});
            run_gemm(lds, Z + 384, 768, (const bf16_t*)(ws + OFF_WUKV), 2048, 256, 0, pg8::EpiMlaKV{KV, SSQ, Z, p.in[I_MGKN], XX});
            PH_END
            PH_BEGIN
            attn_phase<96, 64, 0>(lds, AttnArgs{QB, KV, KV + 96, HB, 1536, 96, 2560, 160, 2560, 160, 16, 0, 1, nullptr, 0.10206207261596575f * LOG2E});
            PH_END
            PH_BEGIN
            run_gemm(lds, HB, 1024, (const bf16_t*)(ws + OFF_WMO), 1024, 1024, 0, pg8::EpiRes{LAT, XC, ada, 2, p.in[I_X], p.in[I_CTX]});
            PH_END
        } else if (layer == 1) {
            bf16_t* YF = (bf16_t*)(ws + OFF_BIG);
            PH_BEGIN
            s5_scan_phase(lds, p, HB, YF);
            PH_END
            PH_BEGIN
            run_gemm(lds, HB, 1024, (const bf16_t*)(ws + OFF_WGLU), 2048, 1024, 0, pg8::EpiGluRes{LAT, XC, ada, 2});
            PH_END
        } else if (layer == 2) {
            bf16_t* QKV = (bf16_t*)(ws + OFF_BIG);
            PH_BEGIN
            run_gemm(lds, HB, 1024, (const bf16_t*)(ws + OFF_WNQ), 3072, 1024, 0, pg8::EpiStoreHN64{QKV, 3072, p.in[I_NGQN], p.in[I_NGKN], (LAS float*)(lds + 133120 + 64)});
            PH_END
            PH_BEGIN
            attn_phase<64, 64, 1>(lds, AttnArgs{QKV, QKV + 1024, QKV + 2048, HB, 3072, 64, 3072, 64, 3072, 64, 16, 0, 1, p.in[I_NRPB], 0.125f * LOG2E});
            PH_END
            PH_BEGIN
            run_gemm(lds, HB, 1024, (const bf16_t*)(ws + OFF_WNO), 1024, 1024, 0, pg8::EpiRes{LAT, XC, ada, 2, LAT, XC});
            PH_END
        } else {
            bf16_t* QKV = (bf16_t*)(ws + OFF_BIG);
            PH_BEGIN
            run_gemm(lds, HB, 1024, (const bf16_t*)(ws + OFF_WGQ), 1536, 1024, 0, pg8::EpiStoreHN128{QKV, 1536, p.in[I_GGQN], p.in[I_GGKN], (LAS float*)(lds + 133120 + 64)});
            PH_END
            PH_BEGIN
            attn_phase<128, 128, 0>(lds, AttnArgs{QKV, QKV + 1024, QKV + 1280, HB, 1536, 128, 1536, 128, 1536, 128, 8, 2, 0, nullptr, 0.08838834764831845f * LOG2E});
            PH_END
            PH_BEGIN
            run_gemm(lds, HB, 1024, (const bf16_t*)(ws + OFF_WGO), 1024, 1024, 1, pg8::EpiRes{LAT, XC, ada, 2, LAT, XC});
            PH_END
        }
        bf16_t* ACT = (bf16_t*)(ws + OFF_BIG);
        PH_BEGIN
        norm_phase(LAT, XC, LAT, XC, false, p.in[I_NFFN] + layer * 1024, ada, 3, HB, last);
        PH_END
        PH_BEGIN
        run_gemm(lds, HB, 1024, (const bf16_t*)(ws + OFF_WFI + layer * SZ_WFI), 5632, 1024, last, pg8::EpiSwiglu{ACT, FH});
        PH_END
        PH_BEGIN
        run_gemm(lds, ACT, 2816, (const bf16_t*)(ws + OFF_WFO + layer * SZ_WFO), 1024, 2816, last, pg8::EpiRes{LAT, XC, ada, 5, LAT, XC});
        PH_END
    }
}

extern "C" void kernel_launch(void* const* d_in, const int* in_sizes, int n_in, void* d_out, int out_size, void* d_ws, size_t ws_size, hipStream_t stream) {
    static int grid_blocks = 0;
    if (!grid_blocks) {
        hipFuncSetAttribute((const void*)mega, hipFuncAttributeMaxDynamicSharedMemorySize, LDS_BYTES);
        int dev = 0, cus = 0, per_cu = 0;
        hipGetDevice(&dev);
        hipDeviceGetAttribute(&cus, hipDeviceAttributeMultiprocessorCount, dev);
        hipOccupancyMaxActiveBlocksPerMultiprocessor(&per_cu, mega, 512, LDS_BYTES);
        if (per_cu < 1) per_cu = 1;
        grid_blocks = cus * 1;
    }
    if (ws_size < WS_NEED) fprintf(stderr, "workspace too small: %zu < %zu\n", ws_size, (size_t)WS_NEED);
    Params p; memset(&p, 0, sizeof(p));
    for (int i = 0; i < N_IN; ++i) p.in[i] = (const float*)d_in[i];
    p.out = (float*)d_out; p.ws = (unsigned char*)d_ws; p.ph_lo = 0; p.ph_hi = 1000;
    hipMemsetAsync((unsigned char*)d_ws + OFF_BAR, 0, 16384, stream);
    void* args[] = {&p};
    hipError_t e = hipLaunchCooperativeKernel((const void*)mega, dim3(grid_blocks), dim3(512), args, LDS_BYTES, stream);
    if (e != hipSuccess) fprintf(stderr, "cooperative launch failed: %s (grid %d)\n", hipGetErrorString(e), grid_blocks);
}
```

```cpp
#include <hip/hip_runtime.h>
#include <hip/hip_cooperative_groups.h>
#include <cstdio>
#include <cstring>
namespace cg = cooperative_groups;

#define DI __device__ __forceinline__
#define LAS __attribute__((address_space(3)))
typedef unsigned short bf16_t;
typedef short bf16x8 __attribute__((ext_vector_type(8)));
typedef short s16x4 __attribute__((ext_vector_type(4)));
typedef float f32x4 __attribute__((ext_vector_type(4)));
typedef float f32x16 __attribute__((ext_vector_type(16)));
typedef unsigned u32x4 __attribute__((ext_vector_type(4)));
typedef unsigned u32x2 __attribute__((ext_vector_type(2)));
typedef __bf16 bf2_t __attribute__((ext_vector_type(2)));
typedef float f2_t __attribute__((ext_vector_type(2)));

constexpr int NB = 32, SEQ = 2048, CTXL = 256, TT = 2304, NR = NB * TT, DM = 1024, FH = 2816;
constexpr float EPS = 1e-6f, LOG2E = 1.4426950408889634f, L2_10000 = 13.287712379549449f;
constexpr int LDS_BYTES = 133120 + 64 + 8192;

enum { I_X, I_C, I_CTX, I_CCTX, I_ADAW, I_ADAB, I_NMIX, I_NFFN, I_FWIN, I_FWOUT,
       I_MWIN, I_MGQ, I_MGKV, I_MWUQ, I_MWUKV, I_MGQN, I_MGKN, I_MWO,
       I_SARE, I_SAIM, I_SLDT, I_SBRE, I_SBIM, I_SCRE, I_SCIM, I_SD, I_SWGLU,
       I_NWQKV, I_NGQN, I_NGKN, I_NRPB, I_NWO, I_GWQKV, I_GGQN, I_GGKN, I_GWO, N_IN };

constexpr size_t SZ_WFI = (size_t)5632 * 1024 * 2, SZ_WFO = (size_t)1024 * 2816 * 2;
constexpr size_t OFF_WFI = 0;
constexpr size_t OFF_WFO = OFF_WFI + 4 * SZ_WFI;
constexpr size_t OFF_WMI = OFF_WFO + 4 * SZ_WFO;
constexpr size_t OFF_WUQ = OFF_WMI + (size_t)768 * 1024 * 2;
constexpr size_t OFF_WUKV = OFF_WUQ + (size_t)2048 * 384 * 2;
constexpr size_t OFF_WMO = OFF_WUKV + (size_t)2048 * 256 * 2;
constexpr size_t OFF_WGLU = OFF_WMO + (size_t)1024 * 1024 * 2;
constexpr size_t OFF_WNQ = OFF_WGLU + (size_t)2048 * 1024 * 2;
constexpr size_t OFF_WNO = OFF_WNQ + (size_t)3072 * 1024 * 2;
constexpr size_t OFF_WGQ = OFF_WNO + (size_t)1024 * 1024 * 2;
constexpr size_t OFF_WGO = OFF_WGQ + (size_t)1536 * 1024 * 2;
constexpr size_t OFF_ADA = OFF_WGO + (size_t)1024 * 1024 * 2;
constexpr size_t OFF_XC = OFF_ADA + (size_t)4 * 33 * 6144 * 4;
constexpr size_t OFF_HB = OFF_XC + (size_t)NB * CTXL * 1024 * 4;
constexpr size_t OFF_BIG = OFF_HB + (size_t)NR * 1024 * 2;
constexpr size_t OFF_KV = OFF_BIG;
constexpr size_t OFF_QB = OFF_KV + (size_t)NR * 2560 * 2;
constexpr size_t OFF_Z = OFF_QB + (size_t)NR * 1536 * 2;
constexpr size_t OFF_BAR = OFF_Z + (size_t)NR * 768 * 2;
constexpr size_t OFF_SSQ = OFF_BAR + 16384;
constexpr size_t WS_NEED = OFF_SSQ + (size_t)NR * 16;

struct Params {
    const float* in[N_IN];
    float* out;
    unsigned char* ws;
    int ph_lo, ph_hi;
};

DI unsigned pk_bf16(float a, float b) { f2_t v = {a, b}; bf2_t r = __builtin_convertvector(v, bf2_t); return __builtin_bit_cast(unsigned, r); }
DI float bf_lo(unsigned u) { return __uint_as_float(u << 16); }
DI float bf_hi(unsigned u) { return __uint_as_float(u & 0xffff0000u); }
DI float wsum(float v) {
#pragma unroll
    for (int o = 32; o > 0; o >>= 1) v += __shfl_xor(v, o);
    return v;
}
DI int otid() { int t = threadIdx.x; asm volatile("" : "+v"(t)); return t; }
DI int obid() { int b = blockIdx.x; asm volatile("" : "+s"(b)); return b; }
DI int mla_dim_of_pos(int pos) { if (pos < 64) return pos; const int p = pos - 64, a = p >> 4, w = p & 15; return 64 + 16 * a + (w >> 1) + 8 * (w & 1); }
DI int gqa_dim_of_pos(int pos) { return (pos >> 6) * 64 + ((pos & 63) >> 1) + 32 * (pos & 1); }
DI int clampi(int v, int lo, int hi) { return v < lo ? lo : (v > hi ? hi : v); }
DI float fexp2(float x) { return __builtin_amdgcn_exp2f(x); }
DI float frcp(float x) { return __builtin_amdgcn_rcpf(x); }
DI float silu_f(float a) { return a * frcp(1.f + __expf(-a)); }
DI float sigmoid_f(float a) { return frcp(1.f + __expf(-a)); }
DI float gelu_tanh(float y) {
    const float z = 0.7978845608028654f * (y + 0.044715f * y * y * y);
    const float t = 1.f - 2.f * frcp(__expf(2.f * z) + 1.f);
    return 0.5f * y * (1.f + t);
}
DI void unpack8(const u32x4 u, float* f) {
#pragma unroll
    for (int i = 0; i < 4; ++i) { f[2 * i] = bf_lo(u[i]); f[2 * i + 1] = bf_hi(u[i]); }
}
DI u32x4 pack8(const float* f) { return (u32x4){pk_bf16(f[0], f[1]), pk_bf16(f[2], f[3]), pk_bf16(f[4], f[5]), pk_bf16(f[6], f[7])}; }

namespace pg8 {
constexpr int BM = 256, BK = 64, HALF = 128, HTB = HALF * BK * 2, NXCD = 8, WGM = 8;
DI int lds_byte(int r, int c) { const int st = (r >> 4) * 2 + (c >> 5), rr = r & 15, cc = c & 31, ob = rr * 64 + cc * 2; return st * 1024 + (ob ^ (((ob >> 9) & 1) << 5)); }
DI void stage_rc(int b, int& R, int& C) { const int st = b / 1024, sb = b % 1024, swz = sb ^ (((sb >> 9) & 1) << 5); R = (st >> 1) * 16 + swz / 64; C = (st & 1) * 32 + (swz % 64) / 2; }
DI int perm32(int rho) { const int n = rho >> 4, i = rho & 15; return 8 * (i >> 2) + 4 * n + (i & 3); }
struct Unit { int pm, pn; };
struct Gemm { const bf16_t* A; const bf16_t* Bt; int M, N, K, lda; };
struct Order {
    int nM, nN, nwg, G, c, skip;
    DI void init(int N, int G_, int c_, int skipctx) { skip = skipctx; nM = skipctx ? 256 : 288; nN = N / BM; nwg = nM * nN; G = G_; c = c_; }
    DI bool next(int i, Unit& u) const {
        const long L = (long)i * G + c; if (L >= nwg) return false;
        int wgid = (int)L; { const int q = nwg / NXCD, r = nwg % NXCD, xcd = wgid % NXCD, off = wgid / NXCD; wgid = (xcd < r ? xcd * (q + 1) : r * (q + 1) + (xcd - r) * q) + off; }
        const int nig = WGM * nN, gid = wgid / nig, fm = gid * WGM, gsz = (nM - fm) < WGM ? (nM - fm) : WGM;
        int pm = fm + ((wgid % nig) % gsz); u.pn = (wgid % nig) / gsz;
        if (skip) pm = pm + (pm >> 3) + 1;
        u.pm = pm; return true;
    }
};

DI float* tile_res_base(float* lat, float* xc, int pm) { const int bb = pm / 9, sub = pm - bb * 9; return sub == 0 ? xc + ((size_t)bb * CTXL << 10) : lat + ((size_t)(bb * SEQ + (sub - 1) * 256) << 10); }
DI int tile_ada_row(int pm) { const int bb = pm / 9, sub = pm - bb * 9; return sub == 0 ? 32 : bb; }

struct EpiStore {
    static constexpr bool PERM = true;
    bf16_t* O; int ldc; int remap;
    DI void operator()(const f32x4 (&acc)[2][2][4][2], const Unit& u, int wr, int wc, int fr, int fq) const {
        const int row0 = u.pm * BM + wr * 64 + fr, col0 = u.pn * BM + wc * 32 + 8 * fq;
#pragma unroll
        for (int ai = 0; ai < 2; ++ai)
#pragma unroll
            for (int m = 0; m < 4; ++m) {
                bf16_t* rowp = O + (size_t)(row0 + ai * HALF + m * 16) * ldc;
#pragma unroll
                for (int bj = 0; bj < 2; ++bj) {
                    const int c = col0 + bj * HALF; const int cc = remap ? (c >> 7) * 160 + (c & 127) : c;
                    const f32x4 v0 = acc[ai][bj][m][0], v1 = acc[ai][bj][m][1];
                    *(u32x4*)(rowp + cc) = (u32x4){pk_bf16(v0[0], v0[1]), pk_bf16(v0[2], v0[3]), pk_bf16(v1[0], v1[1]), pk_bf16(v1[2], v1[3])};
                }
            }
    }
};
struct EpiStoreHN64 {
    static constexpr bool PERM = true;
    bf16_t* O; int ldc; const float* gq; const float* gk; LAS float* X;
    DI void operator()(const f32x4 (&acc)[2][2][4][2], const Unit& u, int wr_, int wc_, int fr_, int fq_) const {
        int wr = wr_, wc = wc_, fr = fr_, fq = fq_; asm volatile("" : "+s"(wr), "+s"(wc), "+v"(fr), "+v"(fq));
        const int wid = wr * 4 + wc;
        const int kind = u.pn < 4 ? 0 : (u.pn < 8 ? 1 : 2);
        float part[2][2][4];
#pragma unroll
        for (int ai = 0; ai < 2; ++ai)
#pragma unroll
            for (int bj = 0; bj < 2; ++bj)
#pragma unroll
                for (int m = 0; m < 4; ++m) {
                    float ss = 0.f;
#pragma unroll
                    for (int n = 0; n < 2; ++n)
#pragma unroll
                        for (int i = 0; i < 4; ++i) ss += acc[ai][bj][m][n][i] * acc[ai][bj][m][n][i];
                    ss += __shfl_xor(ss, 16); ss += __shfl_xor(ss, 32);
                    part[ai][bj][m] = ss;
                    if (fq == 0) X[(wid * 16 + ai * 8 + bj * 4 + m) * 16 + fr] = ss;
                }
        asm volatile("s_waitcnt lgkmcnt(0)" ::: "memory");
        __builtin_amdgcn_s_barrier();
        asm volatile("" ::: "memory");
        const float* g = kind == 0 ? gq : gk;
        const int gc0 = 32 * (wc & 1) + 8 * fq;
        float gv[8];
#pragma unroll
        for (int i = 0; i < 8; ++i) gv[i] = g[gc0 + i];
        const int row0 = u.pm * BM + wr * 64 + fr, col0 = u.pn * BM + wc * 32 + 8 * fq;
#pragma unroll
        for (int ai = 0; ai < 2; ++ai)
#pragma unroll
            for (int m = 0; m < 4; ++m) {
                bf16_t* rowp = O + (size_t)(row0 + ai * HALF + m * 16) * ldc;
#pragma unroll
                for (int bj = 0; bj < 2; ++bj) {
                    const float tot = part[ai][bj][m] + X[((wid ^ 1) * 16 + ai * 8 + bj * 4 + m) * 16 + fr];
                    const float r = rsqrtf(tot * (1.f / 64.f) + EPS);
                    float v[8];
#pragma unroll
                    for (int n = 0; n < 2; ++n)
#pragma unroll
                        for (int i = 0; i < 4; ++i) v[n * 4 + i] = kind == 2 ? acc[ai][bj][m][n][i] : acc[ai][bj][m][n][i] * r * gv[n * 4 + i];
                    *(u32x4*)(rowp + col0 + bj * HALF) = pack8(v);
                }
            }
    }
};
struct EpiStoreHN128 {
    static constexpr bool PERM = true;
    bf16_t* O; int ldc; const float* gq; const float* gk; LAS float* X;
    DI void operator()(const f32x4 (&acc)[2][2][4][2], const Unit& u, int wr_, int wc_, int fr_, int fq_) const {
        int wr = wr_, wc = wc_, fr = fr_, fq = fq_; asm volatile("" : "+s"(wr), "+s"(wc), "+v"(fr), "+v"(fq));
        const int wid = wr * 4 + wc;
        const int kind = u.pn < 4 ? 0 : (u.pn < 5 ? 1 : 2);
        float part[2][2][4];
#pragma unroll
        for (int ai = 0; ai < 2; ++ai)
#pragma unroll
            for (int bj = 0; bj < 2; ++bj)
#pragma unroll
                for (int m = 0; m < 4; ++m) {
                    float ss = 0.f;
#pragma unroll
                    for (int n = 0; n < 2; ++n)
#pragma unroll
                        for (int i = 0; i < 4; ++i) ss += acc[ai][bj][m][n][i] * acc[ai][bj][m][n][i];
                    ss += __shfl_xor(ss, 16); ss += __shfl_xor(ss, 32);
                    part[ai][bj][m] = ss;
                    if (fq == 0) X[(wid * 16 + ai * 8 + bj * 4 + m) * 16 + fr] = ss;
                }
        asm volatile("s_waitcnt lgkmcnt(0)" ::: "memory");
        __builtin_amdgcn_s_barrier();
        asm volatile("" ::: "memory");
        const float* g = kind == 0 ? gq : gk;
        const int pos0 = 32 * wc + 8 * fq;
        float gv[8];
#pragma unroll
        for (int i = 0; i < 8; ++i) gv[i] = g[gqa_dim_of_pos(pos0 + i)];
        const int axis = wc >> 1, f0 = 16 * (wc & 1) + 4 * fq;
        float invf[4];
#pragma unroll
        for (int j = 0; j < 4; ++j) invf[j] = fexp2(-(float)(f0 + j) * (L2_10000 / 32.f));
        const int bb = u.pm / 9, sub = u.pm - bb * 9;
        const bool latent = sub != 0;
        const int row0 = u.pm * BM + wr * 64 + fr, col0 = u.pn * BM + wc * 32 + 8 * fq;
        const int wb = wr * 4;
#pragma unroll
        for (int ai = 0; ai < 2; ++ai)
#pragma unroll
            for (int m = 0; m < 4; ++m) {
                bf16_t* rowp = O + (size_t)(row0 + ai * HALF + m * 16) * ldc;
                const int sidx = (sub - 1) * 256 + ai * HALF + wr * 64 + m * 16 + fr;
                const float posv = (float)(axis ? (sidx & 63) : (sidx >> 6));
                float cs[4], sn[4];
#pragma unroll
                for (int j = 0; j < 4; ++j) { const float ang = posv * invf[j]; cs[j] = __cosf(ang); sn[j] = __sinf(ang); }
#pragma unroll
                for (int bj = 0; bj < 2; ++bj) {
                    const int cb = ai * 8 + bj * 4 + m;
                    const float tot = X[((wb + 0) * 16 + cb) * 16 + fr] + X[((wb + 1) * 16 + cb) * 16 + fr] + X[((wb + 2) * 16 + cb) * 16 + fr] + X[((wb + 3) * 16 + cb) * 16 + fr];
                    const float r = rsqrtf(tot * (1.f / 128.f) + EPS);
                    float v[8];
#pragma unroll
                    for (int n = 0; n < 2; ++n)
#pragma unroll
                        for (int i = 0; i < 4; ++i) v[n * 4 + i] = kind == 2 ? acc[ai][bj][m][n][i] : acc[ai][bj][m][n][i] * r * gv[n * 4 + i];
                    if (kind != 2 && latent) {
#pragma unroll
                        for (int j = 0; j < 4; ++j) { const float x1 = v[2 * j], x2 = v[2 * j + 1]; v[2 * j] = x1 * cs[j] - x2 * sn[j]; v[2 * j + 1] = x1 * sn[j] + x2 * cs[j]; }
                    }
                    *(u32x4*)(rowp + col0 + bj * HALF) = pack8(v);
                }
            }
    }
};
struct EpiMlaZ {
    static constexpr bool PERM = true;
    bf16_t* O; float* SSQ;
    DI void operator()(const f32x4 (&acc)[2][2][4][2], const Unit& u, int wr_, int wc_, int fr_, int fq_) const {
        int wr = wr_, wc = wc_, fr = fr_, fq = fq_; asm volatile("" : "+s"(wr), "+s"(wc), "+v"(fr), "+v"(fq));
        const int row0 = u.pm * BM + wr * 64 + fr, col0 = u.pn * BM + wc * 32 + 8 * fq;
#pragma unroll
        for (int ai = 0; ai < 2; ++ai)
#pragma unroll
            for (int m = 0; m < 4; ++m) {
                const int row = row0 + ai * HALF + m * 16;
                bf16_t* rowp = O + (size_t)row * 768;
#pragma unroll
                for (int bj = 0; bj < 2; ++bj) {
                    const f32x4 v0 = acc[ai][bj][m][0], v1 = acc[ai][bj][m][1];
                    *(u32x4*)(rowp + col0 + bj * HALF) = (u32x4){pk_bf16(v0[0], v0[1]), pk_bf16(v0[2], v0[3]), pk_bf16(v1[0], v1[1]), pk_bf16(v1[2], v1[3])};
                    float ss = 0.f;
#pragma unroll
                    for (int i = 0; i < 4; ++i) ss += v0[i] * v0[i] + v1[i] * v1[i];
                    ss += __shfl_xor(ss, 16); ss += __shfl_xor(ss, 32);
                    const int cbase = u.pn * BM + bj * HALF + wc * 32;
                    const int cat = cbase < 384 ? 0 : (cbase < 640 ? 1 : (cbase < 672 ? 2 : 3));
                    if (fq == 0 && cat < 3) atomicAdd(SSQ + (size_t)row * 4 + cat, ss);
                }
            }
    }
};
struct EpiMlaQ {
    static constexpr bool PERM = true;
    bf16_t* O; const float* SSQ; const float* gqn; LAS float* X;
    DI void operator()(const f32x4 (&acc)[2][2][4][2], const Unit& u, int wr_, int wc_, int fr_, int fq_) const {
        int wr = wr_, wc = wc_, fr = fr_, fq = fq_; asm volatile("" : "+s"(wr), "+s"(wc), "+v"(fr), "+v"(fq));
        const int wid = wr * 4 + wc, wb = wr * 4;
#pragma unroll
        for (int ai = 0; ai < 2; ++ai)
#pragma unroll
            for (int bj = 0; bj < 2; ++bj)
#pragma unroll
                for (int m = 0; m < 4; ++m) {
                    float ss = 0.f;
#pragma unroll
                    for (int n = 0; n < 2; ++n)
#pragma unroll
                        for (int i = 0; i < 4; ++i) ss += acc[ai][bj][m][n][i] * acc[ai][bj][m][n][i];
                    ss += __shfl_xor(ss, 16); ss += __shfl_xor(ss, 32);
                    if (fq == 0) X[(wid * 16 + ai * 8 + bj * 4 + m) * 16 + fr] = ss;
                }
        asm volatile("s_waitcnt lgkmcnt(0)" ::: "memory");
        __builtin_amdgcn_s_barrier();
        asm volatile("" ::: "memory");
        const int pos0 = 32 * wc + 8 * fq;
        const int axis = fq >> 1;
        const int bb = u.pm / 9, sub = u.pm - bb * 9;
        const bool latent = sub != 0;
        const int row0 = u.pm * BM + wr * 64 + fr;
#pragma unroll
        for (int ai = 0; ai < 2; ++ai)
#pragma unroll
            for (int m = 0; m < 4; ++m) {
                int pz = pos0; asm volatile("" : "+v"(pz));
                float gv[8];
#pragma unroll
                for (int i = 0; i < 8; ++i) gv[i] = pz < 96 ? gqn[mla_dim_of_pos(pz + i)] : 0.f;
                float invf[4];
#pragma unroll
                for (int j = 0; j < 4; ++j) invf[j] = fexp2(-(float)(((pz >> 3) & 1) * 4 + j) * (L2_10000 / 8.f));
                const int row = row0 + ai * HALF + m * 16;
                const float rq0 = rsqrtf(SSQ[(size_t)row * 4 + 0] * (1.f / 384.f) + EPS);
                const int sidx = (sub - 1) * 256 + ai * HALF + wr * 64 + m * 16 + fr;
                const float posv = (float)(axis ? (sidx & 63) : (sidx >> 6));
                float cs[4], sn[4];
#pragma unroll
                for (int j = 0; j < 4; ++j) { cs[j] = 1.f; sn[j] = 0.f; }
                if (wc == 2 && latent) {
#pragma unroll
                    for (int j = 0; j < 4; ++j) { const float ang = posv * invf[j]; cs[j] = __cosf(ang); sn[j] = __sinf(ang); }
                }
#pragma unroll
                for (int bj = 0; bj < 2; ++bj) {
                    const int cb = ai * 8 + bj * 4 + m;
                    const float tot = X[((wb + 0) * 16 + cb) * 16 + fr] + X[((wb + 1) * 16 + cb) * 16 + fr] + X[((wb + 2) * 16 + cb) * 16 + fr];
                    const float r = rq0 * rsqrtf(rq0 * rq0 * tot * (1.f / 96.f) + EPS);
                    float v[8];
#pragma unroll
                    for (int n = 0; n < 2; ++n)
#pragma unroll
                        for (int i = 0; i < 4; ++i) v[n * 4 + i] = acc[ai][bj][m][n][i] * r * gv[n * 4 + i];
                    if (wc == 2 && latent) {
#pragma unroll
                        for (int j = 0; j < 4; ++j) { const float x1 = v[2 * j], x2 = v[2 * j + 1]; v[2 * j] = x1 * cs[j] - x2 * sn[j]; v[2 * j + 1] = x1 * sn[j] + x2 * cs[j]; }
                    }
                    if (wc < 3) *(u32x4*)(O + (size_t)row * 1536 + (u.pn * 2 + bj) * 96 + pos0) = pack8(v);
                }
                __builtin_amdgcn_sched_barrier(0);
            }
    }
};
struct EpiMlaKV {
    static constexpr bool PERM = true;
    bf16_t* O; const float* SSQ; const bf16_t* Z; const float* gkn; LAS float* X;
    DI void operator()(const f32x4 (&acc)[2][2][4][2], const Unit& u, int wr_, int wc_, int fr_, int fq_) const {
        int wr = wr_, wc = wc_, fr = fr_, fq = fq_; asm volatile("" : "+s"(wr), "+s"(wc), "+v"(fr), "+v"(fq));
        const int wid = wr * 4 + wc, wb = wr * 4;
#pragma unroll
        for (int ai = 0; ai < 2; ++ai)
#pragma unroll
            for (int bj = 0; bj < 2; ++bj)
#pragma unroll
                for (int m = 0; m < 4; ++m) {
                    float ss = 0.f;
#pragma unroll
                    for (int n = 0; n < 2; ++n)
#pragma unroll
                        for (int i = 0; i < 4; ++i) ss += acc[ai][bj][m][n][i] * acc[ai][bj][m][n][i];
                    ss += __shfl_xor(ss, 16); ss += __shfl_xor(ss, 32);
                    if (fq == 0) X[(wid * 16 + ai * 8 + bj * 4 + m) * 16 + fr] = ss;
                }
        asm volatile("s_waitcnt lgkmcnt(0)" ::: "memory");
        __builtin_amdgcn_s_barrier();
        asm volatile("" ::: "memory");
        const int pos0 = 32 * (wc & 1) + 8 * fq;
        const int axis = fq >> 1;
        const int bb = u.pm / 9, sub = u.pm - bb * 9;
        const bool latent = sub != 0;
        const int row0 = u.pm * BM + wr * 64 + fr;
#pragma unroll
        for (int ai = 0; ai < 2; ++ai)
#pragma unroll
            for (int m = 0; m < 4; ++m) {
                int pz = pos0; asm volatile("" : "+v"(pz));
                const int i0 = ((pz >> 3) & 1) * 4;
                float gv[8];
#pragma unroll
                for (int i = 0; i < 8; ++i) gv[i] = gkn[pz + i];
                float invf[4], g1[4], g2[4];
#pragma unroll
                for (int j = 0; j < 4; ++j) { invf[j] = fexp2(-(float)(i0 + j) * (L2_10000 / 8.f)); g1[j] = gkn[64 + 16 * axis + i0 + j]; g2[j] = gkn[64 + 16 * axis + i0 + j + 8]; }
                const int row = row0 + ai * HALF + m * 16;
                const float rkv0 = rsqrtf(SSQ[(size_t)row * 4 + 1] * (1.f / 256.f) + EPS);
                const float ssr = SSQ[(size_t)row * 4 + 2];
                float x1[4], x2[4], cs[4], sn[4];
                if (wc == 2) {
                    const bf16_t* zr = Z + (size_t)row * 768 + 640 + 16 * axis + i0;
                    const u32x2 a1 = *(const u32x2*)zr, a2 = *(const u32x2*)(zr + 8);
                    x1[0] = bf_lo(a1[0]); x1[1] = bf_hi(a1[0]); x1[2] = bf_lo(a1[1]); x1[3] = bf_hi(a1[1]);
                    x2[0] = bf_lo(a2[0]); x2[1] = bf_hi(a2[0]); x2[2] = bf_lo(a2[1]); x2[3] = bf_hi(a2[1]);
                    const int sidx = (sub - 1) * 256 + ai * HALF + wr * 64 + m * 16 + fr;
                    const float posv = (float)(axis ? (sidx & 63) : (sidx >> 6));
#pragma unroll
                    for (int j = 0; j < 4; ++j) { const float ang = posv * invf[j]; cs[j] = latent ? __cosf(ang) : 1.f; sn[j] = latent ? __sinf(ang) : 0.f; }
                }
#pragma unroll
                for (int bj = 0; bj < 2; ++bj) {
                    const int cb = ai * 8 + bj * 4 + m;
                    const float ssn = X[((wb + 0) * 16 + cb) * 16 + fr] + X[((wb + 1) * 16 + cb) * 16 + fr];
                    const float rk = rsqrtf((rkv0 * rkv0 * ssn + ssr) * (1.f / 96.f) + EPS);
                    bf16_t* hp = O + (size_t)row * 2560 + (u.pn * 2 + bj) * 160;
                    float v[8];
                    if (wc < 2) {
#pragma unroll
                        for (int n = 0; n < 2; ++n)
#pragma unroll
                            for (int i = 0; i < 4; ++i) v[n * 4 + i] = acc[ai][bj][m][n][i] * (rkv0 * rk) * gv[n * 4 + i];
                        *(u32x4*)(hp + pos0) = pack8(v);
                    } else {
#pragma unroll
                        for (int n = 0; n < 2; ++n)
#pragma unroll
                            for (int i = 0; i < 4; ++i) v[n * 4 + i] = acc[ai][bj][m][n][i] * rkv0;
                        *(u32x4*)(hp + 96 + pos0) = pack8(v);
                        if (wc == 2) {
                            float w[8];
#pragma unroll
                            for (int j = 0; j < 4; ++j) {
                                const float y1 = x1[j] * rk * g1[j], y2 = x2[j] * rk * g2[j];
                                w[2 * j] = y1 * cs[j] - y2 * sn[j]; w[2 * j + 1] = y1 * sn[j] + y2 * cs[j];
                            }
                            *(u32x4*)(hp + 64 + 8 * fq) = pack8(w);
                        }
                    }
                }
                __builtin_amdgcn_sched_barrier(0);
            }
    }
};
struct EpiSwiglu {
    static constexpr bool PERM = true;
    bf16_t* O; int ldc;
    DI void operator()(const f32x4 (&acc)[2][2][4][2], const Unit& u, int wr, int wc, int fr, int fq) const {
        const int row0 = u.pm * BM + wr * 64 + fr, col0 = u.pn * HALF + wc * 32 + 8 * fq;
#pragma unroll
        for (int ai = 0; ai < 2; ++ai)
#pragma unroll
            for (int m = 0; m < 4; ++m) {
                float v[8];
#pragma unroll
                for (int n = 0; n < 2; ++n)
#pragma unroll
                    for (int i = 0; i < 4; ++i) v[n * 4 + i] = silu_f(acc[ai][0][m][n][i]) * acc[ai][1][m][n][i];
                *(u32x4*)(O + (size_t)(row0 + ai * HALF + m * 16) * ldc + col0) = pack8(v);
            }
    }
};
struct EpiGluRes {
    static constexpr bool PERM = true;
    float* lat; float* xc; const float* ada; int gidx;
    DI void operator()(const f32x4 (&acc)[2][2][4][2], const Unit& u, int wr, int wc, int fr, int fq) const {
        float* base = tile_res_base(lat, xc, u.pm);
        const float* gate = ada + (size_t)tile_ada_row(u.pm) * 6144 + gidx * 1024;
        const int col0 = u.pn * HALF + wc * 32 + 8 * fq;
        const f32x4 g0 = *(const f32x4*)(gate + col0), g1 = *(const f32x4*)(gate + col0 + 4);
#pragma unroll
        for (int ai = 0; ai < 2; ++ai)
#pragma unroll
            for (int m = 0; m < 4; ++m) {
                float* rp = base + ((size_t)(ai * HALF + wr * 64 + m * 16 + fr) << 10) + col0;
                f32x4 x0 = *(f32x4*)rp, x1 = *(f32x4*)(rp + 4);
#pragma unroll
                for (int i = 0; i < 4; ++i) {
                    x0[i] += g0[i] * (acc[ai][0][m][0][i] * sigmoid_f(acc[ai][1][m][0][i]));
                    x1[i] += g1[i] * (acc[ai][0][m][1][i] * sigmoid_f(acc[ai][1][m][1][i]));
                }
                *(f32x4*)rp = x0; *(f32x4*)(rp + 4) = x1;
            }
    }
};
struct EpiRes {
    static constexpr bool PERM = true;
    float* lat; float* xc; const float* ada; int gidx; const float* lat_in; const float* xc_in;
    DI void operator()(const f32x4 (&acc)[2][2][4][2], const Unit& u, int wr, int wc, int fr, int fq) const {
        float* base = tile_res_base(lat, xc, u.pm);
        const float* base_in = tile_res_base((float*)lat_in, (float*)xc_in, u.pm);
        const float* gate = ada + (size_t)tile_ada_row(u.pm) * 6144 + gidx * 1024;
        const int col0 = u.pn * BM + wc * 32 + 8 * fq;
        f32x4 gv[2][2];
#pragma unroll
        for (int bj = 0; bj < 2; ++bj)
#pragma unroll
            for (int n = 0; n < 2; ++n) gv[bj][n] = *(const f32x4*)(gate + col0 + bj * HALF + n * 4);
#pragma unroll
        for (int ai = 0; ai < 2; ++ai)
#pragma unroll
            for (int m = 0; m < 4; ++m) {
                float* rp = base + ((size_t)(ai * HALF + wr * 64 + m * 16 + fr) << 10) + col0;
                const float* rpi = base_in + ((size_t)(ai * HALF + wr * 64 + m * 16 + fr) << 10) + col0;
#pragma unroll
                for (int bj = 0; bj < 2; ++bj)
#pragma unroll
                    for (int n = 0; n < 2; ++n) {
                        f32x4 x = *(const f32x4*)(rpi + bj * HALF + n * 4);
                        x += gv[bj][n] * acc[ai][bj][m][n];
                        *(f32x4*)(rp + bj * HALF + n * 4) = x;
                    }
            }
    }
};

template <class Epi>
DI void gemm_phase(LAS unsigned char* lds, const Gemm g, const Order& S, const Epi& E) {
    const int TIDX = otid(); const int BIDX = obid(); (void)TIDX; (void)BIDX;
    const int tid = TIDX, wid = __builtin_amdgcn_readfirstlane(tid >> 6), lane = tid & 63, wr = wid >> 2, wc = wid & 3, fr = lane & 15, fq = lane >> 4;
    const int K = g.K, nt = K / BK;
    unsigned voffA[2], voffB[2];
#pragma unroll
    for (int i = 0; i < 2; ++i) { int R, C; stage_rc(tid * 16 + i * 8192, R, C); const int Rb = Epi::PERM ? ((R & ~31) + perm32(R & 31)) : R;
        voffA[i] = (unsigned)(R * g.lda + C) * 2u; voffB[i] = (unsigned)(Rb * K + C) * 2u; }
    const size_t kstep = (size_t)(BK * 2);
    const size_t hstep = (size_t)HALF * K * 2, hstepA = (size_t)HALF * g.lda * 2;
    const size_t tstep = 2 * hstep, tstepA = 2 * hstepA;
    const unsigned ldsw = (unsigned)wid * 1024u;
    const int aoff = lds_byte(wr * 64 + fr, fq * 8), boff = lds_byte(wc * 32 + fr, fq * 8);
#define PG8_SA(b, h) (((b) * 2 + (h)) * HTB)
#define PG8_SB(b, h) ((4 + (b) * 2 + (h)) * HTB)
#define PG8_STAGE(bufoff, gbase, voff) do { _Pragma("unroll") for (int _i = 0; _i < 2; ++_i) \
        __builtin_amdgcn_global_load_lds((const unsigned*)((const char*)(gbase) + (voff)[_i]), (LAS unsigned*)(lds + (bufoff) + ldsw + _i * 8192), 16, 0, 0); } while (0)
#define PG8_LDA(dst, b, h) do { _Pragma("unroll") for (int m = 0; m < 4; ++m) _Pragma("unroll") for (int k = 0; k < 2; ++k) dst[m][k] = *(const LAS bf16x8*)(lds + PG8_SA(b, h) + aoff + m * 2048 + k * 1024); } while (0)
#define PG8_LDB(dst, b, h) do { _Pragma("unroll") for (int n = 0; n < 2; ++n) _Pragma("unroll") for (int k = 0; k < 2; ++k) dst[n][k] = *(const LAS bf16x8*)(lds + PG8_SB(b, h) + boff + n * 2048 + k * 1024); } while (0)
#define PG8_MMA(ai, bj, At, Bt) do { __builtin_amdgcn_s_setprio(1); _Pragma("unroll") for (int m = 0; m < 4; ++m) _Pragma("unroll") for (int n = 0; n < 2; ++n) _Pragma("unroll") for (int k = 0; k < 2; ++k) \
        acc[ai][bj][m][n] = __builtin_amdgcn_mfma_f32_16x16x32_bf16(Bt[n][k], At[m][k], acc[ai][bj][m][n], 0, 0, 0); __builtin_amdgcn_s_setprio(0); } while (0)
#define PG8_WAIT_V(n) asm volatile("s_waitcnt vmcnt(" #n ")" ::: "memory")
#define PG8_WAIT_L(n) asm volatile("s_waitcnt lgkmcnt(" #n ")" ::: "memory")
#define PG8_BAR __builtin_amdgcn_s_barrier()
#define PG8_SCHED __builtin_amdgcn_sched_barrier(0)
    Unit cur, nxt; int ui = 0;
    if (!S.next(0, cur)) return;
    f32x4 acc[2][2][4][2];
#pragma unroll
    for (int a = 0; a < 2; ++a)
#pragma unroll
        for (int b = 0; b < 2; ++b)
#pragma unroll
            for (int m = 0; m < 4; ++m)
#pragma unroll
                for (int n = 0; n < 2; ++n) acc[a][b][m][n] = (f32x4){0.f, 0.f, 0.f, 0.f};
    bf16x8 At[4][2], B0[2][2], B1[2][2];
    const char* cA = (const char*)g.A + (size_t)cur.pm * tstepA; const char* cB = (const char*)g.Bt + (size_t)cur.pn * tstep;
    PG8_STAGE(PG8_SB(0, 0), cB, voffB); PG8_STAGE(PG8_SA(0, 0), cA, voffA); PG8_STAGE(PG8_SB(0, 1), cB + hstep, voffB); PG8_STAGE(PG8_SA(0, 1), cA + hstepA, voffA);
    if (wr == 1) PG8_BAR;
    PG8_WAIT_V(4); PG8_BAR;
    PG8_STAGE(PG8_SB(1, 0), cB + kstep, voffB); PG8_STAGE(PG8_SA(1, 0), cA + kstep, voffA); PG8_STAGE(PG8_SB(1, 1), cB + hstep + kstep, voffB);
    PG8_WAIT_V(6); PG8_BAR;
    for (;;) {
        const bool has_next = S.next(ui + 1, nxt);
        const char* nA = has_next ? (const char*)g.A + (size_t)nxt.pm * tstepA : cA; const char* nB = has_next ? (const char*)g.Bt + (size_t)nxt.pn * tstep : cB;
        for (int t = 0; t < nt; t += 2) {
            const bool last = (t == nt - 2);
            const char* a1 = cA + (size_t)(t + 1) * kstep;
            const char* a2 = last ? nA : cA + (size_t)(t + 2) * kstep; const char* b2 = last ? nB : cB + (size_t)(t + 2) * kstep;
            const char* a3 = a2 + kstep; const char* b3 = b2 + kstep;
            PG8_LDB(B0, 0, 0); PG8_SCHED; PG8_LDA(At, 0, 0); PG8_STAGE(PG8_SA(1, 1), a1 + hstepA, voffA);
            PG8_WAIT_L(8); PG8_BAR; PG8_WAIT_L(0); PG8_MMA(0, 0, At, B0); PG8_BAR; PG8_SCHED;
            PG8_LDB(B1, 0, 1); PG8_STAGE(PG8_SB(0, 0), b2, voffB);
            PG8_BAR; PG8_WAIT_L(0); PG8_MMA(0, 1, At, B1); PG8_BAR;
            PG8_LDA(At, 0, 1); PG8_STAGE(PG8_SA(0, 0), a2, voffA);
            PG8_BAR; PG8_WAIT_L(0); PG8_MMA(1, 0, At, B0); PG8_BAR; PG8_SCHED;
            PG8_STAGE(PG8_SB(0, 1), b2 + hstep, voffB);
            PG8_WAIT_V(6); PG8_BAR; PG8_MMA(1, 1, At, B1); PG8_BAR;
            PG8_LDB(B0, 1, 0); PG8_SCHED; PG8_LDA(At, 1, 0); PG8_STAGE(PG8_SA(0, 1), a2 + hstepA, voffA);
            PG8_WAIT_L(8); PG8_BAR; PG8_WAIT_L(0); PG8_MMA(0, 0, At, B0); PG8_BAR; PG8_SCHED;
            PG8_LDB(B1, 1, 1); PG8_STAGE(PG8_SB(1, 0), b3, voffB);
            PG8_BAR; PG8_WAIT_L(0); PG8_MMA(0, 1, At, B1); PG8_BAR;
            PG8_LDA(At, 1, 1); PG8_STAGE(PG8_SA(1, 0), a3, voffA);
            PG8_BAR; PG8_WAIT_L(0); PG8_MMA(1, 0, At, B0); PG8_BAR; PG8_SCHED;
            PG8_STAGE(PG8_SB(1, 1), b3 + hstep, voffB);
            PG8_WAIT_V(6); PG8_BAR; PG8_MMA(1, 1, At, B1); PG8_BAR;
        }
        E(acc, cur, wr, wc, fr, fq);
        if (!has_next) break;
#pragma unroll
        for (int a = 0; a < 2; ++a)
#pragma unroll
            for (int b = 0; b < 2; ++b)
#pragma unroll
                for (int m = 0; m < 4; ++m)
#pragma unroll
                    for (int n = 0; n < 2; ++n) acc[a][b][m][n] = (f32x4){0.f, 0.f, 0.f, 0.f};
        cur = nxt; cA = nA; cB = nB; ++ui;
    }
    PG8_WAIT_V(0);
    if (wr == 0) PG8_BAR;
    PG8_BAR;
#undef PG8_SA
#undef PG8_SB
#undef PG8_STAGE
#undef PG8_LDA
#undef PG8_LDB
#undef PG8_MMA
#undef PG8_WAIT_V
#undef PG8_WAIT_L
#undef PG8_BAR
#undef PG8_SCHED
}
}

template <class Epi>
DI void run_gemm(LAS unsigned char* lds, const bf16_t* A, int lda, const bf16_t* Bt, int N, int K, int skipctx, const Epi& E) {
    const int BIDX = obid();
    asm volatile("" : "+s"(K));
    pg8::Order S; S.init(N, (int)gridDim.x, BIDX, skipctx);
    pg8::Gemm g{A, Bt, NR, N, K, lda};
    pg8::gemm_phase<Epi>(lds, g, S, E);
}

struct WDesc { const float* src; bf16_t* dst; int K, N, Nout, half; const float* kscale; int perm; };

DI WDesc wdesc_of(const Params& p, int m) {
    unsigned char* ws = p.ws;
    if (m < 4) return WDesc{p.in[I_FWIN] + (size_t)m * 1024 * 5632, (bf16_t*)(ws + OFF_WFI + m * SZ_WFI), 1024, 5632, 5632, 2816, nullptr, 0};
    if (m < 8) return WDesc{p.in[I_FWOUT] + (size_t)(m - 4) * 2816 * 1024, (bf16_t*)(ws + OFF_WFO + (m - 4) * SZ_WFO), 2816, 1024, 1024, 0, nullptr, 0};
    switch (m) {
        case 8: return WDesc{p.in[I_MWIN], (bf16_t*)(ws + OFF_WMI), 1024, 672, 768, 0, nullptr, 0};
        case 9: return WDesc{p.in[I_MWUQ], (bf16_t*)(ws + OFF_WUQ), 384, 1536, 2048, 0, p.in[I_MGQ], 2};
        case 10: return WDesc{p.in[I_MWUKV], (bf16_t*)(ws + OFF_WUKV), 256, 2048, 2048, 0, p.in[I_MGKV], 0};
        case 11: return WDesc{p.in[I_MWO], (bf16_t*)(ws + OFF_WMO), 1024, 1024, 1024, 0, nullptr, 0};
        case 12: return WDesc{p.in[I_SWGLU], (bf16_t*)(ws + OFF_WGLU), 1024, 2048, 2048, 1024, nullptr, 0};
        case 13: return WDesc{p.in[I_NWQKV], (bf16_t*)(ws + OFF_WNQ), 1024, 3072, 3072, 0, nullptr, 0};
        case 14: return WDesc{p.in[I_NWO], (bf16_t*)(ws + OFF_WNO), 1024, 1024, 1024, 0, nullptr, 0};
        case 15: return WDesc{p.in[I_GWQKV], (bf16_t*)(ws + OFF_WGQ), 1024, 1536, 1536, 0, nullptr, 1};
        default: return WDesc{p.in[I_GWO], (bf16_t*)(ws + OFF_WGO), 1024, 1024, 1024, 0, nullptr, 0};
    }
}
DI void prep_tile(LAS float* tile, const WDesc w, int tidx, int lane) {
    const int ntk = w.K / 64;
    const int kt = tidx % ntk, nt = tidx / ntk;
    const int n0 = nt * 64;
    int scol = n0;
    if (w.half) { const int t256 = n0 >> 8, ww = n0 & 255; scol = (ww >= 128 ? w.half : 0) + t256 * 128 + (ww & 127); }
    const int c4 = (lane & 15) * 4;
    f32x4 v[16];
#pragma unroll
    for (int i = 0; i < 16; ++i) {
        const int r = (lane >> 4) + 4 * i;
        v[i] = (f32x4){0.f, 0.f, 0.f, 0.f};
        if (w.perm == 2) {
            const float* rp = w.src + (size_t)(kt * 64 + r) * w.N + (n0 >> 7) * 96;
#pragma unroll
            for (int j = 0; j < 4; ++j) { const int pos = (n0 & 127) + c4 + j; v[i][j] = pos < 96 ? rp[mla_dim_of_pos(pos)] : 0.f; }
        } else if (w.perm == 1 && n0 < 1280) {
            const float* rp = w.src + (size_t)(kt * 64 + r) * w.N + (n0 & ~127);
#pragma unroll
            for (int j = 0; j < 4; ++j) v[i][j] = rp[gqa_dim_of_pos((n0 & 127) + c4 + j)];
        } else if (scol + c4 < w.N) v[i] = *(const f32x4*)(w.src + (size_t)(kt * 64 + r) * w.N + scol + c4);
    }
#pragma unroll
    for (int i = 0; i < 16; ++i) {
        const int r = (lane >> 4) + 4 * i;
        f32x4 x = v[i];
        if (w.kscale) x *= w.kscale[kt * 64 + r];
#pragma unroll
        for (int j = 0; j < 4; ++j) tile[r * 65 + c4 + j] = x[j];
    }
    bf16_t* d = w.dst + (size_t)(n0 + lane) * w.K + kt * 64;
#pragma unroll
    for (int q = 0; q < 8; ++q) {
        float f[8];
#pragma unroll
        for (int k = 0; k < 8; ++k) f[k] = tile[(q * 8 + k) * 65 + lane];
        *(u32x4*)(d + q * 8) = pack8(f);
    }
}

DI void ada_item(const Params& p, float* ADA, int item, int lane) {
    const int layer = item / 192, n0 = (item - layer * 192) * 32;
    const int r = lane & 31, kh = lane >> 5;
    const float* W = p.in[I_ADAW] + (size_t)layer * 1024 * 6144 + n0 + r;
    const float* cb = p.in[I_C] + r * 1024 + kh * 8;
    const float* cc = p.in[I_CCTX] + kh * 8;
    f32x16 acc;
#pragma unroll
    for (int i = 0; i < 16; ++i) acc[i] = 0.f;
    float accc = 0.f;
    for (int k0 = 0; k0 < 1024; k0 += 32) {
        float wv[16], cv[16], xv[16];
#pragma unroll
        for (int h2 = 0; h2 < 2; ++h2) {
            const f32x4 c0 = *(const f32x4*)(cb + k0 + h2 * 16), c1 = *(const f32x4*)(cb + k0 + h2 * 16 + 4);
            const f32x4 x0 = *(const f32x4*)(cc + k0 + h2 * 16), x1 = *(const f32x4*)(cc + k0 + h2 * 16 + 4);
#pragma unroll
            for (int u = 0; u < 4; ++u) { cv[h2 * 8 + u] = c0[u]; cv[h2 * 8 + 4 + u] = c1[u]; xv[h2 * 8 + u] = x0[u]; xv[h2 * 8 + 4 + u] = x1[u]; }
#pragma unroll
            for (int u = 0; u < 8; ++u) wv[h2 * 8 + u] = W[(size_t)(k0 + h2 * 16 + kh * 8 + u) * 6144];
        }
#pragma unroll
        for (int u = 0; u < 16; ++u) {
            acc = __builtin_amdgcn_mfma_f32_32x32x2f32(silu_f(cv[u]), wv[u], acc, 0, 0, 0);
            accc += silu_f(xv[u]) * wv[u];
        }
    }
    accc += __shfl_xor(accc, 32);
    const float bias = p.in[I_ADAB][layer * 6144 + n0 + r];
#pragma unroll
    for (int i = 0; i < 16; ++i) {
        const int v = (i & 3) + 8 * (i >> 2) + 4 * kh;
        ADA[((size_t)layer * 33 + v) * 6144 + n0 + r] = acc[i] + bias;
    }
    if (kh == 0) ADA[((size_t)layer * 33 + 32) * 6144 + n0 + r] = accc + bias;
}

DI void phase0(LAS unsigned char* lds, const Params& p, float* ADA, unsigned* counter) {
    const int TIDX = otid();
    const int wave = __builtin_amdgcn_readfirstlane(TIDX >> 6), lane = TIDX & 63;
    LAS float* tile = (LAS float*)(lds + wave * 16640);
    constexpr int NADA = 4 * 192;
    for (;;) {
        int item = 0;
        if (lane == 0) item = (int)atomicAdd(counter, 1u);
        item = __builtin_amdgcn_readfirstlane(item);
        if (item < NADA) { ada_item(p, ADA, item, lane); continue; }
        int t = item - NADA, m = 0;
        bool found = false;
        for (m = 0; m < 17; ++m) {
            const WDesc w = wdesc_of(p, m);
            const int nt = (w.K / 64) * (w.Nout / 64);
            if (t < nt) { prep_tile(tile, w, t, lane); found = true; break; }
            t -= nt;
        }
        if (!found) break;
    }
}

DI void norm_phase(const float* lat_in, const float* ctx_in, float* lat_out, float* ctx_out, bool copy, const float* g,
                   const float* ada, int shidx, bf16_t* H, bool skipctx, float* ssq_zero = nullptr) {
    const int TIDX = otid(); const int BIDX = obid(); (void)TIDX; (void)BIDX;
    const int wave = TIDX >> 6, lane = TIDX & 63;
    for (int row = BIDX * 8 + wave; row < NR; row += gridDim.x * 8) {
        const int b = row / TT, t = row - b * TT;
        if (skipctx && t < CTXL) continue;
        if (ssq_zero && lane < 4) ssq_zero[(size_t)row * 4 + lane] = 0.f;
        const size_t ro = t < CTXL ? ((size_t)(b * CTXL + t) << 10) : ((size_t)(b * SEQ + t - CTXL) << 10);
        const float* src = (t < CTXL ? ctx_in : lat_in) + ro;
        const float* sh = ada + (size_t)(t < CTXL ? 32 : b) * 6144 + shidx * 1024;
        const float* sc = sh + 1024;
        f32x4 a[4];
        a[0] = *(const f32x4*)(src + lane * 8); a[1] = *(const f32x4*)(src + lane * 8 + 4);
        a[2] = *(const f32x4*)(src + 512 + lane * 8); a[3] = *(const f32x4*)(src + 512 + lane * 8 + 4);
        float ss = 0.f;
#pragma unroll
        for (int i = 0; i < 4; ++i)
#pragma unroll
            for (int j = 0; j < 4; ++j) ss += a[i][j] * a[i][j];
        ss = wsum(ss);
        const float r = rsqrtf(ss * (1.f / 1024.f) + EPS);
        if (copy) {
            float* dst = (t < CTXL ? ctx_out : lat_out) + ro;
            *(f32x4*)(dst + lane * 8) = a[0]; *(f32x4*)(dst + lane * 8 + 4) = a[1];
            *(f32x4*)(dst + 512 + lane * 8) = a[2]; *(f32x4*)(dst + 512 + lane * 8 + 4) = a[3];
        }
#pragma unroll
        for (int hf = 0; hf < 2; ++hf) {
            const int c0 = hf * 512 + lane * 8;
            float y[8];
#pragma unroll
            for (int q = 0; q < 2; ++q) {
                const f32x4 gv = *(const f32x4*)(g + c0 + q * 4), sv = *(const f32x4*)(sc + c0 + q * 4), hv = *(const f32x4*)(sh + c0 + q * 4);
#pragma unroll
                for (int j = 0; j < 4; ++j) y[q * 4 + j] = a[hf * 2 + q][j] * r * gv[j] * (1.f + sv[j]) + hv[j];
            }
            *(u32x4*)(H + ((size_t)row << 10) + c0) = pack8(y);
        }
    }
}

DI void mla_rope8(float* v, int sub, int s) {
    const float pos = (float)((sub < 2) ? (s >> 6) : (s & 63));
    const bool isx2 = sub & 1;
#pragma unroll
    for (int i = 0; i < 8; ++i) {
        const float other = __shfl_xor(v[i], 1);
        const float ang = pos * fexp2(-(float)i * (L2_10000 / 8.f));
        const float c = __cosf(ang), sn = __sinf(ang);
        v[i] = isx2 ? (other * sn + v[i] * c) : (v[i] * c - other * sn);
    }
}

DI void mla_r2(bf16_t* QB, bf16_t* KV, const bf16_t* Z, const float* gqn, const float* gkn) {
    const int TIDX = otid(); const int BIDX = obid(); (void)TIDX; (void)BIDX;
    const int wave = TIDX >> 6, lane = TIDX & 63, hd = lane >> 2, sub = lane & 3;
    for (int row = BIDX * 8 + wave; row < NR; row += gridDim.x * 8) {
        const int b = row / TT, t = row - b * TT; const bool latent = t >= CTXL; const int s = t - CTXL;
        const bf16_t* z = Z + (size_t)row * 768;
        bf16_t* qp = QB + (size_t)row * 1536 + hd * 96;
        bf16_t* kp = KV + (size_t)row * 2560 + hd * 160;
        unsigned zq[3];
#pragma unroll
        for (int i = 0; i < 3; ++i) zq[i] = *(const unsigned*)(z + lane * 6 + 2 * i);
        const u32x2 zk = *(const u32x2*)(z + 384 + lane * 4);
        const u32x4 q0 = *(const u32x4*)(qp + sub * 16), q1 = *(const u32x4*)(qp + sub * 16 + 8), q2 = *(const u32x4*)(qp + 64 + sub * 8);
        const u32x4 k0 = *(const u32x4*)(kp + sub * 16), k1 = *(const u32x4*)(kp + sub * 16 + 8);
        const u32x4 v0 = *(const u32x4*)(kp + 64 + sub * 16), v1 = *(const u32x4*)(kp + 64 + sub * 16 + 8);
        const u32x4 k2 = *(const u32x4*)(z + 640 + sub * 8);
        asm volatile("s_waitcnt vmcnt(0)" ::: "memory");
        float sq0 = 0.f, sk0 = 0.f;
#pragma unroll
        for (int i = 0; i < 3; ++i) { const float a0 = bf_lo(zq[i]), a1 = bf_hi(zq[i]); sq0 += a0 * a0 + a1 * a1; }
        { const float a0 = bf_lo(zk[0]), a1 = bf_hi(zk[0]), a2 = bf_lo(zk[1]), a3 = bf_hi(zk[1]); sk0 = a0 * a0 + a1 * a1 + a2 * a2 + a3 * a3; }
        sq0 = wsum(sq0); sk0 = wsum(sk0);
        const float rq0 = rsqrtf(sq0 * (1.f / 384.f) + EPS), rk0 = rsqrtf(sk0 * (1.f / 256.f) + EPS);
        float qn[16], qr[8], kn[16], kr[8], vv[16];
        unpack8(q0, qn); unpack8(q1, qn + 8); unpack8(q2, qr);
        unpack8(k0, kn); unpack8(k1, kn + 8); unpack8(k2, kr);
        unpack8(v0, vv); unpack8(v1, vv + 8);
#pragma unroll
        for (int i = 0; i < 16; ++i) { qn[i] *= rq0; kn[i] *= rk0; vv[i] *= rk0; }
#pragma unroll
        for (int i = 0; i < 8; ++i) qr[i] *= rq0;
        float sq = 0.f, sk = 0.f;
#pragma unroll
        for (int i = 0; i < 16; ++i) { sq += qn[i] * qn[i]; sk += kn[i] * kn[i]; }
#pragma unroll
        for (int i = 0; i < 8; ++i) { sq += qr[i] * qr[i]; sk += kr[i] * kr[i]; }
        sq += __shfl_xor(sq, 1); sq += __shfl_xor(sq, 2);
        sk += __shfl_xor(sk, 1); sk += __shfl_xor(sk, 2);
        const float rq = rsqrtf(sq * (1.f / 96.f) + EPS), rk = rsqrtf(sk * (1.f / 96.f) + EPS);
#pragma unroll
        for (int i = 0; i < 16; ++i) { qn[i] *= rq * gqn[sub * 16 + i]; kn[i] *= rk * gkn[sub * 16 + i]; }
#pragma unroll
        for (int i = 0; i < 8; ++i) { qr[i] *= rq * gqn[64 + sub * 8 + i]; kr[i] *= rk * gkn[64 + sub * 8 + i]; }
        if (latent) { mla_rope8(qr, sub, s); mla_rope8(kr, sub, s); }
        *(u32x4*)(qp + sub * 16) = pack8(qn); *(u32x4*)(qp + sub * 16 + 8) = pack8(qn + 8); *(u32x4*)(qp + 64 + sub * 8) = pack8(qr);
        *(u32x4*)(kp + sub * 16) = pack8(kn); *(u32x4*)(kp + sub * 16 + 8) = pack8(kn + 8); *(u32x4*)(kp + 64 + sub * 8) = pack8(kr);
        *(u32x4*)(kp + 96 + sub * 16) = pack8(vv); *(u32x4*)(kp + 96 + sub * 16 + 8) = pack8(vv + 8);
    }
}

template <int HD, int LPH, int ROPE>
DI void headnorm_phase(bf16_t* X, int stride, int nq, int koff, int nk, const float* gq, const float* gk) {
    const int TIDX = otid(); const int BIDX = obid(); (void)TIDX; (void)BIDX;
    const int wave = TIDX >> 6, lane = TIDX & 63, sub = lane % LPH, hl = lane / LPH;
    const int rstep = gridDim.x * 8;
    for (int row = BIDX * 8 + wave; row < NR; row += 2 * rstep) {
        u32x4 u[2][2][2];
#pragma unroll
        for (int rr = 0; rr < 2; ++rr)
#pragma unroll
            for (int pass = 0; pass < 2; ++pass) {
                const int r2 = row + rr * rstep;
                const bool act = (r2 < NR) && (hl < (pass ? nk : nq));
                const bf16_t* ptr = X + (size_t)r2 * stride + (pass ? koff : 0) + hl * HD + sub * 16;
                u[rr][pass][0] = (u32x4){0, 0, 0, 0}; u[rr][pass][1] = (u32x4){0, 0, 0, 0};
                if (act) { u[rr][pass][0] = *(const u32x4*)ptr; u[rr][pass][1] = *(const u32x4*)(ptr + 8); }
            }
        asm volatile("s_waitcnt vmcnt(0)" ::: "memory");
#pragma unroll
        for (int rr = 0; rr < 2; ++rr) {
            const int r2 = row + rr * rstep;
            const int b = r2 / TT, t = r2 - b * TT; const bool latent = t >= CTXL; const int s = t - CTXL;
#pragma unroll
            for (int pass = 0; pass < 2; ++pass) {
                const bool act = (r2 < NR) && (hl < (pass ? nk : nq));
                const float* g = pass ? gk : gq;
                bf16_t* ptr = X + (size_t)r2 * stride + (pass ? koff : 0) + hl * HD + sub * 16;
                float v[16]; unpack8(u[rr][pass][0], v); unpack8(u[rr][pass][1], v + 8);
                float ss = 0.f;
#pragma unroll
                for (int i = 0; i < 16; ++i) ss += v[i] * v[i];
#pragma unroll
                for (int o = 1; o < LPH; o <<= 1) ss += __shfl_xor(ss, o);
                const float rr_ = rsqrtf(ss * (1.f / HD) + EPS);
#pragma unroll
                for (int i = 0; i < 16; ++i) v[i] *= rr_ * g[sub * 16 + i];
                if (ROPE) {
                    if (latent) {
                        const int axis = sub >> 2; const bool isx2 = (sub >> 1) & 1;
                        const float pos = (float)(axis ? (s & 63) : (s >> 6));
#pragma unroll
                        for (int i = 0; i < 16; ++i) {
                            const float other = __shfl_xor(v[i], 2);
                            const int fi = (sub & 1) * 16 + i;
                            const float ang = pos * fexp2(-(float)fi * (L2_10000 / 32.f));
                            const float c = __cosf(ang), sn = __sinf(ang);
                            v[i] = isx2 ? (other * sn + v[i] * c) : (v[i] * c - other * sn);
                        }
                    }
                }
                if (act) { *(u32x4*)ptr = pack8(v); *(u32x4*)(ptr + 8) = pack8(v + 8); }
            }
        }
    }
}

struct AttnArgs { const bf16_t* Q; const bf16_t* K; const bf16_t* V; bf16_t* O; int qs, qh, ks, kh, vs, vh, nheads, gshift, ctx_out; const float* rpb; float sc; };

template <int DK, int DV, int NA>
DI void attn_phase(LAS unsigned char* lds, const AttnArgs a) {
    const int TIDX = otid(); const int BIDX = obid(); (void)TIDX; (void)BIDX;
    constexpr int KROW = DK * 2 + 16, VROW = DV * 2 + 16;
    constexpr int KBUF = 64 * KROW, VBUF = 64 * VROW;
    constexpr int OFFK = 0, OFFV = 2 * KBUF, OFFR = OFFV + 2 * VBUF;
    constexpr int KCH = DK / 8, VCH = DV / 8, NKC = 64 * KCH, NVC = 64 * VCH;
    constexpr int KPT = (NKC + 511) / 512, VPT = (NVC + 511) / 512;
    constexpr int NK0 = DK / 16, NQG = NK0 / 2;
    const int tid = TIDX, wave = __builtin_amdgcn_readfirstlane(tid >> 6), lane = tid & 63, r = lane & 31, hh = lane >> 5;
    const int i16 = lane & 15, tq = i16 >> 2, tp = i16 & 3, blk = (lane >> 4) & 1;
    const int nlat = NB * a.nheads * 8, ntot = nlat + (a.ctx_out ? NB * a.nheads : 0);
    LAS float* rpbL = (LAS float*)(lds + OFFR);
    for (int item = BIDX; item < ntot; item += gridDim.x) {
        int b, h, qb = 0; const bool isctx = item >= nlat;
        if (!isctx) { const int R = item >> 8, u = item & 255; const int qp = (R * 8 + (u & 7)) * 4 + (u >> 6); qb = (u >> 3) & 7; h = qp % a.nheads; b = qp / a.nheads; }
        else { const int bh = item - nlat; h = bh % a.nheads; b = bh / a.nheads; }
        const int hk = h >> a.gshift;
        const size_t rb = (size_t)b * TT;
        const bf16_t* Kb = a.K + hk * a.kh; const bf16_t* Vb = a.V + hk * a.vh;
        int ntiles = isctx ? 4 : 36, rlo = 0, wi = 0, wr0 = 0, c0 = 0;
        if (NA) {
            if (!isctx) { const int i0 = qb * 4; rlo = clampi(i0 - 4, 0, 24); const int rhi = clampi(i0 - 1, 0, 24) + 8; ntiles = 4 + rhi - rlo;
                wi = i0 + (wave >> 1); wr0 = clampi(wi - 4, 0, 24); c0 = (wave & 1) * 32; }
            if (tid < 465) rpbL[64 + tid] = a.rpb[h * 465 + tid] * LOG2E;
        }
        const size_t qrow = rb + (isctx ? 0 : 256 + qb * 256) + wave * 32 + r;
        bf16x8 qf[DK / 16];
#pragma unroll
        for (int k0 = 0; k0 < DK / 16; ++k0) qf[k0] = *(const bf16x8*)(a.Q + qrow * a.qs + h * a.qh + k0 * 16 + hh * 8);
        u32x4 sreg[KPT > VPT ? KPT : VPT];
#define ATT_TILE_ROW(j) ((NA && (j) >= 4) ? rb + 256 + (size_t)(rlo + (j) - 4) * 64 : rb + (size_t)(j) * 64)
#define ATT_GLOADK(j) do { const size_t _tr = ATT_TILE_ROW(j); \
        _Pragma("unroll") for (int _i = 0; _i < KPT; ++_i) { const int _c = tid + _i * 512; if (_c < NKC) { const int _row = _c / KCH, _cc = _c - _row * KCH; sreg[_i] = *(const u32x4*)(Kb + (_tr + _row) * a.ks + _cc * 8); } } } while (0)
#define ATT_GLOADV(j) do { const size_t _tr = ATT_TILE_ROW(j); \
        _Pragma("unroll") for (int _i = 0; _i < VPT; ++_i) { const int _c = tid + _i * 512; if (_c < NVC) { const int _row = _c / VCH, _cc = _c - _row * VCH; sreg[_i] = *(const u32x4*)(Vb + (_tr + _row) * a.vs + _cc * 8); } } } while (0)
#define ATT_LSTOREK(buf) do { \
        _Pragma("unroll") for (int _i = 0; _i < KPT; ++_i) { const int _c = tid + _i * 512; if (_c < NKC) { const int _row = _c / KCH, _cc = _c - _row * KCH; *(LAS u32x4*)(lds + OFFK + (buf) * KBUF + _row * KROW + _cc * 16) = sreg[_i]; } } } while (0)
#define ATT_LSTOREV(buf) do { \
        _Pragma("unroll") for (int _i = 0; _i < VPT; ++_i) { const int _c = tid + _i * 512; if (_c < NVC) { const int _row = _c / VCH, _cc = _c - _row * VCH; *(LAS u32x4*)(lds + OFFV + (buf) * VBUF + _row * VROW + _cc * 16) = sreg[_i]; } } } while (0)
#define ATT_KFRAG(buf, idx) (*(const LAS bf16x8*)(lds + OFFK + (buf) * KBUF + (((idx) / NK0) * 32 + r) * KROW + ((idx) % NK0) * 32 + hh * 16))
#define ATT_QK(dst, buf) do { \
        _Pragma("unroll") for (int _x = 0; _x < 2 * NK0; ++_x) { const bf16x8 kf = ATT_KFRAG(buf, _x); \
            dst[_x / NK0] = __builtin_amdgcn_mfma_f32_32x32x16_bf16(kf, qf[_x % NK0], (_x % NK0) == 0 ? zero16 : dst[_x / NK0], 0, 0, 0); } } while (0)
#define ATT_ACTIVE(j) (!(NA && (j) >= 4) || ((rlo + (j) - 4 >= wr0) && (rlo + (j) - 4 < wr0 + 8)))
#define ATT_TILE(j, S, SN) do { \
        if ((j) + 1 < ntiles) ATT_GLOADV((j) + 1); \
        if (ATT_ACTIVE(j)) { \
            const int nb = ((j) + 1) & 1; \
            const LAS unsigned char* Vt = lds + OFFV + ((j) & 1) * VBUF; \
            bf16x8 kfr[2][NQG]; \
            _Pragma("unroll") for (int q = 0; q < NQG; ++q) kfr[0][q] = ATT_KFRAG(nb, q); \
            float mx = m_run; \
            if (NA && (j) >= 4) { \
                const int kr = rlo + (j) - 4; \
                const int ri = kr - wi + 7, qj = c0 + r, cs = clampi(qj - 8, 0, 48); \
                const LAS float* bp = rpbL + 64 + ri * 31 + (4 * hh - qj + 15); \
                const int vb = 4 * hh - cs; \
                _Pragma("unroll") for (int kb = 0; kb < 2; ++kb) \
                    _Pragma("unroll") for (int i = 0; i < 16; ++i) { \
                        const int ci = kb * 32 + (i & 3) + 8 * (i >> 2); \
                        const bool valid = (unsigned)(vb + ci) < 16u; \
                        const float x = valid ? __builtin_fmaf(S[kb][i], a.sc, bp[ci]) : -1e30f; \
                        S[kb][i] = x; mx = fmaxf(mx, x); } \
                mx = fmaxf(mx, __shfl_xor(mx, 32)); \
            } else { \
                float mr = -1e30f; \
                _Pragma("unroll") for (int kb = 0; kb < 2; ++kb) \
                    _Pragma("unroll") for (int i = 0; i < 16; ++i) mr = fmaxf(mr, S[kb][i]); \
                mr = fmaxf(mr, __shfl_xor(mr, 32)); \
                mx = fmaxf(mx, mr * a.sc); \
            } \
            if (__any(mx > m_run + 8.f)) {     \
                const float alpha = fexp2(m_run - mx); \
                lsum *= alpha; \
                _Pragma("unroll") for (int d = 0; d < DV / 32; ++d) \
                    _Pragma("unroll") for (int i = 0; i < 16; ++i) o[d][i] *= alpha; \
                m_run = mx; \
            } \
            mx = m_run; \
            __builtin_amdgcn_sched_barrier(0); \
            _Pragma("unroll") for (int grp = 0; grp < 4; ++grp) { \
                const int kb = grp >> 1, st = grp & 1; \
                if (grp < 3) { _Pragma("unroll") for (int q = 0; q < NQG; ++q) kfr[(grp + 1) & 1][q] = ATT_KFRAG(nb, (grp + 1) * NQG + q); } \
                bf16x8 vf[DV / 32]; \
                _Pragma("unroll") for (int d = 0; d < DV / 32; ++d) { \
                    const LAS unsigned char* ad = Vt + (kb * 32 + 16 * st + 4 * hh + tq) * VROW + (d * 32 + 16 * blk + 4 * tp) * 2; \
                    const s16x4 lo = __builtin_amdgcn_ds_read_tr16_b64_v4i16((LAS s16x4*)ad); \
                    const s16x4 hi = __builtin_amdgcn_ds_read_tr16_b64_v4i16((LAS s16x4*)(ad + 8 * VROW)); \
                    vf[d] = __builtin_shufflevector(lo, hi, 0, 1, 2, 3, 4, 5, 6, 7); } \
                _Pragma("unroll") for (int q = 0; q < NQG; ++q) { const int idx = grp * NQG + q; \
                    SN[idx / NK0] = __builtin_amdgcn_mfma_f32_32x32x16_bf16(kfr[grp & 1][q], qf[idx % NK0], (idx % NK0) == 0 ? zero16 : SN[idx / NK0], 0, 0, 0); } \
                __builtin_amdgcn_sched_barrier(0); \
                float pp[8]; \
                _Pragma("unroll") for (int i = 0; i < 8; ++i) { \
                    pp[i] = (NA && (j) >= 4) ? fexp2(S[kb][8 * st + i] - mx) : fexp2(__builtin_fmaf(S[kb][8 * st + i], a.sc, -mx)); lsum += pp[i]; } \
                const bf16x8 pf = __builtin_bit_cast(bf16x8, pack8(pp)); \
                __builtin_amdgcn_sched_barrier(0); \
                _Pragma("unroll") for (int d = 0; d < DV / 32; ++d) o[d] = __builtin_amdgcn_mfma_f32_32x32x16_bf16(vf[d], pf, o[d], 0, 0, 0); \
                __builtin_amdgcn_sched_barrier(0); \
                if (grp == 1) { \
                    if ((j) + 1 < ntiles) ATT_LSTOREV(((j) + 1) & 1); \
                    if ((j) + 2 < ntiles) ATT_GLOADK((j) + 2); \
                    __builtin_amdgcn_sched_barrier(0); \
                } \
            } \
        } else { \
            ATT_QK(SN, ((j) + 1) & 1); \
            if ((j) + 1 < ntiles) ATT_LSTOREV(((j) + 1) & 1); \
            if ((j) + 2 < ntiles) ATT_GLOADK((j) + 2); \
        } \
        if ((j) + 2 < ntiles) ATT_LSTOREK((j) & 1); \
        __syncthreads(); } while (0)
        ATT_GLOADK(0); ATT_LSTOREK(0); ATT_GLOADV(0); ATT_LSTOREV(0);
        ATT_GLOADK(1); ATT_LSTOREK(1);
        __syncthreads();
        f32x16 o[DV / 32];
#pragma unroll
        for (int d = 0; d < DV / 32; ++d)
#pragma unroll
            for (int i = 0; i < 16; ++i) o[d][i] = 0.f;
        f32x16 zero16;
#pragma unroll
        for (int i = 0; i < 16; ++i) zero16[i] = 0.f;
        float m_run = -1e30f, lsum = 0.f;
        f32x16 s[2], sn[2];
        ATT_QK(s, 0);
        __syncthreads();
        for (int j = 0; j < ntiles; j += 2) {
            ATT_TILE(j, s, sn);
            if (j + 1 < ntiles) ATT_TILE(j + 1, sn, s);
        }
        lsum += __shfl_xor(lsum, 32);
        const float inv = frcp(lsum);
        bf16_t* orow = a.O + (qrow << 10) + h * DV;
#pragma unroll
        for (int d = 0; d < DV / 32; ++d)
#pragma unroll
            for (int g = 0; g < 4; ++g)
                *(u32x2*)(orow + d * 32 + 8 * g + 4 * hh) = (u32x2){pk_bf16(o[d][4 * g] * inv, o[d][4 * g + 1] * inv), pk_bf16(o[d][4 * g + 2] * inv, o[d][4 * g + 3] * inv)};
#undef ATT_TILE_ROW
#undef ATT_GLOADK
#undef ATT_GLOADV
#undef ATT_LSTOREK
#undef ATT_LSTOREV
#undef ATT_KFRAG
#undef ATT_QK
#undef ATT_ACTIVE
#undef ATT_TILE
    }
}

namespace ad {
constexpr int D = 128, NW = 8, QBLK = 32, KVBLK = 64;
constexpr float SCALE = 0.088388347648318440f, THR = 8.f;
constexpr int LDQ = 1536, LDK = 1536, LDO = 1024;
constexpr size_t SHM_V = KVBLK * D * 2, SHM_K = KVBLK * D * 2;
typedef float f32x8 __attribute__((ext_vector_type(8)));
#define AD_KSWZ(row, colB) ((row) * 256 + ((colB) ^ (((row) & 7) << 4)))
#define AD_SBAR() __builtin_amdgcn_sched_barrier(0)
DI int crow(int r, int hi) { return (r & 3) + 8 * (r >> 2) + 4 * hi; }
DI unsigned cvtpk(float lo, float hi) { unsigned r; asm volatile("v_cvt_pk_bf16_f32 %0, %1, %2" : "=v"(r) : "v"(lo), "v"(hi)); return r; }
DI bf16x8 ld8(const bf16_t* p) { return *reinterpret_cast<const bf16x8*>(p); }
DI void partialSM(f32x16& p0, f32x16& p1, float& m_reg, float& mn, float& alpha) {
  constexpr float C = SCALE * 1.4426950408889634f;
  float pmax = p0[0];
#pragma unroll
  for (int r = 1; r < 16; ++r) pmax = fmaxf(pmax, p0[r]);
#pragma unroll
  for (int r = 0; r < 16; ++r) pmax = fmaxf(pmax, p1[r]);
  { auto rr = __builtin_amdgcn_permlane32_swap(__float_as_uint(pmax), __float_as_uint(pmax), false, false);
    pmax = fmaxf(__uint_as_float(rr[0]), __uint_as_float(rr[1])); }
  if (__builtin_expect(__all(pmax - m_reg <= THR / SCALE), 1)) { mn = m_reg; alpha = 1.f; }
  else { mn = fmaxf(m_reg, pmax); alpha = __builtin_amdgcn_exp2f((m_reg - mn) * C); m_reg = mn; }
  float mnC = -mn * C;
#pragma unroll
  for (int r = 0; r < 16; ++r) p0[r] = fmaf(p0[r], C, mnC);
#pragma unroll
  for (int r = 0; r < 16; ++r) p1[r] = fmaf(p1[r], C, mnC);
#pragma unroll
  for (int r = 0; r < 16; ++r) p0[r] = __builtin_amdgcn_exp2f(p0[r]);
}
DI void finishSM(f32x16& p0, f32x16& p1, float alpha, float& l_reg, bf16x8& pa0, bf16x8& pa1, bf16x8& pa2, bf16x8& pa3) {
#pragma unroll
  for (int r = 0; r < 16; ++r) p1[r] = __builtin_amdgcn_exp2f(p1[r]);
  float ps = 0;
#pragma unroll
  for (int r = 0; r < 16; ++r) ps += p0[r];
#pragma unroll
  for (int r = 0; r < 16; ++r) ps += p1[r];
  { auto rr = __builtin_amdgcn_permlane32_swap(__float_as_uint(ps), __float_as_uint(ps), false, false);
    ps = __uint_as_float(rr[0]) + __uint_as_float(rr[1]); }
  l_reg = l_reg * alpha + ps;
#define AD_PK4(P, BASE, OUT) do { unsigned a0 = cvtpk(P[BASE + 0], P[BASE + 1]), a1 = cvtpk(P[BASE + 2], P[BASE + 3]);   \
    unsigned b0 = cvtpk(P[BASE + 4], P[BASE + 5]), b1 = cvtpk(P[BASE + 6], P[BASE + 7]);                              \
    auto r0 = __builtin_amdgcn_permlane32_swap(a0, b0, false, false); auto r1 = __builtin_amdgcn_permlane32_swap(a1, b1, false, false); \
    u32x4 w = {r0[0], r1[0], r0[1], r1[1]}; OUT = *reinterpret_cast<bf16x8*>(&w); } while (0)
  AD_PK4(p0, 0, pa0); AD_PK4(p0, 8, pa1); AD_PK4(p1, 0, pa2); AD_PK4(p1, 8, pa3);
#undef AD_PK4
}
DI void qkt(f32x16& p0, f32x16& p1, const char* Ks, const bf16x8* qr, int r32, int hi) {
#pragma unroll
  for (int i = 0; i < 16; ++i) { p0[i] = 0.f; p1[i] = 0.f; }
#pragma unroll
  for (int d0 = 0; d0 < 8; ++d0) { int cb = (d0 * 16 + hi * 8) * 2;
    bf16x8 b0 = *reinterpret_cast<const bf16x8*>(Ks + AD_KSWZ(r32, cb));
    bf16x8 b1 = *reinterpret_cast<const bf16x8*>(Ks + AD_KSWZ(32 + r32, cb));
    p0 = __builtin_amdgcn_mfma_f32_32x32x16_bf16(b0, qr[d0], p0, 0, 0, 0);
    p1 = __builtin_amdgcn_mfma_f32_32x32x16_bf16(b1, qr[d0], p1, 0, 0, 0); }
}
DI int v_st(int k, int c) { const int kk = (k & ~0xC) | ((k & 4) << 1) | ((k & 8) >> 1); return ((kk >> 3) * 4 + (c >> 5)) * 512 + ((kk & 7) * 32 + (c & 31)) * 2; }
DI int v_rd_base(int lane) { return ((lane & 3) << 3) | (((lane >> 2) & 3) << 6) | (((lane >> 4) & 1) << 5) | (((lane >> 5) & 1) << 8); }
constexpr int v_rd_off(int d0, int ks, int half) { return d0 * 512 + ks * 4096 + half * 2048; }
template <int OFF> DI s16x4 tr_read(int vb) { s16x4 r; asm volatile("ds_read_b64_tr_b16 %0, %1 offset:%2" : "=&v"(r) : "v"(vb), "i"(OFF) : "memory"); return r; }
template <int D0> DI void pv_one(f32x16& od, int vb, bf16x8 pa0, bf16x8 pa1, bf16x8 pa2, bf16x8 pa3) {
  const s16x4 l0 = tr_read<v_rd_off(D0, 0, 0)>(vb), h0 = tr_read<v_rd_off(D0, 0, 1)>(vb), l1 = tr_read<v_rd_off(D0, 1, 0)>(vb), h1 = tr_read<v_rd_off(D0, 1, 1)>(vb);
  const s16x4 l2 = tr_read<v_rd_off(D0, 2, 0)>(vb), h2 = tr_read<v_rd_off(D0, 2, 1)>(vb), l3 = tr_read<v_rd_off(D0, 3, 0)>(vb), h3 = tr_read<v_rd_off(D0, 3, 1)>(vb);
  asm volatile("s_waitcnt lgkmcnt(0)" ::: "memory"); AD_SBAR();
#define AD_PK(L, H) (bf16x8){L[0], L[1], L[2], L[3], H[0], H[1], H[2], H[3]}
  od = __builtin_amdgcn_mfma_f32_32x32x16_bf16(pa0, AD_PK(l0, h0), od, 0, 0, 0);
  od = __builtin_amdgcn_mfma_f32_32x32x16_bf16(pa1, AD_PK(l1, h1), od, 0, 0, 0);
  od = __builtin_amdgcn_mfma_f32_32x32x16_bf16(pa2, AD_PK(l2, h2), od, 0, 0, 0);
  od = __builtin_amdgcn_mfma_f32_32x32x16_bf16(pa3, AD_PK(l3, h3), od, 0, 0, 0);
#undef AD_PK
}
DI void pv_d0(f32x16* o, int vb, bf16x8 pa0, bf16x8 pa1, bf16x8 pa2, bf16x8 pa3) {
  pv_one<0>(o[0], vb, pa0, pa1, pa2, pa3); pv_one<1>(o[1], vb, pa0, pa1, pa2, pa3); pv_one<2>(o[2], vb, pa0, pa1, pa2, pa3); pv_one<3>(o[3], vb, pa0, pa1, pa2, pa3);
}
DI void body(int tid, const bf16_t* __restrict__ Qb, const bf16_t* __restrict__ Kh, bf16_t* __restrict__ Ob, int seq, char* lds) {
  const int wid = tid >> 6, lane = tid & 63, r32 = lane & 31, hi = lane >> 5;
  char* V_lds = lds; char* K_lds = lds + 2 * SHM_V;
  float* ws = (float*)(lds + 2 * SHM_V + 2 * SHM_K) + wid * 64; float* li_l = ws; float* al_l = ws + 32;
  float m_reg = -1e30f, l_reg = 0; f32x16 o[4]; bf16x8 qr[8];
#pragma unroll
  for (int d = 0; d < 4; ++d)
#pragma unroll
    for (int i = 0; i < 16; ++i) o[d][i] = 0.f;
  const bf16_t* Qw = Qb + (long)(wid * QBLK + r32) * LDQ + hi * 8;
#pragma unroll
  for (int d0 = 0; d0 < 8; ++d0) qr[d0] = ld8(Qw + d0 * 16);
  const int sr = tid >> 4, sc = (tid & 15) * 8, vst0 = v_st(sr, sc), vst1 = v_st(32 + sr, sc);
  const int vb0 = (int)(uintptr_t)V_lds + v_rd_base(lane);
  struct { bf16x8 vs0, vs1, ks0, ks1; } sr_[2];
  const bf16_t* kp = Kh + (long)sr * LDK + sc;
#define AD_SLOAD(i, k0) do { const bf16_t* _p = kp; asm volatile("" : "+v"(_p)); sr_[i].ks0 = ld8(_p); sr_[i].vs0 = ld8(_p + 256); \
    sr_[i].ks1 = ld8(_p + 32 * LDK); sr_[i].vs1 = ld8(_p + 32 * LDK + 256); kp += KVBLK * LDK; } while (0)
#define AD_SWRITE(b, i) do { *(bf16x8*)(V_lds + (b) * SHM_V + vst0) = sr_[i].vs0; *(bf16x8*)(V_lds + (b) * SHM_V + vst1) = sr_[i].vs1; int kc = sc * 2; \
    *(bf16x8*)(K_lds + (b) * SHM_K + AD_KSWZ(sr, kc)) = sr_[i].ks0; *(bf16x8*)(K_lds + (b) * SHM_K + AD_KSWZ(32 + sr, kc)) = sr_[i].ks1; } while (0)
#define AD_SWAIT() asm volatile("s_waitcnt vmcnt(4)" ::: "memory")
#define AD_RESC(a) do { if (__any((a) < 1.f)) { if (hi == 0) al_l[r32] = (a); asm volatile("s_waitcnt lgkmcnt(0)" ::: "memory"); \
    _Pragma("unroll") for (int d = 0; d < 4; ++d) _Pragma("unroll") for (int r = 0; r < 16; ++r) o[d][r] *= al_l[crow(r, hi)]; } } while (0)
  f32x16 pA0, pA1, pB0, pB1; float mnA, mnB, alA, alB; bf16x8 pa0, pa1, pa2, pa3; const int NT = seq / KVBLK;
  AD_SLOAD(0, 0); asm volatile("s_waitcnt vmcnt(0)" ::: "memory"); AD_SWRITE(0, 0); __syncthreads();
  qkt(pA0, pA1, K_lds, qr, r32, hi); partialSM(pA0, pA1, m_reg, mnA, alA);
  AD_SLOAD(1, KVBLK); if (2 < NT) AD_SLOAD(0, 2 * KVBLK);
  AD_SWAIT(); AD_SWRITE(1, 1); __syncthreads();
  for (int j = 1; j + 1 < NT; j += 2) {
    AD_SBAR(); qkt(pB0, pB1, K_lds + SHM_K, qr, r32, hi);
    finishSM(pA0, pA1, alA, l_reg, pa0, pa1, pa2, pa3); AD_SBAR();
    AD_SLOAD(1, (j + 2) * KVBLK); AD_SBAR();
    pv_d0(o, vb0, pa0, pa1, pa2, pa3); partialSM(pB0, pB1, m_reg, mnB, alB);
    __syncthreads(); AD_SWAIT(); AD_SWRITE(0, 0);
    AD_RESC(alB); __syncthreads();
    AD_SBAR(); qkt(pA0, pA1, K_lds, qr, r32, hi);
    finishSM(pB0, pB1, alB, l_reg, pa0, pa1, pa2, pa3); AD_SBAR();
    if (j + 3 < NT) AD_SLOAD(0, (j + 3) * KVBLK); AD_SBAR();
    pv_d0(o, vb0 + (int)SHM_V, pa0, pa1, pa2, pa3); partialSM(pA0, pA1, m_reg, mnA, alA);
    __syncthreads(); AD_SWAIT(); AD_SWRITE(1, 1);
    AD_RESC(alA); __syncthreads();
  }
  AD_SBAR(); qkt(pB0, pB1, K_lds + SHM_K, qr, r32, hi);
  finishSM(pA0, pA1, alA, l_reg, pa0, pa1, pa2, pa3); AD_SBAR();
  pv_d0(o, vb0, pa0, pa1, pa2, pa3); partialSM(pB0, pB1, m_reg, mnB, alB);
  __syncthreads(); AD_RESC(alB);
  finishSM(pB0, pB1, alB, l_reg, pa0, pa1, pa2, pa3); AD_SBAR();
  pv_d0(o, vb0 + (int)SHM_V, pa0, pa1, pa2, pa3);
  if (hi == 0) li_l[r32] = l_reg; asm volatile("s_waitcnt lgkmcnt(0)" ::: "memory");
  int hi2 = hi, c2 = r32; asm volatile("" : "+v"(hi2), "+v"(c2));
  bf16_t* Ow = Ob + (long)(wid * QBLK) * LDO + c2;
#pragma unroll
  for (int r = 0; r < 16; ++r) { const int orow = crow(r, hi2); const float rl = __builtin_amdgcn_rcpf(li_l[orow]);
#pragma unroll
    for (int d0 = 0; d0 < 4; ++d0) Ow[orow * LDO + d0 * 32] = (bf16_t)(pk_bf16(o[d0][r] * rl, 0.f) & 0xffffu); }
#undef AD_SLOAD
#undef AD_SWRITE
#undef AD_SWAIT
#undef AD_RESC
}
}

DI void gqa_attn_phase(char* shm, const bf16_t* QKV, bf16_t* O) {
    const int TIDX = otid(); const int BIDX = obid();
    for (int item = BIDX; item < NB * 8 * 8; item += gridDim.x) {
        const int R = item >> 8, u = item & 255; const int qp = (R * 8 + (u & 7)) * 4 + (u >> 6); const int qb = (u >> 3) & 7; const int h = qp & 7, b = qp >> 3;
        const size_t rb = (size_t)b * TT, q0 = rb + 256 + (size_t)qb * 256;
        ad::body(TIDX, QKV + q0 * 1536 + h * 128, QKV + rb * 1536 + 1024 + (h >> 2) * 128, O + q0 * 1024 + h * 128, TT, shm);
        __syncthreads();
    }
}

DI void s5_scan_phase(LAS unsigned char* lds, const Params& p, bf16_t* H, bf16_t* YF) {
    const int TIDX = otid(); const int BIDX = obid(); (void)TIDX; (void)BIDX;
    const int wave = __builtin_amdgcn_readfirstlane(TIDX >> 6), lane = TIDX & 63;
    LAS float* BU = (LAS float*)(lds + wave * 14592);
    LAS bf16_t* Hh = (LAS bf16_t*)(lds + wave * 14592 + 10240);
    const int l15 = lane & 15, l4 = lane >> 4;
    for (int item = BIDX * 8 + wave; item < NB * 64; item += gridDim.x * 8) {
        const int g = item & 63, b = item >> 6;
        const float dsk = p.in[I_SD][g * 16 + l15];
        for (int dir = 0; dir < 2; ++dir) {
            const int pg = dir * 64 + g;
            const float dt = __expf(p.in[I_SLDT][pg]);
            const float* are = p.in[I_SARE] + pg * 64; const float* aim = p.in[I_SAIM] + pg * 64;
            float abr, abi;
            { const float ar = are[lane], ai = aim[lane]; const float mag = __expf(dt * ar); abr = mag * __cosf(dt * ai); abi = mag * __sinf(dt * ai); }
            bf16x8 bfr[8], cfr[4];
#pragma unroll
            for (int nt = 0; nt < 8; ++nt) {
                const int st = (nt & 3) * 16 + l15;
                const float ar = are[st], ai = aim[st]; const float mag = __expf(dt * ar);
                const float er = mag * __cosf(dt * ai), ei = mag * __sinf(dt * ai);
                const float den = ar * ar + ai * ai, nr = er - 1.f;
                const float fre = (nr * ar + ei * ai) / den, fim = (ei * ar - nr * ai) / den;
                float bb[8];
#pragma unroll
                for (int j = 0; j < 8; ++j) bb[j] = 0.f;
                if (lane < 32) {
                    const float* br = p.in[I_SBRE] + ((size_t)pg * 64 + st) * 16 + l4 * 8; const float* bi = p.in[I_SBIM] + ((size_t)pg * 64 + st) * 16 + l4 * 8;
#pragma unroll
                    for (int j = 0; j < 8; ++j) bb[j] = (nt < 4) ? (fre * br[j] - fim * bi[j]) : (fre * bi[j] + fim * br[j]);
                }
                bfr[nt] = __builtin_bit_cast(bf16x8, pack8(bb));
            }
#pragma unroll
            for (int kk = 0; kk < 4; ++kk) {
                const int st0 = kk * 16 + l4 * 4;
                const f32x4 cr4 = *(const f32x4*)(p.in[I_SCRE] + ((size_t)pg * 16 + l15) * 64 + st0);
                const f32x4 ci4 = *(const f32x4*)(p.in[I_SCIM] + ((size_t)pg * 16 + l15) * 64 + st0);
                float cc[8];
#pragma unroll
                for (int j = 0; j < 4; ++j) { cc[2 * j] = cr4[j]; cc[2 * j + 1] = -ci4[j]; }
                cfr[kk] = __builtin_bit_cast(bf16x8, pack8(cc));
            }
            float hr = 0.f, hi = 0.f;
#define S5_TB(j) (dir ? ((j) < 16 ? 16 * (15 - (j)) : 256 + 16 * (143 - (j))) : 16 * (j))
            bf16x8 ufn = (bf16x8){0, 0, 0, 0, 0, 0, 0, 0};
            if (lane < 32) ufn = *(const bf16x8*)(H + (((size_t)b * TT + S5_TB(0) + l15) << 10) + g * 16 + l4 * 8);
            for (int j = 0; j < 144; ++j) {
                const int tb = S5_TB(j);
                const size_t row0 = (size_t)b * TT + tb;
                const bf16x8 uf = ufn;
                if (lane < 32 && j + 1 < 144) ufn = *(const bf16x8*)(H + (((size_t)b * TT + S5_TB(j + 1) + l15) << 10) + g * 16 + l4 * 8);
                float yfv[4], uv[4];
                if (dir) {
#pragma unroll
                    for (int i = 0; i < 4; ++i) {
                        const size_t o = ((row0 + l4 * 4 + i) << 10) + g * 16 + l15;
                        yfv[i] = __uint_as_float(((unsigned)YF[o]) << 16); uv[i] = __uint_as_float(((unsigned)H[o]) << 16);
                    }
                }
#pragma unroll
                for (int nt = 0; nt < 8; ++nt) {
                    const f32x4 acc = __builtin_amdgcn_mfma_f32_16x16x32_bf16(uf, bfr[nt], (f32x4){0.f, 0.f, 0.f, 0.f}, 0, 0, 0);
                    *(LAS f32x4*)(BU + (nt * 16 + l15) * 20 + l4 * 4) = acc;
                }
                float bur[16], bui[16];
#pragma unroll
                for (int q = 0; q < 4; ++q) {
                    const f32x4 r4 = *(const LAS f32x4*)(BU + lane * 20 + q * 4), i4 = *(const LAS f32x4*)(BU + (64 + lane) * 20 + q * 4);
#pragma unroll
                    for (int e = 0; e < 4; ++e) { bur[q * 4 + e] = r4[e]; bui[q * 4 + e] = i4[e]; }
                }
                if (dir) {
#pragma unroll
                    for (int tt = 15; tt >= 0; --tt) {
                        const float nhr = abr * hr - abi * hi + bur[tt], nhi = abr * hi + abi * hr + bui[tt];
                        hr = nhr; hi = nhi;
                        *(LAS unsigned*)(Hh + tt * 136 + 2 * lane) = pk_bf16(hr, hi);
                    }
                } else {
#pragma unroll
                    for (int tt = 0; tt < 16; ++tt) {
                        const float nhr = abr * hr - abi * hi + bur[tt], nhi = abr * hi + abi * hr + bui[tt];
                        hr = nhr; hi = nhi;
                        *(LAS unsigned*)(Hh + tt * 136 + 2 * lane) = pk_bf16(hr, hi);
                    }
                }
                f32x4 ya = (f32x4){0.f, 0.f, 0.f, 0.f};
#pragma unroll
                for (int kk = 0; kk < 4; ++kk) {
                    const bf16x8 af = *(const LAS bf16x8*)(Hh + l15 * 136 + kk * 32 + l4 * 8);
                    ya = __builtin_amdgcn_mfma_f32_16x16x32_bf16(af, cfr[kk], ya, 0, 0, 0);
                }
                if (dir == 0) {
#pragma unroll
                    for (int i = 0; i < 4; ++i) YF[((row0 + l4 * 4 + i) << 10) + g * 16 + l15] = (bf16_t)(pk_bf16(ya[i], 0.f) & 0xffffu);
                } else {
#pragma unroll
                    for (int i = 0; i < 4; ++i) {
                        const size_t o = ((row0 + l4 * 4 + i) << 10) + g * 16 + l15;
                        const float y = gelu_tanh(dsk * uv[i] + yfv[i] + ya[i]);
                        H[o] = (bf16_t)(pk_bf16(y, 0.f) & 0xffffu);
                    }
                }
            }
        }
    }
}

#define XB_TMO      128
#define XB_XCNT(j)  (256  + 64 * (j))
#define XB_XSUB(j)  (1280 + 64 * (j))
#define XB_XGEN(j)  (2304 + 64 * (j))
#define XB_TOP      3328
#define XB_TOPGEN   3392
#define XCD_BAR_WORDS 3456
#define XB_SPIN_CAP (1u << 18)
DI unsigned xb_ld(unsigned* p)              { return __hip_atomic_load(p, __ATOMIC_RELAXED, __HIP_MEMORY_SCOPE_AGENT); }
DI unsigned xb_add(unsigned* p, unsigned v) { return __hip_atomic_fetch_add(p, v, __ATOMIC_RELAXED, __HIP_MEMORY_SCOPE_AGENT); }
DI unsigned xb_xcc_id() { return (unsigned)__builtin_amdgcn_s_getreg((3 << 11) | 20) & 0xFu; }
#define XB_SPIN(cond, bar) do { unsigned _sp = 0; while (cond) { __builtin_amdgcn_s_sleep(1); \
    if ((++_sp & 255u) == 0u) { if (xb_ld(&(bar)[XB_TMO])) break; if (_sp > XB_SPIN_CAP) { atomicAdd(&(bar)[XB_TMO], 1u); break; } } } } while (0)
struct XcdBarrier { unsigned* bar; unsigned x; volatile LAS unsigned* st; };
DI XcdBarrier xcd_barrier_post(unsigned* bar, volatile LAS unsigned* st) {
    XcdBarrier b; b.bar = bar; b.x = xb_xcc_id(); b.st = st;
    if (threadIdx.x == 0) (void)xb_add(&bar[XB_XCNT(b.x)], 1u);
    return b;
}
DI void xcd_barrier_complete(unsigned* bar, unsigned x, unsigned& nloc, unsigned& nx) {
    const unsigned G = gridDim.x * gridDim.y * gridDim.z;
    unsigned sum, cnt, mine, sp = 0u;
    for (;;) {
        sum = 0u; cnt = 0u; mine = 0u;
#pragma unroll
        for (unsigned j = 0; j < 16; ++j) { const unsigned c = xb_ld(&bar[XB_XCNT(j)]); sum += c; cnt += (c > 0u) ? 1u : 0u; mine = (j == x) ? c : mine; }
        if (sum == G) break;
        __builtin_amdgcn_s_sleep(1);
        if ((++sp & 255u) == 0u) { if (xb_ld(&bar[XB_TMO])) break; if (sp > XB_SPIN_CAP) { atomicAdd(&bar[XB_TMO], 1u); break; } }
    }
    nloc = mine > 0u ? mine : 1u; nx = cnt > 0u ? cnt : 1u;
}
DI void xcd_barrier(const XcdBarrier& b) {
    asm volatile("s_waitcnt vmcnt(0)" ::: "memory");
    __syncthreads();
    if (threadIdx.x == 0) {
        unsigned* bar = b.bar;
        __builtin_amdgcn_s_waitcnt(0);
        unsigned nloc = b.st[0], nx = b.st[1];
        if (nloc == 0u) { xcd_barrier_complete(bar, b.x, nloc, nx); b.st[0] = nloc; b.st[1] = nx; }
        const unsigned old = xb_add(&bar[XB_XSUB(b.x)], 1u);
        const unsigned gen = old / nloc;
        if (old + 1u == (gen + 1u) * nloc) {
            __builtin_amdgcn_fence(__ATOMIC_RELEASE, "agent");
            asm volatile("s_waitcnt vmcnt(0)" ::: "memory");
            const unsigned og = xb_add(&bar[XB_TOP], 1u);
            const unsigned tg = og / nx;
            if (og + 1u == (tg + 1u) * nx) xb_add(&bar[XB_TOPGEN], 1u);
            else XB_SPIN(xb_ld(&bar[XB_TOPGEN]) == tg, bar);
            __builtin_amdgcn_fence(__ATOMIC_ACQUIRE, "agent");
            xb_add(&bar[XB_XGEN(b.x)], 1u);
            asm volatile("s_waitcnt vmcnt(0)" ::: "memory");
        } else {
            XB_SPIN(xb_ld(&bar[XB_XGEN(b.x)]) == gen, bar);
            __builtin_amdgcn_fence(__ATOMIC_ACQUIRE, "agent");
            asm volatile("s_waitcnt vmcnt(0)" ::: "memory");
        }
    }
    __syncthreads();
}

__global__ void __launch_bounds__(512, 2) mega(const Params p) {
    extern __shared__ __attribute__((aligned(16))) unsigned char shm[];
    LAS unsigned char* lds = (LAS unsigned char*)shm;
    cg::grid_group grid = cg::this_grid();
    LAS unsigned* xbst = (LAS unsigned*)(lds + 133120);
    if (threadIdx.x < 4) xbst[threadIdx.x] = 0u;
    __syncthreads();
    const XcdBarrier xb = xcd_barrier_post((unsigned*)(p.ws + OFF_BAR), (volatile LAS unsigned*)xbst);
    unsigned char* ws = p.ws;
    float* ADA = (float*)(ws + OFF_ADA);
    float* XC = (float*)(ws + OFF_XC);
    bf16_t* HB = (bf16_t*)(ws + OFF_HB);
    float* LAT = p.out;
    int pid = 0;
#define PH_BEGIN if (pid >= p.ph_lo && pid < p.ph_hi) {
#define PH_END if (pid + 1 < p.ph_hi) { if (pid == 0) grid.sync(); else xcd_barrier(xb); } } ++pid;

    PH_BEGIN
    {
        phase0(lds, p, ADA, (unsigned*)(ws + OFF_BAR + 14336));
    }
    PH_END

    for (int layer = 0; layer < 4; ++layer) {
        const float* ada = ADA + (size_t)layer * 33 * 6144;
        const int last = layer == 3;
        PH_BEGIN
        norm_phase(layer == 0 ? p.in[I_X] : LAT, layer == 0 ? p.in[I_CTX] : XC, LAT, XC, false, p.in[I_NMIX] + layer * 1024, ada, 0, HB, false, layer == 0 ? (float*)(ws + OFF_SSQ) : nullptr);
        PH_END
        if (layer == 0) {
            bf16_t* Z = (bf16_t*)(ws + OFF_Z); bf16_t* KV = (bf16_t*)(ws + OFF_KV); bf16_t* QB = (bf16_t*)(ws + OFF_QB);
            float* SSQ = (float*)(ws + OFF_SSQ); LAS float* XX = (LAS float*)(lds + 133120 + 64);
            PH_BEGIN
            run_gemm(lds, HB, 1024, (const bf16_t*)(ws + OFF_WMI), 768, 1024, 0, pg8::EpiMlaZ{Z, SSQ});
            PH_END
            PH_BEGIN
            run_gemm(lds, Z, 768, (const bf16_t*)(ws + OFF_WUQ), 2048, 384, 0, pg8::EpiMlaQ{QB, SSQ, p.in[I_MGQN], XX});
            run_gemm(lds, Z + 384, 768, (const bf16_t*)(ws + OFF_WUKV), 2048, 256, 0, pg8::EpiMlaKV{KV, SSQ, Z, p.in[I_MGKN], XX});
            PH_END
            PH_BEGIN
            attn_phase<96, 64, 0>(lds, AttnArgs{QB, KV, KV + 96, HB, 1536, 96, 2560, 160, 2560, 160, 16, 0, 1, nullptr, 0.10206207261596575f * LOG2E});
            PH_END
            PH_BEGIN
            run_gemm(lds, HB, 1024, (const bf16_t*)(ws + OFF_WMO), 1024, 1024, 0, pg8::EpiRes{LAT, XC, ada, 2, p.in[I_X], p.in[I_CTX]});
            PH_END
        } else if (layer == 1) {
            bf16_t* YF = (bf16_t*)(ws + OFF_BIG);
            PH_BEGIN
            s5_scan_phase(lds, p, HB, YF);
            PH_END
            PH_BEGIN
            run_gemm(lds, HB, 1024, (const bf16_t*)(ws + OFF_WGLU), 2048, 1024, 0, pg8::EpiGluRes{LAT, XC, ada, 2});
            PH_END
        } else if (layer == 2) {
            bf16_t* QKV = (bf16_t*)(ws + OFF_BIG);
            PH_BEGIN
            run_gemm(lds, HB, 1024, (const bf16_t*)(ws + OFF_WNQ), 3072, 1024, 0, pg8::EpiStoreHN64{QKV, 3072, p.in[I_NGQN], p.in[I_NGKN], (LAS float*)(lds + 133120 + 64)});
            PH_END
            PH_BEGIN
            attn_phase<64, 64, 1>(lds, AttnArgs{QKV, QKV + 1024, QKV + 2048, HB, 3072, 64, 3072, 64, 3072, 64, 16, 0, 1, p.in[I_NRPB], 0.125f * LOG2E});
            PH_END
            PH_BEGIN
            run_gemm(lds, HB, 1024, (const bf16_t*)(ws + OFF_WNO), 1024, 1024, 0, pg8::EpiRes{LAT, XC, ada, 2, LAT, XC});
            PH_END
        } else {
            bf16_t* QKV = (bf16_t*)(ws + OFF_BIG);
            PH_BEGIN
            run_gemm(lds, HB, 1024, (const bf16_t*)(ws + OFF_WGQ), 1536, 1024, 0, pg8::EpiStoreHN128{QKV, 1536, p.in[I_GGQN], p.in[I_GGKN], (LAS float*)(lds + 133120 + 64)});
            PH_END
            PH_BEGIN
            gqa_attn_phase((char*)shm, QKV, HB);
            PH_END
            PH_BEGIN
            run_gemm(lds, HB, 1024, (const bf16_t*)(ws + OFF_WGO), 1024, 1024, 1, pg8::EpiRes{LAT, XC, ada, 2, LAT, XC});
            PH_END
        }
        bf16_t* ACT = (bf16_t*)(ws + OFF_BIG);
        PH_BEGIN
        norm_phase(LAT, XC, LAT, XC, false, p.in[I_NFFN] + layer * 1024, ada, 3, HB, last);
        PH_END
        PH_BEGIN
        run_gemm(lds, HB, 1024, (const bf16_t*)(ws + OFF_WFI + layer * SZ_WFI), 5632, 1024, last, pg8::EpiSwiglu{ACT, FH});
        PH_END
        PH_BEGIN
        run_gemm(lds, ACT, 2816, (const bf16_t*)(ws + OFF_WFO + layer * SZ_WFO), 1024, 2816, last, pg8::EpiRes{LAT, XC, ada, 5, LAT, XC});
        PH_END
    }
}

extern "C" void kernel_launch(void* const* d_in, const int* in_sizes, int n_in, void* d_out, int out_size, void* d_ws, size_t ws_size, hipStream_t stream) {
    static int grid_blocks = 0;
    if (!grid_blocks) {
        hipFuncSetAttribute((const void*)mega, hipFuncAttributeMaxDynamicSharedMemorySize, LDS_BYTES);
        int dev = 0, cus = 0, per_cu = 0;
        hipGetDevice(&dev);
        hipDeviceGetAttribute(&cus, hipDeviceAttributeMultiprocessorCount, dev);
        hipOccupancyMaxActiveBlocksPerMultiprocessor(&per_cu, mega, 512, LDS_BYTES);
        if (per_cu < 1) per_cu = 1;
        grid_blocks = cus * 1;
    }
    if (ws_size < WS_NEED) fprintf(stderr, "workspace too small: %zu < %zu\n", ws_size, (size_t)WS_NEED);
    Params p; memset(&p, 0, sizeof(p));
    for (int i = 0; i < N_IN; ++i) p.in[i] = (const float*)d_in[i];
    p.out = (float*)d_out; p.ws = (unsigned char*)d_ws; p.ph_lo = 0; p.ph_hi = 1000;
    hipMemsetAsync((unsigned char*)d_ws + OFF_BAR, 0, 16384, stream);
    void* args[] = {&p};
    hipError_t e = hipLaunchCooperativeKernel((const void*)mega, dim3(grid_blocks), dim3(512), args, LDS_BYTES, stream);
    if (e != hipSuccess) fprintf(stderr, "cooperative launch failed: %s (grid %d)\n", hipGetErrorString(e), grid_blocks);
}
```

```cpp
#include <hip/hip_runtime.h>
#include <hip/hip_cooperative_groups.h>
#include <cstdio>
#include <cstring>
namespace cg = cooperative_groups;

#define DI __device__ __forceinline__
#define LAS __attribute__((address_space(3)))
typedef unsigned short bf16_t;
typedef short bf16x8 __attribute__((ext_vector_type(8)));
typedef short s16x4 __attribute__((ext_vector_type(4)));
typedef float f32x4 __attribute__((ext_vector_type(4)));
typedef float f32x16 __attribute__((ext_vector_type(16)));
typedef unsigned u32x4 __attribute__((ext_vector_type(4)));
typedef unsigned u32x2 __attribute__((ext_vector_type(2)));
typedef __bf16 bf2_t __attribute__((ext_vector_type(2)));
typedef float f2_t __attribute__((ext_vector_type(2)));

constexpr int NB = 32, SEQ = 2048, CTXL = 256, TT = 2304, NR = NB * TT, DM = 1024, FH = 2816;
constexpr float EPS = 1e-6f, LOG2E = 1.4426950408889634f, L2_10000 = 13.287712379549449f;
constexpr int LDS_BYTES = 133120 + 64 + 8192;

enum { I_X, I_C, I_CTX, I_CCTX, I_ADAW, I_ADAB, I_NMIX, I_NFFN, I_FWIN, I_FWOUT,
       I_MWIN, I_MGQ, I_MGKV, I_MWUQ, I_MWUKV, I_MGQN, I_MGKN, I_MWO,
       I_SARE, I_SAIM, I_SLDT, I_SBRE, I_SBIM, I_SCRE, I_SCIM, I_SD, I_SWGLU,
       I_NWQKV, I_NGQN, I_NGKN, I_NRPB, I_NWO, I_GWQKV, I_GGQN, I_GGKN, I_GWO, N_IN };

constexpr size_t SZ_WFI = (size_t)5632 * 1024 * 2, SZ_WFO = (size_t)1024 * 2816 * 2;
constexpr size_t OFF_WFI = 0;
constexpr size_t OFF_WFO = OFF_WFI + 4 * SZ_WFI;
constexpr size_t OFF_WMI = OFF_WFO + 4 * SZ_WFO;
constexpr size_t OFF_WUQ = OFF_WMI + (size_t)768 * 1024 * 2;
constexpr size_t OFF_WUKV = OFF_WUQ + (size_t)2048 * 384 * 2;
constexpr size_t OFF_WMO = OFF_WUKV + (size_t)2048 * 256 * 2;
constexpr size_t OFF_WGLU = OFF_WMO + (size_t)1024 * 1024 * 2;
constexpr size_t OFF_WNQ = OFF_WGLU + (size_t)2048 * 1024 * 2;
constexpr size_t OFF_WNO = OFF_WNQ + (size_t)3072 * 1024 * 2;
constexpr size_t OFF_WGQ = OFF_WNO + (size_t)1024 * 1024 * 2;
constexpr size_t OFF_WGO = OFF_WGQ + (size_t)1536 * 1024 * 2;
constexpr size_t OFF_ADA = OFF_WGO + (size_t)1024 * 1024 * 2;
constexpr size_t OFF_XC = OFF_ADA + (size_t)4 * 33 * 6144 * 4;
constexpr size_t OFF_HB = OFF_XC + (size_t)NB * CTXL * 1024 * 4;
constexpr size_t OFF_BIG = OFF_HB + (size_t)NR * 1024 * 2;
constexpr size_t OFF_KV = OFF_BIG;
constexpr size_t OFF_QB = OFF_KV + (size_t)NR * 2560 * 2;
constexpr size_t OFF_Z = OFF_QB + (size_t)NR * 1536 * 2;
constexpr size_t OFF_BAR = OFF_Z + (size_t)NR * 768 * 2;
constexpr size_t OFF_SSQ = OFF_BAR + 16384;
constexpr size_t WS_NEED = OFF_SSQ + (size_t)NR * 16;

struct Params {
    const float* in[N_IN];
    float* out;
    unsigned char* ws;
    int ph_lo, ph_hi;
};

DI unsigned pk_bf16(float a, float b) { f2_t v = {a, b}; bf2_t r = __builtin_convertvector(v, bf2_t); return __builtin_bit_cast(unsigned, r); }
DI float bf_lo(unsigned u) { return __uint_as_float(u << 16); }
DI float bf_hi(unsigned u) { return __uint_as_float(u & 0xffff0000u); }
DI float wsum(float v) {
#pragma unroll
    for (int o = 32; o > 0; o >>= 1) v += __shfl_xor(v, o);
    return v;
}
DI int otid() { int t = threadIdx.x; asm volatile("" : "+v"(t)); return t; }
DI int obid() { int b = blockIdx.x; asm volatile("" : "+s"(b)); return b; }
DI int mla_dim_of_pos(int pos) { if (pos < 64) return pos; const int p = pos - 64, a = p >> 4, w = p & 15; return 64 + 16 * a + (w >> 1) + 8 * (w & 1); }
DI int gqa_dim_of_pos(int pos) { return (pos >> 6) * 64 + ((pos & 63) >> 1) + 32 * (pos & 1); }
DI float pairmax32(float x) { auto rr = __builtin_amdgcn_permlane32_swap(__float_as_uint(x), __float_as_uint(x), false, false); return fmaxf(__uint_as_float(rr[0]), __uint_as_float(rr[1])); }
DI int clampi(int v, int lo, int hi) { return v < lo ? lo : (v > hi ? hi : v); }
DI float fexp2(float x) { return __builtin_amdgcn_exp2f(x); }
DI float frcp(float x) { return __builtin_amdgcn_rcpf(x); }
DI float silu_f(float a) { return a * frcp(1.f + __expf(-a)); }
DI float sigmoid_f(float a) { return frcp(1.f + __expf(-a)); }
DI float gelu_tanh(float y) {
    const float z = 0.7978845608028654f * (y + 0.044715f * y * y * y);
    const float t = 1.f - 2.f * frcp(__expf(2.f * z) + 1.f);
    return 0.5f * y * (1.f + t);
}
DI void unpack8(const u32x4 u, float* f) {
#pragma unroll
    for (int i = 0; i < 4; ++i) { f[2 * i] = bf_lo(u[i]); f[2 * i + 1] = bf_hi(u[i]); }
}
DI u32x4 pack8(const float* f) { return (u32x4){pk_bf16(f[0], f[1]), pk_bf16(f[2], f[3]), pk_bf16(f[4], f[5]), pk_bf16(f[6], f[7])}; }

namespace pg8 {
constexpr int BM = 256, BK = 64, HALF = 128, HTB = HALF * BK * 2, NXCD = 8, WGM = 8;
DI int lds_byte(int r, int c) { const int st = (r >> 4) * 2 + (c >> 5), rr = r & 15, cc = c & 31, ob = rr * 64 + cc * 2; return st * 1024 + (ob ^ (((ob >> 9) & 1) << 5)); }
DI void stage_rc(int b, int& R, int& C) { const int st = b / 1024, sb = b % 1024, swz = sb ^ (((sb >> 9) & 1) << 5); R = (st >> 1) * 16 + swz / 64; C = (st & 1) * 32 + (swz % 64) / 2; }
DI int perm32(int rho) { const int n = rho >> 4, i = rho & 15; return 8 * (i >> 2) + 4 * n + (i & 3); }
struct Unit { int pm, pn; };
struct Gemm { const bf16_t* A; const bf16_t* Bt; int M, N, K, lda; };
struct Order {
    int nM, nN, nwg, G, c, skip;
    DI void init(int N, int G_, int c_, int skipctx) { skip = skipctx; nM = skipctx ? 256 : 288; nN = N / BM; nwg = nM * nN; G = G_; c = c_; }
    DI bool next(int i, Unit& u) const {
        const long L = (long)i * G + c; if (L >= nwg) return false;
        int wgid = (int)L; { const int q = nwg / NXCD, r = nwg % NXCD, xcd = wgid % NXCD, off = wgid / NXCD; wgid = (xcd < r ? xcd * (q + 1) : r * (q + 1) + (xcd - r) * q) + off; }
        const int nig = WGM * nN, gid = wgid / nig, fm = gid * WGM, gsz = (nM - fm) < WGM ? (nM - fm) : WGM;
        int pm = fm + ((wgid % nig) % gsz); u.pn = (wgid % nig) / gsz;
        if (skip) pm = pm + (pm >> 3) + 1;
        u.pm = pm; return true;
    }
};

DI float* tile_res_base(float* lat, float* xc, int pm) { const int bb = pm / 9, sub = pm - bb * 9; return sub == 0 ? xc + ((size_t)bb * CTXL << 10) : lat + ((size_t)(bb * SEQ + (sub - 1) * 256) << 10); }
DI int tile_ada_row(int pm) { const int bb = pm / 9, sub = pm - bb * 9; return sub == 0 ? 32 : bb; }

struct EpiStore {
    static constexpr bool PERM = true;
    bf16_t* O; int ldc; int remap;
    DI void operator()(const f32x4 (&acc)[2][2][4][2], const Unit& u, int wr, int wc, int fr, int fq) const {
        const int row0 = u.pm * BM + wr * 64 + fr, col0 = u.pn * BM + wc * 32 + 8 * fq;
#pragma unroll
        for (int ai = 0; ai < 2; ++ai)
#pragma unroll
            for (int m = 0; m < 4; ++m) {
                bf16_t* rowp = O + (size_t)(row0 + ai * HALF + m * 16) * ldc;
#pragma unroll
                for (int bj = 0; bj < 2; ++bj) {
                    const int c = col0 + bj * HALF; const int cc = remap ? (c >> 7) * 160 + (c & 127) : c;
                    const f32x4 v0 = acc[ai][bj][m][0], v1 = acc[ai][bj][m][1];
                    *(u32x4*)(rowp + cc) = (u32x4){pk_bf16(v0[0], v0[1]), pk_bf16(v0[2], v0[3]), pk_bf16(v1[0], v1[1]), pk_bf16(v1[2], v1[3])};
                }
            }
    }
};
struct EpiStoreHN64 {
    static constexpr bool PERM = true;
    bf16_t* O; int ldc; const float* gq; const float* gk; LAS float* X;
    DI void operator()(const f32x4 (&acc)[2][2][4][2], const Unit& u, int wr_, int wc_, int fr_, int fq_) const {
        int wr = wr_, wc = wc_, fr = fr_, fq = fq_; asm volatile("" : "+s"(wr), "+s"(wc), "+v"(fr), "+v"(fq));
        const int wid = wr * 4 + wc;
        const int kind = u.pn < 4 ? 0 : (u.pn < 8 ? 1 : 2);
        float part[2][2][4];
#pragma unroll
        for (int ai = 0; ai < 2; ++ai)
#pragma unroll
            for (int bj = 0; bj < 2; ++bj)
#pragma unroll
                for (int m = 0; m < 4; ++m) {
                    float ss = 0.f;
#pragma unroll
                    for (int n = 0; n < 2; ++n)
#pragma unroll
                        for (int i = 0; i < 4; ++i) ss += acc[ai][bj][m][n][i] * acc[ai][bj][m][n][i];
                    ss += __shfl_xor(ss, 16); ss += __shfl_xor(ss, 32);
                    part[ai][bj][m] = ss;
                    if (fq == 0) X[(wid * 16 + ai * 8 + bj * 4 + m) * 16 + fr] = ss;
                }
        asm volatile("s_waitcnt lgkmcnt(0)" ::: "memory");
        __builtin_amdgcn_s_barrier();
        asm volatile("" ::: "memory");
        const float* g = kind == 0 ? gq : gk;
        const int gc0 = 32 * (wc & 1) + 8 * fq;
        float gv[8];
#pragma unroll
        for (int i = 0; i < 8; ++i) gv[i] = g[gc0 + i];
        const int row0 = u.pm * BM + wr * 64 + fr, col0 = u.pn * BM + wc * 32 + 8 * fq;
#pragma unroll
        for (int ai = 0; ai < 2; ++ai)
#pragma unroll
            for (int m = 0; m < 4; ++m) {
                bf16_t* rowp = O + (size_t)(row0 + ai * HALF + m * 16) * ldc;
#pragma unroll
                for (int bj = 0; bj < 2; ++bj) {
                    const float tot = part[ai][bj][m] + X[((wid ^ 1) * 16 + ai * 8 + bj * 4 + m) * 16 + fr];
                    const float r = rsqrtf(tot * (1.f / 64.f) + EPS);
                    float v[8];
#pragma unroll
                    for (int n = 0; n < 2; ++n)
#pragma unroll
                        for (int i = 0; i < 4; ++i) v[n * 4 + i] = kind == 2 ? acc[ai][bj][m][n][i] : acc[ai][bj][m][n][i] * r * gv[n * 4 + i];
                    *(u32x4*)(rowp + col0 + bj * HALF) = pack8(v);
                }
            }
    }
};
struct EpiStoreHN128 {
    static constexpr bool PERM = true;
    bf16_t* O; int ldc; const float* gq; const float* gk; LAS float* X;
    DI void operator()(const f32x4 (&acc)[2][2][4][2], const Unit& u, int wr_, int wc_, int fr_, int fq_) const {
        int wr = wr_, wc = wc_, fr = fr_, fq = fq_; asm volatile("" : "+s"(wr), "+s"(wc), "+v"(fr), "+v"(fq));
        const int wid = wr * 4 + wc;
        const int kind = u.pn < 4 ? 0 : (u.pn < 5 ? 1 : 2);
        float part[2][2][4];
#pragma unroll
        for (int ai = 0; ai < 2; ++ai)
#pragma unroll
            for (int bj = 0; bj < 2; ++bj)
#pragma unroll
                for (int m = 0; m < 4; ++m) {
                    float ss = 0.f;
#pragma unroll
                    for (int n = 0; n < 2; ++n)
#pragma unroll
                        for (int i = 0; i < 4; ++i) ss += acc[ai][bj][m][n][i] * acc[ai][bj][m][n][i];
                    ss += __shfl_xor(ss, 16); ss += __shfl_xor(ss, 32);
                    part[ai][bj][m] = ss;
                    if (fq == 0) X[(wid * 16 + ai * 8 + bj * 4 + m) * 16 + fr] = ss;
                }
        asm volatile("s_waitcnt lgkmcnt(0)" ::: "memory");
        __builtin_amdgcn_s_barrier();
        asm volatile("" ::: "memory");
        const float* g = kind == 0 ? gq : gk;
        const int pos0 = 32 * wc + 8 * fq;
        float gv[8];
#pragma unroll
        for (int i = 0; i < 8; ++i) gv[i] = g[gqa_dim_of_pos(pos0 + i)];
        const int axis = wc >> 1, f0 = 16 * (wc & 1) + 4 * fq;
        float invf[4];
#pragma unroll
        for (int j = 0; j < 4; ++j) invf[j] = fexp2(-(float)(f0 + j) * (L2_10000 / 32.f));
        const int bb = u.pm / 9, sub = u.pm - bb * 9;
        const bool latent = sub != 0;
        const int row0 = u.pm * BM + wr * 64 + fr, col0 = u.pn * BM + wc * 32 + 8 * fq;
        const int wb = wr * 4;
#pragma unroll
        for (int ai = 0; ai < 2; ++ai)
#pragma unroll
            for (int m = 0; m < 4; ++m) {
                bf16_t* rowp = O + (size_t)(row0 + ai * HALF + m * 16) * ldc;
                const int sidx = (sub - 1) * 256 + ai * HALF + wr * 64 + m * 16 + fr;
                const float posv = (float)(axis ? (sidx & 63) : (sidx >> 6));
                float cs[4], sn[4];
#pragma unroll
                for (int j = 0; j < 4; ++j) { const float ang = posv * invf[j]; cs[j] = __cosf(ang); sn[j] = __sinf(ang); }
#pragma unroll
                for (int bj = 0; bj < 2; ++bj) {
                    const int cb = ai * 8 + bj * 4 + m;
                    const float tot = X[((wb + 0) * 16 + cb) * 16 + fr] + X[((wb + 1) * 16 + cb) * 16 + fr] + X[((wb + 2) * 16 + cb) * 16 + fr] + X[((wb + 3) * 16 + cb) * 16 + fr];
                    const float r = rsqrtf(tot * (1.f / 128.f) + EPS);
                    float v[8];
#pragma unroll
                    for (int n = 0; n < 2; ++n)
#pragma unroll
                        for (int i = 0; i < 4; ++i) v[n * 4 + i] = kind == 2 ? acc[ai][bj][m][n][i] : acc[ai][bj][m][n][i] * r * gv[n * 4 + i];
                    if (kind != 2 && latent) {
#pragma unroll
                        for (int j = 0; j < 4; ++j) { const float x1 = v[2 * j], x2 = v[2 * j + 1]; v[2 * j] = x1 * cs[j] - x2 * sn[j]; v[2 * j + 1] = x1 * sn[j] + x2 * cs[j]; }
                    }
                    *(u32x4*)(rowp + col0 + bj * HALF) = pack8(v);
                }
            }
    }
};
struct EpiMlaZ {
    static constexpr bool PERM = true;
    bf16_t* O; float* SSQ;
    DI void operator()(const f32x4 (&acc)[2][2][4][2], const Unit& u, int wr_, int wc_, int fr_, int fq_) const {
        int wr = wr_, wc = wc_, fr = fr_, fq = fq_; asm volatile("" : "+s"(wr), "+s"(wc), "+v"(fr), "+v"(fq));
        const int row0 = u.pm * BM + wr * 64 + fr, col0 = u.pn * BM + wc * 32 + 8 * fq;
#pragma unroll
        for (int ai = 0; ai < 2; ++ai)
#pragma unroll
            for (int m = 0; m < 4; ++m) {
                const int row = row0 + ai * HALF + m * 16;
                bf16_t* rowp = O + (size_t)row * 768;
#pragma unroll
                for (int bj = 0; bj < 2; ++bj) {
                    const f32x4 v0 = acc[ai][bj][m][0], v1 = acc[ai][bj][m][1];
                    *(u32x4*)(rowp + col0 + bj * HALF) = (u32x4){pk_bf16(v0[0], v0[1]), pk_bf16(v0[2], v0[3]), pk_bf16(v1[0], v1[1]), pk_bf16(v1[2], v1[3])};
                    float ss = 0.f;
#pragma unroll
                    for (int i = 0; i < 4; ++i) ss += v0[i] * v0[i] + v1[i] * v1[i];
                    ss += __shfl_xor(ss, 16); ss += __shfl_xor(ss, 32);
                    const int cbase = u.pn * BM + bj * HALF + wc * 32;
                    const int cat = cbase < 384 ? 0 : (cbase < 640 ? 1 : (cbase < 672 ? 2 : 3));
                    if (fq == 0 && cat < 3) atomicAdd(SSQ + (size_t)row * 4 + cat, ss);
                }
            }
    }
};
struct EpiMlaQ {
    static constexpr bool PERM = true;
    bf16_t* O; const float* SSQ; const float* gqn; LAS float* X;
    DI void operator()(const f32x4 (&acc)[2][2][4][2], const Unit& u, int wr_, int wc_, int fr_, int fq_) const {
        int wr = wr_, wc = wc_, fr = fr_, fq = fq_; asm volatile("" : "+s"(wr), "+s"(wc), "+v"(fr), "+v"(fq));
        const int wid = wr * 4 + wc, wb = wr * 4;
#pragma unroll
        for (int ai = 0; ai < 2; ++ai)
#pragma unroll
            for (int bj = 0; bj < 2; ++bj)
#pragma unroll
                for (int m = 0; m < 4; ++m) {
                    float ss = 0.f;
#pragma unroll
                    for (int n = 0; n < 2; ++n)
#pragma unroll
                        for (int i = 0; i < 4; ++i) ss += acc[ai][bj][m][n][i] * acc[ai][bj][m][n][i];
                    ss += __shfl_xor(ss, 16); ss += __shfl_xor(ss, 32);
                    if (fq == 0) X[(wid * 16 + ai * 8 + bj * 4 + m) * 16 + fr] = ss;
                }
        asm volatile("s_waitcnt lgkmcnt(0)" ::: "memory");
        __builtin_amdgcn_s_barrier();
        asm volatile("" ::: "memory");
        const int pos0 = 32 * wc + 8 * fq;
        const int axis = fq >> 1;
        const int bb = u.pm / 9, sub = u.pm - bb * 9;
        const bool latent = sub != 0;
        const int row0 = u.pm * BM + wr * 64 + fr;
#pragma unroll
        for (int ai = 0; ai < 2; ++ai)
#pragma unroll
            for (int m = 0; m < 4; ++m) {
                int pz = pos0; asm volatile("" : "+v"(pz));
                float gv[8];
#pragma unroll
                for (int i = 0; i < 8; ++i) gv[i] = pz < 96 ? gqn[mla_dim_of_pos(pz + i)] : 0.f;
                float invf[4];
#pragma unroll
                for (int j = 0; j < 4; ++j) invf[j] = fexp2(-(float)(((pz >> 3) & 1) * 4 + j) * (L2_10000 / 8.f));
                const int row = row0 + ai * HALF + m * 16;
                const float rq0 = rsqrtf(SSQ[(size_t)row * 4 + 0] * (1.f / 384.f) + EPS);
                const int sidx = (sub - 1) * 256 + ai * HALF + wr * 64 + m * 16 + fr;
                const float posv = (float)(axis ? (sidx & 63) : (sidx >> 6));
                float cs[4], sn[4];
#pragma unroll
                for (int j = 0; j < 4; ++j) { cs[j] = 1.f; sn[j] = 0.f; }
                if (wc == 2 && latent) {
#pragma unroll
                    for (int j = 0; j < 4; ++j) { const float ang = posv * invf[j]; cs[j] = __cosf(ang); sn[j] = __sinf(ang); }
                }
#pragma unroll
                for (int bj = 0; bj < 2; ++bj) {
                    const int cb = ai * 8 + bj * 4 + m;
                    const float tot = X[((wb + 0) * 16 + cb) * 16 + fr] + X[((wb + 1) * 16 + cb) * 16 + fr] + X[((wb + 2) * 16 + cb) * 16 + fr];
                    const float r = rq0 * rsqrtf(rq0 * rq0 * tot * (1.f / 96.f) + EPS);
                    float v[8];
#pragma unroll
                    for (int n = 0; n < 2; ++n)
#pragma unroll
                        for (int i = 0; i < 4; ++i) v[n * 4 + i] = acc[ai][bj][m][n][i] * r * gv[n * 4 + i];
                    if (wc == 2 && latent) {
#pragma unroll
                        for (int j = 0; j < 4; ++j) { const float x1 = v[2 * j], x2 = v[2 * j + 1]; v[2 * j] = x1 * cs[j] - x2 * sn[j]; v[2 * j + 1] = x1 * sn[j] + x2 * cs[j]; }
                    }
                    if (wc < 3) *(u32x4*)(O + (size_t)row * 1536 + (u.pn * 2 + bj) * 96 + pos0) = pack8(v);
                }
                __builtin_amdgcn_sched_barrier(0);
            }
    }
};
struct EpiMlaKV {
    static constexpr bool PERM = true;
    bf16_t* O; const float* SSQ; const bf16_t* Z; const float* gkn; LAS float* X;
    DI void operator()(const f32x4 (&acc)[2][2][4][2], const Unit& u, int wr_, int wc_, int fr_, int fq_) const {
        int wr = wr_, wc = wc_, fr = fr_, fq = fq_; asm volatile("" : "+s"(wr), "+s"(wc), "+v"(fr), "+v"(fq));
        const int wid = wr * 4 + wc, wb = wr * 4;
#pragma unroll
        for (int ai = 0; ai < 2; ++ai)
#pragma unroll
            for (int bj = 0; bj < 2; ++bj)
#pragma unroll
                for (int m = 0; m < 4; ++m) {
                    float ss = 0.f;
#pragma unroll
                    for (int n = 0; n < 2; ++n)
#pragma unroll
                        for (int i = 0; i < 4; ++i) ss += acc[ai][bj][m][n][i] * acc[ai][bj][m][n][i];
                    ss += __shfl_xor(ss, 16); ss += __shfl_xor(ss, 32);
                    if (fq == 0) X[(wid * 16 + ai * 8 + bj * 4 + m) * 16 + fr] = ss;
                }
        asm volatile("s_waitcnt lgkmcnt(0)" ::: "memory");
        __builtin_amdgcn_s_barrier();
        asm volatile("" ::: "memory");
        const int pos0 = 32 * (wc & 1) + 8 * fq;
        const int axis = fq >> 1;
        const int bb = u.pm / 9, sub = u.pm - bb * 9;
        const bool latent = sub != 0;
        const int row0 = u.pm * BM + wr * 64 + fr;
#pragma unroll
        for (int ai = 0; ai < 2; ++ai)
#pragma unroll
            for (int m = 0; m < 4; ++m) {
                int pz = pos0; asm volatile("" : "+v"(pz));
                const int i0 = ((pz >> 3) & 1) * 4;
                float gv[8];
#pragma unroll
                for (int i = 0; i < 8; ++i) gv[i] = gkn[pz + i];
                float invf[4], g1[4], g2[4];
#pragma unroll
                for (int j = 0; j < 4; ++j) { invf[j] = fexp2(-(float)(i0 + j) * (L2_10000 / 8.f)); g1[j] = gkn[64 + 16 * axis + i0 + j]; g2[j] = gkn[64 + 16 * axis + i0 + j + 8]; }
                const int row = row0 + ai * HALF + m * 16;
                const float rkv0 = rsqrtf(SSQ[(size_t)row * 4 + 1] * (1.f / 256.f) + EPS);
                const float ssr = SSQ[(size_t)row * 4 + 2];
                float x1[4], x2[4], cs[4], sn[4];
                if (wc == 2) {
                    const bf16_t* zr = Z + (size_t)row * 768 + 640 + 16 * axis + i0;
                    const u32x2 a1 = *(const u32x2*)zr, a2 = *(const u32x2*)(zr + 8);
                    x1[0] = bf_lo(a1[0]); x1[1] = bf_hi(a1[0]); x1[2] = bf_lo(a1[1]); x1[3] = bf_hi(a1[1]);
                    x2[0] = bf_lo(a2[0]); x2[1] = bf_hi(a2[0]); x2[2] = bf_lo(a2[1]); x2[3] = bf_hi(a2[1]);
                    const int sidx = (sub - 1) * 256 + ai * HALF + wr * 64 + m * 16 + fr;
                    const float posv = (float)(axis ? (sidx & 63) : (sidx >> 6));
#pragma unroll
                    for (int j = 0; j < 4; ++j) { const float ang = posv * invf[j]; cs[j] = latent ? __cosf(ang) : 1.f; sn[j] = latent ? __sinf(ang) : 0.f; }
                }
#pragma unroll
                for (int bj = 0; bj < 2; ++bj) {
                    const int cb = ai * 8 + bj * 4 + m;
                    const float ssn = X[((wb + 0) * 16 + cb) * 16 + fr] + X[((wb + 1) * 16 + cb) * 16 + fr];
                    const float rk = rsqrtf((rkv0 * rkv0 * ssn + ssr) * (1.f / 96.f) + EPS);
                    bf16_t* hp = O + (size_t)row * 2560 + (u.pn * 2 + bj) * 160;
                    float v[8];
                    if (wc < 2) {
#pragma unroll
                        for (int n = 0; n < 2; ++n)
#pragma unroll
                            for (int i = 0; i < 4; ++i) v[n * 4 + i] = acc[ai][bj][m][n][i] * (rkv0 * rk) * gv[n * 4 + i];
                        *(u32x4*)(hp + pos0) = pack8(v);
                    } else {
#pragma unroll
                        for (int n = 0; n < 2; ++n)
#pragma unroll
                            for (int i = 0; i < 4; ++i) v[n * 4 + i] = acc[ai][bj][m][n][i] * rkv0;
                        *(u32x4*)(hp + 96 + pos0) = pack8(v);
                        if (wc == 2) {
                            float w[8];
#pragma unroll
                            for (int j = 0; j < 4; ++j) {
                                const float y1 = x1[j] * rk * g1[j], y2 = x2[j] * rk * g2[j];
                                w[2 * j] = y1 * cs[j] - y2 * sn[j]; w[2 * j + 1] = y1 * sn[j] + y2 * cs[j];
                            }
                            *(u32x4*)(hp + 64 + 8 * fq) = pack8(w);
                        }
                    }
                }
                __builtin_amdgcn_sched_barrier(0);
            }
    }
};
struct EpiSwiglu {
    static constexpr bool PERM = true;
    bf16_t* O; int ldc;
    DI void operator()(const f32x4 (&acc)[2][2][4][2], const Unit& u, int wr, int wc, int fr, int fq) const {
        const int row0 = u.pm * BM + wr * 64 + fr, col0 = u.pn * HALF + wc * 32 + 8 * fq;
#pragma unroll
        for (int ai = 0; ai < 2; ++ai)
#pragma unroll
            for (int m = 0; m < 4; ++m) {
                float v[8];
#pragma unroll
                for (int n = 0; n < 2; ++n)
#pragma unroll
                    for (int i = 0; i < 4; ++i) v[n * 4 + i] = silu_f(acc[ai][0][m][n][i]) * acc[ai][1][m][n][i];
                *(u32x4*)(O + (size_t)(row0 + ai * HALF + m * 16) * ldc + col0) = pack8(v);
            }
    }
};
struct EpiGluRes {
    static constexpr bool PERM = true;
    float* lat; float* xc; const float* ada; int gidx;
    DI void operator()(const f32x4 (&acc)[2][2][4][2], const Unit& u, int wr, int wc, int fr, int fq) const {
        float* base = tile_res_base(lat, xc, u.pm);
        const float* gate = ada + (size_t)tile_ada_row(u.pm) * 6144 + gidx * 1024;
        const int col0 = u.pn * HALF + wc * 32 + 8 * fq;
        const f32x4 g0 = *(const f32x4*)(gate + col0), g1 = *(const f32x4*)(gate + col0 + 4);
#pragma unroll
        for (int ai = 0; ai < 2; ++ai)
#pragma unroll
            for (int m = 0; m < 4; ++m) {
                float* rp = base + ((size_t)(ai * HALF + wr * 64 + m * 16 + fr) << 10) + col0;
                f32x4 x0 = *(f32x4*)rp, x1 = *(f32x4*)(rp + 4);
#pragma unroll
                for (int i = 0; i < 4; ++i) {
                    x0[i] += g0[i] * (acc[ai][0][m][0][i] * sigmoid_f(acc[ai][1][m][0][i]));
                    x1[i] += g1[i] * (acc[ai][0][m][1][i] * sigmoid_f(acc[ai][1][m][1][i]));
                }
                *(f32x4*)rp = x0; *(f32x4*)(rp + 4) = x1;
            }
    }
};
struct EpiRes {
    static constexpr bool PERM = true;
    float* lat; float* xc; const float* ada; int gidx; const float* lat_in; const float* xc_in;
    DI void operator()(const f32x4 (&acc)[2][2][4][2], const Unit& u, int wr, int wc, int fr, int fq) const {
        float* base = tile_res_base(lat, xc, u.pm);
        const float* base_in = tile_res_base((float*)lat_in, (float*)xc_in, u.pm);
        const float* gate = ada + (size_t)tile_ada_row(u.pm) * 6144 + gidx * 1024;
        const int col0 = u.pn * BM + wc * 32 + 8 * fq;
        f32x4 gv[2][2];
#pragma unroll
        for (int bj = 0; bj < 2; ++bj)
#pragma unroll
            for (int n = 0; n < 2; ++n) gv[bj][n] = *(const f32x4*)(gate + col0 + bj * HALF + n * 4);
#pragma unroll
        for (int ai = 0; ai < 2; ++ai)
#pragma unroll
            for (int m = 0; m < 4; ++m) {
                float* rp = base + ((size_t)(ai * HALF + wr * 64 + m * 16 + fr) << 10) + col0;
                const float* rpi = base_in + ((size_t)(ai * HALF + wr * 64 + m * 16 + fr) << 10) + col0;
#pragma unroll
                for (int bj = 0; bj < 2; ++bj)
#pragma unroll
                    for (int n = 0; n < 2; ++n) {
                        f32x4 x = *(const f32x4*)(rpi + bj * HALF + n * 4);
                        x += gv[bj][n] * acc[ai][bj][m][n];
                        *(f32x4*)(rp + bj * HALF + n * 4) = x;
                    }
            }
    }
};

template <class Epi>
DI void gemm_phase(LAS unsigned char* lds, const Gemm g, const Order& S, const Epi& E) {
    const int TIDX = otid(); const int BIDX = obid(); (void)TIDX; (void)BIDX;
    const int tid = TIDX, wid = __builtin_amdgcn_readfirstlane(tid >> 6), lane = tid & 63, wr = wid >> 2, wc = wid & 3, fr = lane & 15, fq = lane >> 4;
    const int K = g.K, nt = K / BK;
    unsigned voffA[2], voffB[2];
#pragma unroll
    for (int i = 0; i < 2; ++i) { int R, C; stage_rc(tid * 16 + i * 8192, R, C); const int Rb = Epi::PERM ? ((R & ~31) + perm32(R & 31)) : R;
        voffA[i] = (unsigned)(R * g.lda + C) * 2u; voffB[i] = (unsigned)(Rb * K + C) * 2u; }
    const size_t kstep = (size_t)(BK * 2);
    const size_t hstep = (size_t)HALF * K * 2, hstepA = (size_t)HALF * g.lda * 2;
    const size_t tstep = 2 * hstep, tstepA = 2 * hstepA;
    const unsigned ldsw = (unsigned)wid * 1024u;
    const int aoff = lds_byte(wr * 64 + fr, fq * 8), boff = lds_byte(wc * 32 + fr, fq * 8);
#define PG8_SA(b, h) (((b) * 2 + (h)) * HTB)
#define PG8_SB(b, h) ((4 + (b) * 2 + (h)) * HTB)
#define PG8_STAGE(bufoff, gbase, voff) do { _Pragma("unroll") for (int _i = 0; _i < 2; ++_i) \
        __builtin_amdgcn_global_load_lds((const unsigned*)((const char*)(gbase) + (voff)[_i]), (LAS unsigned*)(lds + (bufoff) + ldsw + _i * 8192), 16, 0, 0); } while (0)
#define PG8_LDA(dst, b, h) do { _Pragma("unroll") for (int m = 0; m < 4; ++m) _Pragma("unroll") for (int k = 0; k < 2; ++k) dst[m][k] = *(const LAS bf16x8*)(lds + PG8_SA(b, h) + aoff + m * 2048 + k * 1024); } while (0)
#define PG8_LDB(dst, b, h) do { _Pragma("unroll") for (int n = 0; n < 2; ++n) _Pragma("unroll") for (int k = 0; k < 2; ++k) dst[n][k] = *(const LAS bf16x8*)(lds + PG8_SB(b, h) + boff + n * 2048 + k * 1024); } while (0)
#define PG8_MMA(ai, bj, At, Bt) do { __builtin_amdgcn_s_setprio(1); _Pragma("unroll") for (int m = 0; m < 4; ++m) _Pragma("unroll") for (int n = 0; n < 2; ++n) _Pragma("unroll") for (int k = 0; k < 2; ++k) \
        acc[ai][bj][m][n] = __builtin_amdgcn_mfma_f32_16x16x32_bf16(Bt[n][k], At[m][k], acc[ai][bj][m][n], 0, 0, 0); __builtin_amdgcn_s_setprio(0); } while (0)
#define PG8_WAIT_V(n) asm volatile("s_waitcnt vmcnt(" #n ")" ::: "memory")
#define PG8_WAIT_L(n) asm volatile("s_waitcnt lgkmcnt(" #n ")" ::: "memory")
#define PG8_BAR __builtin_amdgcn_s_barrier()
#define PG8_SCHED __builtin_amdgcn_sched_barrier(0)
    Unit cur, nxt; int ui = 0;
    if (!S.next(0, cur)) return;
    f32x4 acc[2][2][4][2];
#pragma unroll
    for (int a = 0; a < 2; ++a)
#pragma unroll
        for (int b = 0; b < 2; ++b)
#pragma unroll
            for (int m = 0; m < 4; ++m)
#pragma unroll
                for (int n = 0; n < 2; ++n) acc[a][b][m][n] = (f32x4){0.f, 0.f, 0.f, 0.f};
    bf16x8 At[4][2], B0[2][2], B1[2][2];
    const char* cA = (const char*)g.A + (size_t)cur.pm * tstepA; const char* cB = (const char*)g.Bt + (size_t)cur.pn * tstep;
    PG8_STAGE(PG8_SB(0, 0), cB, voffB); PG8_STAGE(PG8_SA(0, 0), cA, voffA); PG8_STAGE(PG8_SB(0, 1), cB + hstep, voffB); PG8_STAGE(PG8_SA(0, 1), cA + hstepA, voffA);
    if (wr == 1) PG8_BAR;
    PG8_WAIT_V(4); PG8_BAR;
    PG8_STAGE(PG8_SB(1, 0), cB + kstep, voffB); PG8_STAGE(PG8_SA(1, 0), cA + kstep, voffA); PG8_STAGE(PG8_SB(1, 1), cB + hstep + kstep, voffB);
    PG8_WAIT_V(6); PG8_BAR;
    for (;;) {
        const bool has_next = S.next(ui + 1, nxt);
        const char* nA = has_next ? (const char*)g.A + (size_t)nxt.pm * tstepA : cA; const char* nB = has_next ? (const char*)g.Bt + (size_t)nxt.pn * tstep : cB;
        for (int t = 0; t < nt; t += 2) {
            const bool last = (t == nt - 2);
            const char* a1 = cA + (size_t)(t + 1) * kstep;
            const char* a2 = last ? nA : cA + (size_t)(t + 2) * kstep; const char* b2 = last ? nB : cB + (size_t)(t + 2) * kstep;
            const char* a3 = a2 + kstep; const char* b3 = b2 + kstep;
            PG8_LDB(B0, 0, 0); PG8_SCHED; PG8_LDA(At, 0, 0); PG8_STAGE(PG8_SA(1, 1), a1 + hstepA, voffA);
            PG8_WAIT_L(8); PG8_BAR; PG8_WAIT_L(0); PG8_MMA(0, 0, At, B0); PG8_BAR; PG8_SCHED;
            PG8_LDB(B1, 0, 1); PG8_STAGE(PG8_SB(0, 0), b2, voffB);
            PG8_BAR; PG8_WAIT_L(0); PG8_MMA(0, 1, At, B1); PG8_BAR;
            PG8_LDA(At, 0, 1); PG8_STAGE(PG8_SA(0, 0), a2, voffA);
            PG8_BAR; PG8_WAIT_L(0); PG8_MMA(1, 0, At, B0); PG8_BAR; PG8_SCHED;
            PG8_STAGE(PG8_SB(0, 1), b2 + hstep, voffB);
            PG8_WAIT_V(6); PG8_BAR; PG8_MMA(1, 1, At, B1); PG8_BAR;
            PG8_LDB(B0, 1, 0); PG8_SCHED; PG8_LDA(At, 1, 0); PG8_STAGE(PG8_SA(0, 1), a2 + hstepA, voffA);
            PG8_WAIT_L(8); PG8_BAR; PG8_WAIT_L(0); PG8_MMA(0, 0, At, B0); PG8_BAR; PG8_SCHED;
            PG8_LDB(B1, 1, 1); PG8_STAGE(PG8_SB(1, 0), b3, voffB);
            PG8_BAR; PG8_WAIT_L(0); PG8_MMA(0, 1, At, B1); PG8_BAR;
            PG8_LDA(At, 1, 1); PG8_STAGE(PG8_SA(1, 0), a3, voffA);
            PG8_BAR; PG8_WAIT_L(0); PG8_MMA(1, 0, At, B0); PG8_BAR; PG8_SCHED;
            PG8_STAGE(PG8_SB(1, 1), b3 + hstep, voffB);
            PG8_WAIT_V(6); PG8_BAR; PG8_MMA(1, 1, At, B1); PG8_BAR;
        }
        E(acc, cur, wr, wc, fr, fq);
        if (!has_next) break;
#pragma unroll
        for (int a = 0; a < 2; ++a)
#pragma unroll
            for (int b = 0; b < 2; ++b)
#pragma unroll
                for (int m = 0; m < 4; ++m)
#pragma unroll
                    for (int n = 0; n < 2; ++n) acc[a][b][m][n] = (f32x4){0.f, 0.f, 0.f, 0.f};
        cur = nxt; cA = nA; cB = nB; ++ui;
    }
    PG8_WAIT_V(0);
    if (wr == 0) PG8_BAR;
    PG8_BAR;
#undef PG8_SA
#undef PG8_SB
#undef PG8_STAGE
#undef PG8_LDA
#undef PG8_LDB
#undef PG8_MMA
#undef PG8_WAIT_V
#undef PG8_WAIT_L
#undef PG8_BAR
#undef PG8_SCHED
}
}

template <class Epi>
DI void run_gemm(LAS unsigned char* lds, const bf16_t* A, int lda, const bf16_t* Bt, int N, int K, int skipctx, const Epi& E) {
    const int BIDX = obid();
    asm volatile("" : "+s"(K));
    pg8::Order S; S.init(N, (int)gridDim.x, BIDX, skipctx);
    pg8::Gemm g{A, Bt, NR, N, K, lda};
    pg8::gemm_phase<Epi>(lds, g, S, E);
}

struct WDesc { const float* src; bf16_t* dst; int K, N, Nout, half; const float* kscale; int perm; };

DI WDesc wdesc_of(const Params& p, int m) {
    unsigned char* ws = p.ws;
    if (m < 4) return WDesc{p.in[I_FWIN] + (size_t)m * 1024 * 5632, (bf16_t*)(ws + OFF_WFI + m * SZ_WFI), 1024, 5632, 5632, 2816, nullptr, 0};
    if (m < 8) return WDesc{p.in[I_FWOUT] + (size_t)(m - 4) * 2816 * 1024, (bf16_t*)(ws + OFF_WFO + (m - 4) * SZ_WFO), 2816, 1024, 1024, 0, nullptr, 0};
    switch (m) {
        case 8: return WDesc{p.in[I_MWIN], (bf16_t*)(ws + OFF_WMI), 1024, 672, 768, 0, nullptr, 0};
        case 9: return WDesc{p.in[I_MWUQ], (bf16_t*)(ws + OFF_WUQ), 384, 1536, 2048, 0, p.in[I_MGQ], 2};
        case 10: return WDesc{p.in[I_MWUKV], (bf16_t*)(ws + OFF_WUKV), 256, 2048, 2048, 0, p.in[I_MGKV], 0};
        case 11: return WDesc{p.in[I_MWO], (bf16_t*)(ws + OFF_WMO), 1024, 1024, 1024, 0, nullptr, 0};
        case 12: return WDesc{p.in[I_SWGLU], (bf16_t*)(ws + OFF_WGLU), 1024, 2048, 2048, 1024, nullptr, 0};
        case 13: return WDesc{p.in[I_NWQKV], (bf16_t*)(ws + OFF_WNQ), 1024, 3072, 3072, 0, nullptr, 0};
        case 14: return WDesc{p.in[I_NWO], (bf16_t*)(ws + OFF_WNO), 1024, 1024, 1024, 0, nullptr, 0};
        case 15: return WDesc{p.in[I_GWQKV], (bf16_t*)(ws + OFF_WGQ), 1024, 1536, 1536, 0, nullptr, 1};
        default: return WDesc{p.in[I_GWO], (bf16_t*)(ws + OFF_WGO), 1024, 1024, 1024, 0, nullptr, 0};
    }
}
DI void prep_tile(LAS float* tile, const WDesc w, int tidx, int lane) {
    const int ntk = w.K / 64;
    const int kt = tidx % ntk, nt = tidx / ntk;
    const int n0 = nt * 64;
    int scol = n0;
    if (w.half) { const int t256 = n0 >> 8, ww = n0 & 255; scol = (ww >= 128 ? w.half : 0) + t256 * 128 + (ww & 127); }
    const int c4 = (lane & 15) * 4;
    f32x4 v[16];
#pragma unroll
    for (int i = 0; i < 16; ++i) {
        const int r = (lane >> 4) + 4 * i;
        v[i] = (f32x4){0.f, 0.f, 0.f, 0.f};
        if (w.perm == 2) {
            const float* rp = w.src + (size_t)(kt * 64 + r) * w.N + (n0 >> 7) * 96;
#pragma unroll
            for (int j = 0; j < 4; ++j) { const int pos = (n0 & 127) + c4 + j; v[i][j] = pos < 96 ? rp[mla_dim_of_pos(pos)] : 0.f; }
        } else if (w.perm == 1 && n0 < 1280) {
            const float* rp = w.src + (size_t)(kt * 64 + r) * w.N + (n0 & ~127);
#pragma unroll
            for (int j = 0; j < 4; ++j) v[i][j] = rp[gqa_dim_of_pos((n0 & 127) + c4 + j)];
        } else if (scol + c4 < w.N) v[i] = *(const f32x4*)(w.src + (size_t)(kt * 64 + r) * w.N + scol + c4);
    }
#pragma unroll
    for (int i = 0; i < 16; ++i) {
        const int r = (lane >> 4) + 4 * i;
        f32x4 x = v[i];
        if (w.kscale) x *= w.kscale[kt * 64 + r];
#pragma unroll
        for (int j = 0; j < 4; ++j) tile[r * 65 + c4 + j] = x[j];
    }
    bf16_t* d = w.dst + (size_t)(n0 + lane) * w.K + kt * 64;
#pragma unroll
    for (int q = 0; q < 8; ++q) {
        float f[8];
#pragma unroll
        for (int k = 0; k < 8; ++k) f[k] = tile[(q * 8 + k) * 65 + lane];
        *(u32x4*)(d + q * 8) = pack8(f);
    }
}

DI void ada_item(const Params& p, float* ADA, int item, int lane) {
    const int layer = item / 192, n0 = (item - layer * 192) * 32;
    const int r = lane & 31, kh = lane >> 5;
    const float* W = p.in[I_ADAW] + (size_t)layer * 1024 * 6144 + n0 + r;
    const float* cb = p.in[I_C] + r * 1024 + kh * 8;
    const float* cc = p.in[I_CCTX] + kh * 8;
    f32x16 acc;
#pragma unroll
    for (int i = 0; i < 16; ++i) acc[i] = 0.f;
    float accc = 0.f;
    for (int k0 = 0; k0 < 1024; k0 += 32) {
        float wv[16], cv[16], xv[16];
#pragma unroll
        for (int h2 = 0; h2 < 2; ++h2) {
            const f32x4 c0 = *(const f32x4*)(cb + k0 + h2 * 16), c1 = *(const f32x4*)(cb + k0 + h2 * 16 + 4);
            const f32x4 x0 = *(const f32x4*)(cc + k0 + h2 * 16), x1 = *(const f32x4*)(cc + k0 + h2 * 16 + 4);
#pragma unroll
            for (int u = 0; u < 4; ++u) { cv[h2 * 8 + u] = c0[u]; cv[h2 * 8 + 4 + u] = c1[u]; xv[h2 * 8 + u] = x0[u]; xv[h2 * 8 + 4 + u] = x1[u]; }
#pragma unroll
            for (int u = 0; u < 8; ++u) wv[h2 * 8 + u] = W[(size_t)(k0 + h2 * 16 + kh * 8 + u) * 6144];
        }
#pragma unroll
        for (int u = 0; u < 16; ++u) {
            acc = __builtin_amdgcn_mfma_f32_32x32x2f32(silu_f(cv[u]), wv[u], acc, 0, 0, 0);
            accc += silu_f(xv[u]) * wv[u];
        }
    }
    accc += __shfl_xor(accc, 32);
    const float bias = p.in[I_ADAB][layer * 6144 + n0 + r];
#pragma unroll
    for (int i = 0; i < 16; ++i) {
        const int v = (i & 3) + 8 * (i >> 2) + 4 * kh;
        ADA[((size_t)layer * 33 + v) * 6144 + n0 + r] = acc[i] + bias;
    }
    if (kh == 0) ADA[((size_t)layer * 33 + 32) * 6144 + n0 + r] = accc + bias;
}

DI void phase0(LAS unsigned char* lds, const Params& p, float* ADA, unsigned* counter) {
    const int TIDX = otid();
    const int wave = __builtin_amdgcn_readfirstlane(TIDX >> 6), lane = TIDX & 63;
    LAS float* tile = (LAS float*)(lds + wave * 16640);
    constexpr int NADA = 4 * 192;
    for (;;) {
        int item = 0;
        if (lane == 0) item = (int)atomicAdd(counter, 1u);
        item = __builtin_amdgcn_readfirstlane(item);
        if (item < NADA) { ada_item(p, ADA, item, lane); continue; }
        int t = item - NADA, m = 0;
        bool found = false;
        for (m = 0; m < 17; ++m) {
            const WDesc w = wdesc_of(p, m);
            const int nt = (w.K / 64) * (w.Nout / 64);
            if (t < nt) { prep_tile(tile, w, t, lane); found = true; break; }
            t -= nt;
        }
        if (!found) break;
    }
}

DI void norm_phase(const float* lat_in, const float* ctx_in, float* lat_out, float* ctx_out, bool copy, const float* g,
                   const float* ada, int shidx, bf16_t* H, bool skipctx, float* ssq_zero = nullptr) {
    const int TIDX = otid(); const int BIDX = obid(); (void)TIDX; (void)BIDX;
    const int wave = TIDX >> 6, lane = TIDX & 63;
    for (int row = BIDX * 8 + wave; row < NR; row += gridDim.x * 8) {
        const int b = row / TT, t = row - b * TT;
        if (skipctx && t < CTXL) continue;
        if (ssq_zero && lane < 4) ssq_zero[(size_t)row * 4 + lane] = 0.f;
        const size_t ro = t < CTXL ? ((size_t)(b * CTXL + t) << 10) : ((size_t)(b * SEQ + t - CTXL) << 10);
        const float* src = (t < CTXL ? ctx_in : lat_in) + ro;
        const float* sh = ada + (size_t)(t < CTXL ? 32 : b) * 6144 + shidx * 1024;
        const float* sc = sh + 1024;
        f32x4 a[4];
        a[0] = *(const f32x4*)(src + lane * 8); a[1] = *(const f32x4*)(src + lane * 8 + 4);
        a[2] = *(const f32x4*)(src + 512 + lane * 8); a[3] = *(const f32x4*)(src + 512 + lane * 8 + 4);
        float ss = 0.f;
#pragma unroll
        for (int i = 0; i < 4; ++i)
#pragma unroll
            for (int j = 0; j < 4; ++j) ss += a[i][j] * a[i][j];
        ss = wsum(ss);
        const float r = rsqrtf(ss * (1.f / 1024.f) + EPS);
        if (copy) {
            float* dst = (t < CTXL ? ctx_out : lat_out) + ro;
            *(f32x4*)(dst + lane * 8) = a[0]; *(f32x4*)(dst + lane * 8 + 4) = a[1];
            *(f32x4*)(dst + 512 + lane * 8) = a[2]; *(f32x4*)(dst + 512 + lane * 8 + 4) = a[3];
        }
#pragma unroll
        for (int hf = 0; hf < 2; ++hf) {
            const int c0 = hf * 512 + lane * 8;
            float y[8];
#pragma unroll
            for (int q = 0; q < 2; ++q) {
                const f32x4 gv = *(const f32x4*)(g + c0 + q * 4), sv = *(const f32x4*)(sc + c0 + q * 4), hv = *(const f32x4*)(sh + c0 + q * 4);
#pragma unroll
                for (int j = 0; j < 4; ++j) y[q * 4 + j] = a[hf * 2 + q][j] * r * gv[j] * (1.f + sv[j]) + hv[j];
            }
            *(u32x4*)(H + ((size_t)row << 10) + c0) = pack8(y);
        }
    }
}

DI void mla_rope8(float* v, int sub, int s) {
    const float pos = (float)((sub < 2) ? (s >> 6) : (s & 63));
    const bool isx2 = sub & 1;
#pragma unroll
    for (int i = 0; i < 8; ++i) {
        const float other = __shfl_xor(v[i], 1);
        const float ang = pos * fexp2(-(float)i * (L2_10000 / 8.f));
        const float c = __cosf(ang), sn = __sinf(ang);
        v[i] = isx2 ? (other * sn + v[i] * c) : (v[i] * c - other * sn);
    }
}

DI void mla_r2(bf16_t* QB, bf16_t* KV, const bf16_t* Z, const float* gqn, const float* gkn) {
    const int TIDX = otid(); const int BIDX = obid(); (void)TIDX; (void)BIDX;
    const int wave = TIDX >> 6, lane = TIDX & 63, hd = lane >> 2, sub = lane & 3;
    for (int row = BIDX * 8 + wave; row < NR; row += gridDim.x * 8) {
        const int b = row / TT, t = row - b * TT; const bool latent = t >= CTXL; const int s = t - CTXL;
        const bf16_t* z = Z + (size_t)row * 768;
        bf16_t* qp = QB + (size_t)row * 1536 + hd * 96;
        bf16_t* kp = KV + (size_t)row * 2560 + hd * 160;
        unsigned zq[3];
#pragma unroll
        for (int i = 0; i < 3; ++i) zq[i] = *(const unsigned*)(z + lane * 6 + 2 * i);
        const u32x2 zk = *(const u32x2*)(z + 384 + lane * 4);
        const u32x4 q0 = *(const u32x4*)(qp + sub * 16), q1 = *(const u32x4*)(qp + sub * 16 + 8), q2 = *(const u32x4*)(qp + 64 + sub * 8);
        const u32x4 k0 = *(const u32x4*)(kp + sub * 16), k1 = *(const u32x4*)(kp + sub * 16 + 8);
        const u32x4 v0 = *(const u32x4*)(kp + 64 + sub * 16), v1 = *(const u32x4*)(kp + 64 + sub * 16 + 8);
        const u32x4 k2 = *(const u32x4*)(z + 640 + sub * 8);
        asm volatile("s_waitcnt vmcnt(0)" ::: "memory");
        float sq0 = 0.f, sk0 = 0.f;
#pragma unroll
        for (int i = 0; i < 3; ++i) { const float a0 = bf_lo(zq[i]), a1 = bf_hi(zq[i]); sq0 += a0 * a0 + a1 * a1; }
        { const float a0 = bf_lo(zk[0]), a1 = bf_hi(zk[0]), a2 = bf_lo(zk[1]), a3 = bf_hi(zk[1]); sk0 = a0 * a0 + a1 * a1 + a2 * a2 + a3 * a3; }
        sq0 = wsum(sq0); sk0 = wsum(sk0);
        const float rq0 = rsqrtf(sq0 * (1.f / 384.f) + EPS), rk0 = rsqrtf(sk0 * (1.f / 256.f) + EPS);
        float qn[16], qr[8], kn[16], kr[8], vv[16];
        unpack8(q0, qn); unpack8(q1, qn + 8); unpack8(q2, qr);
        unpack8(k0, kn); unpack8(k1, kn + 8); unpack8(k2, kr);
        unpack8(v0, vv); unpack8(v1, vv + 8);
#pragma unroll
        for (int i = 0; i < 16; ++i) { qn[i] *= rq0; kn[i] *= rk0; vv[i] *= rk0; }
#pragma unroll
        for (int i = 0; i < 8; ++i) qr[i] *= rq0;
        float sq = 0.f, sk = 0.f;
#pragma unroll
        for (int i = 0; i < 16; ++i) { sq += qn[i] * qn[i]; sk += kn[i] * kn[i]; }
#pragma unroll
        for (int i = 0; i < 8; ++i) { sq += qr[i] * qr[i]; sk += kr[i] * kr[i]; }
        sq += __shfl_xor(sq, 1); sq += __shfl_xor(sq, 2);
        sk += __shfl_xor(sk, 1); sk += __shfl_xor(sk, 2);
        const float rq = rsqrtf(sq * (1.f / 96.f) + EPS), rk = rsqrtf(sk * (1.f / 96.f) + EPS);
#pragma unroll
        for (int i = 0; i < 16; ++i) { qn[i] *= rq * gqn[sub * 16 + i]; kn[i] *= rk * gkn[sub * 16 + i]; }
#pragma unroll
        for (int i = 0; i < 8; ++i) { qr[i] *= rq * gqn[64 + sub * 8 + i]; kr[i] *= rk * gkn[64 + sub * 8 + i]; }
        if (latent) { mla_rope8(qr, sub, s); mla_rope8(kr, sub, s); }
        *(u32x4*)(qp + sub * 16) = pack8(qn); *(u32x4*)(qp + sub * 16 + 8) = pack8(qn + 8); *(u32x4*)(qp + 64 + sub * 8) = pack8(qr);
        *(u32x4*)(kp + sub * 16) = pack8(kn); *(u32x4*)(kp + sub * 16 + 8) = pack8(kn + 8); *(u32x4*)(kp + 64 + sub * 8) = pack8(kr);
        *(u32x4*)(kp + 96 + sub * 16) = pack8(vv); *(u32x4*)(kp + 96 + sub * 16 + 8) = pack8(vv + 8);
    }
}

template <int HD, int LPH, int ROPE>
DI void headnorm_phase(bf16_t* X, int stride, int nq, int koff, int nk, const float* gq, const float* gk) {
    const int TIDX = otid(); const int BIDX = obid(); (void)TIDX; (void)BIDX;
    const int wave = TIDX >> 6, lane = TIDX & 63, sub = lane % LPH, hl = lane / LPH;
    const int rstep = gridDim.x * 8;
    for (int row = BIDX * 8 + wave; row < NR; row += 2 * rstep) {
        u32x4 u[2][2][2];
#pragma unroll
        for (int rr = 0; rr < 2; ++rr)
#pragma unroll
            for (int pass = 0; pass < 2; ++pass) {
                const int r2 = row + rr * rstep;
                const bool act = (r2 < NR) && (hl < (pass ? nk : nq));
                const bf16_t* ptr = X + (size_t)r2 * stride + (pass ? koff : 0) + hl * HD + sub * 16;
                u[rr][pass][0] = (u32x4){0, 0, 0, 0}; u[rr][pass][1] = (u32x4){0, 0, 0, 0};
                if (act) { u[rr][pass][0] = *(const u32x4*)ptr; u[rr][pass][1] = *(const u32x4*)(ptr + 8); }
            }
        asm volatile("s_waitcnt vmcnt(0)" ::: "memory");
#pragma unroll
        for (int rr = 0; rr < 2; ++rr) {
            const int r2 = row + rr * rstep;
            const int b = r2 / TT, t = r2 - b * TT; const bool latent = t >= CTXL; const int s = t - CTXL;
#pragma unroll
            for (int pass = 0; pass < 2; ++pass) {
                const bool act = (r2 < NR) && (hl < (pass ? nk : nq));
                const float* g = pass ? gk : gq;
                bf16_t* ptr = X + (size_t)r2 * stride + (pass ? koff : 0) + hl * HD + sub * 16;
                float v[16]; unpack8(u[rr][pass][0], v); unpack8(u[rr][pass][1], v + 8);
                float ss = 0.f;
#pragma unroll
                for (int i = 0; i < 16; ++i) ss += v[i] * v[i];
#pragma unroll
                for (int o = 1; o < LPH; o <<= 1) ss += __shfl_xor(ss, o);
                const float rr_ = rsqrtf(ss * (1.f / HD) + EPS);
#pragma unroll
                for (int i = 0; i < 16; ++i) v[i] *= rr_ * g[sub * 16 + i];
                if (ROPE) {
                    if (latent) {
                        const int axis = sub >> 2; const bool isx2 = (sub >> 1) & 1;
                        const float pos = (float)(axis ? (s & 63) : (s >> 6));
#pragma unroll
                        for (int i = 0; i < 16; ++i) {
                            const float other = __shfl_xor(v[i], 2);
                            const int fi = (sub & 1) * 16 + i;
                            const float ang = pos * fexp2(-(float)fi * (L2_10000 / 32.f));
                            const float c = __cosf(ang), sn = __sinf(ang);
                            v[i] = isx2 ? (other * sn + v[i] * c) : (v[i] * c - other * sn);
                        }
                    }
                }
                if (act) { *(u32x4*)ptr = pack8(v); *(u32x4*)(ptr + 8) = pack8(v + 8); }
            }
        }
    }
}

struct AttnArgs { const bf16_t* Q; const bf16_t* K; const bf16_t* V; bf16_t* O; int qs, qh, ks, kh, vs, vh, nheads, gshift, ctx_out; const float* rpb; float sc; };

template <int DK, int DV, int NA>
DI void attn_phase(LAS unsigned char* lds, const AttnArgs a) {
    const int TIDX = otid(); const int BIDX = obid(); (void)TIDX; (void)BIDX;
    constexpr int KROW = DK * 2 + 16, VROW = DV * 2 + 16;
    constexpr int KBUF = 64 * KROW, VBUF = 64 * VROW;
    constexpr int OFFK = 0, OFFV = 2 * KBUF, OFFR = OFFV + 2 * VBUF;
    constexpr int KCH = DK / 8, VCH = DV / 8, NKC = 64 * KCH, NVC = 64 * VCH;
    constexpr int KPT = (NKC + 511) / 512, VPT = (NVC + 511) / 512;
    constexpr int NK0 = DK / 16, NQG = NK0 / 2;
    const int tid = TIDX, wave = __builtin_amdgcn_readfirstlane(tid >> 6), lane = tid & 63, r = lane & 31, hh = lane >> 5;
    const int i16 = lane & 15, tq = i16 >> 2, tp = i16 & 3, blk = (lane >> 4) & 1;
    const int nlat = NB * a.nheads * 8, ntot = nlat + (a.ctx_out ? NB * a.nheads : 0);
    LAS float* rpbL = (LAS float*)(lds + OFFR);
    for (int item = BIDX; item < ntot; item += gridDim.x) {
        int b, h, qb = 0; const bool isctx = item >= nlat;
        if (!isctx) { const int R = item >> 8, u = item & 255; const int qp = (R * 8 + (u & 7)) * 4 + (u >> 6); qb = (u >> 3) & 7; h = qp % a.nheads; b = qp / a.nheads; }
        else { const int bh = item - nlat; h = bh % a.nheads; b = bh / a.nheads; }
        const int hk = h >> a.gshift;
        const size_t rb = (size_t)b * TT;
        const bf16_t* Kb = a.K + hk * a.kh; const bf16_t* Vb = a.V + hk * a.vh;
        int ntiles = isctx ? 4 : 36, rlo = 0, wi = 0, wr0 = 0, c0 = 0;
        if (NA) {
            if (!isctx) { const int i0 = qb * 4; rlo = clampi(i0 - 4, 0, 24); const int rhi = clampi(i0 - 1, 0, 24) + 8; ntiles = 4 + rhi - rlo;
                wi = i0 + (wave >> 1); wr0 = clampi(wi - 4, 0, 24); c0 = (wave & 1) * 32; }
            if (tid < 465) rpbL[64 + tid] = a.rpb[h * 465 + tid] * LOG2E;
        }
        const size_t qrow = rb + (isctx ? 0 : 256 + qb * 256) + wave * 32 + r;
        bf16x8 qf[DK / 16];
#pragma unroll
        for (int k0 = 0; k0 < DK / 16; ++k0) qf[k0] = *(const bf16x8*)(a.Q + qrow * a.qs + h * a.qh + k0 * 16 + hh * 8);
        u32x4 sreg[KPT > VPT ? KPT : VPT];
#define ATT_TILE_ROW(j) ((NA && (j) >= 4) ? rb + 256 + (size_t)(rlo + (j) - 4) * 64 : rb + (size_t)(j) * 64)
#define ATT_GLOADK(j) do { const size_t _tr = ATT_TILE_ROW(j); \
        _Pragma("unroll") for (int _i = 0; _i < KPT; ++_i) { const int _c = tid + _i * 512; if (_c < NKC) { const int _row = _c / KCH, _cc = _c - _row * KCH; sreg[_i] = *(const u32x4*)(Kb + (_tr + _row) * a.ks + _cc * 8); } } } while (0)
#define ATT_GLOADV(j) do { const size_t _tr = ATT_TILE_ROW(j); \
        _Pragma("unroll") for (int _i = 0; _i < VPT; ++_i) { const int _c = tid + _i * 512; if (_c < NVC) { const int _row = _c / VCH, _cc = _c - _row * VCH; sreg[_i] = *(const u32x4*)(Vb + (_tr + _row) * a.vs + _cc * 8); } } } while (0)
#define ATT_LSTOREK(buf) do { \
        _Pragma("unroll") for (int _i = 0; _i < KPT; ++_i) { const int _c = tid + _i * 512; if (_c < NKC) { const int _row = _c / KCH, _cc = _c - _row * KCH; *(LAS u32x4*)(lds + OFFK + (buf) * KBUF + _row * KROW + _cc * 16) = sreg[_i]; } } } while (0)
#define ATT_LSTOREV(buf) do { \
        _Pragma("unroll") for (int _i = 0; _i < VPT; ++_i) { const int _c = tid + _i * 512; if (_c < NVC) { const int _row = _c / VCH, _cc = _c - _row * VCH; *(LAS u32x4*)(lds + OFFV + (buf) * VBUF + _row * VROW + _cc * 16) = sreg[_i]; } } } while (0)
#define ATT_KFRAG(buf, idx) (*(const LAS bf16x8*)(lds + OFFK + (buf) * KBUF + (((idx) / NK0) * 32 + r) * KROW + ((idx) % NK0) * 32 + hh * 16))
#define ATT_QK(dst, buf) do { \
        _Pragma("unroll") for (int _x = 0; _x < 2 * NK0; ++_x) { const bf16x8 kf = ATT_KFRAG(buf, _x); \
            dst[_x / NK0] = __builtin_amdgcn_mfma_f32_32x32x16_bf16(kf, qf[_x % NK0], (_x % NK0) == 0 ? zero16 : dst[_x / NK0], 0, 0, 0); } } while (0)
#define ATT_ACTIVE(j) (!(NA && (j) >= 4) || ((rlo + (j) - 4 >= wr0) && (rlo + (j) - 4 < wr0 + 8)))
#define ATT_TILE(j, S, SN) do { \
        if ((j) + 1 < ntiles) ATT_GLOADV((j) + 1); \
        if (ATT_ACTIVE(j)) { \
            const int nb = ((j) + 1) & 1; \
            const LAS unsigned char* Vt = lds + OFFV + ((j) & 1) * VBUF; \
            bf16x8 kfr[2][NQG]; \
            _Pragma("unroll") for (int q = 0; q < NQG; ++q) kfr[0][q] = ATT_KFRAG(nb, q); \
            float mx = m_run; \
            if (NA && (j) >= 4) { \
                const int kr = rlo + (j) - 4; \
                const int ri = kr - wi + 7, qj = c0 + r, cs = clampi(qj - 8, 0, 48); \
                const LAS float* bp = rpbL + 64 + ri * 31 + (4 * hh - qj + 15); \
                const int vb = 4 * hh - cs; \
                _Pragma("unroll") for (int kb = 0; kb < 2; ++kb) \
                    _Pragma("unroll") for (int i = 0; i < 16; ++i) { \
                        const int ci = kb * 32 + (i & 3) + 8 * (i >> 2); \
                        const bool valid = (unsigned)(vb + ci) < 16u; \
                        const float x = valid ? __builtin_fmaf(S[kb][i], a.sc, bp[ci]) : -1e30f; \
                        S[kb][i] = x; mx = fmaxf(mx, x); } \
                mx = pairmax32(mx); \
            } else { \
                float mr = -1e30f; \
                _Pragma("unroll") for (int kb = 0; kb < 2; ++kb) \
                    _Pragma("unroll") for (int i = 0; i < 16; ++i) mr = fmaxf(mr, S[kb][i]); \
                mr = pairmax32(mr); \
                mx = fmaxf(mx, mr * a.sc); \
            } \
            if (__any(mx > m_run + 8.f)) {     \
                const float alpha = fexp2(m_run - mx); \
                lsum *= alpha; \
                _Pragma("unroll") for (int d = 0; d < DV / 32; ++d) \
                    _Pragma("unroll") for (int i = 0; i < 16; ++i) o[d][i] *= alpha; \
                m_run = mx; \
            } \
            mx = m_run; \
            __builtin_amdgcn_sched_barrier(0); \
            _Pragma("unroll") for (int grp = 0; grp < 4; ++grp) { \
                const int kb = grp >> 1, st = grp & 1; \
                if (grp < 3) { _Pragma("unroll") for (int q = 0; q < NQG; ++q) kfr[(grp + 1) & 1][q] = ATT_KFRAG(nb, (grp + 1) * NQG + q); } \
                bf16x8 vf[DV / 32]; \
                _Pragma("unroll") for (int d = 0; d < DV / 32; ++d) { \
                    const LAS unsigned char* ad = Vt + (kb * 32 + 16 * st + 4 * hh + tq) * VROW + (d * 32 + 16 * blk + 4 * tp) * 2; \
                    const s16x4 lo = __builtin_amdgcn_ds_read_tr16_b64_v4i16((LAS s16x4*)ad); \
                    const s16x4 hi = __builtin_amdgcn_ds_read_tr16_b64_v4i16((LAS s16x4*)(ad + 8 * VROW)); \
                    vf[d] = __builtin_shufflevector(lo, hi, 0, 1, 2, 3, 4, 5, 6, 7); } \
                _Pragma("unroll") for (int q = 0; q < NQG; ++q) { const int idx = grp * NQG + q; \
                    SN[idx / NK0] = __builtin_amdgcn_mfma_f32_32x32x16_bf16(kfr[grp & 1][q], qf[idx % NK0], (idx % NK0) == 0 ? zero16 : SN[idx / NK0], 0, 0, 0); } \
                __builtin_amdgcn_sched_barrier(0); \
                float pp[8]; \
                _Pragma("unroll") for (int i = 0; i < 8; ++i) { \
                    pp[i] = (NA && (j) >= 4) ? fexp2(S[kb][8 * st + i] - mx) : fexp2(__builtin_fmaf(S[kb][8 * st + i], a.sc, -mx)); lsum += pp[i]; } \
                const bf16x8 pf = __builtin_bit_cast(bf16x8, pack8(pp)); \
                __builtin_amdgcn_sched_barrier(0); \
                _Pragma("unroll") for (int d = 0; d < DV / 32; ++d) o[d] = __builtin_amdgcn_mfma_f32_32x32x16_bf16(vf[d], pf, o[d], 0, 0, 0); \
                __builtin_amdgcn_sched_barrier(0); \
                if (grp == 1) { \
                    if ((j) + 1 < ntiles) ATT_LSTOREV(((j) + 1) & 1); \
                    if ((j) + 2 < ntiles) ATT_GLOADK((j) + 2); \
                    __builtin_amdgcn_sched_barrier(0); \
                } \
            } \
        } else { \
            ATT_QK(SN, ((j) + 1) & 1); \
            if ((j) + 1 < ntiles) ATT_LSTOREV(((j) + 1) & 1); \
            if ((j) + 2 < ntiles) ATT_GLOADK((j) + 2); \
        } \
        if ((j) + 2 < ntiles) ATT_LSTOREK((j) & 1); \
        __syncthreads(); } while (0)
        ATT_GLOADK(0); ATT_LSTOREK(0); ATT_GLOADV(0); ATT_LSTOREV(0);
        ATT_GLOADK(1); ATT_LSTOREK(1);
        __syncthreads();
        f32x16 o[DV / 32];
#pragma unroll
        for (int d = 0; d < DV / 32; ++d)
#pragma unroll
            for (int i = 0; i < 16; ++i) o[d][i] = 0.f;
        f32x16 zero16;
#pragma unroll
        for (int i = 0; i < 16; ++i) zero16[i] = 0.f;
        float m_run = -1e30f, lsum = 0.f;
        f32x16 s[2], sn[2];
        ATT_QK(s, 0);
        __syncthreads();
        for (int j = 0; j < ntiles; j += 2) {
            ATT_TILE(j, s, sn);
            if (j + 1 < ntiles) ATT_TILE(j + 1, sn, s);
        }
        lsum += __shfl_xor(lsum, 32);
        const float inv = frcp(lsum);
        bf16_t* orow = a.O + (qrow << 10) + h * DV;
#pragma unroll
        for (int d = 0; d < DV / 32; ++d)
#pragma unroll
            for (int g = 0; g < 4; ++g)
                *(u32x2*)(orow + d * 32 + 8 * g + 4 * hh) = (u32x2){pk_bf16(o[d][4 * g] * inv, o[d][4 * g + 1] * inv), pk_bf16(o[d][4 * g + 2] * inv, o[d][4 * g + 3] * inv)};
#undef ATT_TILE_ROW
#undef ATT_GLOADK
#undef ATT_GLOADV
#undef ATT_LSTOREK
#undef ATT_LSTOREV
#undef ATT_KFRAG
#undef ATT_QK
#undef ATT_ACTIVE
#undef ATT_TILE
    }
}

namespace ad {
constexpr int D = 128, NW = 8, QBLK = 32, KVBLK = 64;
constexpr float SCALE = 0.088388347648318440f, THR = 8.f;
constexpr int LDQ = 1536, LDK = 1536, LDO = 1024;
constexpr size_t SHM_V = KVBLK * D * 2, SHM_K = KVBLK * D * 2;
typedef float f32x8 __attribute__((ext_vector_type(8)));
#define AD_KSWZ(row, colB) ((row) * 256 + ((colB) ^ (((row) & 7) << 4)))
#define AD_SBAR() __builtin_amdgcn_sched_barrier(0)
DI int crow(int r, int hi) { return (r & 3) + 8 * (r >> 2) + 4 * hi; }
DI unsigned cvtpk(float lo, float hi) { unsigned r; asm volatile("v_cvt_pk_bf16_f32 %0, %1, %2" : "=v"(r) : "v"(lo), "v"(hi)); return r; }
DI bf16x8 ld8(const bf16_t* p) { return *reinterpret_cast<const bf16x8*>(p); }
DI void partialSM(f32x16& p0, f32x16& p1, float& m_reg, float& mn, float& alpha) {
  constexpr float C = SCALE * 1.4426950408889634f;
  float pmax = p0[0];
#pragma unroll
  for (int r = 1; r < 16; ++r) pmax = fmaxf(pmax, p0[r]);
#pragma unroll
  for (int r = 0; r < 16; ++r) pmax = fmaxf(pmax, p1[r]);
  { auto rr = __builtin_amdgcn_permlane32_swap(__float_as_uint(pmax), __float_as_uint(pmax), false, false);
    pmax = fmaxf(__uint_as_float(rr[0]), __uint_as_float(rr[1])); }
  if (__builtin_expect(__all(pmax - m_reg <= THR / SCALE), 1)) { mn = m_reg; alpha = 1.f; }
  else { mn = fmaxf(m_reg, pmax); alpha = __builtin_amdgcn_exp2f((m_reg - mn) * C); m_reg = mn; }
  float mnC = -mn * C;
#pragma unroll
  for (int r = 0; r < 16; ++r) p0[r] = fmaf(p0[r], C, mnC);
#pragma unroll
  for (int r = 0; r < 16; ++r) p1[r] = fmaf(p1[r], C, mnC);
#pragma unroll
  for (int r = 0; r < 16; ++r) p0[r] = __builtin_amdgcn_exp2f(p0[r]);
}
DI void finishSM(f32x16& p0, f32x16& p1, float alpha, float& l_reg, bf16x8& pa0, bf16x8& pa1, bf16x8& pa2, bf16x8& pa3) {
#pragma unroll
  for (int r = 0; r < 16; ++r) p1[r] = __builtin_amdgcn_exp2f(p1[r]);
  float ps = 0;
#pragma unroll
  for (int r = 0; r < 16; ++r) ps += p0[r];
#pragma unroll
  for (int r = 0; r < 16; ++r) ps += p1[r];
  { auto rr = __builtin_amdgcn_permlane32_swap(__float_as_uint(ps), __float_as_uint(ps), false, false);
    ps = __uint_as_float(rr[0]) + __uint_as_float(rr[1]); }
  l_reg = l_reg * alpha + ps;
#define AD_PK4(P, BASE, OUT) do { unsigned a0 = cvtpk(P[BASE + 0], P[BASE + 1]), a1 = cvtpk(P[BASE + 2], P[BASE + 3]);   \
    unsigned b0 = cvtpk(P[BASE + 4], P[BASE + 5]), b1 = cvtpk(P[BASE + 6], P[BASE + 7]);                              \
    auto r0 = __builtin_amdgcn_permlane32_swap(a0, b0, false, false); auto r1 = __builtin_amdgcn_permlane32_swap(a1, b1, false, false); \
    u32x4 w = {r0[0], r1[0], r0[1], r1[1]}; OUT = *reinterpret_cast<bf16x8*>(&w); } while (0)
  AD_PK4(p0, 0, pa0); AD_PK4(p0, 8, pa1); AD_PK4(p1, 0, pa2); AD_PK4(p1, 8, pa3);
#undef AD_PK4
}
DI void qkt(f32x16& p0, f32x16& p1, const char* Ks, const bf16x8* qr, int r32, int hi) {
#pragma unroll
  for (int i = 0; i < 16; ++i) { p0[i] = 0.f; p1[i] = 0.f; }
#pragma unroll
  for (int d0 = 0; d0 < 8; ++d0) { int cb = (d0 * 16 + hi * 8) * 2;
    bf16x8 b0 = *reinterpret_cast<const bf16x8*>(Ks + AD_KSWZ(r32, cb));
    bf16x8 b1 = *reinterpret_cast<const bf16x8*>(Ks + AD_KSWZ(32 + r32, cb));
    p0 = __builtin_amdgcn_mfma_f32_32x32x16_bf16(b0, qr[d0], p0, 0, 0, 0);
    p1 = __builtin_amdgcn_mfma_f32_32x32x16_bf16(b1, qr[d0], p1, 0, 0, 0); }
}
DI int v_st(int k, int c) { const int kk = (k & ~0xC) | ((k & 4) << 1) | ((k & 8) >> 1); return ((kk >> 3) * 4 + (c >> 5)) * 512 + ((kk & 7) * 32 + (c & 31)) * 2; }
DI int v_rd_base(int lane) { return ((lane & 3) << 3) | (((lane >> 2) & 3) << 6) | (((lane >> 4) & 1) << 5) | (((lane >> 5) & 1) << 8); }
constexpr int v_rd_off(int d0, int ks, int half) { return d0 * 512 + ks * 4096 + half * 2048; }
template <int OFF> DI s16x4 tr_read(int vb) { s16x4 r; asm volatile("ds_read_b64_tr_b16 %0, %1 offset:%2" : "=&v"(r) : "v"(vb), "i"(OFF) : "memory"); return r; }
template <int D0> DI void pv_one(f32x16& od, int vb, bf16x8 pa0, bf16x8 pa1, bf16x8 pa2, bf16x8 pa3) {
  const s16x4 l0 = tr_read<v_rd_off(D0, 0, 0)>(vb), h0 = tr_read<v_rd_off(D0, 0, 1)>(vb), l1 = tr_read<v_rd_off(D0, 1, 0)>(vb), h1 = tr_read<v_rd_off(D0, 1, 1)>(vb);
  const s16x4 l2 = tr_read<v_rd_off(D0, 2, 0)>(vb), h2 = tr_read<v_rd_off(D0, 2, 1)>(vb), l3 = tr_read<v_rd_off(D0, 3, 0)>(vb), h3 = tr_read<v_rd_off(D0, 3, 1)>(vb);
  asm volatile("s_waitcnt lgkmcnt(0)" ::: "memory"); AD_SBAR();
#define AD_PK(L, H) (bf16x8){L[0], L[1], L[2], L[3], H[0], H[1], H[2], H[3]}
  od = __builtin_amdgcn_mfma_f32_32x32x16_bf16(pa0, AD_PK(l0, h0), od, 0, 0, 0);
  od = __builtin_amdgcn_mfma_f32_32x32x16_bf16(pa1, AD_PK(l1, h1), od, 0, 0, 0);
  od = __builtin_amdgcn_mfma_f32_32x32x16_bf16(pa2, AD_PK(l2, h2), od, 0, 0, 0);
  od = __builtin_amdgcn_mfma_f32_32x32x16_bf16(pa3, AD_PK(l3, h3), od, 0, 0, 0);
#undef AD_PK
}
DI void pv_d0(f32x16* o, int vb, bf16x8 pa0, bf16x8 pa1, bf16x8 pa2, bf16x8 pa3) {
  pv_one<0>(o[0], vb, pa0, pa1, pa2, pa3); pv_one<1>(o[1], vb, pa0, pa1, pa2, pa3); pv_one<2>(o[2], vb, pa0, pa1, pa2, pa3); pv_one<3>(o[3], vb, pa0, pa1, pa2, pa3);
}
DI void body(int tid, const bf16_t* __restrict__ Qb, const bf16_t* __restrict__ Kh, bf16_t* __restrict__ Ob, int seq, char* lds) {
  const int wid = tid >> 6, lane = tid & 63, r32 = lane & 31, hi = lane >> 5;
  char* V_lds = lds; char* K_lds = lds + 2 * SHM_V;
  float* ws = (float*)(lds + 2 * SHM_V + 2 * SHM_K) + wid * 64; float* li_l = ws; float* al_l = ws + 32;
  float m_reg = -1e30f, l_reg = 0; f32x16 o[4]; bf16x8 qr[8];
#pragma unroll
  for (int d = 0; d < 4; ++d)
#pragma unroll
    for (int i = 0; i < 16; ++i) o[d][i] = 0.f;
  const bf16_t* Qw = Qb + (long)(wid * QBLK + r32) * LDQ + hi * 8;
#pragma unroll
  for (int d0 = 0; d0 < 8; ++d0) qr[d0] = ld8(Qw + d0 * 16);
  const int sr = tid >> 4, sc = (tid & 15) * 8, vst0 = v_st(sr, sc), vst1 = v_st(32 + sr, sc);
  const int vb0 = (int)(uintptr_t)V_lds + v_rd_base(lane);
  struct { bf16x8 vs0, vs1, ks0, ks1; } sr_[2];
  const bf16_t* kp = Kh + (long)sr * LDK + sc;
#define AD_SLOAD(i, k0) do { const bf16_t* _p = kp; asm volatile("" : "+v"(_p)); sr_[i].ks0 = ld8(_p); sr_[i].vs0 = ld8(_p + 256); \
    sr_[i].ks1 = ld8(_p + 32 * LDK); sr_[i].vs1 = ld8(_p + 32 * LDK + 256); kp += KVBLK * LDK; } while (0)
#define AD_SWRITE(b, i) do { *(bf16x8*)(V_lds + (b) * SHM_V + vst0) = sr_[i].vs0; *(bf16x8*)(V_lds + (b) * SHM_V + vst1) = sr_[i].vs1; int kc = sc * 2; \
    *(bf16x8*)(K_lds + (b) * SHM_K + AD_KSWZ(sr, kc)) = sr_[i].ks0; *(bf16x8*)(K_lds + (b) * SHM_K + AD_KSWZ(32 + sr, kc)) = sr_[i].ks1; } while (0)
#define AD_SWAIT() asm volatile("s_waitcnt vmcnt(4)" ::: "memory")
#define AD_RESC(a) do { if (__any((a) < 1.f)) { if (hi == 0) al_l[r32] = (a); asm volatile("s_waitcnt lgkmcnt(0)" ::: "memory"); \
    _Pragma("unroll") for (int d = 0; d < 4; ++d) _Pragma("unroll") for (int r = 0; r < 16; ++r) o[d][r] *= al_l[crow(r, hi)]; } } while (0)
  f32x16 pA0, pA1, pB0, pB1; float mnA, mnB, alA, alB; bf16x8 pa0, pa1, pa2, pa3; const int NT = seq / KVBLK;
  AD_SLOAD(0, 0); asm volatile("s_waitcnt vmcnt(0)" ::: "memory"); AD_SWRITE(0, 0); __syncthreads();
  qkt(pA0, pA1, K_lds, qr, r32, hi); partialSM(pA0, pA1, m_reg, mnA, alA);
  AD_SLOAD(1, KVBLK); if (2 < NT) AD_SLOAD(0, 2 * KVBLK);
  AD_SWAIT(); AD_SWRITE(1, 1); __syncthreads();
  for (int j = 1; j + 1 < NT; j += 2) {
    AD_SBAR(); qkt(pB0, pB1, K_lds + SHM_K, qr, r32, hi);
    finishSM(pA0, pA1, alA, l_reg, pa0, pa1, pa2, pa3); AD_SBAR();
    AD_SLOAD(1, (j + 2) * KVBLK); AD_SBAR();
    pv_d0(o, vb0, pa0, pa1, pa2, pa3); partialSM(pB0, pB1, m_reg, mnB, alB);
    __syncthreads(); AD_SWAIT(); AD_SWRITE(0, 0);
    AD_RESC(alB); __syncthreads();
    AD_SBAR(); qkt(pA0, pA1, K_lds, qr, r32, hi);
    finishSM(pB0, pB1, alB, l_reg, pa0, pa1, pa2, pa3); AD_SBAR();
    if (j + 3 < NT) AD_SLOAD(0, (j + 3) * KVBLK); AD_SBAR();
    pv_d0(o, vb0 + (int)SHM_V, pa0, pa1, pa2, pa3); partialSM(pA0, pA1, m_reg, mnA, alA);
    __syncthreads(); AD_SWAIT(); AD_SWRITE(1, 1);
    AD_RESC(alA); __syncthreads();
  }
  AD_SBAR(); qkt(pB0, pB1, K_lds + SHM_K, qr, r32, hi);
  finishSM(pA0, pA1, alA, l_reg, pa0, pa1, pa2, pa3); AD_SBAR();
  pv_d0(o, vb0, pa0, pa1, pa2, pa3); partialSM(pB0, pB1, m_reg, mnB, alB);
  __syncthreads(); AD_RESC(alB);
  finishSM(pB0, pB1, alB, l_reg, pa0, pa1, pa2, pa3); AD_SBAR();
  pv_d0(o, vb0 + (int)SHM_V, pa0, pa1, pa2, pa3);
  if (hi == 0) li_l[r32] = l_reg; asm volatile("s_waitcnt lgkmcnt(0)" ::: "memory");
  int hi2 = hi, c2 = r32; asm volatile("" : "+v"(hi2), "+v"(c2));
  bf16_t* Ow = Ob + (long)(wid * QBLK) * LDO + c2;
#pragma unroll
  for (int r = 0; r < 16; ++r) { const int orow = crow(r, hi2); const float rl = __builtin_amdgcn_rcpf(li_l[orow]);
#pragma unroll
    for (int d0 = 0; d0 < 4; ++d0) Ow[orow * LDO + d0 * 32] = (bf16_t)(pk_bf16(o[d0][r] * rl, 0.f) & 0xffffu); }
#undef AD_SLOAD
#undef AD_SWRITE
#undef AD_SWAIT
#undef AD_RESC
}
}

DI void gqa_attn_phase(char* shm, const bf16_t* QKV, bf16_t* O) {
    const int TIDX = otid(); const int BIDX = obid();
    for (int item = BIDX; item < NB * 8 * 8; item += gridDim.x) {
        const int R = item >> 8, u = item & 255; const int qp = (R * 8 + (u & 7)) * 4 + (u >> 6); const int qb = (u >> 3) & 7; const int h = qp & 7, b = qp >> 3;
        const size_t rb = (size_t)b * TT, q0 = rb + 256 + (size_t)qb * 256;
        ad::body(TIDX, QKV + q0 * 1536 + h * 128, QKV + rb * 1536 + 1024 + (h >> 2) * 128, O + q0 * 1024 + h * 128, TT, shm);
        __syncthreads();
    }
}

DI void s5_scan_phase(LAS unsigned char* lds, const Params& p, bf16_t* H, bf16_t* YF) {
    const int TIDX = otid(); const int BIDX = obid(); (void)TIDX; (void)BIDX;
    const int wave = __builtin_amdgcn_readfirstlane(TIDX >> 6), lane = TIDX & 63;
    LAS float* BU = (LAS float*)(lds + wave * 14592);
    LAS bf16_t* Hh = (LAS bf16_t*)(lds + wave * 14592 + 10240);
    const int l15 = lane & 15, l4 = lane >> 4;
    for (int item = BIDX * 8 + wave; item < NB * 64; item += gridDim.x * 8) {
        const int g = item & 63, b = item >> 6;
        const float dsk = p.in[I_SD][g * 16 + l15];
        for (int dir = 0; dir < 2; ++dir) {
            const int pg = dir * 64 + g;
            const float dt = __expf(p.in[I_SLDT][pg]);
            const float* are = p.in[I_SARE] + pg * 64; const float* aim = p.in[I_SAIM] + pg * 64;
            float abr, abi;
            { const float ar = are[lane], ai = aim[lane]; const float mag = __expf(dt * ar); abr = mag * __cosf(dt * ai); abi = mag * __sinf(dt * ai); }
            bf16x8 bfr[8], cfr[4];
#pragma unroll
            for (int nt = 0; nt < 8; ++nt) {
                const int st = (nt & 3) * 16 + l15;
                const float ar = are[st], ai = aim[st]; const float mag = __expf(dt * ar);
                const float er = mag * __cosf(dt * ai), ei = mag * __sinf(dt * ai);
                const float den = ar * ar + ai * ai, nr = er - 1.f;
                const float fre = (nr * ar + ei * ai) / den, fim = (ei * ar - nr * ai) / den;
                float bb[8];
#pragma unroll
                for (int j = 0; j < 8; ++j) bb[j] = 0.f;
                if (lane < 32) {
                    const float* br = p.in[I_SBRE] + ((size_t)pg * 64 + st) * 16 + l4 * 8; const float* bi = p.in[I_SBIM] + ((size_t)pg * 64 + st) * 16 + l4 * 8;
#pragma unroll
                    for (int j = 0; j < 8; ++j) bb[j] = (nt < 4) ? (fre * br[j] - fim * bi[j]) : (fre * bi[j] + fim * br[j]);
                }
                bfr[nt] = __builtin_bit_cast(bf16x8, pack8(bb));
            }
#pragma unroll
            for (int kk = 0; kk < 4; ++kk) {
                const int st0 = kk * 16 + l4 * 4;
                const f32x4 cr4 = *(const f32x4*)(p.in[I_SCRE] + ((size_t)pg * 16 + l15) * 64 + st0);
                const f32x4 ci4 = *(const f32x4*)(p.in[I_SCIM] + ((size_t)pg * 16 + l15) * 64 + st0);
                float cc[8];
#pragma unroll
                for (int j = 0; j < 4; ++j) { cc[2 * j] = cr4[j]; cc[2 * j + 1] = -ci4[j]; }
                cfr[kk] = __builtin_bit_cast(bf16x8, pack8(cc));
            }
            float hr = 0.f, hi = 0.f;
#define S5_TB(j) (dir ? ((j) < 16 ? 16 * (15 - (j)) : 256 + 16 * (143 - (j))) : 16 * (j))
            bf16x8 ufn = (bf16x8){0, 0, 0, 0, 0, 0, 0, 0};
            if (lane < 32) ufn = *(const bf16x8*)(H + (((size_t)b * TT + S5_TB(0) + l15) << 10) + g * 16 + l4 * 8);
            for (int j = 0; j < 144; ++j) {
                const int tb = S5_TB(j);
                const size_t row0 = (size_t)b * TT + tb;
                const bf16x8 uf = ufn;
                if (lane < 32 && j + 1 < 144) ufn = *(const bf16x8*)(H + (((size_t)b * TT + S5_TB(j + 1) + l15) << 10) + g * 16 + l4 * 8);
                float yfv[4], uv[4];
                if (dir) {
#pragma unroll
                    for (int i = 0; i < 4; ++i) {
                        const size_t o = ((row0 + l4 * 4 + i) << 10) + g * 16 + l15;
                        yfv[i] = __uint_as_float(((unsigned)YF[o]) << 16); uv[i] = __uint_as_float(((unsigned)H[o]) << 16);
                    }
                }
#pragma unroll
                for (int nt = 0; nt < 8; ++nt) {
                    const f32x4 acc = __builtin_amdgcn_mfma_f32_16x16x32_bf16(uf, bfr[nt], (f32x4){0.f, 0.f, 0.f, 0.f}, 0, 0, 0);
                    *(LAS f32x4*)(BU + (nt * 16 + l15) * 20 + l4 * 4) = acc;
                }
                float bur[16], bui[16];
#pragma unroll
                for (int q = 0; q < 4; ++q) {
                    const f32x4 r4 = *(const LAS f32x4*)(BU + lane * 20 + q * 4), i4 = *(const LAS f32x4*)(BU + (64 + lane) * 20 + q * 4);
#pragma unroll
                    for (int e = 0; e < 4; ++e) { bur[q * 4 + e] = r4[e]; bui[q * 4 + e] = i4[e]; }
                }
                if (dir) {
#pragma unroll
                    for (int tt = 15; tt >= 0; --tt) {
                        const float nhr = abr * hr - abi * hi + bur[tt], nhi = abr * hi + abi * hr + bui[tt];
                        hr = nhr; hi = nhi;
                        *(LAS unsigned*)(Hh + tt * 136 + 2 * lane) = pk_bf16(hr, hi);
                    }
                } else {
#pragma unroll
                    for (int tt = 0; tt < 16; ++tt) {
                        const float nhr = abr * hr - abi * hi + bur[tt], nhi = abr * hi + abi * hr + bui[tt];
                        hr = nhr; hi = nhi;
                        *(LAS unsigned*)(Hh + tt * 136 + 2 * lane) = pk_bf16(hr, hi);
                    }
                }
                f32x4 ya = (f32x4){0.f, 0.f, 0.f, 0.f};
#pragma unroll
                for (int kk = 0; kk < 4; ++kk) {
                    const bf16x8 af = *(const LAS bf16x8*)(Hh + l15 * 136 + kk * 32 + l4 * 8);
                    ya = __builtin_amdgcn_mfma_f32_16x16x32_bf16(af, cfr[kk], ya, 0, 0, 0);
                }
                if (dir == 0) {
#pragma unroll
                    for (int i = 0; i < 4; ++i) YF[((row0 + l4 * 4 + i) << 10) + g * 16 + l15] = (bf16_t)(pk_bf16(ya[i], 0.f) & 0xffffu);
                } else {
#pragma unroll
                    for (int i = 0; i < 4; ++i) {
                        const size_t o = ((row0 + l4 * 4 + i) << 10) + g * 16 + l15;
                        const float y = gelu_tanh(dsk * uv[i] + yfv[i] + ya[i]);
                        H[o] = (bf16_t)(pk_bf16(y, 0.f) & 0xffffu);
                    }
                }
            }
        }
    }
}

#define XB_TMO      128
#define XB_XCNT(j)  (256  + 64 * (j))
#define XB_XSUB(j)  (1280 + 64 * (j))
#define XB_XGEN(j)  (2304 + 64 * (j))
#define XB_TOP      3328
#define XB_TOPGEN   3392
#define XCD_BAR_WORDS 3456
#define XB_SPIN_CAP (1u << 18)
DI unsigned xb_ld(unsigned* p)              { return __hip_atomic_load(p, __ATOMIC_RELAXED, __HIP_MEMORY_SCOPE_AGENT); }
DI unsigned xb_add(unsigned* p, unsigned v) { return __hip_atomic_fetch_add(p, v, __ATOMIC_RELAXED, __HIP_MEMORY_SCOPE_AGENT); }
DI unsigned xb_xcc_id() { return (unsigned)__builtin_amdgcn_s_getreg((3 << 11) | 20) & 0xFu; }
#define XB_SPIN(cond, bar) do { unsigned _sp = 0; while (cond) { __builtin_amdgcn_s_sleep(1); \
    if ((++_sp & 255u) == 0u) { if (xb_ld(&(bar)[XB_TMO])) break; if (_sp > XB_SPIN_CAP) { atomicAdd(&(bar)[XB_TMO], 1u); break; } } } } while (0)
struct XcdBarrier { unsigned* bar; unsigned x; volatile LAS unsigned* st; };
DI XcdBarrier xcd_barrier_post(unsigned* bar, volatile LAS unsigned* st) {
    XcdBarrier b; b.bar = bar; b.x = xb_xcc_id(); b.st = st;
    if (threadIdx.x == 0) (void)xb_add(&bar[XB_XCNT(b.x)], 1u);
    return b;
}
DI void xcd_barrier_complete(unsigned* bar, unsigned x, unsigned& nloc, unsigned& nx) {
    const unsigned G = gridDim.x * gridDim.y * gridDim.z;
    unsigned sum, cnt, mine, sp = 0u;
    for (;;) {
        sum = 0u; cnt = 0u; mine = 0u;
#pragma unroll
        for (unsigned j = 0; j < 16; ++j) { const unsigned c = xb_ld(&bar[XB_XCNT(j)]); sum += c; cnt += (c > 0u) ? 1u : 0u; mine = (j == x) ? c : mine; }
        if (sum == G) break;
        __builtin_amdgcn_s_sleep(1);
        if ((++sp & 255u) == 0u) { if (xb_ld(&bar[XB_TMO])) break; if (sp > XB_SPIN_CAP) { atomicAdd(&bar[XB_TMO], 1u); break; } }
    }
    nloc = mine > 0u ? mine : 1u; nx = cnt > 0u ? cnt : 1u;
}
DI void xcd_barrier(const XcdBarrier& b) {
    asm volatile("s_waitcnt vmcnt(0)" ::: "memory");
    __syncthreads();
    if (threadIdx.x == 0) {
        unsigned* bar = b.bar;
        __builtin_amdgcn_s_waitcnt(0);
        unsigned nloc = b.st[0], nx = b.st[1];
        if (nloc == 0u) { xcd_barrier_complete(bar, b.x, nloc, nx); b.st[0] = nloc; b.st[1] = nx; }
        const unsigned old = xb_add(&bar[XB_XSUB(b.x)], 1u);
        const unsigned gen = old / nloc;
        if (old + 1u == (gen + 1u) * nloc) {
            __builtin_amdgcn_fence(__ATOMIC_RELEASE, "agent");
            asm volatile("s_waitcnt vmcnt(0)" ::: "memory");
            const unsigned og = xb_add(&bar[XB_TOP], 1u);
            const unsigned tg = og / nx;
            if (og + 1u == (tg + 1u) * nx) xb_add(&bar[XB_TOPGEN], 1u);
            else XB_SPIN(xb_ld(&bar[XB_TOPGEN]) == tg, bar);
            __builtin_amdgcn_fence(__ATOMIC_ACQUIRE, "agent");
            xb_add(&bar[XB_XGEN(b.x)], 1u);
            asm volatile("s_waitcnt vmcnt(0)" ::: "memory");
        } else {
            XB_SPIN(xb_ld(&bar[XB_XGEN(b.x)]) == gen, bar);
            __builtin_amdgcn_fence(__ATOMIC_ACQUIRE, "agent");
            asm volatile("s_waitcnt vmcnt(0)" ::: "memory");
        }
    }
    __syncthreads();
}

__global__ void __launch_bounds__(512, 2) mega(const Params p) {
    extern __shared__ __attribute__((aligned(16))) unsigned char shm[];
    LAS unsigned char* lds = (LAS unsigned char*)shm;
    cg::grid_group grid = cg::this_grid();
    LAS unsigned* xbst = (LAS unsigned*)(lds + 133120);
    if (threadIdx.x < 4) xbst[threadIdx.x] = 0u;
    __syncthreads();
    const XcdBarrier xb = xcd_barrier_post((unsigned*)(p.ws + OFF_BAR), (volatile LAS unsigned*)xbst);
    unsigned char* ws = p.ws;
    float* ADA = (float*)(ws + OFF_ADA);
    float* XC = (float*)(ws + OFF_XC);
    bf16_t* HB = (bf16_t*)(ws + OFF_HB);
    float* LAT = p.out;
    int pid = 0;
#define PH_BEGIN if (pid >= p.ph_lo && pid < p.ph_hi) {
#define PH_END if (pid + 1 < p.ph_hi) { if (pid == 0) grid.sync(); else xcd_barrier(xb); } } ++pid;

    PH_BEGIN
    {
        phase0(lds, p, ADA, (unsigned*)(ws + OFF_BAR + 14336));
    }
    PH_END

    for (int layer = 0; layer < 4; ++layer) {
        const float* ada = ADA + (size_t)layer * 33 * 6144;
        const int last = layer == 3;
        PH_BEGIN
        norm_phase(layer == 0 ? p.in[I_X] : LAT, layer == 0 ? p.in[I_CTX] : XC, LAT, XC, false, p.in[I_NMIX] + layer * 1024, ada, 0, HB, false, layer == 0 ? (float*)(ws + OFF_SSQ) : nullptr);
        PH_END
        if (layer == 0) {
            bf16_t* Z = (bf16_t*)(ws + OFF_Z); bf16_t* KV = (bf16_t*)(ws + OFF_KV); bf16_t* QB = (bf16_t*)(ws + OFF_QB);
            float* SSQ = (float*)(ws + OFF_SSQ); LAS float* XX = (LAS float*)(lds + 133120 + 64);
            PH_BEGIN
            run_gemm(lds, HB, 1024, (const bf16_t*)(ws + OFF_WMI), 768, 1024, 0, pg8::EpiMlaZ{Z, SSQ});
            PH_END
            PH_BEGIN
            run_gemm(lds, Z, 768, (const bf16_t*)(ws + OFF_WUQ), 2048, 384, 0, pg8::EpiMlaQ{QB, SSQ, p.in[I_MGQN], XX});
            run_gemm(lds, Z + 384, 768, (const bf16_t*)(ws + OFF_WUKV), 2048, 256, 0, pg8::EpiMlaKV{KV, SSQ, Z, p.in[I_MGKN], XX});
            PH_END
            PH_BEGIN
            attn_phase<96, 64, 0>(lds, AttnArgs{QB, KV, KV + 96, HB, 1536, 96, 2560, 160, 2560, 160, 16, 0, 1, nullptr, 0.10206207261596575f * LOG2E});
            PH_END
            PH_BEGIN
            run_gemm(lds, HB, 1024, (const bf16_t*)(ws + OFF_WMO), 1024, 1024, 0, pg8::EpiRes{LAT, XC, ada, 2, p.in[I_X], p.in[I_CTX]});
            PH_END
        } else if (layer == 1) {
            bf16_t* YF = (bf16_t*)(ws + OFF_BIG);
            PH_BEGIN
            s5_scan_phase(lds, p, HB, YF);
            PH_END
            PH_BEGIN
            run_gemm(lds, HB, 1024, (const bf16_t*)(ws + OFF_WGLU), 2048, 1024, 0, pg8::EpiGluRes{LAT, XC, ada, 2});
            PH_END
        } else if (layer == 2) {
            bf16_t* QKV = (bf16_t*)(ws + OFF_BIG);
            PH_BEGIN
            run_gemm(lds, HB, 1024, (const bf16_t*)(ws + OFF_WNQ), 3072, 1024, 0, pg8::EpiStoreHN64{QKV, 3072, p.in[I_NGQN], p.in[I_NGKN], (LAS float*)(lds + 133120 + 64)});
            PH_END
            PH_BEGIN
            attn_phase<64, 64, 1>(lds, AttnArgs{QKV, QKV + 1024, QKV + 2048, HB, 3072, 64, 3072, 64, 3072, 64, 16, 0, 1, p.in[I_NRPB], 0.125f * LOG2E});
            PH_END
            PH_BEGIN
            run_gemm(lds, HB, 1024, (const bf16_t*)(ws + OFF_WNO), 1024, 1024, 0, pg8::EpiRes{LAT, XC, ada, 2, LAT, XC});
            PH_END
        } else {
            bf16_t* QKV = (bf16_t*)(ws + OFF_BIG);
            PH_BEGIN
            run_gemm(lds, HB, 1024, (const bf16_t*)(ws + OFF_WGQ), 1536, 1024, 0, pg8::EpiStoreHN128{QKV, 1536, p.in[I_GGQN], p.in[I_GGKN], (LAS float*)(lds + 133120 + 64)});
            PH_END
            PH_BEGIN
            gqa_attn_phase((char*)shm, QKV, HB);
            PH_END
            PH_BEGIN
            run_gemm(lds, HB, 1024, (const bf16_t*)(ws + OFF_WGO), 1024, 1024, 1, pg8::EpiRes{LAT, XC, ada, 2, LAT, XC});
            PH_END
        }
        bf16_t* ACT = (bf16_t*)(ws + OFF_BIG);
        PH_BEGIN
        norm_phase(LAT, XC, LAT, XC, false, p.in[I_NFFN] + layer * 1024, ada, 3, HB, last);
        PH_END
        PH_BEGIN
        run_gemm(lds, HB, 1024, (const bf16_t*)(ws + OFF_WFI + layer * SZ_WFI), 5632, 1024, last, pg8::EpiSwiglu{ACT, FH});
        PH_END
        PH_BEGIN
        run_gemm(lds, ACT, 2816, (const bf16_t*)(ws + OFF_WFO + layer * SZ_WFO), 1024, 2816, last, pg8::EpiRes{LAT, XC, ada, 5, LAT, XC});
        PH_END
    }
}

extern "C" void kernel_launch(void* const* d_in, const int* in_sizes, int n_in, void* d_out, int out_size, void* d_ws, size_t ws_size, hipStream_t stream) {
    static int grid_blocks = 0;
    if (!grid_blocks) {
        hipFuncSetAttribute((const void*)mega, hipFuncAttributeMaxDynamicSharedMemorySize, LDS_BYTES);
        int dev = 0, cus = 0, per_cu = 0;
        hipGetDevice(&dev);
        hipDeviceGetAttribute(&cus, hipDeviceAttributeMultiprocessorCount, dev);
        hipOccupancyMaxActiveBlocksPerMultiprocessor(&per_cu, mega, 512, LDS_BYTES);
        if (per_cu < 1) per_cu = 1;
        grid_blocks = cus * 1;
    }
    if (ws_size < WS_NEED) fprintf(stderr, "workspace too small: %zu < %zu\n", ws_size, (size_t)WS_NEED);
    Params p; memset(&p, 0, sizeof(p));
    for (int i = 0; i < N_IN; ++i) p.in[i] = (const float*)d_in[i];
    p.out = (float*)d_out; p.ws = (unsigned char*)d_ws; p.ph_lo = 0; p.ph_hi = 1000;
    hipMemsetAsync((unsigned char*)d_ws + OFF_BAR, 0, 16384, stream);
    void* args[] = {&p};
    hipError_t e = hipLaunchCooperativeKernel((const void*)mega, dim3(grid_blocks), dim3(512), args, LDS_BYTES, stream);
    if (e != hipSuccess) fprintf(stderr, "cooperative launch failed: %s (grid %d)\n", hipGetErrorString(e), grid_blocks);
}
```
